# Optimizing an MI355X kernel written in HIP

```python
import jax, jax.numpy as jnp
from jax import lax
import numpy as np

D_MODEL = 1024
BATCH = 16
SEQ = 4096
DEPTH = 2

EPS = 1e-6
MLA_HEADS = 8
MLA_NOPE = 64
MLA_ROPE = 32
MLA_V = 64
MLA_Q_RANK = 256
MLA_KV_RANK = 128
ROPE_BASE = 10000.0
ATTN_BLOCK = 128
CONV_WIDTH = D_MODEL // 2
CONV_K = 3
SG_GROUPS = 4
SG_WIDTH = D_MODEL // 2
SG_GROUP_DIM = SG_WIDTH // SG_GROUPS
SG_CHUNK = 128
GLA_HEADS = 4
GLA_DK = 64
GLA_DV = 128
GLA_GATE_RANK = 16
GLA_GATE_TAU = 16.0
GLA_CHUNK = 64
N_GROUPS = 4
EXPERTS_PER_GROUP = 8
N_EXPERTS = N_GROUPS * EXPERTS_PER_GROUP
TOP_K = 2
D_EXPERT = 256
MOE_BLOCK = 256

AB_SPLITS = (MLA_Q_RANK, MLA_KV_RANK, MLA_ROPE, CONV_WIDTH, CONV_WIDTH, CONV_WIDTH)
AB_IN = sum(AB_SPLITS)
AB_MIX = MLA_HEADS * MLA_V + CONV_WIDTH
CD_SPLITS = (SG_WIDTH, SG_WIDTH, GLA_HEADS * GLA_DK, GLA_HEADS * GLA_DK, GLA_HEADS * GLA_DV, GLA_GATE_RANK, GLA_HEADS * GLA_DV)
CD_IN = sum(CD_SPLITS)
CD_MIX = SG_WIDTH + GLA_HEADS * GLA_DV

kernel_name = "hybrid_mla_conv_gmlp_gla_hmoe"


def rmsnorm(x, g):
    xf = x.astype(jnp.float32)
    y = xf * lax.rsqrt(jnp.mean(xf * xf, axis=-1, keepdims=True) + EPS)
    return (y * g.astype(jnp.float32)).astype(x.dtype)


def split_cols(h, widths):
    return jnp.split(h, [int(v) for v in np.cumsum(widths)[:-1]], axis=-1)


def rope_tables(positions):
    inv = 1.0 / (ROPE_BASE ** (jnp.arange(0, MLA_ROPE, 2, dtype=jnp.float32) / MLA_ROPE))
    ang = positions.astype(jnp.float32)[..., None] * inv
    return jnp.cos(ang), jnp.sin(ang)


def apply_rope(x, cos, sin):
    half = x.shape[-1] // 2
    x1 = x[..., :half].astype(jnp.float32)
    x2 = x[..., half:].astype(jnp.float32)
    return jnp.concatenate([x1 * cos - x2 * sin, x1 * sin + x2 * cos], axis=-1).astype(x.dtype)


def mla_attention(q_lat, kv_lat, k_rope, q_norm_g, w_uq, kv_norm_g, w_ukv, cos, sin):
    B, S, _ = q_lat.shape
    q = (rmsnorm(q_lat, q_norm_g) @ w_uq).reshape(B, S, MLA_HEADS, MLA_NOPE + MLA_ROPE)
    q_pe = apply_rope(q[..., MLA_NOPE:], cos[:, :, None], sin[:, :, None])
    q = jnp.concatenate([q[..., :MLA_NOPE], q_pe], axis=-1)
    kv = (rmsnorm(kv_lat, kv_norm_g) @ w_ukv).reshape(B, S, MLA_HEADS, MLA_NOPE + MLA_V)
    k_pe = apply_rope(k_rope, cos, sin)
    k = jnp.concatenate([kv[..., :MLA_NOPE], jnp.broadcast_to(k_pe[:, :, None, :], (B, S, MLA_HEADS, MLA_ROPE))], axis=-1)
    qh = q.transpose(0, 2, 1, 3)
    kh = k.transpose(0, 2, 1, 3)
    vh = kv[..., MLA_NOPE:].transpose(0, 2, 1, 3)
    scale = (MLA_NOPE + MLA_ROPE) ** -0.5
    neg = jnp.finfo(jnp.float32).min
    outs = []
    for blk in range(S // ATTN_BLOCK):
        q0 = blk * ATTN_BLOCK
        end = q0 + ATTN_BLOCK
        s = jnp.einsum('bhqd,bhkd->bhqk', qh[:, :, q0:end], kh[:, :, :end]).astype(jnp.float32) * scale
        mask = (q0 + jnp.arange(ATTN_BLOCK))[:, None] >= jnp.arange(end)[None, :]
        p = jax.nn.softmax(jnp.where(mask, s, neg), axis=-1).astype(vh.dtype)
        outs.append(jnp.einsum('bhqk,bhkd->bhqd', p, vh[:, :, :end]))
    o = jnp.concatenate(outs, axis=2)
    return o.transpose(0, 2, 1, 3).reshape(B, S, MLA_HEADS * MLA_V)


def short_gated_conv(b_gate, c_gate, xin, conv_w):
    u = c_gate * xin
    y = lax.conv_general_dilated(u, conv_w[:, None, :].astype(u.dtype), window_strides=(1,),
                                 padding=[(CONV_K - 1, 0)], dimension_numbers=('NWC', 'WIO', 'NWC'),
                                 feature_group_count=CONV_WIDTH)
    return b_gate * y


def spatial_gating(u, v, v_norm_g, w_s, b_s):
    B, S, _ = v.shape
    n = S // SG_CHUNK
    vc = rmsnorm(v, v_norm_g).reshape(B, n, SG_CHUNK, SG_GROUPS, SG_GROUP_DIM)
    w = w_s * jnp.tril(jnp.ones((SG_CHUNK, SG_CHUNK), dtype=w_s.dtype))
    mixed = jnp.einsum('gts,bnsgd->bntgd', w, vc) + b_s.T[None, None, :, :, None]
    return u * mixed.reshape(B, S, SG_WIDTH)


def gated_linear_attention(q, k, v, g_low, r, w_g2, b_g, gn_g):
    B, S, _ = q.shape
    n = S // GLA_CHUNK
    f32 = jnp.float32
    log_a = jax.nn.log_sigmoid((g_low @ w_g2 + b_g).astype(f32)) / GLA_GATE_TAU

    def chunk(t, d):
        return t.astype(f32).reshape(B, n, GLA_CHUNK, GLA_HEADS, d).transpose(0, 3, 1, 2, 4)

    qc = chunk(q, GLA_DK) * (GLA_DK ** -0.5)
    kc = chunk(k, GLA_DK)
    vc = chunk(v, GLA_DV)
    bc = jnp.cumsum(chunk(log_a, GLA_DK), axis=3)
    b_last = bc[..., -1:, :]
    q_dec = qc * jnp.exp(bc)
    k_dec = kc * jnp.exp(-bc)
    k_to_end = kc * jnp.exp(b_last - bc)
    causal = jnp.tril(jnp.ones((GLA_CHUNK, GLA_CHUNK), dtype=bool))
    attn = jnp.where(causal, jnp.einsum('bhntd,bhnsd->bhnts', q_dec, k_dec), 0.0)
    o_intra = jnp.einsum('bhnts,bhnse->bhnte', attn, vc)
    chunk_kv = jnp.einsum('bhnsd,bhnse->bhnde', k_to_end, vc)
    decay = jnp.exp(b_last[..., 0, :])

    def step(state, inp):
        kv_n, dec_n = inp
        return state * dec_n[..., None] + kv_n, state

    init = jnp.zeros((B, GLA_HEADS, GLA_DK, GLA_DV), f32)
    _, states = lax.scan(step, init, (jnp.moveaxis(chunk_kv, 2, 0), jnp.moveaxis(decay, 2, 0)))
    states = jnp.moveaxis(states, 0, 2)
    o = o_intra + jnp.einsum('bhntd,bhnde->bhnte', q_dec, states)
    o = o.transpose(0, 2, 3, 1, 4).reshape(B, S, GLA_HEADS, GLA_DV)
    o = rmsnorm(o, gn_g.reshape(GLA_HEADS, GLA_DV)).reshape(B, S, GLA_HEADS * GLA_DV)
    return jax.nn.silu(r) * o.astype(r.dtype)


def hierarchical_moe(h, w_group, b_group, w_expert, b_expert, w_gate_up, w_down):
    B, S, D = h.shape
    N = B * S
    xt = h.reshape(N, D)
    f32 = jnp.float32
    grp_logits = (xt @ w_group).astype(f32) + b_group.astype(f32)
    grp_prob = jax.nn.softmax(grp_logits, axis=-1)
    _, g_sel = lax.top_k(grp_logits, 1)
    p_g = jnp.take_along_axis(grp_prob, g_sel, axis=-1)
    exp_logits = ((xt @ w_expert).astype(f32) + b_expert.astype(f32)).reshape(N, N_GROUPS, EXPERTS_PER_GROUP)
    in_grp = jnp.take_along_axis(exp_logits, g_sel[:, :, None], axis=1)[:, 0]
    top_val, top_loc = lax.top_k(in_grp, TOP_K)
    weights = p_g * jax.nn.softmax(top_val, axis=-1)
    expert_id = g_sel * EXPERTS_PER_GROUP + top_loc

    NK = N * TOP_K
    flat_e = expert_id.reshape(NK)
    flat_tok = jnp.repeat(jnp.arange(N, dtype=jnp.int32), TOP_K)
    flat_w = weights.reshape(NK)
    order = jnp.argsort(flat_e)
    se = flat_e[order]
    counts = jnp.bincount(flat_e, length=N_EXPERTS)
    padded = (counts + MOE_BLOCK - 1) // MOE_BLOCK * MOE_BLOCK
    pad_end = jnp.cumsum(padded)
    pad_start = pad_end - padded
    start = jnp.cumsum(counts) - counts
    dest = pad_start[se] + jnp.arange(NK, dtype=jnp.int32) - start[se]
    n_blocks = (NK + MOE_BLOCK - 1) // MOE_BLOCK + N_EXPERTS
    n_rows = n_blocks * MOE_BLOCK
    row_tok = jnp.full((n_rows,), N, jnp.int32).at[dest].set(flat_tok[order])
    row_w = jnp.zeros((n_rows,), f32).at[dest].set(flat_w[order])
    blk_expert = jnp.minimum(jnp.searchsorted(pad_end, jnp.arange(n_blocks) * MOE_BLOCK, side='right'), N_EXPERTS - 1)
    x_pad = jnp.concatenate([xt, jnp.zeros((1, D), xt.dtype)], axis=0)
    xb = x_pad[row_tok].reshape(n_blocks, MOE_BLOCK, D)

    def expert_block(args):
        xblk, e = args
        gu = xblk @ w_gate_up[e]
        return (jax.nn.silu(gu[:, :D_EXPERT]) * gu[:, D_EXPERT:]) @ w_down[e]

    yb = lax.map(expert_block, (xb, blk_expert)).reshape(n_rows, D)
    y = jax.ops.segment_sum(yb * row_w[:, None].astype(yb.dtype), row_tok, num_segments=N + 1)[:N]
    return y.reshape(B, S, D)


def setup_inputs(seed: int = 0) -> dict:
    key = jax.random.key(seed)
    ks = iter(jax.random.split(key, 32))
    n_even = (DEPTH + 1) // 2
    n_odd = DEPTH // 2
    D = D_MODEL

    def nrm(shape, scale):
        return jax.random.normal(next(ks), shape, jnp.float32) * scale

    def gain(shape):
        return 1.0 + nrm(shape, 0.02)

    x = nrm((BATCH, SEQ, D), 1.0)
    c = nrm((BATCH, D), 1.0)
    offs = jax.random.randint(next(ks), (BATCH, 1), 0, 2048)
    positions = (offs + jnp.arange(SEQ)[None, :]).astype(jnp.int32)
    return {
        "x": x, "c": c, "positions": positions,
        "adaln_w": nrm((DEPTH, D, 6 * D), 0.5 * D ** -0.5),
        "adaln_b": nrm((DEPTH, 6 * D), 0.02),
        "norm_mix_g": gain((DEPTH, D)),
        "norm_ffn_g": gain((DEPTH, D)),
        "ab_w_in": nrm((n_even, D, AB_IN), D ** -0.5),
        "mla_q_norm_g": gain((n_even, MLA_Q_RANK)),
        "mla_w_uq": nrm((n_even, MLA_Q_RANK, MLA_HEADS * (MLA_NOPE + MLA_ROPE)), MLA_Q_RANK ** -0.5),
        "mla_kv_norm_g": gain((n_even, MLA_KV_RANK)),
        "mla_w_ukv": nrm((n_even, MLA_KV_RANK, MLA_HEADS * (MLA_NOPE + MLA_V)), MLA_KV_RANK ** -0.5),
        "conv_w": nrm((n_even, CONV_K, CONV_WIDTH), CONV_K ** -0.5),
        "ab_w_out": nrm((n_even, AB_MIX, D), AB_MIX ** -0.5),
        "cd_w_in": nrm((n_odd, D, CD_IN), D ** -0.5),
        "sg_v_norm_g": gain((n_odd, SG_WIDTH)),
        "sg_w_s": nrm((n_odd, SG_GROUPS, SG_CHUNK, SG_CHUNK), SG_CHUNK ** -0.5),
        "sg_b_s": 1.0 + nrm((n_odd, SG_GROUPS, SG_CHUNK), 0.1),
        "gla_w_g2": nrm((n_odd, GLA_GATE_RANK, GLA_HEADS * GLA_DK), GLA_GATE_RANK ** -0.5),
        "gla_b_g": nrm((n_odd, GLA_HEADS * GLA_DK), 0.02),
        "gla_norm_g": gain((n_odd, GLA_HEADS * GLA_DV)),
        "cd_w_out": nrm((n_odd, CD_MIX, D), CD_MIX ** -0.5),
        "moe_w_group": nrm((DEPTH, D, N_GROUPS), D ** -0.5),
        "moe_b_group": nrm((DEPTH, N_GROUPS), 0.01),
        "moe_w_expert": nrm((DEPTH, D, N_EXPERTS), D ** -0.5),
        "moe_b_expert": nrm((DEPTH, N_EXPERTS), 0.01),
        "moe_w_gate_up": nrm((DEPTH, N_EXPERTS, D, 2 * D_EXPERT), D ** -0.5),
        "moe_w_down": nrm((DEPTH, N_EXPERTS, D_EXPERT, D), D_EXPERT ** -0.5),
        "final_norm_g": gain((D,)),
    }


def reference(x, c, positions, adaln_w, adaln_b, norm_mix_g, norm_ffn_g,
              ab_w_in, mla_q_norm_g, mla_w_uq, mla_kv_norm_g, mla_w_ukv, conv_w, ab_w_out,
              cd_w_in, sg_v_norm_g, sg_w_s, sg_b_s, gla_w_g2, gla_b_g, gla_norm_g, cd_w_out,
              moe_w_group, moe_b_group, moe_w_expert, moe_b_expert, moe_w_gate_up, moe_w_down,
              final_norm_g):
    cos, sin = rope_tables(positions)
    c_act = jax.nn.silu(c)
    for l in range(DEPTH):
        mod = (c_act @ adaln_w[l] + adaln_b[l])[:, None, :]
        sh1, sc1, g1, sh2, sc2, g2 = jnp.split(mod, 6, axis=-1)
        h = rmsnorm(x, norm_mix_g[l]) * (1.0 + sc1) + sh1
        i = l // 2
        if l % 2 == 0:
            q_lat, kv_lat, k_rope, b_gate, c_gate, xin = split_cols(h @ ab_w_in[i], AB_SPLITS)
            a_out = mla_attention(q_lat, kv_lat, k_rope, mla_q_norm_g[i], mla_w_uq[i],
                                  mla_kv_norm_g[i], mla_w_ukv[i], cos, sin)
            b_out = short_gated_conv(b_gate, c_gate, xin, conv_w[i])
            mix = jnp.concatenate([a_out, b_out], axis=-1) @ ab_w_out[i]
        else:
            proj = h @ cd_w_in[i]
            u, v, gq, gk, gv, g_low, gr = split_cols(proj, CD_SPLITS)
            c_out = spatial_gating(jax.nn.gelu(u), jax.nn.gelu(v), sg_v_norm_g[i], sg_w_s[i], sg_b_s[i])
            d_out = gated_linear_attention(gq, gk, gv, g_low, gr, gla_w_g2[i], gla_b_g[i], gla_norm_g[i])
            mix = jnp.concatenate([c_out, d_out], axis=-1) @ cd_w_out[i]
        x = x + g1 * mix
        h = rmsnorm(x, norm_ffn_g[l]) * (1.0 + sc2) + sh2
        x = x + g2 * hierarchical_moe(h, moe_w_group[l], moe_b_group[l], moe_w_expert[l],
                                      moe_b_expert[l], moe_w_gate_up[l], moe_w_down[l])
    return rmsnorm(x, final_norm_g)
```

```cpp
#include <hip/hip_runtime.h>
#include <stdint.h>
#include <math.h>

typedef unsigned short bf16_t;
typedef short bf16x8 __attribute__((ext_vector_type(8)));
typedef float f32x4 __attribute__((ext_vector_type(4)));
typedef unsigned u32x2 __attribute__((ext_vector_type(2)));
typedef unsigned u32x4 __attribute__((ext_vector_type(4)));
#define DI __device__ __forceinline__

constexpr int D = 1024, NB = 16, SEQ = 4096, NTOK = NB * SEQ;
constexpr float EPS = 1e-6f;
constexpr int AB_IN = 1952, CD_IN = 2576;
constexpr int LD0 = 2048, LD1 = 2816;
constexpr int NEXP = 32, DEXP = 256;
constexpr int MAXSLOT = 2 * NTOK + 64 * 256;
constexpr float QSCALE = 0.10206207261596577f * 1.4426950408889634f;

DI float bf2f(bf16_t v) { return __uint_as_float(((unsigned)v) << 16); }
DI bf16_t f2bf(float f) { unsigned u = __float_as_uint(f); return (bf16_t)((u + 0x7fffu + ((u >> 16) & 1u)) >> 16); }
DI unsigned pk2(float lo, float hi) { return (unsigned)f2bf(lo) | ((unsigned)f2bf(hi) << 16); }
DI float wave_sum(float v) {
#pragma unroll
    for (int o = 32; o >= 1; o >>= 1) v += __shfl_xor(v, o);
    return v;
}
DI float silu_f(float v) { return v / (1.f + __expf(-v)); }
DI float gelu_tanh_f(float v) { const float u = 0.7978845608028654f * (v + 0.044715f * v * v * v); return 0.5f * v * (1.f + tanhf(u)); }
DI float log_sigmoid_f(float z) { return fminf(z, 0.f) - log1pf(__expf(-fabsf(z))); }

struct P {
    const float *x, *c; const int* pos;
    const float *adaln_w, *adaln_b, *norm_mix_g, *norm_ffn_g, *ab_w_in, *q_norm_g, *w_uq, *kv_norm_g, *w_ukv, *conv_w, *ab_w_out,
        *cd_w_in, *sg_v_norm_g, *sg_w_s, *sg_b_s, *gla_w_g2, *gla_b_g, *gla_norm_g, *cd_w_out,
        *moe_w_group, *moe_b_group, *moe_w_expert, *moe_b_expert, *moe_w_gate_up, *moe_w_down, *final_norm_g;
    float* out;
    bf16_t *wt_in0, *wt_uq, *wt_ukv, *wt_out0, *wt_in1, *wt_out1, *wt_gu, *wt_dn, *wt_r;
    float *mod, *ropec, *ropes;
    bf16_t *xa, *proj, *q, *kn, *v, *kpe, *mix, *act, *y;
    float *rq, *rkv, *rv, *loga, *go, *logits, *topw;
    int *tope, *toppos, *topslot, *cnt, *segstart, *ntile, *tile_e, *row_tok;
};

enum { J_IN0 = 0, J_UQ, J_UKV, J_OUT0, J_IN1, J_OUT1, J_GU, J_DN, J_R, J_NUM };
DI float wval(const P& p, int job, int sub, int k, int n) {
    switch (job) {
    case J_IN0: {
        if (n >= AB_IN) return 0.f;
        int src = n;
        if (n >= 384 && n < 416) { const int i = n - 384; src = 384 + (i >> 1) + (i & 1) * 16; }
        return p.ab_w_in[(size_t)k * AB_IN + src];
    }
    case J_UQ: {
        const int h = n / 96, j = n % 96; int src = 96 * h + j;
        if (j >= 64) { const int i = j - 64; src = 96 * h + 64 + (i >> 1) + (i & 1) * 16; }
        return p.w_uq[(size_t)k * 768 + src] * p.q_norm_g[k];
    }
    case J_UKV: {
        int src;
        if (n < 512) { src = 128 * (n >> 6) + (n & 63); } else { const int m = n - 512; src = 128 * (m >> 6) + 64 + (m & 63); }
        return p.w_ukv[(size_t)k * 1024 + src] * p.kv_norm_g[k];
    }
    case J_OUT0: return p.ab_w_out[(size_t)k * 1024 + n];
    case J_IN1: {
        if (n < 2048) return p.cd_w_in[(size_t)k * CD_IN + n];
        if (n < 2304) { const int j = n - 2048; float s = 0.f;
#pragma unroll
            for (int r = 0; r < 16; ++r) s += p.cd_w_in[(size_t)k * CD_IN + 2048 + r] * p.gla_w_g2[r * 256 + j];
            return s; }
        return p.cd_w_in[(size_t)k * CD_IN + 2064 + (n - 2304)];
    }
    case J_OUT1: return p.cd_w_out[(size_t)k * 1024 + n];
    case J_GU: { const int j = n >> 1; const int src = (n & 1) ? 256 + j : j; return p.moe_w_gate_up[((size_t)sub * 1024 + k) * 512 + src]; }
    case J_DN: return p.moe_w_down[((size_t)sub * 256 + k) * 1024 + n];
    case J_R: { if (n < 4) return p.moe_w_group[((size_t)sub * 1024 + k) * 4 + n]; if (n < 36) return p.moe_w_expert[((size_t)sub * 1024 + k) * 32 + (n - 4)]; return 0.f; }
    }
    return 0.f;
}
struct JobInfo { int K, N, nsub; };
DI JobInfo job_info(int job) {
    switch (job) {
    case J_IN0: return {1024, LD0, 1};
    case J_UQ: return {256, 768, 1};
    case J_UKV: return {128, 1024, 1};
    case J_OUT0: return {1024, 1024, 1};
    case J_IN1: return {1024, LD1, 1};
    case J_OUT1: return {1024, 1024, 1};
    case J_GU: return {1024, 512, 64};
    case J_DN: return {256, 1024, 64};
    default: return {1024, 64, 2};
    }
}
DI bf16_t* job_dst(const P& p, int job) {
    switch (job) {
    case J_IN0: return p.wt_in0; case J_UQ: return p.wt_uq; case J_UKV: return p.wt_ukv; case J_OUT0: return p.wt_out0;
    case J_IN1: return p.wt_in1; case J_OUT1: return p.wt_out1; case J_GU: return p.wt_gu; case J_DN: return p.wt_dn; default: return p.wt_r;
    }
}

__global__ void __launch_bounds__(256) k_prep_weights(P p) {
    __shared__ float tl[64 * 65];
    int total = 0;
#pragma unroll
    for (int j = 0; j < J_NUM; ++j) { const JobInfo ji = job_info(j); total += (ji.K / 64) * (ji.N / 64) * ji.nsub; }
    for (int tile = blockIdx.x; tile < total; tile += gridDim.x) {
        int job = 0, jstart = 0, accn = 0;
#pragma unroll
        for (int j = 0; j < J_NUM; ++j) { const JobInfo jj = job_info(j); if (tile >= accn) { job = j; jstart = accn; } accn += (jj.K / 64) * (jj.N / 64) * jj.nsub; }
        const JobInfo ji = job_info(job);
        int r = tile - jstart;
        const int kt = ji.K / 64, nt = ji.N / 64;
        const int sub = r / (kt * nt); r -= sub * kt * nt;
        const int n0 = (r / kt) * 64, k0 = (r % kt) * 64;
        for (int i = threadIdx.x; i < 4096; i += 256) { const int kk = i >> 6, nn = i & 63; tl[kk * 65 + nn] = wval(p, job, sub, k0 + kk, n0 + nn); }
        __syncthreads();
        bf16_t* dst = job_dst(p, job) + (size_t)sub * ji.K * ji.N;
        for (int i = threadIdx.x; i < 4096; i += 256) { const int nn = i >> 6, kk = i & 63; dst[(size_t)(n0 + nn) * ji.K + k0 + kk] = f2bf(tl[kk * 65 + nn]); }
        __syncthreads();
    }
}

__global__ void __launch_bounds__(256) k_prep_mod(P p) {
    extern __shared__ float sm[];
    float* cact = sm;
    float* red = sm + 16 * 1024;
    for (int i = threadIdx.x; i < 16 * 1024; i += 256) cact[i] = silu_f(p.c[i]);
    __syncthreads();
    const int col = threadIdx.x & 63, ks = threadIdx.x >> 6;
    for (int item = blockIdx.x; item < 2 * 96; item += gridDim.x) {
        const int l = item / 96, j = (item % 96) * 64 + col;
        float acc[16];
#pragma unroll
        for (int b = 0; b < 16; ++b) acc[b] = 0.f;
        const float* W = p.adaln_w + (size_t)l * 1024 * 6144 + j;
        for (int k = ks * 256; k < ks * 256 + 256; ++k) {
            const float w = W[(size_t)k * 6144];
#pragma unroll
            for (int b = 0; b < 16; ++b) acc[b] += cact[b * 1024 + k] * w;
        }
#pragma unroll
        for (int b = 0; b < 16; ++b) red[(ks * 16 + b) * 64 + col] = acc[b];
        __syncthreads();
        for (int i = threadIdx.x; i < 1024; i += 256) {
            const int b = i >> 6, cc = i & 63;
            const float s = red[(0 * 16 + b) * 64 + cc] + red[(1 * 16 + b) * 64 + cc] + red[(2 * 16 + b) * 64 + cc] + red[(3 * 16 + b) * 64 + cc];
            const int jj = (item % 96) * 64 + cc;
            p.mod[((size_t)l * 16 + b) * 6144 + jj] = s + p.adaln_b[l * 6144 + jj];
        }
        __syncthreads();
    }
}

__global__ void __launch_bounds__(256) k_prep_rope(P p) {
    const int gid = blockIdx.x * 256 + threadIdx.x;
    if (gid >= NTOK * 16) return;
    const int tok = gid >> 4, i = gid & 15;
    const double inv = pow(10000.0, -(double)i / 16.0);
    const double ang = (double)p.pos[tok] * inv;
    p.ropec[gid] = (float)cos(ang); p.ropes[gid] = (float)sin(ang);
}

__global__ void __launch_bounds__(256) k_norm(P p, const float* xin, const float* g, int l, int which  ) {
    const int lane = threadIdx.x & 63;
    const int row = blockIdx.x * 4 + (threadIdx.x >> 6);
    if (row >= NTOK) return;
    const int b = row >> 12;
    const float* md = p.mod + ((size_t)l * 16 + b) * 6144 + which * 3072;
    const float* xr = xin + (size_t)row * D;
    f32x4 v[4]; float ss = 0.f;
#pragma unroll
    for (int i = 0; i < 4; ++i) { v[i] = *(const f32x4*)(xr + i * 256 + lane * 4); ss += v[i][0] * v[i][0] + v[i][1] * v[i][1] + v[i][2] * v[i][2] + v[i][3] * v[i][3]; }
    ss = wave_sum(ss);
    const float r = rsqrtf(ss * (1.f / D) + EPS);
#pragma unroll
    for (int i = 0; i < 4; ++i) {
        const int c0 = i * 256 + lane * 4;
        const f32x4 gg = *(const f32x4*)(g + c0), sh = *(const f32x4*)(md + c0), sc = *(const f32x4*)(md + 1024 + c0);
        float o[4];
#pragma unroll
        for (int e = 0; e < 4; ++e) o[e] = v[i][e] * r * gg[e] * (1.f + sc[e]) + sh[e];
        u32x2 w; w.x = pk2(o[0], o[1]); w.y = pk2(o[2], o[3]);
        *(u32x2*)(p.xa + (size_t)row * D + c0) = w;
    }
}

template <class Cfg>
__global__ void __launch_bounds__(256) k_gemm(P p, int l) {
    Cfg cfg(p, l);
    const int lane = threadIdx.x & 63, wid = threadIdx.x >> 6;
    const int fr = lane & 15, fq = lane >> 4;
    const int mt_n = cfg.mtiles(), nt_n = cfg.N / 64, K = cfg.K;
    const long total = (long)mt_n * nt_n;
    for (long item = (long)blockIdx.x * 4 + wid; item < total; item += (long)gridDim.x * 4) {
        const int mt = (int)(item / nt_n), nt = (int)(item % nt_n);
        const int m0 = mt * 32, n0 = nt * 64;
        const bf16_t* ap[2]; const bf16_t* bp[4];
#pragma unroll
        for (int i = 0; i < 2; ++i) ap[i] = cfg.a_row(m0 + 16 * i + fr) + fq * 8;
#pragma unroll
        for (int j = 0; j < 4; ++j) bp[j] = cfg.b_row(n0 + 16 * j + fr, m0) + fq * 8;
        f32x4 acc[2][4];
#pragma unroll
        for (int i = 0; i < 2; ++i)
#pragma unroll
            for (int j = 0; j < 4; ++j) acc[i][j] = (f32x4){0.f, 0.f, 0.f, 0.f};
        for (int k = 0; k < K; k += 32) {
            bf16x8 a[2], b[4];
#pragma unroll
            for (int i = 0; i < 2; ++i) a[i] = *(const bf16x8*)(ap[i] + k);
#pragma unroll
            for (int j = 0; j < 4; ++j) b[j] = *(const bf16x8*)(bp[j] + k);
#pragma unroll
            for (int i = 0; i < 2; ++i)
#pragma unroll
                for (int j = 0; j < 4; ++j) acc[i][j] = __builtin_amdgcn_mfma_f32_16x16x32_bf16(b[j], a[i], acc[i][j], 0, 0, 0);
        }
#pragma unroll
        for (int i = 0; i < 2; ++i)
#pragma unroll
            for (int j = 0; j < 4; ++j) cfg.epi(m0 + 16 * i + fr, n0 + 16 * j + 4 * fq, acc[i][j]);
    }
}

DI void store_bf4(bf16_t* dst, const f32x4& v) { u32x2 w; w.x = pk2(v[0], v[1]); w.y = pk2(v[2], v[3]); *(u32x2*)dst = w; }

struct CfgIn0 {
    const P& p; int K, N;
    DI CfgIn0(const P& p_, int) : p(p_), K(1024), N(LD0) {}
    DI int mtiles() const { return NTOK / 32; }
    DI const bf16_t* a_row(int r) const { return p.xa + (size_t)r * D; }
    DI const bf16_t* b_row(int n, int) const { return p.wt_in0 + (size_t)n * 1024; }
    DI void epi(int row, int col, const f32x4& v) const {
        if (col >= 384 && col < 416) {
            const int i0 = (col - 384) >> 1;
            const float c0 = p.ropec[row * 16 + i0], s0 = p.ropes[row * 16 + i0], c1 = p.ropec[row * 16 + i0 + 1], s1 = p.ropes[row * 16 + i0 + 1];
            f32x4 o; o[0] = v[0] * c0 - v[1] * s0; o[1] = v[0] * s0 + v[1] * c0; o[2] = v[2] * c1 - v[3] * s1; o[3] = v[2] * s1 + v[3] * c1;
            store_bf4(p.kpe + (size_t)row * 32 + (col - 384), o);
        } else if (col < AB_IN) store_bf4(p.proj + (size_t)row * LD0 + col, v);
    }
};
struct CfgUq {
    const P& p; int K, N;
    DI CfgUq(const P& p_, int) : p(p_), K(256), N(768) {}
    DI int mtiles() const { return NTOK / 32; }
    DI const bf16_t* a_row(int r) const { return p.proj + (size_t)r * LD0; }
    DI const bf16_t* b_row(int n, int) const { return p.wt_uq + (size_t)n * 256; }
    DI void epi(int row, int col, const f32x4& vin) const {
        const float r = p.rq[row] * QSCALE; f32x4 v = vin * r;
        const int j = col % 96;
        if (j >= 64) {
            const int i0 = (j - 64) >> 1;
            const float c0 = p.ropec[row * 16 + i0], s0 = p.ropes[row * 16 + i0], c1 = p.ropec[row * 16 + i0 + 1], s1 = p.ropes[row * 16 + i0 + 1];
            f32x4 o; o[0] = v[0] * c0 - v[1] * s0; o[1] = v[0] * s0 + v[1] * c0; o[2] = v[2] * c1 - v[3] * s1; o[3] = v[2] * s1 + v[3] * c1; v = o;
        }
        store_bf4(p.q + (size_t)row * 768 + col, v);
    }
};
struct CfgUkv {
    const P& p; int K, N;
    DI CfgUkv(const P& p_, int) : p(p_), K(128), N(1024) {}
    DI int mtiles() const { return NTOK / 32; }
    DI const bf16_t* a_row(int r) const { return p.proj + (size_t)r * LD0 + 256; }
    DI const bf16_t* b_row(int n, int) const { return p.wt_ukv + (size_t)n * 128; }
    DI void epi(int row, int col, const f32x4& vin) const {
        const f32x4 v = vin * p.rkv[row];
        if (col < 512) store_bf4(p.kn + (size_t)row * 512 + col, v); else store_bf4(p.v + (size_t)row * 512 + (col - 512), v);
    }
};
struct CfgOut {
    const P& p; int K, N; int l; const float* xin; const bf16_t* w;
    DI CfgOut(const P& p_, int l_) : p(p_), K(1024), N(1024), l(l_), xin(l_ == 0 ? p_.x : p_.out), w(l_ == 0 ? p_.wt_out0 : p_.wt_out1) {}
    DI int mtiles() const { return NTOK / 32; }
    DI const bf16_t* a_row(int r) const { return p.mix + (size_t)r * D; }
    DI const bf16_t* b_row(int n, int) const { return w + (size_t)n * 1024; }
    DI void epi(int row, int col, const f32x4& v) const {
        const int b = row >> 12;
        const f32x4 g = *(const f32x4*)(p.mod + ((size_t)l * 16 + b) * 6144 + 2048 + col);
        const f32x4 xi = *(const f32x4*)(xin + (size_t)row * D + col);
        *(f32x4*)(p.out + (size_t)row * D + col) = xi + g * v;
    }
};
struct CfgIn1 {
    const P& p; int K, N;
    DI CfgIn1(const P& p_, int) : p(p_), K(1024), N(LD1) {}
    DI int mtiles() const { return NTOK / 32; }
    DI const bf16_t* a_row(int r) const { return p.xa + (size_t)r * D; }
    DI const bf16_t* b_row(int n, int) const { return p.wt_in1 + (size_t)n * 1024; }
    DI void epi(int row, int col, const f32x4& vin) const {
        f32x4 v = vin;
        if (col < 1024) {
#pragma unroll
            for (int e = 0; e < 4; ++e) v[e] = gelu_tanh_f(v[e]);
        } else if (col >= 2048 && col < 2304) {
            f32x4 o;
#pragma unroll
            for (int e = 0; e < 4; ++e) o[e] = log_sigmoid_f(v[e] + p.gla_b_g[col - 2048 + e]) * (1.f / 16.f);
            *(f32x4*)(p.loga + (size_t)row * 256 + (col - 2048)) = o;
            return;
        }
        store_bf4(p.proj + (size_t)row * LD1 + col, v);
    }
};
struct CfgR {
    const P& p; int K, N; int l;
    DI CfgR(const P& p_, int l_) : p(p_), K(1024), N(64), l(l_) {}
    DI int mtiles() const { return NTOK / 32; }
    DI const bf16_t* a_row(int r) const { return p.xa + (size_t)r * D; }
    DI const bf16_t* b_row(int n, int) const { return p.wt_r + ((size_t)l * 64 + n) * 1024; }
    DI void epi(int row, int col, const f32x4& v) const { *(f32x4*)(p.logits + (size_t)row * 64 + col) = v; }
};
struct CfgGu {
    const P& p; int K, N; int l; const int* rt; const int* te; int nt;
    DI CfgGu(const P& p_, int l_) : p(p_), K(1024), N(512), l(l_), rt(p_.row_tok + (size_t)l_ * MAXSLOT), te(p_.tile_e + l_ * 1024), nt(p_.ntile[l_]) {}
    DI int mtiles() const { return nt * 8; }
    DI const bf16_t* a_row(int r) const { return p.xa + (size_t)rt[r] * D; }
    DI const bf16_t* b_row(int n, int m0) const { return p.wt_gu + ((size_t)(l * 32 + te[m0 >> 8]) * 512 + n) * 1024; }
    DI void epi(int row, int col, const f32x4& v) const {
        const float a0 = silu_f(v[0]) * v[1], a1 = silu_f(v[2]) * v[3];
        *(unsigned*)(p.act + (size_t)row * DEXP + (col >> 1)) = pk2(a0, a1);
    }
};
struct CfgDn {
    const P& p; int K, N; int l; const int* te; int nt;
    DI CfgDn(const P& p_, int l_) : p(p_), K(256), N(1024), l(l_), te(p_.tile_e + l_ * 1024), nt(p_.ntile[l_]) {}
    DI int mtiles() const { return nt * 8; }
    DI const bf16_t* a_row(int r) const { return p.act + (size_t)r * DEXP; }
    DI const bf16_t* b_row(int n, int m0) const { return p.wt_dn + ((size_t)(l * 32 + te[m0 >> 8]) * 1024 + n) * 256; }
    DI void epi(int row, int col, const f32x4& v) const { store_bf4(p.y + (size_t)row * D + col, v); }
};

__global__ void __launch_bounds__(256) k_rowstat0(P p) {
    const int lane = threadIdx.x & 63; const int row = blockIdx.x * 4 + (threadIdx.x >> 6);
    const bf16_t* r = p.proj + (size_t)row * LD0;
    float sq = 0.f, sk = 0.f;
#pragma unroll
    for (int i = 0; i < 4; ++i) { const float v = bf2f(r[i * 64 + lane]); sq += v * v; }
#pragma unroll
    for (int i = 0; i < 2; ++i) { const float v = bf2f(r[256 + i * 64 + lane]); sk += v * v; }
    sq = wave_sum(sq); sk = wave_sum(sk);
    if (lane == 0) { p.rq[row] = rsqrtf(sq * (1.f / 256.f) + EPS); p.rkv[row] = rsqrtf(sk * (1.f / 128.f) + EPS); }
}
__global__ void __launch_bounds__(256) k_rowstat1(P p) {
    const int lane = threadIdx.x & 63; const int row = blockIdx.x * 4 + (threadIdx.x >> 6);
    const bf16_t* r = p.proj + (size_t)row * LD1 + 512;
    float s = 0.f;
#pragma unroll
    for (int i = 0; i < 8; ++i) { const float v = bf2f(r[i * 64 + lane]); s += v * v; }
    s = wave_sum(s);
    if (lane == 0) p.rv[row] = rsqrtf(s * (1.f / 512.f) + EPS);
}

__global__ void __launch_bounds__(256) k_attn_naive(P p) {
    const int gid = blockIdx.x * 256 + threadIdx.x;
    const int t = gid & 4095, h = (gid >> 12) & 7, b = gid >> 15;
    const size_t row = (size_t)b * SEQ + t;
    float q[96], o[64];
#pragma unroll
    for (int j = 0; j < 96; ++j) q[j] = bf2f(p.q[row * 768 + h * 96 + j]);
#pragma unroll
    for (int j = 0; j < 64; ++j) o[j] = 0.f;
    float m = -INFINITY, lsum = 0.f;
    const int tmax = t | 63;
    for (int s = 0; s <= tmax; ++s) {
        const size_t rs = (size_t)b * SEQ + s;
        const bf16x8* kp = (const bf16x8*)(p.kn + rs * 512 + h * 64);
        const bf16x8* pp = (const bf16x8*)(p.kpe + rs * 32);
        float d = 0.f;
#pragma unroll
        for (int c = 0; c < 8; ++c) { const bf16x8 kv = kp[c];
#pragma unroll
            for (int e = 0; e < 8; ++e) d += q[c * 8 + e] * bf2f((bf16_t)kv[e]); }
#pragma unroll
        for (int c = 0; c < 4; ++c) { const bf16x8 kv = pp[c];
#pragma unroll
            for (int e = 0; e < 8; ++e) d += q[64 + c * 8 + e] * bf2f((bf16_t)kv[e]); }
        if (s <= t) {
            const float mn = fmaxf(m, d), sc = exp2f(m - mn), pj = exp2f(d - mn);
            lsum = lsum * sc + pj; m = mn;
            const bf16x8* vp = (const bf16x8*)(p.v + rs * 512 + h * 64);
#pragma unroll
            for (int c = 0; c < 8; ++c) { const bf16x8 vv = vp[c];
#pragma unroll
                for (int e = 0; e < 8; ++e) o[c * 8 + e] = o[c * 8 + e] * sc + pj * bf2f((bf16_t)vv[e]); }
        }
    }
    const float inv = 1.f / lsum;
    bf16_t* dst = p.mix + row * D + h * 64;
#pragma unroll
    for (int j = 0; j < 64; j += 2) *(unsigned*)(dst + j) = pk2(o[j] * inv, o[j + 1] * inv);
}

__global__ void __launch_bounds__(256) k_conv(P p) {
    const int gid = blockIdx.x * 256 + threadIdx.x;
    const int ch = gid & 511, row = gid >> 9, t = row & 4095;
    const bf16_t* pr = p.proj + (size_t)row * LD0;
    float y = 0.f;
#pragma unroll
    for (int k = 0; k < 3; ++k) {
        const int dt = k - 2;
        if (t + dt >= 0) { const bf16_t* q = pr + (long)dt * LD0; y += p.conv_w[k * 512 + ch] * (bf2f(q[928 + ch]) * bf2f(q[1440 + ch])); }
    }
    p.mix[(size_t)row * D + 512 + ch] = f2bf(bf2f(pr[416 + ch]) * y);
}

__global__ void __launch_bounds__(256) k_gmlp_naive(P p) {
    const int gid = blockIdx.x * 256 + threadIdx.x;
    const int ch = gid & 511, row = gid >> 9, tt = row & 127, base = row - tt, g = ch >> 7;
    const float* w = p.sg_w_s + ((size_t)g * 128 + tt) * 128;
    float acc = 0.f;
    for (int s = 0; s <= tt; ++s) acc += w[s] * (bf2f(p.proj[(size_t)(base + s) * LD1 + 512 + ch]) * p.rv[base + s]);
    const float mixed = acc * p.sg_v_norm_g[ch] + p.sg_b_s[g * 128 + tt];
    p.mix[(size_t)row * D + ch] = f2bf(bf2f(p.proj[(size_t)row * LD1 + ch]) * mixed);
}

__global__ void __launch_bounds__(128) k_gla_naive(P p) {
    const int gid = blockIdx.x * 128 + threadIdx.x;
    const int dv = gid & 127, h = (gid >> 7) & 3, b = gid >> 9;
    float S[64];
#pragma unroll
    for (int j = 0; j < 64; ++j) S[j] = 0.f;
    for (int t = 0; t < SEQ; ++t) {
        const size_t row = (size_t)b * SEQ + t;
        const bf16_t* pr = p.proj + row * LD1;
        const float vv = bf2f(pr[1536 + h * 128 + dv]);
        const bf16x8* qp = (const bf16x8*)(pr + 1024 + h * 64);
        const bf16x8* kp = (const bf16x8*)(pr + 1280 + h * 64);
        const f32x4* ap = (const f32x4*)(p.loga + row * 256 + h * 64);
        float o = 0.f;
#pragma unroll
        for (int c = 0; c < 8; ++c) {
            const bf16x8 qv = qp[c], kv = kp[c]; const f32x4 a0 = ap[2 * c], a1 = ap[2 * c + 1];
#pragma unroll
            for (int e = 0; e < 8; ++e) {
                const float a = __expf(e < 4 ? a0[e] : a1[e - 4]);
                const int j = c * 8 + e;
                S[j] = a * S[j] + bf2f((bf16_t)kv[e]) * vv;
                o += bf2f((bf16_t)qv[e]) * S[j];
            }
        }
        p.go[row * 512 + h * 128 + dv] = o * 0.125f;
    }
}
__global__ void __launch_bounds__(256) k_gla_post(P p) {
    const int lane = threadIdx.x & 63; const int row = blockIdx.x * 4 + (threadIdx.x >> 6);
#pragma unroll
    for (int h = 0; h < 4; ++h) {
        const float o0 = p.go[(size_t)row * 512 + h * 128 + lane], o1 = p.go[(size_t)row * 512 + h * 128 + 64 + lane];
        const float ss = wave_sum(o0 * o0 + o1 * o1);
        const float r = rsqrtf(ss * (1.f / 128.f) + EPS);
#pragma unroll
        for (int i = 0; i < 2; ++i) {
            const int c = h * 128 + i * 64 + lane;
            const float gr = bf2f(p.proj[(size_t)row * LD1 + 2304 + c]);
            p.mix[(size_t)row * D + 512 + c] = f2bf(silu_f(gr) * ((i ? o1 : o0) * r * p.gla_norm_g[c]));
        }
    }
}

__global__ void __launch_bounds__(256) k_route(P p, int l) {
    const int tok = blockIdx.x * 256 + threadIdx.x;
    const float* lg = p.logits + (size_t)tok * 64;
    float gl[4]; int gs = 0;
#pragma unroll
    for (int j = 0; j < 4; ++j) gl[j] = lg[j] + p.moe_b_group[l * 4 + j];
    float gmax = gl[0];
#pragma unroll
    for (int j = 1; j < 4; ++j) if (gl[j] > gmax) { gmax = gl[j]; gs = j; }
    float den = 0.f;
#pragma unroll
    for (int j = 0; j < 4; ++j) den += __expf(gl[j] - gmax);
    const float pg = 1.f / den;
    float el[8];
#pragma unroll
    for (int j = 0; j < 8; ++j) el[j] = lg[4 + gs * 8 + j] + p.moe_b_expert[l * 32 + gs * 8 + j];
    int i1 = 0; float v1 = el[0];
#pragma unroll
    for (int j = 1; j < 8; ++j) if (el[j] > v1) { v1 = el[j]; i1 = j; }
    int i2 = -1; float v2 = -INFINITY;
#pragma unroll
    for (int j = 0; j < 8; ++j) if (j != i1 && el[j] > v2) { v2 = el[j]; i2 = j; }
    const float e2 = __expf(v2 - v1);
    const float w1 = pg / (1.f + e2), w2 = pg * e2 / (1.f + e2);
    const int ea = gs * 8 + i1, eb = gs * 8 + i2;
    int* cnt = p.cnt + l * 64;
    const int pa = atomicAdd(&cnt[ea], 1), pb = atomicAdd(&cnt[32 + eb], 1);
    const size_t o = (size_t)l * 2 * NTOK;
    p.tope[o + tok] = ea; p.tope[o + NTOK + tok] = eb;
    p.toppos[o + tok] = pa; p.toppos[o + NTOK + tok] = pb;
    p.topw[o + tok] = w1; p.topw[o + NTOK + tok] = w2;
}
__global__ void k_offsets(P p, int l) {
    if (threadIdx.x != 0 || blockIdx.x != 0) return;
    int start = 0, tile = 0;
    for (int seg = 0; seg < 64; ++seg) {
        const int c = p.cnt[l * 64 + seg], nt = (c + 255) >> 8;
        p.segstart[l * 64 + seg] = start;
        for (int i = 0; i < nt; ++i) p.tile_e[l * 1024 + tile + i] = seg & 31;
        tile += nt; start += nt * 256;
    }
    p.ntile[l] = tile;
}
__global__ void __launch_bounds__(256) k_slots(P p, int l) {
    const int gid = blockIdx.x * 256 + threadIdx.x;
    const int k = gid >> 16, tok = gid & (NTOK - 1);
    const size_t o = (size_t)l * 2 * NTOK + gid;
    const int slot = p.segstart[l * 64 + k * 32 + p.tope[o]] + p.toppos[o];
    p.topslot[o] = slot;
    p.row_tok[(size_t)l * MAXSLOT + slot] = tok;
}
__global__ void __launch_bounds__(256) k_combine(P p, int l, int last) {
    const int lane = threadIdx.x & 63; const int row = blockIdx.x * 4 + (threadIdx.x >> 6);
    const int b = row >> 12;
    const size_t o = (size_t)l * 2 * NTOK;
    const int s0 = p.topslot[o + row], s1 = p.topslot[o + NTOK + row];
    const float w0 = p.topw[o + row], w1 = p.topw[o + NTOK + row];
    const float* g2 = p.mod + ((size_t)l * 16 + b) * 6144 + 5 * 1024;
    float* xr = p.out + (size_t)row * D;
    f32x4 v[4]; float ss = 0.f;
#pragma unroll
    for (int i = 0; i < 4; ++i) {
        const int c0 = i * 256 + lane * 4;
        const u32x2 ya = *(const u32x2*)(p.y + (size_t)s0 * D + c0), yb = *(const u32x2*)(p.y + (size_t)s1 * D + c0);
        const f32x4 gg = *(const f32x4*)(g2 + c0); const f32x4 xv = *(const f32x4*)(xr + c0);
        float ye[4];
        ye[0] = w0 * __uint_as_float(ya.x << 16) + w1 * __uint_as_float(yb.x << 16);
        ye[1] = w0 * __uint_as_float(ya.x & 0xffff0000u) + w1 * __uint_as_float(yb.x & 0xffff0000u);
        ye[2] = w0 * __uint_as_float(ya.y << 16) + w1 * __uint_as_float(yb.y << 16);
        ye[3] = w0 * __uint_as_float(ya.y & 0xffff0000u) + w1 * __uint_as_float(yb.y & 0xffff0000u);
#pragma unroll
        for (int e = 0; e < 4; ++e) { v[i][e] = xv[e] + gg[e] * ye[e]; ss += v[i][e] * v[i][e]; }
    }
    ss = wave_sum(ss);
    const float r = rsqrtf(ss * (1.f / D) + EPS);
    if (last) {
#pragma unroll
        for (int i = 0; i < 4; ++i) { const int c0 = i * 256 + lane * 4; const f32x4 gg = *(const f32x4*)(p.final_norm_g + c0); *(f32x4*)(xr + c0) = v[i] * r * gg; }
    } else {
        const float* md = p.mod + ((size_t)(l + 1) * 16 + b) * 6144;
        const float* g = p.norm_mix_g + (l + 1) * D;
#pragma unroll
        for (int i = 0; i < 4; ++i) {
            const int c0 = i * 256 + lane * 4;
            *(f32x4*)(xr + c0) = v[i];
            const f32x4 gg = *(const f32x4*)(g + c0), sh = *(const f32x4*)(md + c0), sc = *(const f32x4*)(md + 1024 + c0);
            float oo[4];
#pragma unroll
            for (int e = 0; e < 4; ++e) oo[e] = v[i][e] * r * gg[e] * (1.f + sc[e]) + sh[e];
            u32x2 w; w.x = pk2(oo[0], oo[1]); w.y = pk2(oo[2], oo[3]);
            *(u32x2*)(p.xa + (size_t)row * D + c0) = w;
        }
    }
}

static size_t carve(size_t& off, size_t bytes) { const size_t o = off; off += (bytes + 255) & ~(size_t)255; return o; }

extern "C" void kernel_launch(void* const* d_in, const int* in_sizes, int n_in, void* d_out, int out_size, void* d_ws, size_t ws_size, hipStream_t stream) {
    (void)in_sizes; (void)n_in; (void)out_size;
    P p{};
    const float* const* fi = (const float* const*)d_in;
    p.x = fi[0]; p.c = fi[1]; p.pos = (const int*)d_in[2];
    p.adaln_w = fi[3]; p.adaln_b = fi[4]; p.norm_mix_g = fi[5]; p.norm_ffn_g = fi[6]; p.ab_w_in = fi[7]; p.q_norm_g = fi[8]; p.w_uq = fi[9];
    p.kv_norm_g = fi[10]; p.w_ukv = fi[11]; p.conv_w = fi[12]; p.ab_w_out = fi[13]; p.cd_w_in = fi[14]; p.sg_v_norm_g = fi[15]; p.sg_w_s = fi[16];
    p.sg_b_s = fi[17]; p.gla_w_g2 = fi[18]; p.gla_b_g = fi[19]; p.gla_norm_g = fi[20]; p.cd_w_out = fi[21]; p.moe_w_group = fi[22]; p.moe_b_group = fi[23];
    p.moe_w_expert = fi[24]; p.moe_b_expert = fi[25]; p.moe_w_gate_up = fi[26]; p.moe_w_down = fi[27]; p.final_norm_g = fi[28];
    p.out = (float*)d_out;
    char* ws = (char*)d_ws; size_t off = 0;
    const size_t ctl0 = off;
    p.cnt = (int*)(ws + carve(off, 2 * 64 * 4));
    p.row_tok = (int*)(ws + carve(off, (size_t)2 * MAXSLOT * 4));
    const size_t ctl_bytes = off - ctl0;
    p.segstart = (int*)(ws + carve(off, 2 * 64 * 4));
    p.ntile = (int*)(ws + carve(off, 256));
    p.tile_e = (int*)(ws + carve(off, 2 * 1024 * 4));
    p.tope = (int*)(ws + carve(off, (size_t)4 * NTOK * 4));
    p.toppos = (int*)(ws + carve(off, (size_t)4 * NTOK * 4));
    p.topslot = (int*)(ws + carve(off, (size_t)4 * NTOK * 4));
    p.topw = (float*)(ws + carve(off, (size_t)4 * NTOK * 4));
    p.mod = (float*)(ws + carve(off, (size_t)2 * 16 * 6144 * 4));
    p.ropec = (float*)(ws + carve(off, (size_t)NTOK * 16 * 4));
    p.ropes = (float*)(ws + carve(off, (size_t)NTOK * 16 * 4));
    p.rq = (float*)(ws + carve(off, (size_t)NTOK * 4));
    p.rkv = (float*)(ws + carve(off, (size_t)NTOK * 4));
    p.rv = (float*)(ws + carve(off, (size_t)NTOK * 4));
    p.wt_in0 = (bf16_t*)(ws + carve(off, (size_t)LD0 * 1024 * 2));
    p.wt_uq = (bf16_t*)(ws + carve(off, (size_t)768 * 256 * 2));
    p.wt_ukv = (bf16_t*)(ws + carve(off, (size_t)1024 * 128 * 2));
    p.wt_out0 = (bf16_t*)(ws + carve(off, (size_t)1024 * 1024 * 2));
    p.wt_in1 = (bf16_t*)(ws + carve(off, (size_t)LD1 * 1024 * 2));
    p.wt_out1 = (bf16_t*)(ws + carve(off, (size_t)1024 * 1024 * 2));
    p.wt_gu = (bf16_t*)(ws + carve(off, (size_t)64 * 512 * 1024 * 2));
    p.wt_dn = (bf16_t*)(ws + carve(off, (size_t)64 * 1024 * 256 * 2));
    p.wt_r = (bf16_t*)(ws + carve(off, (size_t)2 * 64 * 1024 * 2));
    p.logits = (float*)(ws + carve(off, (size_t)NTOK * 64 * 4));
    p.xa = (bf16_t*)(ws + carve(off, (size_t)NTOK * D * 2));
    p.mix = (bf16_t*)(ws + carve(off, (size_t)NTOK * D * 2));
    const size_t r0 = off;
    p.proj = (bf16_t*)(ws + carve(off, (size_t)NTOK * LD1 * 2));
    size_t o2 = off;
    p.q = (bf16_t*)(ws + carve(o2, (size_t)NTOK * 768 * 2));
    p.kn = (bf16_t*)(ws + carve(o2, (size_t)NTOK * 512 * 2));
    p.v = (bf16_t*)(ws + carve(o2, (size_t)NTOK * 512 * 2));
    p.kpe = (bf16_t*)(ws + carve(o2, (size_t)NTOK * 32 * 2));
    size_t o3 = off;
    p.loga = (float*)(ws + carve(o3, (size_t)NTOK * 256 * 4));
    p.go = (float*)(ws + carve(o3, (size_t)NTOK * 512 * 4));
    size_t o4 = r0;
    p.act = (bf16_t*)(ws + carve(o4, (size_t)MAXSLOT * DEXP * 2));
    p.y = (bf16_t*)(ws + carve(o4, (size_t)MAXSLOT * D * 2));

    if (off > ws_size || o2 > ws_size || o3 > ws_size || o4 > ws_size) return;
    hipMemsetAsync(ws + ctl0, 0, ctl_bytes, stream);
    k_prep_weights<<<2048, 256, 0, stream>>>(p);
    hipFuncSetAttribute((const void*)k_prep_mod, hipFuncAttributeMaxDynamicSharedMemorySize, (16 * 1024 + 4 * 16 * 64) * 4);
    k_prep_mod<<<192, 256, (16 * 1024 + 4 * 16 * 64) * 4, stream>>>(p);
    k_prep_rope<<<NTOK * 16 / 256, 256, 0, stream>>>(p);
    const int GG = 2048;
    k_norm<<<NTOK / 4, 256, 0, stream>>>(p, p.x, p.norm_mix_g, 0, 0);
    k_gemm<CfgIn0><<<GG, 256, 0, stream>>>(p, 0);
    k_rowstat0<<<NTOK / 4, 256, 0, stream>>>(p);
    k_gemm<CfgUq><<<GG, 256, 0, stream>>>(p, 0);
    k_gemm<CfgUkv><<<GG, 256, 0, stream>>>(p, 0);
    k_attn_naive<<<NB * 8 * SEQ / 256, 256, 0, stream>>>(p);
    k_conv<<<NTOK * 512 / 256, 256, 0, stream>>>(p);
    k_gemm<CfgOut><<<GG, 256, 0, stream>>>(p, 0);
    for (int l = 0; l < 2; ++l) {
        if (l == 1) {
            k_gemm<CfgIn1><<<GG, 256, 0, stream>>>(p, 1);
            k_rowstat1<<<NTOK / 4, 256, 0, stream>>>(p);
            k_gmlp_naive<<<NTOK * 512 / 256, 256, 0, stream>>>(p);
            k_gla_naive<<<64, 128, 0, stream>>>(p);
            k_gla_post<<<NTOK / 4, 256, 0, stream>>>(p);
            k_gemm<CfgOut><<<GG, 256, 0, stream>>>(p, 1);
        }
        k_norm<<<NTOK / 4, 256, 0, stream>>>(p, p.out, p.norm_ffn_g + l * D, l, 1);
        k_gemm<CfgR><<<GG, 256, 0, stream>>>(p, l);
        k_route<<<NTOK / 256, 256, 0, stream>>>(p, l);
        k_offsets<<<1, 64, 0, stream>>>(p, l);
        k_slots<<<2 * NTOK / 256, 256, 0, stream>>>(p, l);
        k_gemm<CfgGu><<<GG, 256, 0, stream>>>(p, l);
        k_gemm<CfgDn><<<GG, 256, 0, stream>>>(p, l);
        k_combine<<<NTOK / 4, 256, 0, stream>>>(p, l, l == 1);
    }
}
```

```cpp
#include <hip/hip_runtime.h>
#include <stdint.h>
#include <math.h>

typedef unsigned short bf16_t;
typedef short bf16x8 __attribute__((ext_vector_type(8)));
typedef float f32x4 __attribute__((ext_vector_type(4)));
typedef unsigned u32x2 __attribute__((ext_vector_type(2)));
typedef unsigned u32x4 __attribute__((ext_vector_type(4)));
#define DI __device__ __forceinline__
#define LAS __attribute__((address_space(3)))

constexpr int D = 1024, NB = 16, SEQ = 4096, NTOK = NB * SEQ;
constexpr float EPS = 1e-6f;
constexpr int AB_IN = 1952, CD_IN = 2576;
constexpr int LD0 = 2048, LD1 = 2816;
constexpr int DEXP = 256;
constexpr int MAXSLOT = 2 * NTOK + 64 * 256;
constexpr float QSCALE = 0.10206207261596577f * 1.4426950408889634f;
constexpr int NTHR = 512, NWAVE = 8;
constexpr int LDS_BYTES = 147456, LDS_MISC = LDS_BYTES - 256;

DI int tid_() { int t = threadIdx.x; asm volatile("" : "+v"(t)); return t; }
DI float bf2f(bf16_t v) { return __uint_as_float(((unsigned)v) << 16); }
DI bf16_t f2bf(float f) { unsigned u = __float_as_uint(f); return (bf16_t)((u + 0x7fffu + ((u >> 16) & 1u)) >> 16); }
DI unsigned pk2(float lo, float hi) { return (unsigned)f2bf(lo) | ((unsigned)f2bf(hi) << 16); }
DI float wave_sum(float v) {
#pragma unroll
    for (int o = 32; o >= 1; o >>= 1) v += __shfl_xor(v, o);
    return v;
}
DI float silu_f(float v) { return v / (1.f + __expf(-v)); }
DI float gelu_tanh_f(float v) { const float u = 1.5957691216057308f * (v + 0.044715f * v * v * v); return v * __builtin_amdgcn_rcpf(1.f + __expf(-u)); }
DI float log_sigmoid_f(float z) { return fminf(z, 0.f) - __logf(1.f + __expf(-fabsf(z))); }

struct P {
    const float *x, *c; const int* pos;
    const float *adaln_w, *adaln_b, *norm_mix_g, *norm_ffn_g, *ab_w_in, *q_norm_g, *w_uq, *kv_norm_g, *w_ukv, *conv_w, *ab_w_out,
        *cd_w_in, *sg_v_norm_g, *sg_w_s, *sg_b_s, *gla_w_g2, *gla_b_g, *gla_norm_g, *cd_w_out,
        *moe_w_group, *moe_b_group, *moe_w_expert, *moe_b_expert, *moe_w_gate_up, *moe_w_down, *final_norm_g;
    float* out;
    bf16_t *wt_in0, *wt_uq, *wt_ukv, *wt_out0, *wt_in1, *wt_out1, *wt_gu, *wt_dn, *wt_r;
    float *mod, *ropec, *ropes;
    bf16_t *xa, *proj, *q, *kn, *v, *kpe, *mix, *act, *y;
    float *rq, *rkv, *rv, *loga, *go, *topw;
    int *tope, *toppos, *topslot, *cnt, *segstart, *ntile, *tile_e, *row_tok;
    unsigned* bar;
};

#define XB_TMO      128
#define XB_XCNT(j)  (256  + 64 * (j))
#define XB_XSUB(j)  (1280 + 64 * (j))
#define XB_XGEN(j)  (2304 + 64 * (j))
#define XB_TOP      3328
#define XB_TOPGEN   3392
#define XCD_BAR_WORDS 3456
#define XB_SPIN_CAP (1u << 18)
__device__ __forceinline__ unsigned xb_ld(unsigned* p)              { return __hip_atomic_load(p, __ATOMIC_RELAXED, __HIP_MEMORY_SCOPE_AGENT); }
__device__ __forceinline__ unsigned xb_add(unsigned* p, unsigned v) { return __hip_atomic_fetch_add(p, v, __ATOMIC_RELAXED, __HIP_MEMORY_SCOPE_AGENT); }
__device__ __forceinline__ unsigned xb_xcc_id() { return (unsigned)__builtin_amdgcn_s_getreg((3 << 11) | 20) & 0xFu; }
#define XB_SPIN(cond, bar) do { unsigned _sp = 0; while (cond) { __builtin_amdgcn_s_sleep(1); \
    if ((++_sp & 255u) == 0u) { if (xb_ld(&(bar)[XB_TMO])) break; if (_sp > XB_SPIN_CAP) { atomicAdd(&(bar)[XB_TMO], 1u); break; } } } } while (0)
struct XcdBarrier { unsigned* bar; unsigned x; volatile LAS unsigned* st; };
__device__ __forceinline__ XcdBarrier xcd_barrier_post(unsigned* bar, volatile LAS unsigned* st) {
    XcdBarrier b; b.bar = bar; b.x = xb_xcc_id(); b.st = st;
    if (threadIdx.x == 0) (void)xb_add(&bar[XB_XCNT(b.x)], 1u);
    return b;
}
__device__ __forceinline__ void xcd_barrier_complete(unsigned* bar, unsigned x, unsigned& nloc, unsigned& nx) {
    const unsigned G = gridDim.x * gridDim.y * gridDim.z;
    unsigned sum, cnt, mine, sp = 0u;
    for (;;) {
        sum = 0u; cnt = 0u; mine = 0u;
#pragma unroll
        for (unsigned j = 0; j < 16; ++j) { const unsigned c = xb_ld(&bar[XB_XCNT(j)]); sum += c; cnt += (c > 0u) ? 1u : 0u; mine = (j == x) ? c : mine; }
        if (sum == G) break;
        __builtin_amdgcn_s_sleep(1);
        if ((++sp & 255u) == 0u) { if (xb_ld(&bar[XB_TMO])) break; if (sp > XB_SPIN_CAP) { atomicAdd(&bar[XB_TMO], 1u); break; } }
    }
    nloc = mine > 0u ? mine : 1u; nx = cnt > 0u ? cnt : 1u;
}
__device__ __forceinline__ void xcd_barrier(const XcdBarrier& b) {
    asm volatile("s_waitcnt vmcnt(0)" ::: "memory");
    __syncthreads();
    if (threadIdx.x == 0) {
        unsigned* bar = b.bar;
        __builtin_amdgcn_s_waitcnt(0);
        unsigned nloc = b.st[0], nx = b.st[1];
        if (nloc == 0u) { xcd_barrier_complete(bar, b.x, nloc, nx); b.st[0] = nloc; b.st[1] = nx; }
        const unsigned old = xb_add(&bar[XB_XSUB(b.x)], 1u);
        const unsigned gen = old / nloc;
        if (old + 1u == (gen + 1u) * nloc) {
            __builtin_amdgcn_fence(__ATOMIC_RELEASE, "agent");
            asm volatile("s_waitcnt vmcnt(0)" ::: "memory");
            const unsigned og = xb_add(&bar[XB_TOP], 1u);
            const unsigned tg = og / nx;
            if (og + 1u == (tg + 1u) * nx) xb_add(&bar[XB_TOPGEN], 1u);
            else XB_SPIN(xb_ld(&bar[XB_TOPGEN]) == tg, bar);
            __builtin_amdgcn_fence(__ATOMIC_ACQUIRE, "agent");
            xb_add(&bar[XB_XGEN(b.x)], 1u);
            asm volatile("s_waitcnt vmcnt(0)" ::: "memory");
        } else {
            XB_SPIN(xb_ld(&bar[XB_XGEN(b.x)]) == gen, bar);
            __builtin_amdgcn_fence(__ATOMIC_ACQUIRE, "agent");
            asm volatile("s_waitcnt vmcnt(0)" ::: "memory");
        }
    }
    __syncthreads();
}

namespace g8 {
constexpr int BM = 256, BK = 64, HALF = 128, HTB = HALF * BK * 2, NXCD = 8, WGM = 8;
__host__ __device__ __forceinline__ int lds_byte(int r, int c) { const int st = (r >> 4) * 2 + (c >> 5), rr = r & 15, cc = c & 31, ob = rr * 64 + cc * 2; return st * 1024 + (ob ^ (((ob >> 9) & 1) << 5)); }
__host__ __device__ __forceinline__ void stage_rc(int b, int& R, int& C) { const int st = b / 1024, sb = b % 1024, swz = sb ^ (((sb >> 9) & 1) << 5); R = (st >> 1) * 16 + swz / 64; C = (st & 1) * 32 + (swz % 64) / 2; }
__host__ __device__ __forceinline__ int perm32(int rho) { const int n = rho >> 4, i = rho & 15; return 8 * (i >> 2) + 4 * n + (i & 3); }
struct Unit { int pm, pn; };
struct Order {
    int nM, nN, nwg, G, c;
    DI void init(int nM_, int nN_, int G_, int c_) { nM = nM_; nN = nN_; nwg = nM * nN; G = G_; c = c_; }
    DI bool next(int i, Unit& u) const {
        const long L = (long)i * G + c; if (L >= nwg) return false;
        int wgid = (int)L; { const int q = nwg / NXCD, r = nwg % NXCD, xcd = wgid % NXCD, off = wgid / NXCD; wgid = (xcd < r ? xcd * (q + 1) : r * (q + 1) + (xcd - r) * q) + off; }
        const int nig = WGM * nN, gid = wgid / nig, fm = gid * WGM, gsz = (nM - fm) < WGM ? (nM - fm) : WGM;
        u.pm = fm + ((wgid % nig) % gsz); u.pn = (wgid % nig) / gsz; return true;
    }
};
template <class Epi, class Src>
__device__ __forceinline__ void gemm8(LAS unsigned char* lds, const char* A, int K_, const Order& S, const Src& X, const Epi& E) {
    int K = K_;
    int tid = threadIdx.x; asm volatile("" : "+v"(tid));
    const int wid = __builtin_amdgcn_readfirstlane(tid >> 6), lane = tid & 63, wr = wid >> 2, wc = wid & 3, fr = lane & 15, fq = lane >> 4;
    asm volatile("" : "+s"(K));
    const int nt = K / BK;
    int Rr[2], Cc[2]; unsigned voffA[2], voffB[2];
#pragma unroll
    for (int i = 0; i < 2; ++i) { int R, C; stage_rc(tid * 16 + i * 8192, R, C); Rr[i] = R; Cc[i] = C * 2; const int Rb = Epi::PERM ? ((R & ~31) + perm32(R & 31)) : R;
        voffA[i] = (unsigned)R * X.lda + (unsigned)C * 2u; voffB[i] = (unsigned)(Rb * K + C) * 2u; }
    const size_t kstep = (size_t)(BK * 2);
    const size_t hstepB = (size_t)HALF * K * 2;
    const size_t hstepA = (size_t)HALF * X.lda;
    const unsigned ldsw = (unsigned)wid * 1024u;
    const int aoff = lds_byte(wr * 64 + fr, fq * 8), boff = lds_byte(wc * 32 + fr, fq * 8);
#define G8_SA(b, h) (((b) * 2 + (h)) * HTB)
#define G8_SB(b, h) ((4 + (b) * 2 + (h)) * HTB)
#define G8_STAGEB(bufoff, gbase) do { _Pragma("unroll") for (int _i = 0; _i < 2; ++_i) \
        __builtin_amdgcn_global_load_lds((const unsigned*)((const char*)(gbase) + voffB[_i]), (LAS unsigned*)(lds + (bufoff) + ldsw + _i * 8192), 16, 0, 0); } while (0)
#define G8_STAGEA(bufoff, ub, o0, o1) do { \
        __builtin_amdgcn_global_load_lds((const unsigned*)((const char*)(ub) + (o0)), (LAS unsigned*)(lds + (bufoff) + ldsw), 16, 0, 0); \
        __builtin_amdgcn_global_load_lds((const unsigned*)((const char*)(ub) + (o1)), (LAS unsigned*)(lds + (bufoff) + ldsw + 8192), 16, 0, 0); } while (0)
#define G8_LDA(dst, b, h) do { _Pragma("unroll") for (int m = 0; m < 4; ++m) _Pragma("unroll") for (int k = 0; k < 2; ++k) dst[m][k] = *(const LAS bf16x8*)(lds + G8_SA(b, h) + aoff + m * 2048 + k * 1024); } while (0)
#define G8_LDB(dst, b, h) do { _Pragma("unroll") for (int n = 0; n < 2; ++n) _Pragma("unroll") for (int k = 0; k < 2; ++k) dst[n][k] = *(const LAS bf16x8*)(lds + G8_SB(b, h) + boff + n * 2048 + k * 1024); } while (0)
#define G8_MMA(ai, bj, At, Bt) do { __builtin_amdgcn_s_setprio(1); _Pragma("unroll") for (int m = 0; m < 4; ++m) _Pragma("unroll") for (int n = 0; n < 2; ++n) _Pragma("unroll") for (int k = 0; k < 2; ++k) \
        acc[ai][bj][m][n] = __builtin_amdgcn_mfma_f32_16x16x32_bf16(Bt[n][k], At[m][k], acc[ai][bj][m][n], 0, 0, 0); __builtin_amdgcn_s_setprio(0); } while (0)
#define G8_WAIT_V(n) asm volatile("s_waitcnt vmcnt(" #n ")" ::: "memory")
#define G8_WAIT_L(n) asm volatile("s_waitcnt lgkmcnt(" #n ")" ::: "memory")
#define G8_BAR __builtin_amdgcn_s_barrier()
#define G8_SCHED __builtin_amdgcn_sched_barrier(0)
    Unit cur, nxt; int ui = 0;
    if (!S.next(0, cur)) return;
    f32x4 acc[2][2][4][2];
#pragma unroll
    for (int a = 0; a < 2; ++a)
#pragma unroll
        for (int b = 0; b < 2; ++b)
#pragma unroll
            for (int m = 0; m < 4; ++m)
#pragma unroll
                for (int n = 0; n < 2; ++n) acc[a][b][m][n] = (f32x4){0.f, 0.f, 0.f, 0.f};
    bf16x8 At[4][2], B0[2][2], B1[2][2];
    unsigned c00 = 0, c01 = 0, c10 = 0, c11 = 0; const char* cA = A;
    if constexpr (Src::GATHER) { c00 = X.a_off(cur, 0, Rr[0]) + Cc[0]; c01 = X.a_off(cur, 0, Rr[1]) + Cc[1]; c10 = X.a_off(cur, 1, Rr[0]) + Cc[0]; c11 = X.a_off(cur, 1, Rr[1]) + Cc[1]; }
    else cA = A + (size_t)cur.pm * 2 * hstepA;
    const char* cB = X.b_ptr(cur);
    G8_STAGEB(G8_SB(0, 0), cB); G8_STAGEB(G8_SB(0, 1), cB + hstepB);
    if constexpr (Src::GATHER) { G8_STAGEA(G8_SA(0, 0), A, c00, c01); G8_STAGEA(G8_SA(0, 1), A, c10, c11); }
    else { G8_STAGEA(G8_SA(0, 0), cA, voffA[0], voffA[1]); G8_STAGEA(G8_SA(0, 1), cA + hstepA, voffA[0], voffA[1]); }
    if (wr == 1) G8_BAR;
    G8_WAIT_V(2); G8_BAR;
    G8_STAGEB(G8_SB(1, 0), cB + kstep);
    if constexpr (Src::GATHER) G8_STAGEA(G8_SA(1, 0), A + kstep, c00, c01); else G8_STAGEA(G8_SA(1, 0), cA + kstep, voffA[0], voffA[1]);
    G8_STAGEB(G8_SB(1, 1), cB + hstepB + kstep);
    G8_WAIT_V(6); G8_BAR;
    for (;;) {
        const bool has_next = S.next(ui + 1, nxt);
        unsigned n00 = c00, n01 = c01, n10 = c10, n11 = c11; const char* nB = cB; const char* nA = cA;
        if (has_next) {
            if constexpr (Src::GATHER) { n00 = X.a_off(nxt, 0, Rr[0]) + Cc[0]; n01 = X.a_off(nxt, 0, Rr[1]) + Cc[1]; n10 = X.a_off(nxt, 1, Rr[0]) + Cc[0]; n11 = X.a_off(nxt, 1, Rr[1]) + Cc[1]; }
            else nA = A + (size_t)nxt.pm * 2 * hstepA;
            nB = X.b_ptr(nxt);
        }
        for (int t = 0; t < nt; t += 2) {
            const bool last = (t == nt - 2);
            const size_t k1 = (size_t)(t + 1) * kstep;
            const size_t k2 = last ? 0 : (size_t)(t + 2) * kstep, k3 = k2 + kstep;
            const char* b2 = (last ? nB : cB) + k2; const char* b3 = b2 + kstep;
            if constexpr (Src::GATHER) {
            const unsigned a00 = last ? n00 : c00, a01 = last ? n01 : c01, a10 = last ? n10 : c10, a11 = last ? n11 : c11;
            G8_LDB(B0, 0, 0); G8_LDB(B1, 0, 1); G8_SCHED; G8_LDA(At, 0, 0); G8_STAGEA(G8_SA(1, 1), A + k1, c10, c11);
            G8_WAIT_V(8); G8_WAIT_L(0); G8_BAR; G8_MMA(0, 0, At, B0); G8_MMA(0, 1, At, B1); G8_BAR; G8_SCHED;
            G8_LDA(At, 0, 1); G8_STAGEB(G8_SB(0, 0), b2); G8_STAGEB(G8_SB(0, 1), b2 + hstepB); G8_STAGEA(G8_SA(0, 0), A + k2, a00, a01);
            G8_WAIT_V(8); G8_WAIT_L(0); G8_BAR; G8_MMA(1, 0, At, B0); G8_MMA(1, 1, At, B1); G8_BAR; G8_SCHED;
            G8_LDB(B0, 1, 0); G8_LDB(B1, 1, 1); G8_SCHED; G8_LDA(At, 1, 0); G8_STAGEA(G8_SA(0, 1), A + k2, a10, a11);
            G8_WAIT_V(8); G8_WAIT_L(0); G8_BAR; G8_MMA(0, 0, At, B0); G8_MMA(0, 1, At, B1); G8_BAR; G8_SCHED;
            G8_LDA(At, 1, 1); G8_STAGEB(G8_SB(1, 0), b3); G8_STAGEB(G8_SB(1, 1), b3 + hstepB); G8_STAGEA(G8_SA(1, 0), A + k3, a00, a01);
            G8_WAIT_V(8); G8_WAIT_L(0); G8_BAR; G8_MMA(1, 0, At, B0); G8_MMA(1, 1, At, B1); G8_BAR; G8_SCHED;
            } else {
            const char* a1 = cA + k1; const char* a2 = (last ? nA : cA) + k2; const char* a3 = a2 + kstep;
            G8_LDB(B0, 0, 0); G8_LDB(B1, 0, 1); G8_SCHED; G8_LDA(At, 0, 0); G8_STAGEA(G8_SA(1, 1), a1 + hstepA, voffA[0], voffA[1]);
            G8_WAIT_V(8); G8_WAIT_L(0); G8_BAR; G8_MMA(0, 0, At, B0); G8_MMA(0, 1, At, B1); G8_BAR; G8_SCHED;
            G8_LDA(At, 0, 1); G8_STAGEB(G8_SB(0, 0), b2); G8_STAGEB(G8_SB(0, 1), b2 + hstepB); G8_STAGEA(G8_SA(0, 0), a2, voffA[0], voffA[1]);
            G8_WAIT_V(8); G8_WAIT_L(0); G8_BAR; G8_MMA(1, 0, At, B0); G8_MMA(1, 1, At, B1); G8_BAR; G8_SCHED;
            G8_LDB(B0, 1, 0); G8_LDB(B1, 1, 1); G8_SCHED; G8_LDA(At, 1, 0); G8_STAGEA(G8_SA(0, 1), a2 + hstepA, voffA[0], voffA[1]);
            G8_WAIT_V(8); G8_WAIT_L(0); G8_BAR; G8_MMA(0, 0, At, B0); G8_MMA(0, 1, At, B1); G8_BAR; G8_SCHED;
            G8_LDA(At, 1, 1); G8_STAGEB(G8_SB(1, 0), b3); G8_STAGEB(G8_SB(1, 1), b3 + hstepB); G8_STAGEA(G8_SA(1, 0), a3, voffA[0], voffA[1]);
            G8_WAIT_V(8); G8_WAIT_L(0); G8_BAR; G8_MMA(1, 0, At, B0); G8_MMA(1, 1, At, B1); G8_BAR; G8_SCHED;
            }
        }
        if (wr == 0) G8_BAR;
        E(acc, cur, wr, wc, fr, fq);
        if (!has_next) break;
#pragma unroll
        for (int a = 0; a < 2; ++a)
#pragma unroll
            for (int b = 0; b < 2; ++b)
#pragma unroll
                for (int m = 0; m < 4; ++m)
#pragma unroll
                    for (int n = 0; n < 2; ++n) acc[a][b][m][n] = (f32x4){0.f, 0.f, 0.f, 0.f};
        cur = nxt; c00 = n00; c01 = n01; c10 = n10; c11 = n11; cB = nB; cA = nA; ++ui;
        if (wr == 1) G8_BAR;
    }
    G8_WAIT_V(0);
    G8_BAR;
#undef G8_SA
#undef G8_SB
#undef G8_STAGEA
#undef G8_STAGEB
#undef G8_LDA
#undef G8_LDB
#undef G8_MMA
#undef G8_WAIT_V
#undef G8_WAIT_L
#undef G8_BAR
#undef G8_SCHED
}
template <class F> struct Epi {
    static constexpr bool PERM = F::PERM;
    F f;
    DI void operator()(const f32x4 (&acc)[2][2][4][2], const Unit& u, int wr, int wc, int fr, int fq) const {
#pragma unroll
        for (int ai = 0; ai < 2; ++ai)
#pragma unroll
            for (int m = 0; m < 4; ++m) {
                const int row = u.pm * BM + ai * HALF + wr * 64 + m * 16 + fr;
                __builtin_amdgcn_sched_barrier(0);
#pragma unroll
                for (int bj = 0; bj < 2; ++bj) {
                    if constexpr (F::PERM) { f.e8(row, u.pn * BM + bj * HALF + wc * 32 + 8 * fq, acc[ai][bj][m][0], acc[ai][bj][m][1], u); }
                    else {
#pragma unroll
                        for (int n = 0; n < 2; ++n) f.e4(row, u.pn * BM + bj * HALF + wc * 32 + 16 * n + 4 * fq, acc[ai][bj][m][n], u);
                    }
                }
            }
    }
};
}

DI void store_bf8(bf16_t* dst, const f32x4& a, const f32x4& b) { u32x4 w; w.x = pk2(a[0], a[1]); w.y = pk2(a[2], a[3]); w.z = pk2(b[0], b[1]); w.w = pk2(b[2], b[3]); *(u32x4*)dst = w; }
DI void rope8(const P& p, int row, int i0, f32x4& a, f32x4& b) {
    const f32x4 c = *(const f32x4*)(p.ropec + (size_t)row * 16 + i0), s = *(const f32x4*)(p.ropes + (size_t)row * 16 + i0);
    f32x4 oa, ob;
    oa[0] = a[0] * c[0] - a[1] * s[0]; oa[1] = a[0] * s[0] + a[1] * c[0]; oa[2] = a[2] * c[1] - a[3] * s[1]; oa[3] = a[2] * s[1] + a[3] * c[1];
    ob[0] = b[0] * c[2] - b[1] * s[2]; ob[1] = b[0] * s[2] + b[1] * c[2]; ob[2] = b[2] * c[3] - b[3] * s[3]; ob[3] = b[2] * s[3] + b[3] * c[3];
    a = oa; b = ob;
}
struct SrcDense {
    static constexpr bool GATHER = false;
    unsigned lda; const char* B; size_t bt;
    DI unsigned a_off(const g8::Unit&, int, int) const { return 0u; }
    DI const char* b_ptr(const g8::Unit& u) const { return B + (size_t)u.pn * bt; }
};
template <bool G_> struct SrcMoe {
    static constexpr bool GATHER = G_;
    unsigned lda; const int* rt; const int* te; const char* B; size_t be, bt;
    DI unsigned a_off(const g8::Unit& u, int h, int R) const { return (unsigned)rt[u.pm * 256 + h * 128 + R] * lda; }
    DI const char* b_ptr(const g8::Unit& u) const { return B + (size_t)te[u.pm] * be + (size_t)u.pn * bt; }
};
struct FIn0 { static constexpr bool PERM = true; const P& p;
    DI void e8(int row, int col, f32x4 a, f32x4 b, const g8::Unit&) const {
        if (col >= 384 && col < 416) { rope8(p, row, (col - 384) >> 1, a, b); store_bf8(p.kpe + (size_t)row * 32 + (col - 384), a, b); }
        else if (col < AB_IN) store_bf8(p.proj + (size_t)row * LD0 + col, a, b);
    } };
struct FUq { static constexpr bool PERM = true; const P& p;
    DI void e8(int row, int col, f32x4 a, f32x4 b, const g8::Unit&) const {
        const float r = p.rq[row] * QSCALE; a = a * r; b = b * r;
        if (((col >> 5) % 3) == 2) rope8(p, row, (col & 31) >> 1, a, b);
        store_bf8(p.q + (size_t)row * 768 + col, a, b);
    } };
struct FUkv { static constexpr bool PERM = true; const P& p;
    DI void e8(int row, int col, f32x4 a, f32x4 b, const g8::Unit&) const {
        const float r = p.rkv[row]; a = a * r; b = b * r;
        if (col < 512) store_bf8(p.kn + (size_t)row * 512 + col, a, b); else store_bf8(p.v + (size_t)row * 512 + (col - 512), a, b);
    } };
struct FOut { static constexpr bool PERM = false; const P& p; int l; const float* xin;
    DI void e4(int row, int col, const f32x4& v, const g8::Unit&) const {
        const int b = row >> 12;
        const f32x4 g = *(const f32x4*)(p.mod + ((size_t)l * 16 + b) * 6144 + 2048 + col);
        const f32x4 xi = *(const f32x4*)(xin + (size_t)row * D + col);
        *(f32x4*)(p.out + (size_t)row * D + col) = xi + g * v;
    } };
struct FIn1 { static constexpr bool PERM = true; const P& p;
    DI void e8(int row, int col, f32x4 a, f32x4 b, const g8::Unit&) const {
        if (col < 1024) {
#pragma unroll
            for (int e = 0; e < 4; ++e) { a[e] = gelu_tanh_f(a[e]); b[e] = gelu_tanh_f(b[e]); }
        } else if (col >= 2048 && col < 2304) {
            const float* bg = p.gla_b_g + (col - 2048); f32x4 o0, o1;
#pragma unroll
            for (int e = 0; e < 4; ++e) { o0[e] = log_sigmoid_f(a[e] + bg[e]) * (1.f / 16.f); o1[e] = log_sigmoid_f(b[e] + bg[4 + e]) * (1.f / 16.f); }
            float* dst = p.loga + (size_t)row * 256 + (col - 2048);
            *(f32x4*)dst = o0; *(f32x4*)(dst + 4) = o1;
            return;
        }
        store_bf8(p.proj + (size_t)row * LD1 + col, a, b);
    } };
struct FGu { static constexpr bool PERM = true; const P& p;
    DI void e8(int row, int col, const f32x4& a, const f32x4& b, const g8::Unit&) const {
        u32x2 w; w.x = pk2(silu_f(a[0]) * a[1], silu_f(a[2]) * a[3]); w.y = pk2(silu_f(b[0]) * b[1], silu_f(b[2]) * b[3]);
        *(u32x2*)(p.act + (size_t)row * DEXP + (col >> 1)) = w;
    } };
struct FDn { static constexpr bool PERM = true; const P& p;
    DI void e8(int row, int col, const f32x4& a, const f32x4& b, const g8::Unit&) const { store_bf8(p.y + (size_t)row * D + col, a, b); } };

enum { J_IN0 = 0, J_UQ, J_UKV, J_OUT0, J_IN1, J_OUT1, J_GU, J_DN, J_R, J_NUM };
DI float wval(const P& p, int job, int sub, int k, int n) {
    switch (job) {
    case J_IN0: {
        if (n >= AB_IN) return 0.f;
        int src = n;
        if (n >= 384 && n < 416) { const int i = n - 384; src = 384 + (i >> 1) + (i & 1) * 16; }
        return p.ab_w_in[(size_t)k * AB_IN + src];
    }
    case J_UQ: {
        const int h = n / 96, j = n % 96; int src = 96 * h + j;
        if (j >= 64) { const int i = j - 64; src = 96 * h + 64 + (i >> 1) + (i & 1) * 16; }
        return p.w_uq[(size_t)k * 768 + src] * p.q_norm_g[k];
    }
    case J_UKV: {
        int src;
        if (n < 512) { src = 128 * (n >> 6) + (n & 63); } else { const int m = n - 512; src = 128 * (m >> 6) + 64 + (m & 63); }
        return p.w_ukv[(size_t)k * 1024 + src] * p.kv_norm_g[k];
    }
    case J_OUT0: return p.ab_w_out[(size_t)k * 1024 + n];
    case J_IN1: {
        if (n < 2048) return p.cd_w_in[(size_t)k * CD_IN + n];
        if (n < 2304) { const int j = n - 2048; float s = 0.f;
#pragma unroll
            for (int r = 0; r < 16; ++r) s += p.cd_w_in[(size_t)k * CD_IN + 2048 + r] * p.gla_w_g2[r * 256 + j];
            return s; }
        return p.cd_w_in[(size_t)k * CD_IN + 2064 + (n - 2304)];
    }
    case J_OUT1: return p.cd_w_out[(size_t)k * 1024 + n];
    case J_GU: { const int j = n >> 1; const int src = (n & 1) ? 256 + j : j; return p.moe_w_gate_up[((size_t)sub * 1024 + k) * 512 + src]; }
    case J_DN: return p.moe_w_down[((size_t)sub * 256 + k) * 1024 + n];
    case J_R: { if (n < 4) return p.moe_w_group[((size_t)sub * 1024 + k) * 4 + n]; if (n < 36) return p.moe_w_expert[((size_t)sub * 1024 + k) * 32 + (n - 4)]; return 0.f; }
    }
    return 0.f;
}
struct JobInfo { int K, N, nsub; };
DI JobInfo job_info(int job) {
    switch (job) {
    case J_IN0: return {1024, LD0, 1};
    case J_UQ: return {256, 768, 1};
    case J_UKV: return {128, 1024, 1};
    case J_OUT0: return {1024, 1024, 1};
    case J_IN1: return {1024, LD1, 1};
    case J_OUT1: return {1024, 1024, 1};
    case J_GU: return {1024, 512, 64};
    case J_DN: return {256, 1024, 64};
    default: return {1024, 64, 2};
    }
}
constexpr size_t WO_IN0 = 0, WO_UQ = WO_IN0 + (size_t)LD0 * 1024, WO_UKV = WO_UQ + 768 * 256, WO_OUT0 = WO_UKV + 1024 * 128, WO_IN1 = WO_OUT0 + 1024 * 1024,
    WO_OUT1 = WO_IN1 + (size_t)LD1 * 1024, WO_GU = WO_OUT1 + 1024 * 1024, WO_DN = WO_GU + (size_t)64 * 512 * 1024, WO_R = WO_DN + (size_t)64 * 1024 * 256, WO_END = WO_R + 2 * 64 * 1024;
DI size_t job_dst_off(int job) {
    switch (job) {
    case J_IN0: return WO_IN0; case J_UQ: return WO_UQ; case J_UKV: return WO_UKV; case J_OUT0: return WO_OUT0;
    case J_IN1: return WO_IN1; case J_OUT1: return WO_OUT1; case J_GU: return WO_GU; case J_DN: return WO_DN; default: return WO_R;
    }
}
DI void ph_prep(const P& p, LAS unsigned char* lds) {
    const int tid = tid_();
    if (blockIdx.x < 192) {
        LAS float* cact = (LAS float*)lds;
        LAS float* red = cact + 16 * 1024;
        for (int i = tid; i < 16 * 1024; i += NTHR) cact[i] = silu_f(p.c[i]);
        __syncthreads();
        const int col = tid & 63, ks = tid >> 6;
        for (int item = blockIdx.x; item < 192; item += gridDim.x) {
            const int l = item / 96, j = (item % 96) * 64 + col;
            float acc[16];
#pragma unroll
            for (int b = 0; b < 16; ++b) acc[b] = 0.f;
            const float* W = p.adaln_w + (size_t)l * 1024 * 6144 + j;
            for (int k = ks * 128; k < ks * 128 + 128; ++k) {
                const float w = W[(size_t)k * 6144];
#pragma unroll
                for (int b = 0; b < 16; ++b) acc[b] += cact[b * 1024 + k] * w;
            }
#pragma unroll
            for (int b = 0; b < 16; ++b) red[(ks * 16 + b) * 64 + col] = acc[b];
            __syncthreads();
            for (int i = tid; i < 1024; i += NTHR) {
                const int b = i >> 6, cc = i & 63; float s = 0.f;
#pragma unroll
                for (int q = 0; q < 8; ++q) s += red[(q * 16 + b) * 64 + cc];
                const int jj = (item % 96) * 64 + cc;
                p.mod[((size_t)l * 16 + b) * 6144 + jj] = s + p.adaln_b[l * 6144 + jj];
            }
            __syncthreads();
        }
    }
    {
        LAS float* tl = (LAS float*)lds;
        int total = 0;
#pragma unroll
        for (int j = 0; j < J_NUM; ++j) { const JobInfo ji = job_info(j); total += (ji.K / 64) * (ji.N / 64) * ji.nsub; }
        for (int tile = blockIdx.x; tile < total; tile += gridDim.x) {
            int job = 0, jstart = 0, accn = 0;
#pragma unroll
            for (int j = 0; j < J_NUM; ++j) { const JobInfo jj = job_info(j); if (tile >= accn) { job = j; jstart = accn; } accn += (jj.K / 64) * (jj.N / 64) * jj.nsub; }
            const JobInfo ji = job_info(job);
            int r = tile - jstart;
            const int kt = ji.K / 64, nt = ji.N / 64;
            const int sub = r / (kt * nt); r -= sub * kt * nt;
            const int n0 = (r / kt) * 64, k0 = (r % kt) * 64;
            for (int i = tid; i < 4096; i += NTHR) { const int kk = i >> 6, nn = i & 63; tl[kk * 65 + nn] = wval(p, job, sub, k0 + kk, n0 + nn); }
            __syncthreads();
            bf16_t* dst = p.wt_in0 + job_dst_off(job) + (size_t)sub * ji.K * ji.N;
            for (int i = tid; i < 4096; i += NTHR) { const int nn = i >> 6, kk = i & 63; dst[(size_t)(n0 + nn) * ji.K + k0 + kk] = f2bf(tl[kk * 65 + nn]); }
            __syncthreads();
        }
    }
    for (int gid = blockIdx.x * NTHR + tid; gid < NTOK * 16; gid += gridDim.x * NTHR) {
        const int tok = gid >> 4, i = gid & 15;
        const double inv = pow(10000.0, -(double)i / 16.0);
        const double ang = (double)p.pos[tok] * inv;
        p.ropec[gid] = (float)cos(ang); p.ropes[gid] = (float)sin(ang);
    }
}

DI void ph_norm(const P& p, const float* xin, const float* g, int l, int which) {
    const int tid = tid_(); const int lane = tid & 63;
    for (int row = blockIdx.x * NWAVE + (tid >> 6); row < NTOK; row += gridDim.x * NWAVE) {
        const int b = row >> 12;
        const float* md = p.mod + ((size_t)l * 16 + b) * 6144 + which * 3072;
        const float* xr = xin + (size_t)row * D;
        f32x4 v[4]; float ss = 0.f;
#pragma unroll
        for (int i = 0; i < 4; ++i) { v[i] = *(const f32x4*)(xr + i * 256 + lane * 4); ss += v[i][0] * v[i][0] + v[i][1] * v[i][1] + v[i][2] * v[i][2] + v[i][3] * v[i][3]; }
        ss = wave_sum(ss);
        const float r = rsqrtf(ss * (1.f / D) + EPS);
#pragma unroll
        for (int i = 0; i < 4; ++i) {
            const int c0 = i * 256 + lane * 4;
            const f32x4 gg = *(const f32x4*)(g + c0), sh = *(const f32x4*)(md + c0), sc = *(const f32x4*)(md + 1024 + c0);
            float o[4];
#pragma unroll
            for (int e = 0; e < 4; ++e) o[e] = v[i][e] * r * gg[e] * (1.f + sc[e]) + sh[e];
            u32x2 w; w.x = pk2(o[0], o[1]); w.y = pk2(o[2], o[3]);
            *(u32x2*)(p.xa + (size_t)row * D + c0) = w;
        }
    }
}
DI void ph_rowstat0_conv(const P& p) {
    const int tid = tid_(); const int lane = tid & 63;
    for (int row = blockIdx.x * NWAVE + (tid >> 6); row < NTOK; row += gridDim.x * NWAVE) {
        const bf16_t* r = p.proj + (size_t)row * LD0;
        float sq = 0.f, sk = 0.f;
#pragma unroll
        for (int i = 0; i < 4; ++i) { const float v = bf2f(r[i * 64 + lane]); sq += v * v; }
#pragma unroll
        for (int i = 0; i < 2; ++i) { const float v = bf2f(r[256 + i * 64 + lane]); sk += v * v; }
        sq = wave_sum(sq); sk = wave_sum(sk);
        if (lane == 0) { p.rq[row] = rsqrtf(sq * (1.f / 256.f) + EPS); p.rkv[row] = rsqrtf(sk * (1.f / 128.f) + EPS); }
        const int t = row & 4095;
#pragma unroll
        for (int i = 0; i < 8; ++i) {
            const int ch = i * 64 + lane; float y = 0.f;
#pragma unroll
            for (int k = 0; k < 3; ++k) {
                const int dt = k - 2;
                if (t + dt >= 0) { const bf16_t* q = r + (long)dt * LD0; y += p.conv_w[k * 512 + ch] * (bf2f(q[928 + ch]) * bf2f(q[1440 + ch])); }
            }
            p.mix[(size_t)row * D + 512 + ch] = f2bf(bf2f(r[416 + ch]) * y);
        }
    }
}
DI void ph_rowstat1(const P& p) {
    const int tid = tid_(); const int lane = tid & 63;
    for (int row = blockIdx.x * NWAVE + (tid >> 6); row < NTOK; row += gridDim.x * NWAVE) {
        const bf16_t* r = p.proj + (size_t)row * LD1 + 512;
        float s = 0.f;
#pragma unroll
        for (int i = 0; i < 8; ++i) { const float v = bf2f(r[i * 64 + lane]); s += v * v; }
        s = wave_sum(s);
        if (lane == 0) p.rv[row] = rsqrtf(s * (1.f / 512.f) + EPS);
    }
}

DI void ph_router(const P& p, int l, LAS unsigned char* lds) {
    const int tid = tid_(); const int lane = tid & 63, wid = tid >> 6, fr = lane & 15, fq = lane >> 4;
    LAS float* lg = (LAS float*)lds + wid * (32 * 65);
    const bf16_t* W = p.wt_r + (size_t)l * 64 * 1024;
    int* cnt = p.cnt + l * 64;
    const size_t o = (size_t)l * 2 * NTOK;
    for (int mt = blockIdx.x * NWAVE + wid; mt < NTOK / 32; mt += gridDim.x * NWAVE) {
        const int m0 = mt * 32;
        const bf16_t* ap[2]; const bf16_t* bp[4];
#pragma unroll
        for (int i = 0; i < 2; ++i) ap[i] = p.xa + (size_t)(m0 + 16 * i + fr) * D + fq * 8;
#pragma unroll
        for (int j = 0; j < 4; ++j) bp[j] = W + (size_t)(16 * j + fr) * 1024 + fq * 8;
        f32x4 acc[2][4];
#pragma unroll
        for (int i = 0; i < 2; ++i)
#pragma unroll
            for (int j = 0; j < 4; ++j) acc[i][j] = (f32x4){0.f, 0.f, 0.f, 0.f};
        for (int k = 0; k < 1024; k += 32) {
            bf16x8 a[2], b[4];
#pragma unroll
            for (int i = 0; i < 2; ++i) a[i] = *(const bf16x8*)(ap[i] + k);
#pragma unroll
            for (int j = 0; j < 4; ++j) b[j] = *(const bf16x8*)(bp[j] + k);
#pragma unroll
            for (int i = 0; i < 2; ++i)
#pragma unroll
                for (int j = 0; j < 4; ++j) acc[i][j] = __builtin_amdgcn_mfma_f32_16x16x32_bf16(b[j], a[i], acc[i][j], 0, 0, 0);
        }
#pragma unroll
        for (int i = 0; i < 2; ++i)
#pragma unroll
            for (int j = 0; j < 4; ++j)
#pragma unroll
                for (int e = 0; e < 4; ++e) lg[(16 * i + fr) * 65 + 16 * j + 4 * fq + e] = acc[i][j][e];
        asm volatile("s_waitcnt lgkmcnt(0)" ::: "memory");
        if (lane < 32) {
            const LAS float* r = lg + lane * 65; const int tok = m0 + lane;
            float gl[4]; int gs = 0;
#pragma unroll
            for (int j = 0; j < 4; ++j) gl[j] = r[j] + p.moe_b_group[l * 4 + j];
            float gmax = gl[0];
#pragma unroll
            for (int j = 1; j < 4; ++j) if (gl[j] > gmax) { gmax = gl[j]; gs = j; }
            float den = 0.f;
#pragma unroll
            for (int j = 0; j < 4; ++j) den += __expf(gl[j] - gmax);
            const float pg = 1.f / den;
            float el[8];
#pragma unroll
            for (int j = 0; j < 8; ++j) el[j] = r[4 + gs * 8 + j] + p.moe_b_expert[l * 32 + gs * 8 + j];
            int i1 = 0; float v1 = el[0];
#pragma unroll
            for (int j = 1; j < 8; ++j) if (el[j] > v1) { v1 = el[j]; i1 = j; }
            int i2 = -1; float v2 = -INFINITY;
#pragma unroll
            for (int j = 0; j < 8; ++j) if (j != i1 && el[j] > v2) { v2 = el[j]; i2 = j; }
            const float e2 = __expf(v2 - v1);
            const float w1 = pg / (1.f + e2), w2 = pg * e2 / (1.f + e2);
            const int ea = gs * 8 + i1, eb = gs * 8 + i2;
            const int pa = atomicAdd(&cnt[ea], 1), pb = atomicAdd(&cnt[32 + eb], 1);
            p.tope[o + tok] = ea; p.tope[o + NTOK + tok] = eb;
            p.toppos[o + tok] = pa; p.toppos[o + NTOK + tok] = pb;
            p.topw[o + tok] = w1; p.topw[o + NTOK + tok] = w2;
        }
        asm volatile("s_waitcnt lgkmcnt(0)" ::: "memory");
    }
}
DI void ph_slots(const P& p, int l, LAS unsigned char* lds) {
    LAS int* ss = (LAS int*)lds;
    const int tid = tid_();
    if (tid == 0) {
        int start = 0, tile = 0;
        for (int seg = 0; seg < 64; ++seg) { const int c = p.cnt[l * 64 + seg], nt = (c + 255) >> 8; ss[seg] = start; ss[64 + seg] = tile; tile += nt; start += nt * 256; }
        ss[128] = tile;
    }
    __syncthreads();
    if (blockIdx.x == 0) {
        if (tid < 64) { const int t0 = ss[64 + tid], t1 = (tid == 63) ? ss[128] : ss[64 + tid + 1]; for (int i = t0; i < t1; ++i) p.tile_e[l * 1024 + i] = tid & 31; }
        if (tid == 0) p.ntile[l] = ss[128];
    }
    for (int gid = blockIdx.x * NTHR + tid; gid < 2 * NTOK; gid += gridDim.x * NTHR) {
        const int k = gid >> 16, tok = gid & (NTOK - 1);
        const size_t o = (size_t)l * 2 * NTOK + gid;
        const int slot = ss[k * 32 + p.tope[o]] + p.toppos[o];
        p.topslot[o] = slot;
        p.row_tok[(size_t)l * MAXSLOT + slot] = tok;
    }
    __syncthreads();
}
DI void ph_combine(const P& p, int l, int last) {
    const int tid = tid_(); const int lane = tid & 63;
    for (int row = blockIdx.x * NWAVE + (tid >> 6); row < NTOK; row += gridDim.x * NWAVE) {
        const int b = row >> 12;
        const size_t o = (size_t)l * 2 * NTOK;
        const int s0 = p.topslot[o + row], s1 = p.topslot[o + NTOK + row];
        const float w0 = p.topw[o + row], w1 = p.topw[o + NTOK + row];
        const float* g2 = p.mod + ((size_t)l * 16 + b) * 6144 + 5 * 1024;
        float* xr = p.out + (size_t)row * D;
        f32x4 v[4]; float ss = 0.f;
#pragma unroll
        for (int i = 0; i < 4; ++i) {
            const int c0 = i * 256 + lane * 4;
            const u32x2 ya = *(const u32x2*)(p.y + (size_t)s0 * D + c0), yb = *(const u32x2*)(p.y + (size_t)s1 * D + c0);
            const f32x4 gg = *(const f32x4*)(g2 + c0); const f32x4 xv = *(const f32x4*)(xr + c0);
            float ye[4];
            ye[0] = w0 * __uint_as_float(ya.x << 16) + w1 * __uint_as_float(yb.x << 16);
            ye[1] = w0 * __uint_as_float(ya.x & 0xffff0000u) + w1 * __uint_as_float(yb.x & 0xffff0000u);
            ye[2] = w0 * __uint_as_float(ya.y << 16) + w1 * __uint_as_float(yb.y << 16);
            ye[3] = w0 * __uint_as_float(ya.y & 0xffff0000u) + w1 * __uint_as_float(yb.y & 0xffff0000u);
#pragma unroll
            for (int e = 0; e < 4; ++e) { v[i][e] = xv[e] + gg[e] * ye[e]; ss += v[i][e] * v[i][e]; }
        }
        ss = wave_sum(ss);
        const float r = rsqrtf(ss * (1.f / D) + EPS);
        if (last) {
#pragma unroll
            for (int i = 0; i < 4; ++i) { const int c0 = i * 256 + lane * 4; const f32x4 gg = *(const f32x4*)(p.final_norm_g + c0); *(f32x4*)(xr + c0) = v[i] * r * gg; }
        } else {
            const float* md = p.mod + ((size_t)(l + 1) * 16 + b) * 6144;
            const float* g = p.norm_mix_g + (l + 1) * D;
#pragma unroll
            for (int i = 0; i < 4; ++i) {
                const int c0 = i * 256 + lane * 4;
                *(f32x4*)(xr + c0) = v[i];
                const f32x4 gg = *(const f32x4*)(g + c0), sh = *(const f32x4*)(md + c0), sc = *(const f32x4*)(md + 1024 + c0);
                float oo[4];
#pragma unroll
                for (int e = 0; e < 4; ++e) oo[e] = v[i][e] * r * gg[e] * (1.f + sc[e]) + sh[e];
                u32x2 w; w.x = pk2(oo[0], oo[1]); w.y = pk2(oo[2], oo[3]);
                *(u32x2*)(p.xa + (size_t)row * D + c0) = w;
            }
        }
    }
}


typedef float f32x16 __attribute__((ext_vector_type(16)));
typedef short s16x4 __attribute__((ext_vector_type(4)));
typedef short v4i16_t __attribute__((ext_vector_type(4)));
typedef float f32x2_t __attribute__((ext_vector_type(2))); typedef __bf16 bf16x2_t __attribute__((ext_vector_type(2)));
DI unsigned cvtpk(float lo, float hi) { f32x2_t v = {lo, hi}; bf16x2_t b = __builtin_convertvector(v, bf16x2_t); return __builtin_bit_cast(unsigned, b); }
DI int crow(int r, int hi) { return (r & 3) + 8 * (r >> 2) + 4 * hi; }
DI s16x4 vtr(const LAS unsigned char* p) { return __builtin_bit_cast(s16x4, __builtin_amdgcn_ds_read_tr16_b64_v4i16((LAS v4i16_t*)p)); }
constexpr int AT_KB = 12 * 1024, AT_VB = 8 * 1024, AT_BUF = AT_KB + AT_VB, AT_WS = 2 * AT_BUF, AT_OST = AT_WS + 8 * 256, AT_LDS = AT_OST + 8 * 4096;
constexpr float AT_THR = 8.f;
DI void attn_unit(const P& p, LAS unsigned char* lds, int b, int h, int qb, int tid) {
    const int lane = tid & 63, wid = __builtin_amdgcn_readfirstlane(tid >> 6), r32 = lane & 31, hi = lane >> 5;
    const size_t rowbase = (size_t)b * SEQ; const int q0 = qb * 256;
    const int NT = 4 * (qb + 1);
    const bf16_t* ksrc = p.kn + (rowbase + lane) * 512 + h * 64 + wid * 8;
    const bf16_t* psrc = p.kpe + (rowbase + lane) * 32 + (wid & 3) * 8;
    const bf16_t* vsrc = p.v + (rowbase + 16 * (wid & 3) + (lane >> 2)) * 512 + h * 64 + (wid >> 2) * 32 + (lane & 3) * 8;
#define AT_LOAD(t, buf) do { \
        __builtin_amdgcn_global_load_lds((const unsigned*)(ksrc + (size_t)(t) * 64 * 512), (LAS unsigned*)(lds + (buf) * AT_BUF + wid * 1024), 16, 0, 0); \
        if (wid < 4) __builtin_amdgcn_global_load_lds((const unsigned*)(psrc + (size_t)(t) * 64 * 32), (LAS unsigned*)(lds + (buf) * AT_BUF + (8 + wid) * 1024), 16, 0, 0); \
        __builtin_amdgcn_global_load_lds((const unsigned*)(vsrc + (size_t)(t) * 64 * 512), (LAS unsigned*)(lds + (buf) * AT_BUF + AT_KB + wid * 1024), 16, 0, 0); } while (0)
    AT_LOAD(0, 0);
    bf16x8 qr[6];
    { const bf16_t* Qw = p.q + (rowbase + q0 + wid * 32 + r32) * 768 + h * 96 + hi * 8;
#pragma unroll
      for (int d0 = 0; d0 < 6; ++d0) qr[d0] = *(const bf16x8*)(Qw + d0 * 16); }
    LAS float* wsf = (LAS float*)(lds + AT_WS) + wid * 64;
    float mhat = -INFINITY, lsum = 0.f;
    f32x16 o[2];
#pragma unroll
    for (int r = 0; r < 16; ++r) { o[0][r] = 0.f; o[1][r] = 0.f; }
    const int qrel = wid * 32 + r32;
    const int koff = hi * 1024 + r32 * 16;
    const int voff = AT_KB + ((lane >> 4) & 1) * 32 + (lane & 3) * 8 + (4 * hi + ((lane & 15) >> 2)) * 64;
    for (int t = 0; t < NT; ++t) {
        asm volatile("s_waitcnt vmcnt(0)" ::: "memory");
        __syncthreads();
        if (t + 1 < NT) AT_LOAD(t + 1, (t + 1) & 1);
        const int jb = t - (NT - 4);
        if (jb >= 0 && 64 * jb > wid * 32 + 31) continue;
        const LAS unsigned char* kb = lds + (t & 1) * AT_BUF + koff;
        const LAS unsigned char* vb = lds + (t & 1) * AT_BUF + voff;
        f32x16 p0, p1;
#pragma unroll
        for (int r = 0; r < 16; ++r) { p0[r] = 0.f; p1[r] = 0.f; }
#pragma unroll
        for (int d0 = 0; d0 < 6; ++d0) {
            const bf16x8 k0 = *(const LAS bf16x8*)(kb + d0 * 2048), k1 = *(const LAS bf16x8*)(kb + d0 * 2048 + 512);
            p0 = __builtin_amdgcn_mfma_f32_32x32x16_bf16(k0, qr[d0], p0, 0, 0, 0);
            p1 = __builtin_amdgcn_mfma_f32_32x32x16_bf16(k1, qr[d0], p1, 0, 0, 0);
        }
        if (jb >= 0) {
            const int kbase = 64 * jb + 4 * hi;
#pragma unroll
            for (int r = 0; r < 16; ++r) { const int kv = kbase + (r & 3) + 8 * (r >> 2); if (kv > qrel) p0[r] = -INFINITY; if (kv + 32 > qrel) p1[r] = -INFINITY; }
        }
        float mx = fmaxf(p0[0], p1[0]);
#pragma unroll
        for (int r = 1; r < 16; ++r) mx = fmaxf(mx, fmaxf(p0[r], p1[r]));
        { auto rr = __builtin_amdgcn_permlane32_swap(__float_as_uint(mx), __float_as_uint(mx), false, false); mx = fmaxf(__uint_as_float(rr[0]), __uint_as_float(rr[1])); }
        const bool need = mx > mhat + AT_THR;
        if (__any(need)) {
            const float mnew = need ? mx : mhat;
            const float alpha = __builtin_amdgcn_exp2f(mhat - mnew);
            mhat = mnew; lsum *= alpha;
            if (hi == 0) wsf[r32] = alpha;
            asm volatile("s_waitcnt lgkmcnt(0)" ::: "memory");
#pragma unroll
            for (int r = 0; r < 16; ++r) { const float a = wsf[crow(r, hi)]; o[0][r] *= a; o[1][r] *= a; }
        }
        float sacc = 0.f;
#pragma unroll
        for (int r = 0; r < 16; ++r) { p0[r] = __builtin_amdgcn_exp2f(p0[r] - mhat); p1[r] = __builtin_amdgcn_exp2f(p1[r] - mhat); sacc += p0[r] + p1[r]; }
        lsum += sacc;
        u32x4 pw[4];
#pragma unroll
        for (int j = 0; j < 4; ++j) { pw[0][j] = cvtpk(p0[2 * j], p0[2 * j + 1]); pw[1][j] = cvtpk(p0[8 + 2 * j], p0[8 + 2 * j + 1]); pw[2][j] = cvtpk(p1[2 * j], p1[2 * j + 1]); pw[3][j] = cvtpk(p1[8 + 2 * j], p1[8 + 2 * j + 1]); }
#pragma unroll
        for (int d0 = 0; d0 < 2; ++d0)
#pragma unroll
            for (int ks = 0; ks < 4; ++ks) {
                const s16x4 lo = vtr(vb + d0 * 4096 + ks * 1024), hi4 = vtr(vb + d0 * 4096 + ks * 1024 + 512);
                const bf16x8 vf = (bf16x8){lo[0], lo[1], lo[2], lo[3], hi4[0], hi4[1], hi4[2], hi4[3]};
                o[d0] = __builtin_amdgcn_mfma_f32_32x32x16_bf16(__builtin_bit_cast(bf16x8, pw[ks]), vf, o[d0], 0, 0, 0);
            }
    }
#undef AT_LOAD
    { auto rr = __builtin_amdgcn_permlane32_swap(__float_as_uint(lsum), __float_as_uint(lsum), false, false); lsum = __uint_as_float(rr[0]) + __uint_as_float(rr[1]); }
    if (hi == 0) wsf[32 + r32] = lsum;
    asm volatile("s_waitcnt lgkmcnt(0)" ::: "memory");
    LAS bf16_t* stg = (LAS bf16_t*)(lds + AT_OST) + wid * 2048;
#pragma unroll
    for (int r = 0; r < 16; ++r) {
        const int orow = crow(r, hi); const float rl = __builtin_amdgcn_rcpf(wsf[32 + orow]);
        stg[orow * 64 + r32] = f2bf(o[0][r] * rl); stg[orow * 64 + 32 + r32] = f2bf(o[1][r] * rl);
    }
    asm volatile("s_waitcnt lgkmcnt(0)" ::: "memory");
    bf16_t* Ow = p.mix + (rowbase + q0 + wid * 32) * D + h * 64;
#pragma unroll
    for (int i = 0; i < 4; ++i) { const int row = i * 8 + (lane >> 3), ch = lane & 7; const u32x4 v = *(const LAS u32x4*)(stg + row * 64 + ch * 8); *(u32x4*)(Ow + (size_t)row * D + ch * 8) = v; }
    __syncthreads();
}
DI void ph_attn(const P& p, LAS unsigned char* lds) {
    const int tid = tid_();
    const int G = gridDim.x, bx = blockIdx.x;
    const int vcu = (G % 8 == 0) ? (bx % 8) * (G / 8) + bx / 8 : bx;
    for (int grp = vcu; grp < 256; grp += G) {
        const int bh = grp >> 1, par = grp & 1;
#pragma unroll 1
        for (int i = 0; i < 8; ++i) {
            const int s = 2 * (i >> 1) + par;
            const int qb = (i & 1) ? 15 - s : s;
            attn_unit(p, lds, bh >> 3, bh & 7, qb, tid);
        }
    }
}

constexpr int GL_QS = 72, GL_VS = 144;
constexpr int GL_QD = 0, GL_KD = 64 * GL_QS * 2, GL_KE = 2 * GL_KD, GL_V = 3 * GL_KD, GL_DEC = GL_V + 64 * GL_VS * 2, GL_BUF = GL_DEC + 256, GL_PART = 2 * GL_BUF, GL_END = GL_PART + 2 * 8 * 64 * 4;
static_assert(GL_END <= 147200, "GLA LDS map");
DI void gla_item(const P& p, LAS unsigned char* lds, int b, int h, int tid) {
    const int lane = tid & 63, w = __builtin_amdgcn_readfirstlane(tid >> 6), l15 = lane & 15, g = lane >> 4, tq = l15 >> 2, tp = l15 & 3;
    const size_t rowb = (size_t)b * SEQ;
    bf16x8 rq, rk; f32x4 la0, la1; u32x4 rvv[2];
#define GL_LOADRAW(n) do { const size_t row_ = rowb + 64 * (n) + lane; const bf16_t* pr_ = p.proj + row_ * LD1; \
        rq = *(const bf16x8*)(pr_ + 1024 + h * 64 + 8 * w); rk = *(const bf16x8*)(pr_ + 1280 + h * 64 + 8 * w); \
        la0 = *(const f32x4*)(p.loga + row_ * 256 + h * 64 + 8 * w); la1 = *(const f32x4*)(p.loga + row_ * 256 + h * 64 + 8 * w + 4); \
        _Pragma("unroll") for (int i_ = 0; i_ < 2; ++i_) { const int c_ = i_ * 512 + tid; rvv[i_] = *(const u32x4*)(p.proj + (rowb + 64 * (n) + (c_ >> 4)) * LD1 + 1536 + h * 128 + (c_ & 15) * 8); } } while (0)
#define GL_P1(buf) do { LAS unsigned char* B_ = lds + (buf) * GL_BUF; \
        float x_[8]; _Pragma("unroll") for (int e = 0; e < 4; ++e) { x_[e] = la0[e]; x_[4 + e] = la1[e]; } \
        _Pragma("unroll") for (int off = 1; off < 64; off <<= 1) { _Pragma("unroll") for (int e = 0; e < 8; ++e) { const float y_ = __shfl_up(x_[e], off); if (lane >= off) x_[e] += y_; } } \
        u32x4 wq_, wk_, we_; \
        _Pragma("unroll") for (int e = 0; e < 8; e += 2) { float qd_[2], kd_[2], ke_[2]; \
            _Pragma("unroll") for (int z = 0; z < 2; ++z) { const float bl_ = __uint_as_float(__builtin_amdgcn_readlane(__float_as_uint(x_[e + z]), 63)); const float eb_ = __expf(x_[e + z]); \
                const float kf_ = bf2f((bf16_t)rk[e + z]); qd_[z] = bf2f((bf16_t)rq[e + z]) * 0.125f * eb_; kd_[z] = kf_ * __builtin_amdgcn_rcpf(eb_); ke_[z] = kf_ * __expf(bl_ - x_[e + z]); \
                if (lane == 63) ((LAS float*)(B_ + GL_DEC))[8 * w + e + z] = eb_; } \
            wq_[e >> 1] = pk2(qd_[0], qd_[1]); wk_[e >> 1] = pk2(kd_[0], kd_[1]); we_[e >> 1] = pk2(ke_[0], ke_[1]); } \
        *(LAS u32x4*)(B_ + GL_QD + (lane * GL_QS + 8 * w) * 2) = wq_; *(LAS u32x4*)(B_ + GL_KD + (lane * GL_QS + 8 * w) * 2) = wk_; *(LAS u32x4*)(B_ + GL_KE + (lane * GL_QS + 8 * w) * 2) = we_; \
        _Pragma("unroll") for (int i_ = 0; i_ < 2; ++i_) { const int c_ = i_ * 512 + tid; *(LAS u32x4*)(B_ + GL_V + ((c_ >> 4) * GL_VS + (c_ & 15) * 8) * 2) = rvv[i_]; } } while (0)
    f32x4 Sacc[4], otile[4]; u32x2 grv[4];
#pragma unroll
    for (int i = 0; i < 4; ++i) { Sacc[i] = (f32x4){0.f, 0.f, 0.f, 0.f}; otile[i] = Sacc[i]; grv[i] = (u32x2){0u, 0u}; }
    const f32x4 gng = *(const f32x4*)(p.gla_norm_g + h * 128 + 16 * w + 4 * g);
    GL_LOADRAW(0); GL_P1(0); GL_LOADRAW(1);
    for (int n = 0; n <= 64; ++n) {
        __syncthreads();
        if (n > 0) {
            const LAS float* PT = (const LAS float*)(lds + GL_PART) + ((n - 1) & 1) * 512;
#pragma unroll
            for (int tt = 0; tt < 4; ++tt) {
                float ss = 0.f;
#pragma unroll
                for (int ww = 0; ww < 8; ++ww) ss += PT[ww * 64 + 16 * tt + l15];
                const float r = rsqrtf(ss * (1.f / 128.f) + EPS);
                const float g0 = __uint_as_float(grv[tt].x << 16), g1 = __uint_as_float(grv[tt].x & 0xffff0000u), g2 = __uint_as_float(grv[tt].y << 16), g3 = __uint_as_float(grv[tt].y & 0xffff0000u);
                u32x2 o2; o2.x = pk2(silu_f(g0) * (otile[tt][0] * r * gng[0]), silu_f(g1) * (otile[tt][1] * r * gng[1]));
                o2.y = pk2(silu_f(g2) * (otile[tt][2] * r * gng[2]), silu_f(g3) * (otile[tt][3] * r * gng[3]));
                *(u32x2*)(p.mix + (rowb + 64 * (n - 1) + 16 * tt + l15) * D + 512 + h * 128 + 16 * w + 4 * g) = o2;
            }
        }
        if (n == 64) break;
        if (n + 1 < 64) { GL_P1((n + 1) & 1); if (n + 2 < 64) GL_LOADRAW(n + 2); }
        const LAS unsigned char* B_ = lds + (n & 1) * GL_BUF;
#pragma unroll
        for (int tt = 0; tt < 4; ++tt) grv[tt] = *(const u32x2*)(p.proj + (rowb + 64 * n + 16 * tt + l15) * LD1 + 2304 + h * 128 + 16 * w + 4 * g);
        bf16x8 kdA[4][2];
#pragma unroll
        for (int st = 0; st < 4; ++st)
#pragma unroll
            for (int ks = 0; ks < 2; ++ks) kdA[st][ks] = *(const LAS bf16x8*)(B_ + GL_KD + ((16 * st + l15) * GL_QS + 32 * ks + 8 * g) * 2);
        bf16x8 vP[2], sA[2];
#pragma unroll
        for (int ks = 0; ks < 2; ++ks) {
            const s16x4 lo = vtr(B_ + GL_V + ((32 * ks + 4 * g + tq) * GL_VS + 16 * w + 4 * tp) * 2), hi4 = vtr(B_ + GL_V + ((32 * ks + 16 + 4 * g + tq) * GL_VS + 16 * w + 4 * tp) * 2);
            vP[ks] = (bf16x8){lo[0], lo[1], lo[2], lo[3], hi4[0], hi4[1], hi4[2], hi4[3]};
            u32x4 sp; sp.x = pk2(Sacc[2 * ks][0], Sacc[2 * ks][1]); sp.y = pk2(Sacc[2 * ks][2], Sacc[2 * ks][3]); sp.z = pk2(Sacc[2 * ks + 1][0], Sacc[2 * ks + 1][1]); sp.w = pk2(Sacc[2 * ks + 1][2], Sacc[2 * ks + 1][3]);
            sA[ks] = __builtin_bit_cast(bf16x8, sp);
        }
        LAS float* PW = (LAS float*)(lds + GL_PART) + (n & 1) * 512 + w * 64;
#pragma unroll
        for (int tt = 0; tt < 4; ++tt) {
            bf16x8 qdB[2], qP[2];
#pragma unroll
            for (int ks = 0; ks < 2; ++ks) {
                qdB[ks] = *(const LAS bf16x8*)(B_ + GL_QD + ((16 * tt + l15) * GL_QS + 32 * ks + 8 * g) * 2);
                const u32x2 a = *(const LAS u32x2*)(B_ + GL_QD + ((16 * tt + l15) * GL_QS + 32 * ks + 4 * g) * 2), c = *(const LAS u32x2*)(B_ + GL_QD + ((16 * tt + l15) * GL_QS + 32 * ks + 16 + 4 * g) * 2);
                qP[ks] = __builtin_bit_cast(bf16x8, (u32x4){a.x, a.y, c.x, c.y});
            }
            f32x4 at[4];
#pragma unroll
            for (int st = 0; st < 4; ++st) {
                at[st] = (f32x4){0.f, 0.f, 0.f, 0.f};
                if (st <= tt) { at[st] = __builtin_amdgcn_mfma_f32_16x16x32_bf16(kdA[st][0], qdB[0], at[st], 0, 0, 0); at[st] = __builtin_amdgcn_mfma_f32_16x16x32_bf16(kdA[st][1], qdB[1], at[st], 0, 0, 0); }
            }
#pragma unroll
            for (int j = 0; j < 4; ++j) if (4 * g + j > l15) at[tt][j] = 0.f;
            f32x4 ot = (f32x4){0.f, 0.f, 0.f, 0.f};
            { u32x4 ab; ab.x = pk2(at[0][0], at[0][1]); ab.y = pk2(at[0][2], at[0][3]); ab.z = pk2(at[1][0], at[1][1]); ab.w = pk2(at[1][2], at[1][3]);
              ot = __builtin_amdgcn_mfma_f32_16x16x32_bf16(vP[0], __builtin_bit_cast(bf16x8, ab), ot, 0, 0, 0); }
            if (tt >= 2) { u32x4 ab; ab.x = pk2(at[2][0], at[2][1]); ab.y = pk2(at[2][2], at[2][3]); ab.z = pk2(at[3][0], at[3][1]); ab.w = pk2(at[3][2], at[3][3]);
              ot = __builtin_amdgcn_mfma_f32_16x16x32_bf16(vP[1], __builtin_bit_cast(bf16x8, ab), ot, 0, 0, 0); }
            ot = __builtin_amdgcn_mfma_f32_16x16x32_bf16(sA[0], qP[0], ot, 0, 0, 0);
            ot = __builtin_amdgcn_mfma_f32_16x16x32_bf16(sA[1], qP[1], ot, 0, 0, 0);
            otile[tt] = ot;
            float ss = ot[0] * ot[0] + ot[1] * ot[1] + ot[2] * ot[2] + ot[3] * ot[3];
            ss += __shfl_xor(ss, 16); ss += __shfl_xor(ss, 32);
            if (g == 0) PW[16 * tt + l15] = ss;
        }
        bf16x8 vN[2];
#pragma unroll
        for (int ks = 0; ks < 2; ++ks) {
            const s16x4 lo = vtr(B_ + GL_V + ((32 * ks + 8 * g + tq) * GL_VS + 16 * w + 4 * tp) * 2), hi4 = vtr(B_ + GL_V + ((32 * ks + 8 * g + 4 + tq) * GL_VS + 16 * w + 4 * tp) * 2);
            vN[ks] = (bf16x8){lo[0], lo[1], lo[2], lo[3], hi4[0], hi4[1], hi4[2], hi4[3]};
        }
#pragma unroll
        for (int dkt = 0; dkt < 4; ++dkt) {
            const f32x4 dc = *(const LAS f32x4*)(B_ + GL_DEC + (16 * dkt + 4 * g) * 4);
            f32x4 sc = Sacc[dkt] * dc;
#pragma unroll
            for (int ks = 0; ks < 2; ++ks) {
                const s16x4 lo = vtr(B_ + GL_KE + ((32 * ks + 8 * g + tq) * GL_QS + 16 * dkt + 4 * tp) * 2), hi4 = vtr(B_ + GL_KE + ((32 * ks + 8 * g + 4 + tq) * GL_QS + 16 * dkt + 4 * tp) * 2);
                const bf16x8 keT = (bf16x8){lo[0], lo[1], lo[2], lo[3], hi4[0], hi4[1], hi4[2], hi4[3]};
                sc = __builtin_amdgcn_mfma_f32_16x16x32_bf16(keT, vN[ks], sc, 0, 0, 0);
            }
            Sacc[dkt] = sc;
        }
    }
    __syncthreads();
#undef GL_LOADRAW
#undef GL_P1
}
constexpr int SG_WS = 136, SG_VS = 144, SG_OS = 132;
constexpr int SG_W = 0, SG_V = 128 * SG_WS * 2, SG_O = SG_V + 128 * SG_VS * 2, SG_END = SG_O + 128 * SG_OS * 4;
static_assert(SG_END <= 147200, "gMLP LDS map");
DI void ph_mix1(const P& p, LAS unsigned char* lds) {
    const int tid = tid_();
    const int G = gridDim.x, bx = blockIdx.x;
    const int nG = (G >= 128) ? 64 : 0;
    if (bx < nG || nG == 0) { for (int it = bx; it < 64; it += (nG ? nG : G)) gla_item(p, lds, it >> 2, it & 3, tid); if (nG) return; }
    const int lane = tid & 63, w = __builtin_amdgcn_readfirstlane(tid >> 6), l15 = lane & 15, gq = lane >> 4, tq = l15 >> 2, tp = l15 & 3;
    int cur_g = -1;
    for (int u = bx - nG; u < 2048; u += G - nG) {
        const int g = u >> 9, bn = u & 511; const size_t r0 = (size_t)bn * 128;
        if (g != cur_g) {
            cur_g = g;
#pragma unroll
            for (int it = 0; it < 4; ++it) { const int c = it * 512 + tid, t = c >> 4, ch = c & 15; const float* src = p.sg_w_s + ((size_t)g * 128 + t) * 128 + ch * 8;
                const f32x4 a = *(const f32x4*)src, b = *(const f32x4*)(src + 4); float v[8] = {a[0], a[1], a[2], a[3], b[0], b[1], b[2], b[3]};
#pragma unroll
                for (int e = 0; e < 8; ++e) if (ch * 8 + e > t) v[e] = 0.f;
                u32x4 wv; wv.x = pk2(v[0], v[1]); wv.y = pk2(v[2], v[3]); wv.z = pk2(v[4], v[5]); wv.w = pk2(v[6], v[7]);
                *(LAS u32x4*)(lds + SG_W + (t * SG_WS + ch * 8) * 2) = wv; }
        }
#pragma unroll
        for (int it = 0; it < 4; ++it) { const int c = it * 512 + tid, s_ = c >> 4, ch = c & 15;
            const u32x4 raw = *(const u32x4*)(p.proj + (r0 + s_) * LD1 + 512 + g * 128 + ch * 8); const float rv = p.rv[r0 + s_];
            u32x4 wv; wv.x = pk2(__uint_as_float(raw.x << 16) * rv, __uint_as_float(raw.x & 0xffff0000u) * rv); wv.y = pk2(__uint_as_float(raw.y << 16) * rv, __uint_as_float(raw.y & 0xffff0000u) * rv);
            wv.z = pk2(__uint_as_float(raw.z << 16) * rv, __uint_as_float(raw.z & 0xffff0000u) * rv); wv.w = pk2(__uint_as_float(raw.w << 16) * rv, __uint_as_float(raw.w & 0xffff0000u) * rv);
            *(LAS u32x4*)(lds + SG_V + (s_ * SG_VS + ch * 8) * 2) = wv; }
        __syncthreads();
        bf16x8 vA[4];
#pragma unroll
        for (int ks = 0; ks < 4; ++ks) {
            const s16x4 lo = vtr(lds + SG_V + ((32 * ks + 8 * gq + tq) * SG_VS + 16 * w + 4 * tp) * 2), hi4 = vtr(lds + SG_V + ((32 * ks + 8 * gq + 4 + tq) * SG_VS + 16 * w + 4 * tp) * 2);
            vA[ks] = (bf16x8){lo[0], lo[1], lo[2], lo[3], hi4[0], hi4[1], hi4[2], hi4[3]};
        }
#pragma unroll
        for (int tt = 0; tt < 8; ++tt) {
            f32x4 acc = (f32x4){0.f, 0.f, 0.f, 0.f};
#pragma unroll
            for (int ks = 0; ks <= tt / 2; ++ks) {
                const bf16x8 wB = *(const LAS bf16x8*)(lds + SG_W + ((16 * tt + l15) * SG_WS + 32 * ks + 8 * gq) * 2);
                acc = __builtin_amdgcn_mfma_f32_16x16x32_bf16(vA[ks], wB, acc, 0, 0, 0);
            }
            *(LAS f32x4*)(lds + SG_O + ((16 * tt + l15) * SG_OS + 16 * w + 4 * gq) * 4) = acc;
        }
        __syncthreads();
#pragma unroll
        for (int it = 0; it < 4; ++it) { const int c = it * 512 + tid, t = c >> 4, ch = c & 15;
            const f32x4 a = *(const LAS f32x4*)(lds + SG_O + (t * SG_OS + ch * 8) * 4), b = *(const LAS f32x4*)(lds + SG_O + (t * SG_OS + ch * 8 + 4) * 4);
            const f32x4 ga = *(const f32x4*)(p.sg_v_norm_g + g * 128 + ch * 8), gb = *(const f32x4*)(p.sg_v_norm_g + g * 128 + ch * 8 + 4);
            const float bs = p.sg_b_s[g * 128 + t];
            const u32x4 uu = *(const u32x4*)(p.proj + (r0 + t) * LD1 + g * 128 + ch * 8);
            u32x4 o;
            o.x = pk2(__uint_as_float(uu.x << 16) * (a[0] * ga[0] + bs), __uint_as_float(uu.x & 0xffff0000u) * (a[1] * ga[1] + bs));
            o.y = pk2(__uint_as_float(uu.y << 16) * (a[2] * ga[2] + bs), __uint_as_float(uu.y & 0xffff0000u) * (a[3] * ga[3] + bs));
            o.z = pk2(__uint_as_float(uu.z << 16) * (b[0] * gb[0] + bs), __uint_as_float(uu.z & 0xffff0000u) * (b[1] * gb[1] + bs));
            o.w = pk2(__uint_as_float(uu.w << 16) * (b[2] * gb[2] + bs), __uint_as_float(uu.w & 0xffff0000u) * (b[3] * gb[3] + bs));
            *(u32x4*)(p.mix + (r0 + t) * D + g * 128 + ch * 8) = o; }
    }
    __syncthreads();
}

enum { PH_PREP = 0, PH_NORM0, PH_IN0, PH_STAT0, PH_UP0, PH_ATTN, PH_OUT0,
       PH_MOE0  , PH_IN1 = PH_MOE0 + 6, PH_STAT1, PH_MIX1, PH_OUT1, PH_MOE1, PH_END = PH_MOE1 + 6 };

typedef __attribute__((address_space(4))) const P* KP;
#if defined(__HIP_DEVICE_COMPILE__)
#define LOADP() ({ KP k_ = kp; asm volatile("" : "+s"(k_)); *k_; })
#else
#define LOADP() (P{})
#endif
__global__ void __launch_bounds__(NTHR, 2) mega(P p_unused, int lo, int hi) {
    (void)p_unused;
    const KP kp = (KP)__builtin_amdgcn_kernarg_segment_ptr();
    extern __shared__ __attribute__((aligned(16))) unsigned char lds_raw[];
    LAS unsigned char* lds = (LAS unsigned char*)lds_raw;
    volatile LAS unsigned* misc = (volatile LAS unsigned*)(lds + LDS_MISC);
    { const int t0 = tid_(); if (t0 < 64) misc[t0] = 0u; }
    __syncthreads();
    XcdBarrier bar; { const P p = LOADP(); bar.bar = p.bar; } bar.x = 0; bar.st = misc + 8;
    if (hi - lo > 1) bar = xcd_barrier_post(bar.bar, misc + 8);
#define IN(k) (lo <= (k) && (k) < hi)
#define SEAM(k) do { if (IN(k) && IN((k) + 1)) xcd_barrier(bar); } while (0)
    const int G = gridDim.x, bx = blockIdx.x;
    if (IN(PH_PREP)) { const P p = LOADP(); ph_prep(p, lds); }
    SEAM(PH_PREP);
    if (IN(PH_NORM0)) { const P p = LOADP(); ph_norm(p, p.x, p.norm_mix_g, 0, 0); }
    SEAM(PH_NORM0);
    if (IN(PH_IN0)) {
        const P p = LOADP();
        g8::Order S; S.init(NTOK / 256, LD0 / 256, G, bx);
        SrcDense X{(unsigned)(D * 2), (const char*)p.wt_in0, (size_t)256 * 1024 * 2};
        g8::Epi<FIn0> E{{p}};
        g8::gemm8(lds, (const char*)p.xa, 1024, S, X, E);
    }
    SEAM(PH_IN0);
    if (IN(PH_STAT0)) { const P p = LOADP(); ph_rowstat0_conv(p); }
    SEAM(PH_STAT0);
    if (IN(PH_UP0)) {
        const P p = LOADP();
        { g8::Order S; S.init(NTOK / 256, 3, G, bx);
          SrcDense X{(unsigned)(LD0 * 2), (const char*)p.wt_uq, (size_t)256 * 256 * 2};
          g8::Epi<FUq> E{{p}};
          g8::gemm8(lds, (const char*)p.proj, 256, S, X, E); }
        { g8::Order S; S.init(NTOK / 256, 4, G, bx);
          SrcDense X{(unsigned)(LD0 * 2), (const char*)p.wt_ukv, (size_t)256 * 128 * 2};
          g8::Epi<FUkv> E{{p}};
          g8::gemm8(lds, (const char*)(p.proj + 256), 128, S, X, E); }
    }
    SEAM(PH_UP0);
    if (IN(PH_ATTN)) { const P p = LOADP(); ph_attn(p, lds); }
    SEAM(PH_ATTN);
    if (IN(PH_OUT0)) {
        const P p = LOADP();
        g8::Order S; S.init(NTOK / 256, 4, G, bx);
        SrcDense X{(unsigned)(D * 2), (const char*)p.wt_out0, (size_t)256 * 1024 * 2};
        g8::Epi<FOut> E{{p, 0, p.x}};
        g8::gemm8(lds, (const char*)p.mix, 1024, S, X, E);
    }
    SEAM(PH_OUT0);
#define MOE_PHASES(l, base) do { \
        if (IN((base) + 0)) { const P p = LOADP(); ph_norm(p, p.out, p.norm_ffn_g + (l) * D, (l), 1); } \
        SEAM((base) + 0); \
        if (IN((base) + 1)) { const P p = LOADP(); ph_router(p, (l), lds); } \
        SEAM((base) + 1); \
        if (IN((base) + 2)) { const P p = LOADP(); ph_slots(p, (l), lds); } \
        SEAM((base) + 2); \
        if (IN((base) + 3)) { \
            const P p = LOADP(); \
            g8::Order S; S.init(p.ntile[(l)], 2, G, bx); \
            SrcMoe<true> X{(unsigned)(D * 2), p.row_tok + (size_t)(l) * MAXSLOT, p.tile_e + (l) * 1024, (const char*)(p.wt_gu + (size_t)(l) * 32 * 512 * 1024), (size_t)512 * 1024 * 2, (size_t)256 * 1024 * 2}; \
            g8::Epi<FGu> E{{p}}; \
            g8::gemm8(lds, (const char*)p.xa, 1024, S, X, E); \
        } \
        SEAM((base) + 3); \
        if (IN((base) + 4)) { \
            const P p = LOADP(); \
            g8::Order S; S.init(p.ntile[(l)], 4, G, bx); \
            SrcMoe<false> X{(unsigned)(DEXP * 2), nullptr, p.tile_e + (l) * 1024, (const char*)(p.wt_dn + (size_t)(l) * 32 * 1024 * 256), (size_t)1024 * 256 * 2, (size_t)256 * 256 * 2}; \
            g8::Epi<FDn> E{{p}}; \
            g8::gemm8(lds, (const char*)p.act, 256, S, X, E); \
        } \
        SEAM((base) + 4); \
        if (IN((base) + 5)) { const P p = LOADP(); ph_combine(p, (l), (l) == 1); } \
    } while (0)
    MOE_PHASES(0, PH_MOE0);
    SEAM(PH_MOE0 + 5);
    if (IN(PH_IN1)) {
        const P p = LOADP();
        g8::Order S; S.init(NTOK / 256, LD1 / 256, G, bx);
        SrcDense X{(unsigned)(D * 2), (const char*)p.wt_in1, (size_t)256 * 1024 * 2};
        g8::Epi<FIn1> E{{p}};
        g8::gemm8(lds, (const char*)p.xa, 1024, S, X, E);
    }
    SEAM(PH_IN1);
    if (IN(PH_STAT1)) { const P p = LOADP(); ph_rowstat1(p); }
    SEAM(PH_STAT1);
    if (IN(PH_MIX1)) { const P p = LOADP(); ph_mix1(p, lds); }
    SEAM(PH_MIX1);
    if (IN(PH_OUT1)) {
        const P p = LOADP();
        g8::Order S; S.init(NTOK / 256, 4, G, bx);
        SrcDense X{(unsigned)(D * 2), (const char*)p.wt_out1, (size_t)256 * 1024 * 2};
        g8::Epi<FOut> E{{p, 1, p.out}};
        g8::gemm8(lds, (const char*)p.mix, 1024, S, X, E);
    }
    SEAM(PH_OUT1);
    MOE_PHASES(1, PH_MOE1);
#undef MOE_PHASES
#undef IN
#undef SEAM
}

static size_t carve(size_t& off, size_t bytes) { const size_t o = off; off += (bytes + 255) & ~(size_t)255; return o; }

extern "C" void kernel_launch(void* const* d_in, const int* in_sizes, int n_in, void* d_out, int out_size, void* d_ws, size_t ws_size, hipStream_t stream) {
    (void)in_sizes; (void)n_in; (void)out_size;
    P p{};
    const float* const* fi = (const float* const*)d_in;
    p.x = fi[0]; p.c = fi[1]; p.pos = (const int*)d_in[2];
    p.adaln_w = fi[3]; p.adaln_b = fi[4]; p.norm_mix_g = fi[5]; p.norm_ffn_g = fi[6]; p.ab_w_in = fi[7]; p.q_norm_g = fi[8]; p.w_uq = fi[9];
    p.kv_norm_g = fi[10]; p.w_ukv = fi[11]; p.conv_w = fi[12]; p.ab_w_out = fi[13]; p.cd_w_in = fi[14]; p.sg_v_norm_g = fi[15]; p.sg_w_s = fi[16];
    p.sg_b_s = fi[17]; p.gla_w_g2 = fi[18]; p.gla_b_g = fi[19]; p.gla_norm_g = fi[20]; p.cd_w_out = fi[21]; p.moe_w_group = fi[22]; p.moe_b_group = fi[23];
    p.moe_w_expert = fi[24]; p.moe_b_expert = fi[25]; p.moe_w_gate_up = fi[26]; p.moe_w_down = fi[27]; p.final_norm_g = fi[28];
    p.out = (float*)d_out;
    char* ws = (char*)d_ws; size_t off = 0;
    const size_t ctl0 = off;
    p.bar = (unsigned*)(ws + carve(off, (size_t)XCD_BAR_WORDS * 4));
    p.cnt = (int*)(ws + carve(off, 2 * 64 * 4));
    p.row_tok = (int*)(ws + carve(off, (size_t)2 * MAXSLOT * 4));
    const size_t ctl_bytes = off - ctl0;
    p.segstart = (int*)(ws + carve(off, 2 * 64 * 4));
    p.ntile = (int*)(ws + carve(off, 256));
    p.tile_e = (int*)(ws + carve(off, 2 * 1024 * 4));
    p.tope = (int*)(ws + carve(off, (size_t)4 * NTOK * 4));
    p.toppos = (int*)(ws + carve(off, (size_t)4 * NTOK * 4));
    p.topslot = (int*)(ws + carve(off, (size_t)4 * NTOK * 4));
    p.topw = (float*)(ws + carve(off, (size_t)4 * NTOK * 4));
    p.mod = (float*)(ws + carve(off, (size_t)2 * 16 * 6144 * 4));
    p.ropec = (float*)(ws + carve(off, (size_t)NTOK * 16 * 4));
    p.ropes = (float*)(ws + carve(off, (size_t)NTOK * 16 * 4));
    p.rq = (float*)(ws + carve(off, (size_t)NTOK * 4));
    p.rkv = (float*)(ws + carve(off, (size_t)NTOK * 4));
    p.rv = (float*)(ws + carve(off, (size_t)NTOK * 4));
    p.wt_in0 = (bf16_t*)(ws + carve(off, WO_END * 2));
    p.wt_uq = p.wt_in0 + WO_UQ; p.wt_ukv = p.wt_in0 + WO_UKV; p.wt_out0 = p.wt_in0 + WO_OUT0; p.wt_in1 = p.wt_in0 + WO_IN1; p.wt_out1 = p.wt_in0 + WO_OUT1;
    p.wt_gu = p.wt_in0 + WO_GU; p.wt_dn = p.wt_in0 + WO_DN; p.wt_r = p.wt_in0 + WO_R;
    p.xa = (bf16_t*)(ws + carve(off, (size_t)NTOK * D * 2));
    p.mix = (bf16_t*)(ws + carve(off, (size_t)NTOK * D * 2));
    const size_t r0 = off;
    p.proj = (bf16_t*)(ws + carve(off, (size_t)NTOK * LD1 * 2));
    size_t o2 = off;
    p.q = (bf16_t*)(ws + carve(o2, (size_t)NTOK * 768 * 2));
    p.kn = (bf16_t*)(ws + carve(o2, (size_t)NTOK * 512 * 2));
    p.v = (bf16_t*)(ws + carve(o2, (size_t)NTOK * 512 * 2));
    p.kpe = (bf16_t*)(ws + carve(o2, (size_t)NTOK * 32 * 2));
    size_t o3 = off;
    p.loga = (float*)(ws + carve(o3, (size_t)NTOK * 256 * 4));
    p.go = (float*)(ws + carve(o3, (size_t)NTOK * 512 * 4));
    size_t o4 = r0;
    p.act = (bf16_t*)(ws + carve(o4, (size_t)MAXSLOT * DEXP * 2));
    p.y = (bf16_t*)(ws + carve(o4, (size_t)MAXSLOT * D * 2));
    if (off > ws_size || o2 > ws_size || o3 > ws_size || o4 > ws_size) return;

    static int grid = 0;
    if (grid == 0) {
        int dev = 0, cus = 0;
        if (hipGetDevice(&dev) != hipSuccess || hipDeviceGetAttribute(&cus, hipDeviceAttributeMultiprocessorCount, dev) != hipSuccess) { grid = -1; return; }
        if (hipFuncSetAttribute((const void*)mega, hipFuncAttributeMaxDynamicSharedMemorySize, LDS_BYTES) != hipSuccess) { grid = -1; return; }
        grid = cus;
    }
    if (grid < 0) return;
    (void)hipMemsetAsync(ws + ctl0, 0, ctl_bytes, stream);
#define RUN(a, b) hipLaunchKernelGGL(mega, dim3(grid), dim3(NTHR), LDS_BYTES, stream, p, (a), (b))
    RUN(PH_PREP, PH_END);
#undef RUN
}
```

```cpp
#include <hip/hip_runtime.h>
#include <stdint.h>
#include <math.h>

typedef unsigned short bf16_t;
typedef short bf16x8 __attribute__((ext_vector_type(8)));
typedef float f32x4 __attribute__((ext_vector_type(4)));
typedef unsigned u32x2 __attribute__((ext_vector_type(2)));
typedef unsigned u32x4 __attribute__((ext_vector_type(4)));
#define DI __device__ __forceinline__
#define LAS __attribute__((address_space(3)))

constexpr int D = 1024, NB = 16, SEQ = 4096, NTOK = NB * SEQ;
constexpr float EPS = 1e-6f;
constexpr int AB_IN = 1952, CD_IN = 2576;
constexpr int LD0 = 2048, LD1 = 2816;
constexpr int DEXP = 256;
constexpr int MAXSLOT = 2 * NTOK + 64 * 256;
constexpr float QSCALE = 0.10206207261596577f * 1.4426950408889634f;
constexpr int NTHR = 512, NWAVE = 8;
constexpr int LDS_BYTES = 147456, LDS_MISC = LDS_BYTES - 256;

DI int tid_() { int t = threadIdx.x; asm volatile("" : "+v"(t)); return t; }
DI float bf2f(bf16_t v) { return __uint_as_float(((unsigned)v) << 16); }
DI bf16_t f2bf(float f) { unsigned u = __float_as_uint(f); return (bf16_t)((u + 0x7fffu + ((u >> 16) & 1u)) >> 16); }
DI unsigned pk2(float lo, float hi) { return (unsigned)f2bf(lo) | ((unsigned)f2bf(hi) << 16); }
DI float wave_sum(float v) {
#pragma unroll
    for (int o = 32; o >= 1; o >>= 1) v += __shfl_xor(v, o);
    return v;
}
typedef float f32x16 __attribute__((ext_vector_type(16)));
typedef short s16x4 __attribute__((ext_vector_type(4)));
typedef short v4i16_t __attribute__((ext_vector_type(4)));
typedef float f32x2_t __attribute__((ext_vector_type(2))); typedef __bf16 bf16x2_t __attribute__((ext_vector_type(2)));
DI unsigned cvtpk(float lo, float hi) { f32x2_t v = {lo, hi}; bf16x2_t b = __builtin_convertvector(v, bf16x2_t); return __builtin_bit_cast(unsigned, b); }
DI int crow(int r, int hi) { return (r & 3) + 8 * (r >> 2) + 4 * hi; }
DI s16x4 vtr(const LAS unsigned char* p) { return __builtin_bit_cast(s16x4, __builtin_amdgcn_ds_read_tr16_b64_v4i16((LAS v4i16_t*)p)); }
DI float silu_f(float v) { return v / (1.f + __expf(-v)); }
DI float gelu_tanh_f(float v) { const float u = 1.5957691216057308f * (v + 0.044715f * v * v * v); return v * __builtin_amdgcn_rcpf(1.f + __expf(-u)); }
DI float log_sigmoid_f(float z) { return fminf(z, 0.f) - __logf(1.f + __expf(-fabsf(z))); }

struct P {
    const float *x, *c; const int* pos;
    const float *adaln_w, *adaln_b, *norm_mix_g, *norm_ffn_g, *ab_w_in, *q_norm_g, *w_uq, *kv_norm_g, *w_ukv, *conv_w, *ab_w_out,
        *cd_w_in, *sg_v_norm_g, *sg_w_s, *sg_b_s, *gla_w_g2, *gla_b_g, *gla_norm_g, *cd_w_out,
        *moe_w_group, *moe_b_group, *moe_w_expert, *moe_b_expert, *moe_w_gate_up, *moe_w_down, *final_norm_g;
    float* out;
    bf16_t *wt_in0, *wt_uq, *wt_ukv, *wt_out0, *wt_in1, *wt_out1, *wt_gu, *wt_dn, *wt_r;
    float *mod, *ropec, *ropes;
    bf16_t *xa, *xr, *proj, *q, *kn, *v, *kpe, *mix, *act, *y;
    float *rq, *rkv, *rv, *loga, *gdec, *topw;
    bf16_t *gqd, *gkd, *gkv, *gst;
    int *tope, *toppos, *topslot, *whist, *ntile, *tile_e, *row_tok;
    unsigned* bar;
};

#define XB_TMO      128
#define XB_XCNT(j)  (256  + 64 * (j))
#define XB_XSUB(j)  (1280 + 64 * (j))
#define XB_XGEN(j)  (2304 + 64 * (j))
#define XB_TOP      3328
#define XB_TOPGEN   3392
#define XCD_BAR_WORDS 3456
#define XB_SPIN_CAP (1u << 18)
__device__ __forceinline__ unsigned xb_ld(unsigned* p)              { return __hip_atomic_load(p, __ATOMIC_RELAXED, __HIP_MEMORY_SCOPE_AGENT); }
__device__ __forceinline__ unsigned xb_add(unsigned* p, unsigned v) { return __hip_atomic_fetch_add(p, v, __ATOMIC_RELAXED, __HIP_MEMORY_SCOPE_AGENT); }
__device__ __forceinline__ unsigned xb_xcc_id() { return (unsigned)__builtin_amdgcn_s_getreg((3 << 11) | 20) & 0xFu; }
#define XB_SPIN(cond, bar) do { unsigned _sp = 0; while (cond) { __builtin_amdgcn_s_sleep(1); \
    if ((++_sp & 255u) == 0u) { if (xb_ld(&(bar)[XB_TMO])) break; if (_sp > XB_SPIN_CAP) { atomicAdd(&(bar)[XB_TMO], 1u); break; } } } } while (0)
struct XcdBarrier { unsigned* bar; unsigned x; volatile LAS unsigned* st; };
__device__ __forceinline__ XcdBarrier xcd_barrier_post(unsigned* bar, volatile LAS unsigned* st) {
    XcdBarrier b; b.bar = bar; b.x = xb_xcc_id(); b.st = st;
    if (threadIdx.x == 0) (void)xb_add(&bar[XB_XCNT(b.x)], 1u);
    return b;
}
__device__ __forceinline__ void xcd_barrier_complete(unsigned* bar, unsigned x, unsigned& nloc, unsigned& nx) {
    const unsigned G = gridDim.x * gridDim.y * gridDim.z;
    unsigned sum, cnt, mine, sp = 0u;
    for (;;) {
        sum = 0u; cnt = 0u; mine = 0u;
#pragma unroll
        for (unsigned j = 0; j < 16; ++j) { const unsigned c = xb_ld(&bar[XB_XCNT(j)]); sum += c; cnt += (c > 0u) ? 1u : 0u; mine = (j == x) ? c : mine; }
        if (sum == G) break;
        __builtin_amdgcn_s_sleep(1);
        if ((++sp & 255u) == 0u) { if (xb_ld(&bar[XB_TMO])) break; if (sp > XB_SPIN_CAP) { atomicAdd(&bar[XB_TMO], 1u); break; } }
    }
    nloc = mine > 0u ? mine : 1u; nx = cnt > 0u ? cnt : 1u;
}
__device__ __forceinline__ void xcd_barrier(const XcdBarrier& b) {
    asm volatile("s_waitcnt vmcnt(0)" ::: "memory");
    __syncthreads();
    if (threadIdx.x == 0) {
        unsigned* bar = b.bar;
        __builtin_amdgcn_s_waitcnt(0);
        unsigned nloc = b.st[0], nx = b.st[1];
        if (nloc == 0u) { xcd_barrier_complete(bar, b.x, nloc, nx); b.st[0] = nloc; b.st[1] = nx; }
        const unsigned old = xb_add(&bar[XB_XSUB(b.x)], 1u);
        const unsigned gen = old / nloc;
        if (old + 1u == (gen + 1u) * nloc) {
            __builtin_amdgcn_fence(__ATOMIC_RELEASE, "agent");
            asm volatile("s_waitcnt vmcnt(0)" ::: "memory");
            const unsigned og = xb_add(&bar[XB_TOP], 1u);
            const unsigned tg = og / nx;
            if (og + 1u == (tg + 1u) * nx) xb_add(&bar[XB_TOPGEN], 1u);
            else XB_SPIN(xb_ld(&bar[XB_TOPGEN]) == tg, bar);
            __builtin_amdgcn_fence(__ATOMIC_ACQUIRE, "agent");
            xb_add(&bar[XB_XGEN(b.x)], 1u);
            asm volatile("s_waitcnt vmcnt(0)" ::: "memory");
        } else {
            XB_SPIN(xb_ld(&bar[XB_XGEN(b.x)]) == gen, bar);
            __builtin_amdgcn_fence(__ATOMIC_ACQUIRE, "agent");
            asm volatile("s_waitcnt vmcnt(0)" ::: "memory");
        }
    }
    __syncthreads();
}

namespace g8 {
constexpr int BM = 256, BK = 64, HALF = 128, HTB = HALF * BK * 2, NXCD = 8, WGM = 8;
__host__ __device__ __forceinline__ int lds_byte(int r, int c) { const int st = (r >> 4) * 2 + (c >> 5), rr = r & 15, cc = c & 31, ob = rr * 64 + cc * 2; return st * 1024 + (ob ^ (((ob >> 9) & 1) << 5)); }
__host__ __device__ __forceinline__ void stage_rc(int b, int& R, int& C) { const int st = b / 1024, sb = b % 1024, swz = sb ^ (((sb >> 9) & 1) << 5); R = (st >> 1) * 16 + swz / 64; C = (st & 1) * 32 + (swz % 64) / 2; }
__host__ __device__ __forceinline__ int perm32(int rho) { const int n = rho >> 4, i = rho & 15; return 8 * (i >> 2) + 4 * n + (i & 3); }
struct Unit { int pm, pn; };
struct Order {
    int nM, nN, nwg, G, c;
    DI void init(int nM_, int nN_, int G_, int c_) { nM = nM_; nN = nN_; nwg = nM * nN; G = G_; c = c_; }
    DI bool next(int i, Unit& u) const {
        const long L = (long)i * G + c; if (L >= nwg) return false;
        int wgid = (int)L; { const int q = nwg / NXCD, r = nwg % NXCD, xcd = wgid % NXCD, off = wgid / NXCD; wgid = (xcd < r ? xcd * (q + 1) : r * (q + 1) + (xcd - r) * q) + off; }
        const int nig = WGM * nN, gid = wgid / nig, fm = gid * WGM, gsz = (nM - fm) < WGM ? (nM - fm) : WGM;
        u.pm = fm + ((wgid % nig) % gsz); u.pn = (wgid % nig) / gsz; return true;
    }
};
template <class Epi, class Src>
__device__ __forceinline__ void gemm8(LAS unsigned char* lds, const char* A, int K_, const Order& S, const Src& X, const Epi& E) {
    int K = K_;
    int tid = threadIdx.x; asm volatile("" : "+v"(tid));
    const int wid = __builtin_amdgcn_readfirstlane(tid >> 6), lane = tid & 63, wr = wid >> 2, wc = wid & 3, fr = lane & 15, fq = lane >> 4;
    asm volatile("" : "+s"(K));
    const int nt = K / BK;
    int Rr[2], Cc[2]; unsigned voffA[2], voffB[2];
#pragma unroll
    for (int i = 0; i < 2; ++i) { int R, C; stage_rc(tid * 16 + i * 8192, R, C); Rr[i] = R; Cc[i] = C * 2; const int Rb = Epi::PERM ? ((R & ~31) + perm32(R & 31)) : R;
        voffA[i] = (unsigned)R * X.lda + (unsigned)C * 2u; voffB[i] = (unsigned)(Rb * K + C) * 2u; }
    const size_t kstep = (size_t)(BK * 2);
    const size_t hstepB = (size_t)HALF * K * 2;
    const size_t hstepA = (size_t)HALF * X.lda;
    const unsigned ldsw = (unsigned)wid * 1024u;
    const int aoff = lds_byte(wr * 64 + fr, fq * 8), boff = lds_byte(wc * 32 + fr, fq * 8);
#define G8_SA(b, h) (((b) * 2 + (h)) * HTB)
#define G8_SB(b, h) ((4 + (b) * 2 + (h)) * HTB)
#define G8_STAGEB(bufoff, gbase) do { _Pragma("unroll") for (int _i = 0; _i < 2; ++_i) \
        __builtin_amdgcn_global_load_lds((const unsigned*)((const char*)(gbase) + voffB[_i]), (LAS unsigned*)(lds + (bufoff) + ldsw + _i * 8192), 16, 0, 0); } while (0)
#define G8_STAGEA(bufoff, ub, o0, o1) do { \
        __builtin_amdgcn_global_load_lds((const unsigned*)((const char*)(ub) + (o0)), (LAS unsigned*)(lds + (bufoff) + ldsw), 16, 0, 0); \
        __builtin_amdgcn_global_load_lds((const unsigned*)((const char*)(ub) + (o1)), (LAS unsigned*)(lds + (bufoff) + ldsw + 8192), 16, 0, 0); } while (0)
#define G8_LDA(dst, b, h) do { _Pragma("unroll") for (int m = 0; m < 4; ++m) _Pragma("unroll") for (int k = 0; k < 2; ++k) dst[m][k] = *(const LAS bf16x8*)(lds + G8_SA(b, h) + aoff + m * 2048 + k * 1024); } while (0)
#define G8_LDB(dst, b, h) do { _Pragma("unroll") for (int n = 0; n < 2; ++n) _Pragma("unroll") for (int k = 0; k < 2; ++k) dst[n][k] = *(const LAS bf16x8*)(lds + G8_SB(b, h) + boff + n * 2048 + k * 1024); } while (0)
#define G8_MMA(ai, bj, At, Bt) do { __builtin_amdgcn_s_setprio(1); _Pragma("unroll") for (int m = 0; m < 4; ++m) _Pragma("unroll") for (int n = 0; n < 2; ++n) _Pragma("unroll") for (int k = 0; k < 2; ++k) \
        acc[ai][bj][m][n] = __builtin_amdgcn_mfma_f32_16x16x32_bf16(Bt[n][k], At[m][k], acc[ai][bj][m][n], 0, 0, 0); __builtin_amdgcn_s_setprio(0); } while (0)
#define G8_WAIT_V(n) asm volatile("s_waitcnt vmcnt(" #n ")" ::: "memory")
#define G8_WAIT_L(n) asm volatile("s_waitcnt lgkmcnt(" #n ")" ::: "memory")
#define G8_BAR __builtin_amdgcn_s_barrier()
#define G8_SCHED __builtin_amdgcn_sched_barrier(0)
    Unit cur, nxt; int ui = 0;
    if (!S.next(0, cur)) return;
    f32x4 acc[2][2][4][2];
#pragma unroll
    for (int a = 0; a < 2; ++a)
#pragma unroll
        for (int b = 0; b < 2; ++b)
#pragma unroll
            for (int m = 0; m < 4; ++m)
#pragma unroll
                for (int n = 0; n < 2; ++n) acc[a][b][m][n] = (f32x4){0.f, 0.f, 0.f, 0.f};
    bf16x8 At[4][2], B0[2][2], B1[2][2];
    unsigned c00 = 0, c01 = 0, c10 = 0, c11 = 0; const char* cA = A;
    if constexpr (Src::GATHER) { c00 = X.a_off(cur, 0, Rr[0]) + Cc[0]; c01 = X.a_off(cur, 0, Rr[1]) + Cc[1]; c10 = X.a_off(cur, 1, Rr[0]) + Cc[0]; c11 = X.a_off(cur, 1, Rr[1]) + Cc[1]; }
    else cA = A + (size_t)cur.pm * 2 * hstepA;
    const char* cB = X.b_ptr(cur);
    G8_STAGEB(G8_SB(0, 0), cB); G8_STAGEB(G8_SB(0, 1), cB + hstepB);
    if constexpr (Src::GATHER) { G8_STAGEA(G8_SA(0, 0), A, c00, c01); G8_STAGEA(G8_SA(0, 1), A, c10, c11); }
    else { G8_STAGEA(G8_SA(0, 0), cA, voffA[0], voffA[1]); G8_STAGEA(G8_SA(0, 1), cA + hstepA, voffA[0], voffA[1]); }
    if (wr == 1) G8_BAR;
    G8_WAIT_V(2); G8_BAR;
    G8_STAGEB(G8_SB(1, 0), cB + kstep);
    if constexpr (Src::GATHER) G8_STAGEA(G8_SA(1, 0), A + kstep, c00, c01); else G8_STAGEA(G8_SA(1, 0), cA + kstep, voffA[0], voffA[1]);
    G8_STAGEB(G8_SB(1, 1), cB + hstepB + kstep);
    G8_WAIT_V(6); G8_BAR;
    for (;;) {
        const bool has_next = S.next(ui + 1, nxt);
        unsigned n00 = c00, n01 = c01, n10 = c10, n11 = c11; const char* nB = cB; const char* nA = cA;
        if (has_next) {
            if constexpr (Src::GATHER) { n00 = X.a_off(nxt, 0, Rr[0]) + Cc[0]; n01 = X.a_off(nxt, 0, Rr[1]) + Cc[1]; n10 = X.a_off(nxt, 1, Rr[0]) + Cc[0]; n11 = X.a_off(nxt, 1, Rr[1]) + Cc[1]; }
            else nA = A + (size_t)nxt.pm * 2 * hstepA;
            nB = X.b_ptr(nxt);
        }
        for (int t = 0; t < nt; t += 2) {
            const bool last = (t == nt - 2);
            const size_t k1 = (size_t)(t + 1) * kstep;
            const size_t k2 = last ? 0 : (size_t)(t + 2) * kstep, k3 = k2 + kstep;
            const char* b2 = (last ? nB : cB) + k2; const char* b3 = b2 + kstep;
            if constexpr (Src::GATHER) {
            const unsigned a00 = last ? n00 : c00, a01 = last ? n01 : c01, a10 = last ? n10 : c10, a11 = last ? n11 : c11;
            G8_LDB(B0, 0, 0); G8_LDB(B1, 0, 1); G8_SCHED; G8_LDA(At, 0, 0); G8_STAGEA(G8_SA(1, 1), A + k1, c10, c11);
            G8_WAIT_V(8); G8_WAIT_L(0); G8_BAR; G8_MMA(0, 0, At, B0); G8_MMA(0, 1, At, B1); G8_BAR; G8_SCHED;
            G8_LDA(At, 0, 1); G8_STAGEB(G8_SB(0, 0), b2); G8_STAGEB(G8_SB(0, 1), b2 + hstepB); G8_STAGEA(G8_SA(0, 0), A + k2, a00, a01);
            G8_WAIT_V(8); G8_WAIT_L(0); G8_BAR; G8_MMA(1, 0, At, B0); G8_MMA(1, 1, At, B1); G8_BAR; G8_SCHED;
            G8_LDB(B0, 1, 0); G8_LDB(B1, 1, 1); G8_SCHED; G8_LDA(At, 1, 0); G8_STAGEA(G8_SA(0, 1), A + k2, a10, a11);
            G8_WAIT_V(8); G8_WAIT_L(0); G8_BAR; G8_MMA(0, 0, At, B0); G8_MMA(0, 1, At, B1); G8_BAR; G8_SCHED;
            G8_LDA(At, 1, 1); G8_STAGEB(G8_SB(1, 0), b3); G8_STAGEB(G8_SB(1, 1), b3 + hstepB); G8_STAGEA(G8_SA(1, 0), A + k3, a00, a01);
            G8_WAIT_V(8); G8_WAIT_L(0); G8_BAR; G8_MMA(1, 0, At, B0); G8_MMA(1, 1, At, B1); G8_BAR; G8_SCHED;
            } else {
            const char* a1 = cA + k1; const char* a2 = (last ? nA : cA) + k2; const char* a3 = a2 + kstep;
            G8_LDB(B0, 0, 0); G8_LDB(B1, 0, 1); G8_SCHED; G8_LDA(At, 0, 0); G8_STAGEA(G8_SA(1, 1), a1 + hstepA, voffA[0], voffA[1]);
            G8_WAIT_V(8); G8_WAIT_L(0); G8_BAR; G8_MMA(0, 0, At, B0); G8_MMA(0, 1, At, B1); G8_BAR; G8_SCHED;
            G8_LDA(At, 0, 1); G8_STAGEB(G8_SB(0, 0), b2); G8_STAGEB(G8_SB(0, 1), b2 + hstepB); G8_STAGEA(G8_SA(0, 0), a2, voffA[0], voffA[1]);
            G8_WAIT_V(8); G8_WAIT_L(0); G8_BAR; G8_MMA(1, 0, At, B0); G8_MMA(1, 1, At, B1); G8_BAR; G8_SCHED;
            G8_LDB(B0, 1, 0); G8_LDB(B1, 1, 1); G8_SCHED; G8_LDA(At, 1, 0); G8_STAGEA(G8_SA(0, 1), a2 + hstepA, voffA[0], voffA[1]);
            G8_WAIT_V(8); G8_WAIT_L(0); G8_BAR; G8_MMA(0, 0, At, B0); G8_MMA(0, 1, At, B1); G8_BAR; G8_SCHED;
            G8_LDA(At, 1, 1); G8_STAGEB(G8_SB(1, 0), b3); G8_STAGEB(G8_SB(1, 1), b3 + hstepB); G8_STAGEA(G8_SA(1, 0), a3, voffA[0], voffA[1]);
            G8_WAIT_V(8); G8_WAIT_L(0); G8_BAR; G8_MMA(1, 0, At, B0); G8_MMA(1, 1, At, B1); G8_BAR; G8_SCHED;
            }
        }
        if (wr == 0) G8_BAR;
        E(acc, cur, wr, wc, fr, fq);
        if (!has_next) break;
#pragma unroll
        for (int a = 0; a < 2; ++a)
#pragma unroll
            for (int b = 0; b < 2; ++b)
#pragma unroll
                for (int m = 0; m < 4; ++m)
#pragma unroll
                    for (int n = 0; n < 2; ++n) acc[a][b][m][n] = (f32x4){0.f, 0.f, 0.f, 0.f};
        cur = nxt; c00 = n00; c01 = n01; c10 = n10; c11 = n11; cB = nB; cA = nA; ++ui;
        if (wr == 1) G8_BAR;
    }
    G8_WAIT_V(0);
    G8_BAR;
#undef G8_SA
#undef G8_SB
#undef G8_STAGEA
#undef G8_STAGEB
#undef G8_LDA
#undef G8_LDB
#undef G8_MMA
#undef G8_WAIT_V
#undef G8_WAIT_L
#undef G8_BAR
#undef G8_SCHED
}
template <class F> struct Epi {
    static constexpr bool PERM = F::PERM;
    F f;
    DI void operator()(const f32x4 (&acc)[2][2][4][2], const Unit& u, int wr, int wc, int fr, int fq) const {
#pragma unroll
        for (int ai = 0; ai < 2; ++ai)
#pragma unroll
            for (int m = 0; m < 4; ++m) {
                const int row = u.pm * BM + ai * HALF + wr * 64 + m * 16 + fr;
                __builtin_amdgcn_sched_barrier(0);
#pragma unroll
                for (int bj = 0; bj < 2; ++bj) {
                    if constexpr (F::PERM) { f.e8(row, u.pn * BM + bj * HALF + wc * 32 + 8 * fq, acc[ai][bj][m][0], acc[ai][bj][m][1], u); }
                    else {
#pragma unroll
                        for (int n = 0; n < 2; ++n) f.e4(row, u.pn * BM + bj * HALF + wc * 32 + 16 * n + 4 * fq, acc[ai][bj][m][n], u);
                    }
                }
            }
    }
};
}

DI void store_bf8(bf16_t* dst, const f32x4& a, const f32x4& b) { u32x4 w; w.x = pk2(a[0], a[1]); w.y = pk2(a[2], a[3]); w.z = pk2(b[0], b[1]); w.w = pk2(b[2], b[3]); *(u32x4*)dst = w; }
DI void rope8(const P& p, int row, int i0, f32x4& a, f32x4& b) {
    const f32x4 c = *(const f32x4*)(p.ropec + (size_t)row * 16 + i0), s = *(const f32x4*)(p.ropes + (size_t)row * 16 + i0);
    f32x4 oa, ob;
    oa[0] = a[0] * c[0] - a[1] * s[0]; oa[1] = a[0] * s[0] + a[1] * c[0]; oa[2] = a[2] * c[1] - a[3] * s[1]; oa[3] = a[2] * s[1] + a[3] * c[1];
    ob[0] = b[0] * c[2] - b[1] * s[2]; ob[1] = b[0] * s[2] + b[1] * c[2]; ob[2] = b[2] * c[3] - b[3] * s[3]; ob[3] = b[2] * s[3] + b[3] * c[3];
    a = oa; b = ob;
}
struct SrcDense {
    static constexpr bool GATHER = false;
    unsigned lda; const char* B; size_t bt;
    DI unsigned a_off(const g8::Unit&, int, int) const { return 0u; }
    DI const char* b_ptr(const g8::Unit& u) const { return B + (size_t)u.pn * bt; }
};
template <bool G_> struct SrcMoe {
    static constexpr bool GATHER = G_;
    unsigned lda; const int* rt; const int* te; const char* B; size_t be, bt;
    DI unsigned a_off(const g8::Unit& u, int h, int R) const { return (unsigned)rt[u.pm * 256 + h * 128 + R] * lda; }
    DI const char* b_ptr(const g8::Unit& u) const { return B + (size_t)te[u.pm] * be + (size_t)u.pn * bt; }
};
struct FIn0 { static constexpr bool PERM = true; const P& p;
    DI void e8(int row, int col, f32x4 a, f32x4 b, const g8::Unit&) const {
        if (col >= 384 && col < 416) { rope8(p, row, (col - 384) >> 1, a, b); store_bf8(p.kpe + (size_t)row * 32 + (col - 384), a, b); }
        else if (col < AB_IN) store_bf8(p.proj + (size_t)row * LD0 + col, a, b);
    } };
struct FUq { static constexpr bool PERM = true; const P& p;
    DI void e8(int row, int col, f32x4 a, f32x4 b, const g8::Unit&) const {
        const float r = p.rq[row] * QSCALE; a = a * r; b = b * r;
        if (((col >> 5) % 3) == 2) rope8(p, row, (col & 31) >> 1, a, b);
        store_bf8(p.q + (size_t)row * 768 + col, a, b);
    } };
struct FUkv { static constexpr bool PERM = true; const P& p;
    DI void e8(int row, int col, f32x4 a, f32x4 b, const g8::Unit&) const {
        const float r = p.rkv[row]; a = a * r; b = b * r;
        if (col < 512) store_bf8(p.kn + (size_t)row * 512 + col, a, b); else store_bf8(p.v + (size_t)row * 512 + (col - 512), a, b);
    } };
struct FOut { static constexpr bool PERM = true; const P& p; int l;
    DI void e8(int row, int col, const f32x4& a, const f32x4& b, const g8::Unit&) const {
        const int bb = row >> 12;
        const float* gp = p.mod + ((size_t)l * 16 + bb) * 6144 + 2048 + col;
        const f32x4 g0 = *(const f32x4*)gp, g1 = *(const f32x4*)(gp + 4);
        f32x4 x0, x1;
        if (l == 0) { const float* xp = p.x + (size_t)row * D + col; x0 = *(const f32x4*)xp; x1 = *(const f32x4*)(xp + 4); }
        else { const u32x4 r = *(const u32x4*)(p.xr + (size_t)row * D + col);
            x0 = (f32x4){__uint_as_float(r.x << 16), __uint_as_float(r.x & 0xffff0000u), __uint_as_float(r.y << 16), __uint_as_float(r.y & 0xffff0000u)};
            x1 = (f32x4){__uint_as_float(r.z << 16), __uint_as_float(r.z & 0xffff0000u), __uint_as_float(r.w << 16), __uint_as_float(r.w & 0xffff0000u)}; }
        store_bf8(p.xr + (size_t)row * D + col, x0 + g0 * a, x1 + g1 * b);
    } };
struct FIn1 { static constexpr bool PERM = true; const P& p;
    DI void e8(int row, int col, f32x4 a, f32x4 b, const g8::Unit&) const {
        if (col < 1024) {
#pragma unroll
            for (int e = 0; e < 4; ++e) { a[e] = gelu_tanh_f(a[e]); b[e] = gelu_tanh_f(b[e]); }
        } else if (col >= 2048 && col < 2304) {
            const float* bg = p.gla_b_g + (col - 2048); f32x4 o0, o1;
#pragma unroll
            for (int e = 0; e < 4; ++e) { o0[e] = log_sigmoid_f(a[e] + bg[e]) * (1.f / 16.f); o1[e] = log_sigmoid_f(b[e] + bg[4 + e]) * (1.f / 16.f); }
            float* dst = p.loga + (size_t)row * 256 + (col - 2048);
            *(f32x4*)dst = o0; *(f32x4*)(dst + 4) = o1;
            return;
        }
        store_bf8(p.proj + (size_t)row * LD1 + col, a, b);
    } };
struct FGu { static constexpr bool PERM = true; const P& p;
    DI void e8(int row, int col, const f32x4& a, const f32x4& b, const g8::Unit&) const {
        u32x2 w; w.x = pk2(silu_f(a[0]) * a[1], silu_f(a[2]) * a[3]); w.y = pk2(silu_f(b[0]) * b[1], silu_f(b[2]) * b[3]);
        *(u32x2*)(p.act + (size_t)row * DEXP + (col >> 1)) = w;
    } };
struct FDn { static constexpr bool PERM = true; const P& p;
    DI void e8(int row, int col, const f32x4& a, const f32x4& b, const g8::Unit&) const { store_bf8(p.y + (size_t)row * D + col, a, b); } };

enum { J_IN0 = 0, J_UQ, J_UKV, J_OUT0, J_IN1, J_OUT1, J_GU, J_DN, J_R, J_NUM };
DI float wval(const P& p, int job, int sub, int k, int n) {
    switch (job) {
    case J_IN0: {
        if (n >= AB_IN) return 0.f;
        int src = n;
        if (n >= 384 && n < 416) { const int i = n - 384; src = 384 + (i >> 1) + (i & 1) * 16; }
        return p.ab_w_in[(size_t)k * AB_IN + src];
    }
    case J_UQ: {
        const int h = n / 96, j = n % 96; int src = 96 * h + j;
        if (j >= 64) { const int i = j - 64; src = 96 * h + 64 + (i >> 1) + (i & 1) * 16; }
        return p.w_uq[(size_t)k * 768 + src] * p.q_norm_g[k];
    }
    case J_UKV: {
        int src;
        if (n < 512) { src = 128 * (n >> 6) + (n & 63); } else { const int m = n - 512; src = 128 * (m >> 6) + 64 + (m & 63); }
        return p.w_ukv[(size_t)k * 1024 + src] * p.kv_norm_g[k];
    }
    case J_OUT0: return p.ab_w_out[(size_t)k * 1024 + n];
    case J_IN1: {
        if (n < 2048) return p.cd_w_in[(size_t)k * CD_IN + n];
        if (n < 2304) { const int j = n - 2048; float s = 0.f;
#pragma unroll
            for (int r = 0; r < 16; ++r) s += p.cd_w_in[(size_t)k * CD_IN + 2048 + r] * p.gla_w_g2[r * 256 + j];
            return s; }
        return p.cd_w_in[(size_t)k * CD_IN + 2064 + (n - 2304)];
    }
    case J_OUT1: return p.cd_w_out[(size_t)k * 1024 + n];
    case J_GU: { const int j = n >> 1; const int src = (n & 1) ? 256 + j : j; return p.moe_w_gate_up[((size_t)sub * 1024 + k) * 512 + src]; }
    case J_DN: return p.moe_w_down[((size_t)sub * 256 + k) * 1024 + n];
    case J_R: { if (n < 4) return p.moe_w_group[((size_t)sub * 1024 + k) * 4 + n]; if (n < 36) return p.moe_w_expert[((size_t)sub * 1024 + k) * 32 + (n - 4)]; return 0.f; }
    }
    return 0.f;
}
struct JobInfo { int K, N, nsub; };
DI JobInfo job_info(int job) {
    switch (job) {
    case J_IN0: return {1024, LD0, 1};
    case J_UQ: return {256, 768, 1};
    case J_UKV: return {128, 1024, 1};
    case J_OUT0: return {1024, 1024, 1};
    case J_IN1: return {1024, LD1, 1};
    case J_OUT1: return {1024, 1024, 1};
    case J_GU: return {1024, 512, 64};
    case J_DN: return {256, 1024, 64};
    default: return {1024, 64, 2};
    }
}
constexpr size_t WO_IN0 = 0, WO_UQ = WO_IN0 + (size_t)LD0 * 1024, WO_UKV = WO_UQ + 768 * 256, WO_OUT0 = WO_UKV + 1024 * 128, WO_IN1 = WO_OUT0 + 1024 * 1024,
    WO_OUT1 = WO_IN1 + (size_t)LD1 * 1024, WO_GU = WO_OUT1 + 1024 * 1024, WO_DN = WO_GU + (size_t)64 * 512 * 1024, WO_R = WO_DN + (size_t)64 * 1024 * 256, WO_END = WO_R + 2 * 64 * 1024;
DI size_t job_dst_off(int job) {
    switch (job) {
    case J_IN0: return WO_IN0; case J_UQ: return WO_UQ; case J_UKV: return WO_UKV; case J_OUT0: return WO_OUT0;
    case J_IN1: return WO_IN1; case J_OUT1: return WO_OUT1; case J_GU: return WO_GU; case J_DN: return WO_DN; default: return WO_R;
    }
}
DI void ph_prep(const P& p, LAS unsigned char* lds) {
    const int tid = tid_();
    if (blockIdx.x < 192) {
        LAS float* cact = (LAS float*)lds;
        LAS float* red = cact + 16 * 1024;
        for (int i = tid; i < 16 * 1024; i += NTHR) cact[i] = silu_f(p.c[i]);
        __syncthreads();
        const int col = tid & 63, ks = tid >> 6;
        for (int item = blockIdx.x; item < 192; item += gridDim.x) {
            const int l = item / 96, j = (item % 96) * 64 + col;
            float acc[16];
#pragma unroll
            for (int b = 0; b < 16; ++b) acc[b] = 0.f;
            const float* W = p.adaln_w + (size_t)l * 1024 * 6144 + j;
            for (int k = ks * 128; k < ks * 128 + 128; ++k) {
                const float w = W[(size_t)k * 6144];
#pragma unroll
                for (int b = 0; b < 16; ++b) acc[b] += cact[b * 1024 + k] * w;
            }
#pragma unroll
            for (int b = 0; b < 16; ++b) red[(ks * 16 + b) * 64 + col] = acc[b];
            __syncthreads();
            for (int i = tid; i < 1024; i += NTHR) {
                const int b = i >> 6, cc = i & 63; float s = 0.f;
#pragma unroll
                for (int q = 0; q < 8; ++q) s += red[(q * 16 + b) * 64 + cc];
                const int jj = (item % 96) * 64 + cc;
                p.mod[((size_t)l * 16 + b) * 6144 + jj] = s + p.adaln_b[l * 6144 + jj];
            }
            __syncthreads();
        }
    }
    {
        const int lane = tid & 63, wid = tid >> 6;
        LAS float* scr = (LAS float*)lds + wid * (64 * 33);
        int total = 0;
#pragma unroll
        for (int j = 0; j < J_NUM; ++j) { const JobInfo ji = job_info(j); total += (ji.K / 64) * (ji.N / 32) * ji.nsub; }
        for (int item = blockIdx.x * NWAVE + wid; item < total; item += gridDim.x * NWAVE) {
            int job = 0, jstart = 0, accn = 0;
#pragma unroll
            for (int j = 0; j < J_NUM; ++j) { const JobInfo jj = job_info(j); if (item >= accn) { job = j; jstart = accn; } accn += (jj.K / 64) * (jj.N / 32) * jj.nsub; }
            const JobInfo ji = job_info(job);
            int r = item - jstart;
            const int kt = ji.K / 64, nt = ji.N / 32;
            const int sub = r / (kt * nt); r -= sub * kt * nt;
            const int n0 = (r / kt) * 32, k0 = (r % kt) * 64;
#pragma unroll 8
            for (int i = 0; i < 32; ++i) { const int kk = 2 * i + (lane >> 5); scr[kk * 33 + (lane & 31)] = wval(p, job, sub, k0 + kk, n0 + (lane & 31)); }
            asm volatile("s_waitcnt lgkmcnt(0)" ::: "memory");
            bf16_t* dst = p.wt_in0 + job_dst_off(job) + (size_t)sub * ji.K * ji.N;
            const int c = lane & 7;
#pragma unroll
            for (int j = 0; j < 4; ++j) { const int n = (lane >> 3) + 8 * j; const LAS float* sp = scr + (8 * c) * 33 + n;
                u32x4 o; o.x = pk2(sp[0 * 33], sp[1 * 33]); o.y = pk2(sp[2 * 33], sp[3 * 33]); o.z = pk2(sp[4 * 33], sp[5 * 33]); o.w = pk2(sp[6 * 33], sp[7 * 33]);
                *(u32x4*)(dst + (size_t)(n0 + n) * ji.K + k0 + 8 * c) = o; }
            asm volatile("s_waitcnt lgkmcnt(0)" ::: "memory");
        }
    }
    for (int gid = blockIdx.x * NTHR + tid; gid < NTOK * 16; gid += gridDim.x * NTHR) {
        const int tok = gid >> 4, i = gid & 15;
        const float inv = exp2f(-(float)i * (13.287712379549449f / 16.0f));
        float sn, cs; sincosf((float)p.pos[tok] * inv, &sn, &cs);
        p.ropec[gid] = cs; p.ropes[gid] = sn;
    }
}

template <bool F32IN>
DI void ph_norm(const P& p, const void* xin_, const float* g, int l, int which) {
    const int tid = tid_(); const int lane = tid & 63;
    for (int row = blockIdx.x * NWAVE + (tid >> 6); row < NTOK; row += gridDim.x * NWAVE) {
        const int b = row >> 12;
        const float* md = p.mod + ((size_t)l * 16 + b) * 6144 + which * 3072;
        f32x4 v[4]; float ss = 0.f;
#pragma unroll
        for (int i = 0; i < 4; ++i) {
            if (F32IN) v[i] = *(const f32x4*)((const float*)xin_ + (size_t)row * D + i * 256 + lane * 4);
            else { const u32x2 r = *(const u32x2*)((const bf16_t*)xin_ + (size_t)row * D + i * 256 + lane * 4);
                   v[i] = (f32x4){__uint_as_float(r.x << 16), __uint_as_float(r.x & 0xffff0000u), __uint_as_float(r.y << 16), __uint_as_float(r.y & 0xffff0000u)}; }
            ss += v[i][0] * v[i][0] + v[i][1] * v[i][1] + v[i][2] * v[i][2] + v[i][3] * v[i][3];
        }
        ss = wave_sum(ss);
        const float r = rsqrtf(ss * (1.f / D) + EPS);
#pragma unroll
        for (int i = 0; i < 4; ++i) {
            const int c0 = i * 256 + lane * 4;
            const f32x4 gg = *(const f32x4*)(g + c0), sh = *(const f32x4*)(md + c0), sc = *(const f32x4*)(md + 1024 + c0);
            float o[4];
#pragma unroll
            for (int e = 0; e < 4; ++e) o[e] = v[i][e] * r * gg[e] * (1.f + sc[e]) + sh[e];
            u32x2 w; w.x = pk2(o[0], o[1]); w.y = pk2(o[2], o[3]);
            *(u32x2*)(p.xa + (size_t)row * D + c0) = w;
        }
    }
}
DI void ph_rowstat0_conv(const P& p) {
    const int tid = tid_(); const int lane = tid & 63;
    float cw[3][8];
#pragma unroll
    for (int k = 0; k < 3; ++k) { const f32x4 a = *(const f32x4*)(p.conv_w + k * 512 + lane * 8), b = *(const f32x4*)(p.conv_w + k * 512 + lane * 8 + 4);
#pragma unroll
        for (int e = 0; e < 4; ++e) { cw[k][e] = a[e]; cw[k][4 + e] = b[e]; } }
    for (int blk = blockIdx.x * NWAVE + (tid >> 6); blk < NTOK / 16; blk += gridDim.x * NWAVE) {
        const int row0 = blk * 16;
        float u1[8], u2[8];
#pragma unroll
        for (int e = 0; e < 8; ++e) { u1[e] = 0.f; u2[e] = 0.f; }
        if ((row0 & 4095) != 0) {
#pragma unroll
            for (int d = 1; d <= 2; ++d) { const bf16_t* q = p.proj + (size_t)(row0 - d) * LD0; const u32x4 c = *(const u32x4*)(q + 928 + lane * 8), x = *(const u32x4*)(q + 1440 + lane * 8);
#pragma unroll
                for (int e = 0; e < 4; ++e) { const float v0 = __uint_as_float(c[e] << 16) * __uint_as_float(x[e] << 16), v1 = __uint_as_float(c[e] & 0xffff0000u) * __uint_as_float(x[e] & 0xffff0000u);
                    if (d == 1) { u1[2 * e] = v0; u1[2 * e + 1] = v1; } else { u2[2 * e] = v0; u2[2 * e + 1] = v1; } } }
        }
#pragma unroll 4
        for (int i = 0; i < 16; ++i) {
            const int row = row0 + i;
            const bf16_t* r = p.proj + (size_t)row * LD0;
            { const u32x2 a = *(const u32x2*)(r + lane * 4); const unsigned kk = *(const unsigned*)(r + 256 + lane * 2);
              float sq = 0.f, sk = 0.f;
              { const float a0 = __uint_as_float(a.x << 16), a1 = __uint_as_float(a.x & 0xffff0000u), a2 = __uint_as_float(a.y << 16), a3 = __uint_as_float(a.y & 0xffff0000u); sq = a0 * a0 + a1 * a1 + a2 * a2 + a3 * a3; }
              { const float k0 = __uint_as_float(kk << 16), k1 = __uint_as_float(kk & 0xffff0000u); sk = k0 * k0 + k1 * k1; }
              sq = wave_sum(sq); sk = wave_sum(sk);
              if (lane == 0) { p.rq[row] = rsqrtf(sq * (1.f / 256.f) + EPS); p.rkv[row] = rsqrtf(sk * (1.f / 128.f) + EPS); } }
            const u32x4 bg = *(const u32x4*)(r + 416 + lane * 8), c = *(const u32x4*)(r + 928 + lane * 8), x = *(const u32x4*)(r + 1440 + lane * 8);
            u32x4 o;
#pragma unroll
            for (int e = 0; e < 4; ++e) {
                const float v0 = __uint_as_float(c[e] << 16) * __uint_as_float(x[e] << 16), v1 = __uint_as_float(c[e] & 0xffff0000u) * __uint_as_float(x[e] & 0xffff0000u);
                const float y0 = cw[0][2 * e] * u2[2 * e] + cw[1][2 * e] * u1[2 * e] + cw[2][2 * e] * v0;
                const float y1 = cw[0][2 * e + 1] * u2[2 * e + 1] + cw[1][2 * e + 1] * u1[2 * e + 1] + cw[2][2 * e + 1] * v1;
                u2[2 * e] = u1[2 * e]; u2[2 * e + 1] = u1[2 * e + 1]; u1[2 * e] = v0; u1[2 * e + 1] = v1;
                o[e] = pk2(__uint_as_float(bg[e] << 16) * y0, __uint_as_float(bg[e] & 0xffff0000u) * y1);
            }
            *(u32x4*)(p.mix + (size_t)row * D + 512 + lane * 8) = o;
        }
    }
}
constexpr int GL_QS = 72, GL_VS = 144;
constexpr int GX_SEG = 0, GX_QD = 2048, GX_KD = GX_QD + 64 * GL_QS * 2, GX_KE = GX_KD + 64 * GL_QS * 2, GX_V = GX_KE + 64 * GL_QS * 2, GX_END = GX_V + 64 * GL_VS * 2;
DI void ph_stat1x(const P& p, LAS unsigned char* lds) {
    const int tid = tid_(); const int lane = tid & 63, w = __builtin_amdgcn_readfirstlane(tid >> 6), l15 = lane & 15, g = lane >> 4, tq = l15 >> 2, tp = l15 & 3;
    for (int row = blockIdx.x * NWAVE + w; row < NTOK; row += gridDim.x * NWAVE) {
        const u32x4 a = *(const u32x4*)(p.proj + (size_t)row * LD1 + 512 + lane * 8);
        float s = 0.f;
#pragma unroll
        for (int e = 0; e < 4; ++e) { const float v0 = __uint_as_float(a[e] << 16), v1 = __uint_as_float(a[e] & 0xffff0000u); s += v0 * v0 + v1 * v1; }
        s = wave_sum(s);
        if (lane == 0) p.rv[row] = rsqrtf(s * (1.f / 512.f) + EPS);
    }
    for (int it = blockIdx.x; it < (NTOK / 64) * 4; it += gridDim.x) {
        const int h = it & 3, ck = it >> 2;
        const size_t row0 = (size_t)ck * 64;
        float bc[8], qv[8], kv[8];
        { const float* la = p.loga + (row0 + 8 * w) * 256 + h * 64 + lane; const bf16_t* pq = p.proj + (row0 + 8 * w) * LD1 + 1024 + h * 64 + lane;
#pragma unroll
          for (int i = 0; i < 8; ++i) { bc[i] = la[(size_t)i * 256]; qv[i] = bf2f(pq[(size_t)i * LD1]); kv[i] = bf2f(pq[(size_t)i * LD1 + 256]); } }
        u32x4 rvv[2];
#pragma unroll
        for (int i = 0; i < 2; ++i) { const int c = i * 512 + tid; rvv[i] = *(const u32x4*)(p.proj + (row0 + (c >> 4)) * LD1 + 1536 + h * 128 + (c & 15) * 8); }
#pragma unroll
        for (int i = 1; i < 8; ++i) bc[i] += bc[i - 1];
        ((LAS float*)(lds + GX_SEG))[w * 64 + lane] = bc[7];
#pragma unroll
        for (int i = 0; i < 2; ++i) { const int c = i * 512 + tid; *(LAS u32x4*)(lds + GX_V + ((c >> 4) * GL_VS + (c & 15) * 8) * 2) = rvv[i]; }
        __syncthreads();
        float off = 0.f, bl = 0.f;
#pragma unroll
        for (int ww = 0; ww < 8; ++ww) { const float sg = ((const LAS float*)(lds + GX_SEG))[ww * 64 + lane]; bl += sg; off += (ww < w) ? sg : 0.f; }
#pragma unroll
        for (int i = 0; i < 8; ++i) {
            const float x = bc[i] + off, eb = __expf(x);
            const int o = ((8 * w + i) * GL_QS + lane) * 2;
            *(LAS bf16_t*)(lds + GX_QD + o) = f2bf(qv[i] * 0.125f * eb); *(LAS bf16_t*)(lds + GX_KD + o) = f2bf(kv[i] * __builtin_amdgcn_rcpf(eb)); *(LAS bf16_t*)(lds + GX_KE + o) = f2bf(kv[i] * __expf(bl - x));
        }
        if (w == 0) p.gdec[(size_t)ck * 256 + h * 64 + lane] = __expf(bl);
        __syncthreads();
        { const int o = ((tid >> 3) * GL_QS + (tid & 7) * 8) * 2; const size_t go = (row0 + (tid >> 3)) * 256 + h * 64 + (tid & 7) * 8;
          *(u32x4*)(p.gqd + go) = *(const LAS u32x4*)(lds + GX_QD + o); *(u32x4*)(p.gkd + go) = *(const LAS u32x4*)(lds + GX_KD + o); }
        bf16x8 vN[2];
#pragma unroll
        for (int ks = 0; ks < 2; ++ks) {
            const s16x4 lo = vtr(lds + GX_V + ((32 * ks + 8 * g + tq) * GL_VS + 16 * w + 4 * tp) * 2), hi4 = vtr(lds + GX_V + ((32 * ks + 8 * g + 4 + tq) * GL_VS + 16 * w + 4 * tp) * 2);
            vN[ks] = (bf16x8){lo[0], lo[1], lo[2], lo[3], hi4[0], hi4[1], hi4[2], hi4[3]};
        }
        bf16_t* kvo = p.gkv + ((size_t)it * 64) * 128 + 16 * w + l15;
#pragma unroll
        for (int dkt = 0; dkt < 4; ++dkt) {
            f32x4 sc = (f32x4){0.f, 0.f, 0.f, 0.f};
#pragma unroll
            for (int ks = 0; ks < 2; ++ks) {
                const s16x4 lo = vtr(lds + GX_KE + ((32 * ks + 8 * g + tq) * GL_QS + 16 * dkt + 4 * tp) * 2), hi4 = vtr(lds + GX_KE + ((32 * ks + 8 * g + 4 + tq) * GL_QS + 16 * dkt + 4 * tp) * 2);
                const bf16x8 keT = (bf16x8){lo[0], lo[1], lo[2], lo[3], hi4[0], hi4[1], hi4[2], hi4[3]};
                sc = __builtin_amdgcn_mfma_f32_16x16x32_bf16(keT, vN[ks], sc, 0, 0, 0);
            }
#pragma unroll
            for (int j = 0; j < 4; ++j) kvo[(size_t)(16 * dkt + 4 * g + j) * 128] = f2bf(sc[j]);
        }
        __syncthreads();
    }
}
DI void ph_gla_scan(const P& p) {
    const int tid = tid_();
    for (int gid = blockIdx.x * NTHR + tid; gid < 64 * 64 * 32; gid += gridDim.x * NTHR) {
        const int dvq = gid & 31, dk = (gid >> 5) & 63, bh = gid >> 11, b = bh >> 2, h = bh & 3;
        float st[4] = {0.f, 0.f, 0.f, 0.f};
        const size_t e0 = (((size_t)b * 64 * 4 + h) * 64 + dk) * 128 + dvq * 4;
        const float* dc = p.gdec + (size_t)b * 64 * 256 + h * 64 + dk;
#pragma unroll 8
        for (int n = 0; n < 64; ++n) {
            const size_t e = e0 + (size_t)n * (4 * 64 * 128);
            const u32x2 kvv = *(const u32x2*)(p.gkv + e); const float d = dc[(size_t)n * 256];
            u32x2 o; o.x = pk2(st[0], st[1]); o.y = pk2(st[2], st[3]);
            *(u32x2*)(p.gst + e) = o;
            st[0] = st[0] * d + __uint_as_float(kvv.x << 16); st[1] = st[1] * d + __uint_as_float(kvv.x & 0xffff0000u);
            st[2] = st[2] * d + __uint_as_float(kvv.y << 16); st[3] = st[3] * d + __uint_as_float(kvv.y & 0xffff0000u);
        }
    }
}

DI void ph_router(const P& p, int l, LAS unsigned char* lds) {
    const int tid = tid_(); const int lane = tid & 63, wid = tid >> 6, fr = lane & 15, fq = lane >> 4;
    LAS float* lg = (LAS float*)lds + wid * (32 * 65);
    const bf16_t* W = p.wt_r + (size_t)l * 64 * 1024;
    LAS int* hist = (LAS int*)(lds + 8 * 32 * 65 * 4);
    if (tid < 64) hist[tid] = 0;
    __syncthreads();
    const size_t o = (size_t)l * 2 * NTOK;
    for (int mt = blockIdx.x * NWAVE + wid; mt < NTOK / 32; mt += gridDim.x * NWAVE) {
        const int m0 = mt * 32;
        const bf16_t* ap[2]; const bf16_t* bp[4];
#pragma unroll
        for (int i = 0; i < 2; ++i) ap[i] = p.xa + (size_t)(m0 + 16 * i + fr) * D + fq * 8;
#pragma unroll
        for (int j = 0; j < 4; ++j) bp[j] = W + (size_t)(16 * j + fr) * 1024 + fq * 8;
        f32x4 acc[2][4];
#pragma unroll
        for (int i = 0; i < 2; ++i)
#pragma unroll
            for (int j = 0; j < 4; ++j) acc[i][j] = (f32x4){0.f, 0.f, 0.f, 0.f};
        for (int k = 0; k < 1024; k += 32) {
            bf16x8 a[2], b[4];
#pragma unroll
            for (int i = 0; i < 2; ++i) a[i] = *(const bf16x8*)(ap[i] + k);
#pragma unroll
            for (int j = 0; j < 4; ++j) b[j] = *(const bf16x8*)(bp[j] + k);
#pragma unroll
            for (int i = 0; i < 2; ++i)
#pragma unroll
                for (int j = 0; j < 4; ++j) acc[i][j] = __builtin_amdgcn_mfma_f32_16x16x32_bf16(b[j], a[i], acc[i][j], 0, 0, 0);
        }
#pragma unroll
        for (int i = 0; i < 2; ++i)
#pragma unroll
            for (int j = 0; j < 4; ++j)
#pragma unroll
                for (int e = 0; e < 4; ++e) lg[(16 * i + fr) * 65 + 16 * j + 4 * fq + e] = acc[i][j][e];
        asm volatile("s_waitcnt lgkmcnt(0)" ::: "memory");
        if (lane < 32) {
            const LAS float* r = lg + lane * 65; const int tok = m0 + lane;
            float gl[4]; int gs = 0;
#pragma unroll
            for (int j = 0; j < 4; ++j) gl[j] = r[j] + p.moe_b_group[l * 4 + j];
            float gmax = gl[0];
#pragma unroll
            for (int j = 1; j < 4; ++j) if (gl[j] > gmax) { gmax = gl[j]; gs = j; }
            float den = 0.f;
#pragma unroll
            for (int j = 0; j < 4; ++j) den += __expf(gl[j] - gmax);
            const float pg = 1.f / den;
            float el[8];
#pragma unroll
            for (int j = 0; j < 8; ++j) el[j] = r[4 + gs * 8 + j] + p.moe_b_expert[l * 32 + gs * 8 + j];
            int i1 = 0; float v1 = el[0];
#pragma unroll
            for (int j = 1; j < 8; ++j) if (el[j] > v1) { v1 = el[j]; i1 = j; }
            int i2 = -1; float v2 = -INFINITY;
#pragma unroll
            for (int j = 0; j < 8; ++j) if (j != i1 && el[j] > v2) { v2 = el[j]; i2 = j; }
            const float e2 = __expf(v2 - v1);
            const float w1 = pg / (1.f + e2), w2 = pg * e2 / (1.f + e2);
            const int ea = gs * 8 + i1, eb = gs * 8 + i2;
            const int pa = __hip_atomic_fetch_add(hist + ea, 1, __ATOMIC_RELAXED, __HIP_MEMORY_SCOPE_WORKGROUP), pb = __hip_atomic_fetch_add(hist + 32 + eb, 1, __ATOMIC_RELAXED, __HIP_MEMORY_SCOPE_WORKGROUP);
            p.tope[o + tok] = ea; p.tope[o + NTOK + tok] = eb;
            p.toppos[o + tok] = pa; p.toppos[o + NTOK + tok] = pb;
            p.topw[o + tok] = w1; p.topw[o + NTOK + tok] = w2;
        }
        asm volatile("s_waitcnt lgkmcnt(0)" ::: "memory");
    }
    __syncthreads();
    if (tid < 64) p.whist[((size_t)l * 256 + blockIdx.x) * 64 + tid] = hist[tid];
    __syncthreads();
}
DI void ph_slots(const P& p, int l, LAS unsigned char* lds) {
    LAS int* ss = (LAS int*)lds;
    const int tid = tid_();
    const int G = gridDim.x, bx = blockIdx.x;
    if (tid < 64) {
        int tot = 0, pre = 0;
        for (int w = 0; w < G; ++w) { const int v = p.whist[((size_t)l * 256 + w) * 64 + tid]; tot += v; pre += (w < bx) ? v : 0; }
        ss[192 + tid] = tot; ss[tid] = pre;
    }
    __syncthreads();
    if (tid == 0) {
        int start = 0, tile = 0;
        for (int seg = 0; seg < 64; ++seg) { const int nt = (ss[192 + seg] + 255) >> 8; ss[seg] += start; ss[64 + seg] = tile; tile += nt; start += nt * 256; }
        ss[128] = tile;
    }
    __syncthreads();
    if (bx == 0) {
        if (tid < 64) { const int t0 = ss[64 + tid], t1 = (tid == 63) ? ss[128] : ss[64 + tid + 1]; for (int i = t0; i < t1; ++i) p.tile_e[l * 1024 + i] = tid & 31; }
        if (tid == 0) p.ntile[l] = ss[128];
    }
    const int lane = tid & 63, wid = tid >> 6;
    for (int mt = bx * NWAVE + wid; mt < NTOK / 32; mt += G * NWAVE) {
        const int tok = mt * 32 + (lane & 31), k = lane >> 5;
        const size_t o = (size_t)l * 2 * NTOK + (size_t)k * NTOK + tok;
        const int slot = ss[k * 32 + p.tope[o]] + p.toppos[o];
        p.topslot[o] = slot;
        p.row_tok[(size_t)l * MAXSLOT + slot] = tok;
    }
    __syncthreads();
}
DI void ph_combine(const P& p, int l, int last) {
    const int tid = tid_(); const int lane = tid & 63;
    for (int row = blockIdx.x * NWAVE + (tid >> 6); row < NTOK; row += gridDim.x * NWAVE) {
        const int b = row >> 12;
        const size_t o = (size_t)l * 2 * NTOK;
        const int s0 = p.topslot[o + row], s1 = p.topslot[o + NTOK + row];
        const float w0 = p.topw[o + row], w1 = p.topw[o + NTOK + row];
        const float* g2 = p.mod + ((size_t)l * 16 + b) * 6144 + 5 * 1024;
        bf16_t* xr = p.xr + (size_t)row * D;
        f32x4 v[4]; float ss = 0.f;
#pragma unroll
        for (int i = 0; i < 4; ++i) {
            const int c0 = i * 256 + lane * 4;
            const u32x2 ya = *(const u32x2*)(p.y + (size_t)s0 * D + c0), yb = *(const u32x2*)(p.y + (size_t)s1 * D + c0), xv = *(const u32x2*)(xr + c0);
            const f32x4 gg = *(const f32x4*)(g2 + c0);
            float ye[4], xe[4];
            ye[0] = w0 * __uint_as_float(ya.x << 16) + w1 * __uint_as_float(yb.x << 16);
            ye[1] = w0 * __uint_as_float(ya.x & 0xffff0000u) + w1 * __uint_as_float(yb.x & 0xffff0000u);
            ye[2] = w0 * __uint_as_float(ya.y << 16) + w1 * __uint_as_float(yb.y << 16);
            ye[3] = w0 * __uint_as_float(ya.y & 0xffff0000u) + w1 * __uint_as_float(yb.y & 0xffff0000u);
            xe[0] = __uint_as_float(xv.x << 16); xe[1] = __uint_as_float(xv.x & 0xffff0000u); xe[2] = __uint_as_float(xv.y << 16); xe[3] = __uint_as_float(xv.y & 0xffff0000u);
#pragma unroll
            for (int e = 0; e < 4; ++e) { v[i][e] = xe[e] + gg[e] * ye[e]; ss += v[i][e] * v[i][e]; }
        }
        ss = wave_sum(ss);
        const float r = rsqrtf(ss * (1.f / D) + EPS);
        if (last) {
#pragma unroll
            for (int i = 0; i < 4; ++i) { const int c0 = i * 256 + lane * 4; const f32x4 gg = *(const f32x4*)(p.final_norm_g + c0); *(f32x4*)(p.out + (size_t)row * D + c0) = v[i] * r * gg; }
        } else {
            const float* md = p.mod + ((size_t)(l + 1) * 16 + b) * 6144;
            const float* g = p.norm_mix_g + (l + 1) * D;
#pragma unroll
            for (int i = 0; i < 4; ++i) {
                const int c0 = i * 256 + lane * 4;
                u32x2 xw; xw.x = pk2(v[i][0], v[i][1]); xw.y = pk2(v[i][2], v[i][3]);
                *(u32x2*)(xr + c0) = xw;
                const f32x4 gg = *(const f32x4*)(g + c0), sh = *(const f32x4*)(md + c0), sc = *(const f32x4*)(md + 1024 + c0);
                float oo[4];
#pragma unroll
                for (int e = 0; e < 4; ++e) oo[e] = v[i][e] * r * gg[e] * (1.f + sc[e]) + sh[e];
                u32x2 w; w.x = pk2(oo[0], oo[1]); w.y = pk2(oo[2], oo[3]);
                *(u32x2*)(p.xa + (size_t)row * D + c0) = w;
            }
        }
    }
}

constexpr int AT_KB = 12 * 1024, AT_VB = 8 * 1024, AT_BUF = AT_KB + AT_VB, AT_WS = 3 * AT_BUF, AT_OST = AT_WS + 8 * 256, AT_LDS = AT_OST + 8 * 4096;
constexpr float AT_THR = 8.f;
DI void attn_unit(const P& p, LAS unsigned char* lds, int b, int h, int qb, int tid) {
    const int lane = tid & 63, wid = __builtin_amdgcn_readfirstlane(tid >> 6), r32 = lane & 31, hi = lane >> 5;
    const size_t rowbase = (size_t)b * SEQ; const int q0 = qb * 256;
    const int NT = 4 * (qb + 1);
    const bf16_t* ksrc = p.kn + (rowbase + lane) * 512 + h * 64 + wid * 8;
    const bf16_t* psrc = p.kpe + (rowbase + lane) * 32 + (wid & 3) * 8;
    const bf16_t* vsrc = p.v + (rowbase + 16 * (wid & 3) + (lane >> 2)) * 512 + h * 64 + (wid >> 2) * 32 + (lane & 3) * 8;
#define AT_LOAD(t, buf) do { \
        __builtin_amdgcn_global_load_lds((const unsigned*)(ksrc + (size_t)(t) * 64 * 512), (LAS unsigned*)(lds + (buf) * AT_BUF + wid * 1024), 16, 0, 0); \
        __builtin_amdgcn_global_load_lds((const unsigned*)(psrc + (size_t)(t) * 64 * 32), (LAS unsigned*)(lds + (buf) * AT_BUF + (8 + (wid & 3)) * 1024), 16, 0, 0);   \
        __builtin_amdgcn_global_load_lds((const unsigned*)(vsrc + (size_t)(t) * 64 * 512), (LAS unsigned*)(lds + (buf) * AT_BUF + AT_KB + wid * 1024), 16, 0, 0); } while (0)
    bf16x8 qr[6];
    { const bf16_t* Qw = p.q + (rowbase + q0 + wid * 32 + r32) * 768 + h * 96 + hi * 8;
#pragma unroll
      for (int d0 = 0; d0 < 6; ++d0) qr[d0] = *(const bf16x8*)(Qw + d0 * 16);
      AT_LOAD(0, 0); AT_LOAD(1, 1);
#pragma unroll
      for (int d0 = 0; d0 < 6; ++d0) asm volatile("" : "+v"(qr[d0])); }
    LAS float* wsf = (LAS float*)(lds + AT_WS) + wid * 64;
    float mhat = -INFINITY, lsum = 0.f;
    f32x16 o[2];
#pragma unroll
    for (int r = 0; r < 16; ++r) { o[0][r] = 0.f; o[1][r] = 0.f; }
    const int qrel = wid * 32 + r32;
    const int koff = hi * 1024 + r32 * 16;
    const int voff = AT_KB + ((lane >> 4) & 1) * 32 + (lane & 3) * 8 + (4 * hi + ((lane & 15) >> 2)) * 64;
    int bcur = 0;
    for (int t = 0; t < NT; ++t) {
        if (t + 1 < NT) asm volatile("s_waitcnt vmcnt(3)" ::: "memory"); else asm volatile("s_waitcnt vmcnt(0)" ::: "memory");
        asm volatile("s_waitcnt lgkmcnt(0)" ::: "memory"); __builtin_amdgcn_s_barrier(); asm volatile("" ::: "memory");
        { const int bn = (bcur == 0) ? 2 : bcur - 1;
          if (t + 2 < NT) AT_LOAD(t + 2, bn); }
        const int jb = t - (NT - 4);
        const LAS unsigned char* kb = lds + bcur * AT_BUF + koff;
        const LAS unsigned char* vb = lds + bcur * AT_BUF + voff;
        bcur = (bcur == 2) ? 0 : bcur + 1;
        if (jb >= 0 && 64 * jb > wid * 32 + 31) continue;
        f32x16 p0, p1;
#pragma unroll
        for (int r = 0; r < 16; ++r) { p0[r] = 0.f; p1[r] = 0.f; }
#pragma unroll
        for (int d0 = 0; d0 < 6; ++d0) {
            const bf16x8 k0 = *(const LAS bf16x8*)(kb + d0 * 2048), k1 = *(const LAS bf16x8*)(kb + d0 * 2048 + 512);
            p0 = __builtin_amdgcn_mfma_f32_32x32x16_bf16(k0, qr[d0], p0, 0, 0, 0);
            p1 = __builtin_amdgcn_mfma_f32_32x32x16_bf16(k1, qr[d0], p1, 0, 0, 0);
        }
        if (jb >= 0) {
            const int kbase = 64 * jb + 4 * hi;
#pragma unroll
            for (int r = 0; r < 16; ++r) { const int kv = kbase + (r & 3) + 8 * (r >> 2); if (kv > qrel) p0[r] = -INFINITY; if (kv + 32 > qrel) p1[r] = -INFINITY; }
        }
        float mx = fmaxf(p0[0], p1[0]);
#pragma unroll
        for (int r = 1; r < 16; ++r) mx = fmaxf(mx, fmaxf(p0[r], p1[r]));
        { auto rr = __builtin_amdgcn_permlane32_swap(__float_as_uint(mx), __float_as_uint(mx), false, false); mx = fmaxf(__uint_as_float(rr[0]), __uint_as_float(rr[1])); }
        const bool need = mx > mhat + AT_THR;
        if (__any(need)) {
            const float mnew = need ? mx : mhat;
            const float alpha = __builtin_amdgcn_exp2f(mhat - mnew);
            mhat = mnew; lsum *= alpha;
            if (hi == 0) wsf[r32] = alpha;
            asm volatile("s_waitcnt lgkmcnt(0)" ::: "memory");
#pragma unroll
            for (int r = 0; r < 16; ++r) { const float a = wsf[crow(r, hi)]; o[0][r] *= a; o[1][r] *= a; }
        }
        float sacc = 0.f;
#pragma unroll
        for (int r = 0; r < 16; ++r) { p0[r] = __builtin_amdgcn_exp2f(p0[r] - mhat); p1[r] = __builtin_amdgcn_exp2f(p1[r] - mhat); sacc += p0[r] + p1[r]; }
        lsum += sacc;
        u32x4 pw[4];
#pragma unroll
        for (int j = 0; j < 4; ++j) { pw[0][j] = cvtpk(p0[2 * j], p0[2 * j + 1]); pw[1][j] = cvtpk(p0[8 + 2 * j], p0[8 + 2 * j + 1]); pw[2][j] = cvtpk(p1[2 * j], p1[2 * j + 1]); pw[3][j] = cvtpk(p1[8 + 2 * j], p1[8 + 2 * j + 1]); }
#pragma unroll
        for (int d0 = 0; d0 < 2; ++d0)
#pragma unroll
            for (int ks = 0; ks < 4; ++ks) {
                const s16x4 lo = vtr(vb + d0 * 4096 + ks * 1024), hi4 = vtr(vb + d0 * 4096 + ks * 1024 + 512);
                const bf16x8 vf = (bf16x8){lo[0], lo[1], lo[2], lo[3], hi4[0], hi4[1], hi4[2], hi4[3]};
                o[d0] = __builtin_amdgcn_mfma_f32_32x32x16_bf16(__builtin_bit_cast(bf16x8, pw[ks]), vf, o[d0], 0, 0, 0);
            }
    }
#undef AT_LOAD
    { auto rr = __builtin_amdgcn_permlane32_swap(__float_as_uint(lsum), __float_as_uint(lsum), false, false); lsum = __uint_as_float(rr[0]) + __uint_as_float(rr[1]); }
    if (hi == 0) wsf[32 + r32] = lsum;
    asm volatile("s_waitcnt lgkmcnt(0)" ::: "memory");
    LAS bf16_t* stg = (LAS bf16_t*)(lds + AT_OST) + wid * 2048;
#pragma unroll
    for (int r = 0; r < 16; ++r) {
        const int orow = crow(r, hi); const float rl = __builtin_amdgcn_rcpf(wsf[32 + orow]);
        stg[orow * 64 + r32] = f2bf(o[0][r] * rl); stg[orow * 64 + 32 + r32] = f2bf(o[1][r] * rl);
    }
    asm volatile("s_waitcnt lgkmcnt(0)" ::: "memory");
    bf16_t* Ow = p.mix + (rowbase + q0 + wid * 32) * D + h * 64;
#pragma unroll
    for (int i = 0; i < 4; ++i) { const int row = i * 8 + (lane >> 3), ch = lane & 7; const u32x4 v = *(const LAS u32x4*)(stg + row * 64 + ch * 8); *(u32x4*)(Ow + (size_t)row * D + ch * 8) = v; }
    __syncthreads();
}
DI void ph_attn(const P& p, LAS unsigned char* lds) {
    const int tid = tid_();
    const int G = gridDim.x, bx = blockIdx.x;
    const int vcu = (G % 8 == 0) ? (bx % 8) * (G / 8) + bx / 8 : bx;
    for (int grp = vcu; grp < 256; grp += G) {
        const int bh = grp >> 1, par = grp & 1;
#pragma unroll 1
        for (int i = 0; i < 8; ++i) {
            const int s = 2 * (i >> 1) + par;
            const int qb = (i & 1) ? 15 - s : s;
            attn_unit(p, lds, bh >> 3, bh & 7, qb, tid);
        }
    }
}

constexpr int GZ_QD = 0, GZ_KD = 64 * GL_QS * 2, GZ_V = 2 * GZ_KD, GZ_S = GZ_V + 64 * GL_VS * 2, GZ_BUF = GZ_S + 64 * GL_VS * 2, GZ_PART = 2 * GZ_BUF, GZ_END = GZ_PART + 2 * 8 * 64 * 4;
static_assert(GZ_END <= 147200, "GLA LDS map");
DI void ph_gla_out(const P& p, LAS unsigned char* lds, int tid) {
    const int lane = tid & 63, w = __builtin_amdgcn_readfirstlane(tid >> 6), l15 = lane & 15, g = lane >> 4, tq = l15 >> 2, tp = l15 & 3;
    const int G = gridDim.x, bx = blockIdx.x, NIT = (NTOK / 64) * 4;
    u32x4 rqd, rkd, rvv[2], rss[2];
#define GZ_LOAD(it_) do { const int h_ = (it_) & 3; const size_t row0_ = (size_t)((it_) >> 2) * 64; \
        const size_t o_ = (row0_ + (tid >> 3)) * 256 + h_ * 64 + (tid & 7) * 8; rqd = *(const u32x4*)(p.gqd + o_); rkd = *(const u32x4*)(p.gkd + o_); \
        _Pragma("unroll") for (int i_ = 0; i_ < 2; ++i_) { const int c_ = i_ * 512 + tid; rvv[i_] = *(const u32x4*)(p.proj + (row0_ + (c_ >> 4)) * LD1 + 1536 + h_ * 128 + (c_ & 15) * 8); \
            rss[i_] = *(const u32x4*)(p.gst + ((size_t)(it_) * 64 + (c_ >> 4)) * 128 + (c_ & 15) * 8); } } while (0)
#define GZ_STAGE(buf) do { LAS unsigned char* B_ = lds + (buf) * GZ_BUF; const int o_ = ((tid >> 3) * GL_QS + (tid & 7) * 8) * 2; \
        *(LAS u32x4*)(B_ + GZ_QD + o_) = rqd; *(LAS u32x4*)(B_ + GZ_KD + o_) = rkd; \
        _Pragma("unroll") for (int i_ = 0; i_ < 2; ++i_) { const int c_ = i_ * 512 + tid; const int vo_ = ((c_ >> 4) * GL_VS + (c_ & 15) * 8) * 2; *(LAS u32x4*)(B_ + GZ_V + vo_) = rvv[i_]; *(LAS u32x4*)(B_ + GZ_S + vo_) = rss[i_]; } } while (0)
#define GZ_BAR() do { asm volatile("s_waitcnt lgkmcnt(0)" ::: "memory"); __builtin_amdgcn_s_barrier(); asm volatile("" ::: "memory"); } while (0)
    if (bx < NIT) { GZ_LOAD(bx); GZ_STAGE(0); if (bx + G < NIT) GZ_LOAD(bx + G); }
    int k = 0;
    for (int it = bx; it < NIT; it += G, ++k) {
        const int h = it & 3; const size_t row0 = (size_t)(it >> 2) * 64;
        GZ_BAR();
        if (it + G < NIT) { GZ_STAGE((k + 1) & 1); if (it + 2 * G < NIT) GZ_LOAD(it + 2 * G); }
        const LAS unsigned char* B_ = lds + (k & 1) * GZ_BUF;
        u32x2 grv[4];
#pragma unroll
        for (int tt = 0; tt < 4; ++tt) grv[tt] = *(const u32x2*)(p.proj + (row0 + 16 * tt + l15) * LD1 + 2304 + h * 128 + 16 * w + 4 * g);
        const f32x4 gng = *(const f32x4*)(p.gla_norm_g + h * 128 + 16 * w + 4 * g);
        bf16x8 kdA[4][2];
#pragma unroll
        for (int st = 0; st < 4; ++st)
#pragma unroll
            for (int ks = 0; ks < 2; ++ks) kdA[st][ks] = *(const LAS bf16x8*)(B_ + GZ_KD + ((16 * st + l15) * GL_QS + 32 * ks + 8 * g) * 2);
        bf16x8 vP[2], sA[2];
#pragma unroll
        for (int ks = 0; ks < 2; ++ks) {
            { const s16x4 lo = vtr(B_ + GZ_V + ((32 * ks + 4 * g + tq) * GL_VS + 16 * w + 4 * tp) * 2), hi4 = vtr(B_ + GZ_V + ((32 * ks + 16 + 4 * g + tq) * GL_VS + 16 * w + 4 * tp) * 2);
              vP[ks] = (bf16x8){lo[0], lo[1], lo[2], lo[3], hi4[0], hi4[1], hi4[2], hi4[3]}; }
            { const s16x4 lo = vtr(B_ + GZ_S + ((32 * ks + 8 * g + tq) * GL_VS + 16 * w + 4 * tp) * 2), hi4 = vtr(B_ + GZ_S + ((32 * ks + 8 * g + 4 + tq) * GL_VS + 16 * w + 4 * tp) * 2);
              sA[ks] = (bf16x8){lo[0], lo[1], lo[2], lo[3], hi4[0], hi4[1], hi4[2], hi4[3]}; }
        }
        f32x4 otile[4];
        LAS float* PW = (LAS float*)(lds + GZ_PART) + (k & 1) * 512 + w * 64;
#pragma unroll
        for (int tt = 0; tt < 4; ++tt) {
            bf16x8 qdB[2];
#pragma unroll
            for (int ks = 0; ks < 2; ++ks) qdB[ks] = *(const LAS bf16x8*)(B_ + GZ_QD + ((16 * tt + l15) * GL_QS + 32 * ks + 8 * g) * 2);
            f32x4 at[4];
#pragma unroll
            for (int st = 0; st < 4; ++st) {
                at[st] = (f32x4){0.f, 0.f, 0.f, 0.f};
                if (st <= tt) { at[st] = __builtin_amdgcn_mfma_f32_16x16x32_bf16(kdA[st][0], qdB[0], at[st], 0, 0, 0); at[st] = __builtin_amdgcn_mfma_f32_16x16x32_bf16(kdA[st][1], qdB[1], at[st], 0, 0, 0); }
            }
#pragma unroll
            for (int j = 0; j < 4; ++j) if (4 * g + j > l15) at[tt][j] = 0.f;
            f32x4 ot = (f32x4){0.f, 0.f, 0.f, 0.f};
            ot = __builtin_amdgcn_mfma_f32_16x16x32_bf16(sA[0], qdB[0], ot, 0, 0, 0);
            ot = __builtin_amdgcn_mfma_f32_16x16x32_bf16(sA[1], qdB[1], ot, 0, 0, 0);
            { u32x4 ab; ab.x = pk2(at[0][0], at[0][1]); ab.y = pk2(at[0][2], at[0][3]); ab.z = pk2(at[1][0], at[1][1]); ab.w = pk2(at[1][2], at[1][3]);
              ot = __builtin_amdgcn_mfma_f32_16x16x32_bf16(vP[0], __builtin_bit_cast(bf16x8, ab), ot, 0, 0, 0); }
            if (tt >= 2) { u32x4 ab; ab.x = pk2(at[2][0], at[2][1]); ab.y = pk2(at[2][2], at[2][3]); ab.z = pk2(at[3][0], at[3][1]); ab.w = pk2(at[3][2], at[3][3]);
              ot = __builtin_amdgcn_mfma_f32_16x16x32_bf16(vP[1], __builtin_bit_cast(bf16x8, ab), ot, 0, 0, 0); }
            otile[tt] = ot;
            float ss = ot[0] * ot[0] + ot[1] * ot[1] + ot[2] * ot[2] + ot[3] * ot[3];
            ss += __shfl_xor(ss, 16); ss += __shfl_xor(ss, 32);
            if (g == 0) PW[16 * tt + l15] = ss;
        }
        GZ_BAR();
        const LAS float* PT = (const LAS float*)(lds + GZ_PART) + (k & 1) * 512;
#pragma unroll
        for (int tt = 0; tt < 4; ++tt) {
            float ss = 0.f;
#pragma unroll
            for (int ww = 0; ww < 8; ++ww) ss += PT[ww * 64 + 16 * tt + l15];
            const float r = rsqrtf(ss * (1.f / 128.f) + EPS);
            const float g0 = __uint_as_float(grv[tt].x << 16), g1 = __uint_as_float(grv[tt].x & 0xffff0000u), g2 = __uint_as_float(grv[tt].y << 16), g3 = __uint_as_float(grv[tt].y & 0xffff0000u);
            u32x2 o2; o2.x = pk2(silu_f(g0) * (otile[tt][0] * r * gng[0]), silu_f(g1) * (otile[tt][1] * r * gng[1]));
            o2.y = pk2(silu_f(g2) * (otile[tt][2] * r * gng[2]), silu_f(g3) * (otile[tt][3] * r * gng[3]));
            *(u32x2*)(p.mix + (row0 + 16 * tt + l15) * D + 512 + h * 128 + 16 * w + 4 * g) = o2;
        }
    }
    GZ_BAR();
#undef GZ_LOAD
#undef GZ_STAGE
#undef GZ_BAR
}
constexpr int SG_WS = 136, SG_VS = 144, SG_OS = 132;
constexpr int SG_W = 0, SG_V = 128 * SG_WS * 2, SG_O = SG_V + 128 * SG_VS * 2, SG_END = SG_O + 128 * SG_OS * 4;
static_assert(SG_END <= 147200, "gMLP LDS map");
DI void ph_sg(const P& p, LAS unsigned char* lds) {
    const int tid = tid_();
    const int G = gridDim.x, bx = blockIdx.x;
    const int nG = 0;
#define MIXREP_SG 1
    const int lane = tid & 63, w = __builtin_amdgcn_readfirstlane(tid >> 6), l15 = lane & 15, gq = lane >> 4, tq = l15 >> 2, tp = l15 & 3;
    int cur_g = -1;
    u32x4 rawv[4], uu[4]; float rvs[4];
#define SG_LOADV(u_) do { const int g_ = (u_) >> 9; const size_t r0_ = (size_t)((u_) & 511) * 128; \
        _Pragma("unroll") for (int it = 0; it < 4; ++it) { const int c = it * 512 + tid, s_ = c >> 4, ch = c & 15; rawv[it] = *(const u32x4*)(p.proj + (r0_ + s_) * LD1 + 512 + g_ * 128 + ch * 8); rvs[it] = p.rv[r0_ + s_]; } } while (0)
#define SG_RAWBAR() do { asm volatile("s_waitcnt lgkmcnt(0)" ::: "memory"); __builtin_amdgcn_s_barrier(); asm volatile("" ::: "memory"); } while (0)
    const int u0 = bx - nG, ustep = G - nG;
    for (int rep = 0; rep < MIXREP_SG; ++rep) {
    if (u0 < 2048) SG_LOADV(u0);
    for (int u = u0; u < 2048; u += ustep) {
        const int g = u >> 9, bn = u & 511; const size_t r0 = (size_t)bn * 128;
        if (g != cur_g) {
            cur_g = g;
#pragma unroll
            for (int it = 0; it < 4; ++it) { const int c = it * 512 + tid, t = c >> 4, ch = c & 15; const float* src = p.sg_w_s + ((size_t)g * 128 + t) * 128 + ch * 8;
                const f32x4 a = *(const f32x4*)src, b = *(const f32x4*)(src + 4); float v[8] = {a[0], a[1], a[2], a[3], b[0], b[1], b[2], b[3]};
#pragma unroll
                for (int e = 0; e < 8; ++e) if (ch * 8 + e > t) v[e] = 0.f;
                u32x4 wv; wv.x = pk2(v[0], v[1]); wv.y = pk2(v[2], v[3]); wv.z = pk2(v[4], v[5]); wv.w = pk2(v[6], v[7]);
                *(LAS u32x4*)(lds + SG_W + (t * SG_WS + ch * 8) * 2) = wv; }
        }
#pragma unroll
        for (int it = 0; it < 4; ++it) { const int c = it * 512 + tid, s_ = c >> 4, ch = c & 15; const u32x4 raw = rawv[it]; const float rv = rvs[it];
            u32x4 wv; wv.x = pk2(__uint_as_float(raw.x << 16) * rv, __uint_as_float(raw.x & 0xffff0000u) * rv); wv.y = pk2(__uint_as_float(raw.y << 16) * rv, __uint_as_float(raw.y & 0xffff0000u) * rv);
            wv.z = pk2(__uint_as_float(raw.z << 16) * rv, __uint_as_float(raw.z & 0xffff0000u) * rv); wv.w = pk2(__uint_as_float(raw.w << 16) * rv, __uint_as_float(raw.w & 0xffff0000u) * rv);
            *(LAS u32x4*)(lds + SG_V + (s_ * SG_VS + ch * 8) * 2) = wv; }
        SG_RAWBAR();
#pragma unroll
        for (int it = 0; it < 4; ++it) { const int c = it * 512 + tid; uu[it] = *(const u32x4*)(p.proj + (r0 + (c >> 4)) * LD1 + g * 128 + (c & 15) * 8); }
        if (u + ustep < 2048) SG_LOADV(u + ustep);
        bf16x8 vA[4];
#pragma unroll
        for (int ks = 0; ks < 4; ++ks) {
            const s16x4 lo = vtr(lds + SG_V + ((32 * ks + 8 * gq + tq) * SG_VS + 16 * w + 4 * tp) * 2), hi4 = vtr(lds + SG_V + ((32 * ks + 8 * gq + 4 + tq) * SG_VS + 16 * w + 4 * tp) * 2);
            vA[ks] = (bf16x8){lo[0], lo[1], lo[2], lo[3], hi4[0], hi4[1], hi4[2], hi4[3]};
        }
#pragma unroll
        for (int tt = 0; tt < 8; ++tt) {
            f32x4 acc = (f32x4){0.f, 0.f, 0.f, 0.f};
#pragma unroll
            for (int ks = 0; ks <= tt / 2; ++ks) {
                const bf16x8 wB = *(const LAS bf16x8*)(lds + SG_W + ((16 * tt + l15) * SG_WS + 32 * ks + 8 * gq) * 2);
                acc = __builtin_amdgcn_mfma_f32_16x16x32_bf16(vA[ks], wB, acc, 0, 0, 0);
            }
            *(LAS f32x4*)(lds + SG_O + ((16 * tt + l15) * SG_OS + 16 * w + 4 * gq) * 4) = acc;
        }
        SG_RAWBAR();
#pragma unroll
        for (int it = 0; it < 4; ++it) { const int c = it * 512 + tid, t = c >> 4, ch = c & 15;
            const f32x4 a = *(const LAS f32x4*)(lds + SG_O + (t * SG_OS + ch * 8) * 4), b = *(const LAS f32x4*)(lds + SG_O + (t * SG_OS + ch * 8 + 4) * 4);
            const f32x4 ga = *(const f32x4*)(p.sg_v_norm_g + g * 128 + ch * 8), gb = *(const f32x4*)(p.sg_v_norm_g + g * 128 + ch * 8 + 4);
            const float bs = p.sg_b_s[g * 128 + t];
            const u32x4 ux = uu[it];
            u32x4 o;
            o.x = pk2(__uint_as_float(ux.x << 16) * (a[0] * ga[0] + bs), __uint_as_float(ux.x & 0xffff0000u) * (a[1] * ga[1] + bs));
            o.y = pk2(__uint_as_float(ux.y << 16) * (a[2] * ga[2] + bs), __uint_as_float(ux.y & 0xffff0000u) * (a[3] * ga[3] + bs));
            o.z = pk2(__uint_as_float(ux.z << 16) * (b[0] * gb[0] + bs), __uint_as_float(ux.z & 0xffff0000u) * (b[1] * gb[1] + bs));
            o.w = pk2(__uint_as_float(ux.w << 16) * (b[2] * gb[2] + bs), __uint_as_float(ux.w & 0xffff0000u) * (b[3] * gb[3] + bs));
            *(u32x4*)(p.mix + (r0 + t) * D + g * 128 + ch * 8) = o; }
    }
    SG_RAWBAR();
    }
#undef SG_LOADV
#undef SG_RAWBAR
    __syncthreads();
}

enum { PH_PREP = 0, PH_NORM0, PH_IN0, PH_STAT0, PH_UP0, PH_ATTN, PH_OUT0,
       PH_MOE0  , PH_IN1 = PH_MOE0 + 6, PH_STAT1, PH_SCAN, PH_MIX1, PH_OUT1, PH_MOE1, PH_END = PH_MOE1 + 6 };

typedef __attribute__((address_space(4))) const P* KP;
#if defined(__HIP_DEVICE_COMPILE__)
#define LOADP() ({ KP k_ = kp; asm volatile("" : "+s"(k_)); *k_; })
#else
#define LOADP() (P{})
#endif
__global__ void __launch_bounds__(NTHR, 2) mega(P p_unused, int lo, int hi) {
    (void)p_unused;
    const KP kp = (KP)__builtin_amdgcn_kernarg_segment_ptr();
    extern __shared__ __attribute__((aligned(16))) unsigned char lds_raw[];
    LAS unsigned char* lds = (LAS unsigned char*)lds_raw;
    volatile LAS unsigned* misc = (volatile LAS unsigned*)(lds + LDS_MISC);
    { const int t0 = tid_(); if (t0 < 64) misc[t0] = 0u; }
    __syncthreads();
    XcdBarrier bar; { const P p = LOADP(); bar.bar = p.bar; } bar.x = 0; bar.st = misc + 8;
    if (hi - lo > 1) bar = xcd_barrier_post(bar.bar, misc + 8);
#define IN(k) (lo <= (k) && (k) < hi)
#define SEAM(k) do { if (IN(k) && IN((k) + 1)) xcd_barrier(bar); } while (0)
    const int G = gridDim.x, bx = blockIdx.x;
#ifndef DUPMASK
#define DUPMASK 0u
#endif
#define PHASE(k, ...) do { if (IN(k)) { __VA_ARGS__ } if (((DUPMASK >> (k)) & 1u) && IN(k)) { xcd_barrier(bar); __VA_ARGS__ } SEAM(k); } while (0)
    PHASE(PH_PREP, const P p = LOADP(); ph_prep(p, lds););
    PHASE(PH_NORM0, const P p = LOADP(); ph_norm<true>(p, p.x, p.norm_mix_g, 0, 0););
    PHASE(PH_IN0,
        const P p = LOADP();
        g8::Order S; S.init(NTOK / 256, LD0 / 256, G, bx);
        SrcDense X{(unsigned)(D * 2), (const char*)p.wt_in0, (size_t)256 * 1024 * 2};
        g8::Epi<FIn0> E{{p}};
        g8::gemm8(lds, (const char*)p.xa, 1024, S, X, E););
    PHASE(PH_STAT0, const P p = LOADP(); ph_rowstat0_conv(p););
    PHASE(PH_UP0,
        const P p = LOADP();
        { g8::Order S; S.init(NTOK / 256, 3, G, bx);
          SrcDense X{(unsigned)(LD0 * 2), (const char*)p.wt_uq, (size_t)256 * 256 * 2};
          g8::Epi<FUq> E{{p}};
          g8::gemm8(lds, (const char*)p.proj, 256, S, X, E); }
        { g8::Order S; S.init(NTOK / 256, 4, G, bx);
          SrcDense X{(unsigned)(LD0 * 2), (const char*)p.wt_ukv, (size_t)256 * 128 * 2};
          g8::Epi<FUkv> E{{p}};
          g8::gemm8(lds, (const char*)(p.proj + 256), 128, S, X, E); });
    PHASE(PH_ATTN, const P p = LOADP(); ph_attn(p, lds););
    PHASE(PH_OUT0,
        const P p = LOADP();
        g8::Order S; S.init(NTOK / 256, 4, G, bx);
        SrcDense X{(unsigned)(D * 2), (const char*)p.wt_out0, (size_t)256 * 1024 * 2};
        g8::Epi<FOut> E{{p, 0}};
        g8::gemm8(lds, (const char*)p.mix, 1024, S, X, E););
#define MOE_PHASES(l, base) do { \
        PHASE((base) + 0, const P p = LOADP(); ph_norm<false>(p, p.xr, p.norm_ffn_g + (l) * D, (l), 1);); \
        PHASE((base) + 1, const P p = LOADP(); ph_router(p, (l), lds);); \
        PHASE((base) + 2, const P p = LOADP(); ph_slots(p, (l), lds);); \
        PHASE((base) + 3, \
            const P p = LOADP(); \
            g8::Order S; S.init(p.ntile[(l)], 2, G, bx); \
            SrcMoe<true> X{(unsigned)(D * 2), p.row_tok + (size_t)(l) * MAXSLOT, p.tile_e + (l) * 1024, (const char*)(p.wt_gu + (size_t)(l) * 32 * 512 * 1024), (size_t)512 * 1024 * 2, (size_t)256 * 1024 * 2}; \
            g8::Epi<FGu> E{{p}}; \
            g8::gemm8(lds, (const char*)p.xa, 1024, S, X, E);); \
        PHASE((base) + 4, \
            const P p = LOADP(); \
            g8::Order S; S.init(p.ntile[(l)], 4, G, bx); \
            SrcMoe<false> X{(unsigned)(DEXP * 2), nullptr, p.tile_e + (l) * 1024, (const char*)(p.wt_dn + (size_t)(l) * 32 * 1024 * 256), (size_t)1024 * 256 * 2, (size_t)256 * 256 * 2}; \
            g8::Epi<FDn> E{{p}}; \
            g8::gemm8(lds, (const char*)p.act, 256, S, X, E);); \
        PHASE((base) + 5, const P p = LOADP(); ph_combine(p, (l), (l) == 1);); \
    } while (0)
    MOE_PHASES(0, PH_MOE0);
    PHASE(PH_IN1,
        const P p = LOADP();
        g8::Order S; S.init(NTOK / 256, LD1 / 256, G, bx);
        SrcDense X{(unsigned)(D * 2), (const char*)p.wt_in1, (size_t)256 * 1024 * 2};
        g8::Epi<FIn1> E{{p}};
        g8::gemm8(lds, (const char*)p.xa, 1024, S, X, E););
    PHASE(PH_STAT1, const P p = LOADP(); ph_stat1x(p, lds););
    PHASE(PH_SCAN, const P p = LOADP(); ph_gla_scan(p); ph_sg(p, lds););
    PHASE(PH_MIX1, const P p = LOADP(); ph_gla_out(p, lds, tid_()););
    PHASE(PH_OUT1,
        const P p = LOADP();
        g8::Order S; S.init(NTOK / 256, 4, G, bx);
        SrcDense X{(unsigned)(D * 2), (const char*)p.wt_out1, (size_t)256 * 1024 * 2};
        g8::Epi<FOut> E{{p, 1}};
        g8::gemm8(lds, (const char*)p.mix, 1024, S, X, E););
    MOE_PHASES(1, PH_MOE1);
#undef MOE_PHASES
#undef PHASE
#undef IN
#undef SEAM
}

static size_t carve(size_t& off, size_t bytes) { const size_t o = off; off += (bytes + 255) & ~(size_t)255; return o; }

extern "C" void kernel_launch(void* const* d_in, const int* in_sizes, int n_in, void* d_out, int out_size, void* d_ws, size_t ws_size, hipStream_t stream) {
    (void)in_sizes; (void)n_in; (void)out_size;
    P p{};
    const float* const* fi = (const float* const*)d_in;
    p.x = fi[0]; p.c = fi[1]; p.pos = (const int*)d_in[2];
    p.adaln_w = fi[3]; p.adaln_b = fi[4]; p.norm_mix_g = fi[5]; p.norm_ffn_g = fi[6]; p.ab_w_in = fi[7]; p.q_norm_g = fi[8]; p.w_uq = fi[9];
    p.kv_norm_g = fi[10]; p.w_ukv = fi[11]; p.conv_w = fi[12]; p.ab_w_out = fi[13]; p.cd_w_in = fi[14]; p.sg_v_norm_g = fi[15]; p.sg_w_s = fi[16];
    p.sg_b_s = fi[17]; p.gla_w_g2 = fi[18]; p.gla_b_g = fi[19]; p.gla_norm_g = fi[20]; p.cd_w_out = fi[21]; p.moe_w_group = fi[22]; p.moe_b_group = fi[23];
    p.moe_w_expert = fi[24]; p.moe_b_expert = fi[25]; p.moe_w_gate_up = fi[26]; p.moe_w_down = fi[27]; p.final_norm_g = fi[28];
    p.out = (float*)d_out;
    char* ws = (char*)d_ws; size_t off = 0;
    const size_t ctl0 = off;
    p.bar = (unsigned*)(ws + carve(off, (size_t)XCD_BAR_WORDS * 4));
    p.row_tok = (int*)(ws + carve(off, (size_t)2 * MAXSLOT * 4));
    const size_t ctl_bytes = off - ctl0;
    p.whist = (int*)(ws + carve(off, (size_t)2 * 256 * 64 * 4));
    p.ntile = (int*)(ws + carve(off, 256));
    p.tile_e = (int*)(ws + carve(off, 2 * 1024 * 4));
    p.tope = (int*)(ws + carve(off, (size_t)4 * NTOK * 4));
    p.toppos = (int*)(ws + carve(off, (size_t)4 * NTOK * 4));
    p.topslot = (int*)(ws + carve(off, (size_t)4 * NTOK * 4));
    p.topw = (float*)(ws + carve(off, (size_t)4 * NTOK * 4));
    p.mod = (float*)(ws + carve(off, (size_t)2 * 16 * 6144 * 4));
    p.ropec = (float*)(ws + carve(off, (size_t)NTOK * 16 * 4));
    p.ropes = (float*)(ws + carve(off, (size_t)NTOK * 16 * 4));
    p.rq = (float*)(ws + carve(off, (size_t)NTOK * 4));
    p.rkv = (float*)(ws + carve(off, (size_t)NTOK * 4));
    p.rv = (float*)(ws + carve(off, (size_t)NTOK * 4));
    p.wt_in0 = (bf16_t*)(ws + carve(off, WO_END * 2));
    p.wt_uq = p.wt_in0 + WO_UQ; p.wt_ukv = p.wt_in0 + WO_UKV; p.wt_out0 = p.wt_in0 + WO_OUT0; p.wt_in1 = p.wt_in0 + WO_IN1; p.wt_out1 = p.wt_in0 + WO_OUT1;
    p.wt_gu = p.wt_in0 + WO_GU; p.wt_dn = p.wt_in0 + WO_DN; p.wt_r = p.wt_in0 + WO_R;
    p.xa = (bf16_t*)(ws + carve(off, (size_t)NTOK * D * 2));
    p.mix = (bf16_t*)(ws + carve(off, (size_t)NTOK * D * 2));
    p.xr = (bf16_t*)(ws + carve(off, (size_t)NTOK * D * 2));
    const size_t r0 = off;
    p.proj = (bf16_t*)(ws + carve(off, (size_t)NTOK * LD1 * 2));
    size_t o2 = r0 + (((size_t)NTOK * LD0 * 2 + 255) & ~(size_t)255);
    p.q = (bf16_t*)(ws + carve(o2, (size_t)NTOK * 768 * 2));
    p.kn = (bf16_t*)(ws + carve(o2, (size_t)NTOK * 512 * 2));
    p.v = (bf16_t*)(ws + carve(o2, (size_t)NTOK * 512 * 2));
    p.kpe = (bf16_t*)(ws + carve(o2, (size_t)NTOK * 32 * 2));
    size_t o3 = off;
    p.loga = (float*)(ws + carve(o3, (size_t)NTOK * 256 * 4));
    p.gqd = (bf16_t*)(ws + carve(o3, (size_t)NTOK * 256 * 2));
    p.gkd = (bf16_t*)(ws + carve(o3, (size_t)NTOK * 256 * 2));
    p.gkv = p.xa;
    p.gst = p.xa + (size_t)(NTOK / 64) * 4 * 64 * 128;
    p.gdec = (float*)(ws + carve(o3, (size_t)(NTOK / 64) * 256 * 4));
    size_t o4 = r0;
    p.act = (bf16_t*)(ws + carve(o4, (size_t)MAXSLOT * DEXP * 2));
    p.y = (bf16_t*)(ws + carve(o4, (size_t)MAXSLOT * D * 2));
    if (off > ws_size || o2 > ws_size || o3 > ws_size || o4 > ws_size) return;

    static int grid = 0;
    if (grid == 0) {
        int dev = 0, cus = 0;
        if (hipGetDevice(&dev) != hipSuccess || hipDeviceGetAttribute(&cus, hipDeviceAttributeMultiprocessorCount, dev) != hipSuccess) { grid = -1; return; }
        if (hipFuncSetAttribute((const void*)mega, hipFuncAttributeMaxDynamicSharedMemorySize, LDS_BYTES) != hipSuccess) { grid = -1; return; }
        grid = cus;
    }
    if (grid < 0) return;
    (void)hipMemsetAsync(ws + ctl0, 0, ctl_bytes, stream);
#define RUN(a, b) hipLaunchKernelGGL(mega, dim3(grid), dim3(NTHR), LDS_BYTES, stream, p, (a), (b))
    RUN(PH_PREP, PH_END);
#undef RUN
}
```

```cpp
#include <hip/hip_runtime.h>
#include <stdint.h>
#include <math.h>

typedef unsigned short bf16_t;
typedef short bf16x8 __attribute__((ext_vector_type(8)));
typedef float f32x4 __attribute__((ext_vector_type(4)));
typedef unsigned u32x2 __attribute__((ext_vector_type(2)));
typedef unsigned u32x4 __attribute__((ext_vector_type(4)));
#define DI __device__ __forceinline__
#define LAS __attribute__((address_space(3)))

constexpr int D = 1024, NB = 16, SEQ = 4096, NTOK = NB * SEQ;
constexpr float EPS = 1e-6f;
constexpr int AB_IN = 1952, CD_IN = 2576;
constexpr int LD0 = 2048, LD1 = 2816;
constexpr int DEXP = 256;
constexpr int MAXSLOT = NTOK + 128 * 256;
constexpr float QSCALE = 0.10206207261596577f * 1.4426950408889634f;
constexpr int NTHR = 512, NWAVE = 8;
constexpr int LDS_BYTES = 147456, LDS_MISC = LDS_BYTES - 256;

DI int tid_() { int t = threadIdx.x; asm volatile("" : "+v"(t)); return t; }
DI float bf2f(bf16_t v) { return __uint_as_float(((unsigned)v) << 16); }
DI bf16_t f2bf(float f) { unsigned u = __float_as_uint(f); return (bf16_t)((u + 0x7fffu + ((u >> 16) & 1u)) >> 16); }
DI unsigned pk2(float lo, float hi) { return (unsigned)f2bf(lo) | ((unsigned)f2bf(hi) << 16); }
DI float wave_sum(float v) {
#pragma unroll
    for (int o = 32; o >= 1; o >>= 1) v += __shfl_xor(v, o);
    return v;
}
typedef float f32x16 __attribute__((ext_vector_type(16)));
typedef short s16x4 __attribute__((ext_vector_type(4)));
typedef short v4i16_t __attribute__((ext_vector_type(4)));
typedef float f32x2_t __attribute__((ext_vector_type(2))); typedef __bf16 bf16x2_t __attribute__((ext_vector_type(2)));
DI unsigned cvtpk(float lo, float hi) { f32x2_t v = {lo, hi}; bf16x2_t b = __builtin_convertvector(v, bf16x2_t); return __builtin_bit_cast(unsigned, b); }
DI int crow(int r, int hi) { return (r & 3) + 8 * (r >> 2) + 4 * hi; }
DI s16x4 vtr(const LAS unsigned char* p) { return __builtin_bit_cast(s16x4, __builtin_amdgcn_ds_read_tr16_b64_v4i16((LAS v4i16_t*)p)); }
DI float silu_f(float v) { return v / (1.f + __expf(-v)); }
DI float gelu_tanh_f(float v) { const float u = 1.5957691216057308f * (v + 0.044715f * v * v * v); return v * __builtin_amdgcn_rcpf(1.f + __expf(-u)); }
DI float log_sigmoid_f(float z) { return fminf(z, 0.f) - __logf(1.f + __expf(-fabsf(z))); }

struct P {
    const float *x, *c; const int* pos;
    const float *adaln_w, *adaln_b, *norm_mix_g, *norm_ffn_g, *ab_w_in, *q_norm_g, *w_uq, *kv_norm_g, *w_ukv, *conv_w, *ab_w_out,
        *cd_w_in, *sg_v_norm_g, *sg_w_s, *sg_b_s, *gla_w_g2, *gla_b_g, *gla_norm_g, *cd_w_out,
        *moe_w_group, *moe_b_group, *moe_w_expert, *moe_b_expert, *moe_w_gate_up, *moe_w_down, *final_norm_g;
    float* out;
    bf16_t *wt_in0, *wt_uq, *wt_ukv, *wt_out0, *wt_in1, *wt_out1, *wt_gu, *wt_dn, *wt_r;
    float *mod, *ropec, *ropes;
    bf16_t *xa, *xr, *proj, *q, *kn, *v, *kpe, *mix, *act, *y;
    float *rq, *rkv, *rv, *loga, *gdec, *topw, *row_w;
    bf16_t *gqd, *gkd, *gkv, *gst;
    int *tope, *toppos, *topslot, *whist, *ntile, *tile_e, *row_tok;
    unsigned* bar;
};

#define XB_TMO      128
#define XB_XCNT(j)  (256  + 64 * (j))
#define XB_XSUB(j)  (1280 + 64 * (j))
#define XB_XGEN(j)  (2304 + 64 * (j))
#define XB_TOP      3328
#define XB_TOPGEN   3392
#define XCD_BAR_WORDS 3456
#define XB_SPIN_CAP (1u << 18)
__device__ __forceinline__ unsigned xb_ld(unsigned* p)              { return __hip_atomic_load(p, __ATOMIC_RELAXED, __HIP_MEMORY_SCOPE_AGENT); }
__device__ __forceinline__ unsigned xb_add(unsigned* p, unsigned v) { return __hip_atomic_fetch_add(p, v, __ATOMIC_RELAXED, __HIP_MEMORY_SCOPE_AGENT); }
__device__ __forceinline__ unsigned xb_xcc_id() { return (unsigned)__builtin_amdgcn_s_getreg((3 << 11) | 20) & 0xFu; }
#define XB_SPIN(cond, bar) do { unsigned _sp = 0; while (cond) { __builtin_amdgcn_s_sleep(1); \
    if ((++_sp & 255u) == 0u) { if (xb_ld(&(bar)[XB_TMO])) break; if (_sp > XB_SPIN_CAP) { atomicAdd(&(bar)[XB_TMO], 1u); break; } } } } while (0)
struct XcdBarrier { unsigned* bar; unsigned x; volatile LAS unsigned* st; };
__device__ __forceinline__ XcdBarrier xcd_barrier_post(unsigned* bar, volatile LAS unsigned* st) {
    XcdBarrier b; b.bar = bar; b.x = xb_xcc_id(); b.st = st;
    if (threadIdx.x == 0) (void)xb_add(&bar[XB_XCNT(b.x)], 1u);
    return b;
}
__device__ __forceinline__ void xcd_barrier_complete(unsigned* bar, unsigned x, unsigned& nloc, unsigned& nx) {
    const unsigned G = gridDim.x * gridDim.y * gridDim.z;
    unsigned sum, cnt, mine, sp = 0u;
    for (;;) {
        sum = 0u; cnt = 0u; mine = 0u;
#pragma unroll
        for (unsigned j = 0; j < 16; ++j) { const unsigned c = xb_ld(&bar[XB_XCNT(j)]); sum += c; cnt += (c > 0u) ? 1u : 0u; mine = (j == x) ? c : mine; }
        if (sum == G) break;
        __builtin_amdgcn_s_sleep(1);
        if ((++sp & 255u) == 0u) { if (xb_ld(&bar[XB_TMO])) break; if (sp > XB_SPIN_CAP) { atomicAdd(&bar[XB_TMO], 1u); break; } }
    }
    nloc = mine > 0u ? mine : 1u; nx = cnt > 0u ? cnt : 1u;
}
__device__ __forceinline__ void xcd_barrier(const XcdBarrier& b) {
    asm volatile("s_waitcnt vmcnt(0)" ::: "memory");
    __syncthreads();
    if (threadIdx.x == 0) {
        unsigned* bar = b.bar;
        __builtin_amdgcn_s_waitcnt(0);
        unsigned nloc = b.st[0], nx = b.st[1];
        if (nloc == 0u) { xcd_barrier_complete(bar, b.x, nloc, nx); b.st[0] = nloc; b.st[1] = nx; }
        const unsigned old = xb_add(&bar[XB_XSUB(b.x)], 1u);
        const unsigned gen = old / nloc;
        if (old + 1u == (gen + 1u) * nloc) {
            __builtin_amdgcn_fence(__ATOMIC_RELEASE, "agent");
            asm volatile("s_waitcnt vmcnt(0)" ::: "memory");
            const unsigned og = xb_add(&bar[XB_TOP], 1u);
            const unsigned tg = og / nx;
            if (og + 1u == (tg + 1u) * nx) xb_add(&bar[XB_TOPGEN], 1u);
            else XB_SPIN(xb_ld(&bar[XB_TOPGEN]) == tg, bar);
            __builtin_amdgcn_fence(__ATOMIC_ACQUIRE, "agent");
            xb_add(&bar[XB_XGEN(b.x)], 1u);
            asm volatile("s_waitcnt vmcnt(0)" ::: "memory");
        } else {
            XB_SPIN(xb_ld(&bar[XB_XGEN(b.x)]) == gen, bar);
            __builtin_amdgcn_fence(__ATOMIC_ACQUIRE, "agent");
            asm volatile("s_waitcnt vmcnt(0)" ::: "memory");
        }
    }
    __syncthreads();
}

namespace g8 {
constexpr int BM = 256, BK = 64, HALF = 128, HTB = HALF * BK * 2, NXCD = 8, WGM = 8;
__host__ __device__ __forceinline__ int lds_byte(int r, int c) { const int st = (r >> 4) * 2 + (c >> 5), rr = r & 15, cc = c & 31, ob = rr * 64 + cc * 2; return st * 1024 + (ob ^ (((ob >> 9) & 1) << 5)); }
__host__ __device__ __forceinline__ void stage_rc(int b, int& R, int& C) { const int st = b / 1024, sb = b % 1024, swz = sb ^ (((sb >> 9) & 1) << 5); R = (st >> 1) * 16 + swz / 64; C = (st & 1) * 32 + (swz % 64) / 2; }
__host__ __device__ __forceinline__ int perm32(int rho) { const int n = rho >> 4, i = rho & 15; return 8 * (i >> 2) + 4 * n + (i & 3); }
struct Unit { int pm, pn; };
struct Order {
    int nM, nN, nwg, G, c, pnfast;
    DI void init(int nM_, int nN_, int G_, int c_, int pnfast_ = 0) { nM = nM_; nN = nN_; nwg = nM * nN; G = G_; c = c_; pnfast = pnfast_; }
    DI bool next(int i, Unit& u) const {
        const long L = (long)i * G + c; if (L >= nwg) return false;
        int wgid = (int)L; { const int q = nwg / NXCD, r = nwg % NXCD, xcd = wgid % NXCD, off = wgid / NXCD; wgid = (xcd < r ? xcd * (q + 1) : r * (q + 1) + (xcd - r) * q) + off; }
        if (pnfast) { u.pm = wgid / nN; u.pn = wgid % nN; return true; }
        const int nig = WGM * nN, gid = wgid / nig, fm = gid * WGM, gsz = (nM - fm) < WGM ? (nM - fm) : WGM;
        u.pm = fm + ((wgid % nig) % gsz); u.pn = (wgid % nig) / gsz; return true;
    }
};
template <class Epi, class Src>
__device__ __forceinline__ void gemm8(LAS unsigned char* lds, const char* A, int K_, const Order& S, const Src& X, const Epi& E) {
    int K = K_;
    int tid = threadIdx.x; asm volatile("" : "+v"(tid));
    const int wid = __builtin_amdgcn_readfirstlane(tid >> 6), lane = tid & 63, wr = wid >> 2, wc = wid & 3, fr = lane & 15, fq = lane >> 4;
    asm volatile("" : "+s"(K));
    const int nt = K / BK;
    int Rr[2], Cc[2]; unsigned voffA[2], voffB[2];
#pragma unroll
    for (int i = 0; i < 2; ++i) { int R, C; stage_rc(tid * 16 + i * 8192, R, C); Rr[i] = R; Cc[i] = C * 2; const int Rb = Epi::PERM ? ((R & ~31) + perm32(R & 31)) : R;
        voffA[i] = (unsigned)R * X.lda + (unsigned)C * 2u; voffB[i] = (unsigned)(Rb * X.ldb(K) + C) * 2u; }
    const size_t kstep = (size_t)(BK * 2);
    const size_t hstepB = (size_t)HALF * X.ldb(K) * 2;
    const size_t ksplit = X.ksplit();
    const size_t hstepA = (size_t)HALF * X.lda;
    const unsigned ldsw = (unsigned)wid * 1024u;
    const int aoff = lds_byte(wr * 64 + fr, fq * 8), boff = lds_byte(wc * 32 + fr, fq * 8);
#define G8_SA(b, h) (((b) * 2 + (h)) * HTB)
#define G8_SB(b, h) ((4 + (b) * 2 + (h)) * HTB)
#define G8_STAGEB(bufoff, gbase) do { _Pragma("unroll") for (int _i = 0; _i < 2; ++_i) \
        __builtin_amdgcn_global_load_lds((const unsigned*)((const char*)(gbase) + voffB[_i]), (LAS unsigned*)(lds + (bufoff) + ldsw + _i * 8192), 16, 0, 0); } while (0)
#define G8_STAGEA(bufoff, ub, o0, o1) do { \
        __builtin_amdgcn_global_load_lds((const unsigned*)((const char*)(ub) + (o0)), (LAS unsigned*)(lds + (bufoff) + ldsw), 16, 0, 0); \
        __builtin_amdgcn_global_load_lds((const unsigned*)((const char*)(ub) + (o1)), (LAS unsigned*)(lds + (bufoff) + ldsw + 8192), 16, 0, 0); } while (0)
#define G8_LDA(dst, b, h) do { _Pragma("unroll") for (int m = 0; m < 4; ++m) _Pragma("unroll") for (int k = 0; k < 2; ++k) dst[m][k] = *(const LAS bf16x8*)(lds + G8_SA(b, h) + aoff + m * 2048 + k * 1024); } while (0)
#define G8_LDB(dst, b, h) do { _Pragma("unroll") for (int n = 0; n < 2; ++n) _Pragma("unroll") for (int k = 0; k < 2; ++k) dst[n][k] = *(const LAS bf16x8*)(lds + G8_SB(b, h) + boff + n * 2048 + k * 1024); } while (0)
#define G8_MMA(ai, bj, At, Bt) do { __builtin_amdgcn_s_setprio(1); _Pragma("unroll") for (int m = 0; m < 4; ++m) _Pragma("unroll") for (int n = 0; n < 2; ++n) _Pragma("unroll") for (int k = 0; k < 2; ++k) \
        acc[ai][bj][m][n] = __builtin_amdgcn_mfma_f32_16x16x32_bf16(Bt[n][k], At[m][k], acc[ai][bj][m][n], 0, 0, 0); __builtin_amdgcn_s_setprio(0); } while (0)
#define G8_WAIT_V(n) asm volatile("s_waitcnt vmcnt(" #n ")" ::: "memory")
#define G8_WAIT_L(n) asm volatile("s_waitcnt lgkmcnt(" #n ")" ::: "memory")
#define G8_BAR __builtin_amdgcn_s_barrier()
#define G8_SCHED __builtin_amdgcn_sched_barrier(0)
    Unit cur, nxt; int ui = 0;
    if (!S.next(0, cur)) return;
    f32x4 acc[2][2][4][2];
#pragma unroll
    for (int a = 0; a < 2; ++a)
#pragma unroll
        for (int b = 0; b < 2; ++b)
#pragma unroll
            for (int m = 0; m < 4; ++m)
#pragma unroll
                for (int n = 0; n < 2; ++n) acc[a][b][m][n] = (f32x4){0.f, 0.f, 0.f, 0.f};
    bf16x8 At[4][2], B0[2][2], B1[2][2];
    unsigned c00 = 0, c01 = 0, c10 = 0, c11 = 0; const char* cA = A;
    if constexpr (Src::GATHER) { c00 = X.a_off(cur, 0, Rr[0]) + Cc[0]; c01 = X.a_off(cur, 0, Rr[1]) + Cc[1]; c10 = X.a_off(cur, 1, Rr[0]) + Cc[0]; c11 = X.a_off(cur, 1, Rr[1]) + Cc[1]; }
    else cA = A + (size_t)cur.pm * 2 * hstepA;
    const char* cB0 = X.b_ptr(cur, 0); const char* cB1 = X.b_ptr(cur, 1);
#define G8_BK(b0_, b1_, kb_) (((size_t)(kb_) < ksplit ? (b0_) : (b1_)) + (kb_))
    { const char* cB = G8_BK(cB0, cB1, 0); G8_STAGEB(G8_SB(0, 0), cB); G8_STAGEB(G8_SB(0, 1), cB + hstepB); }
    if constexpr (Src::GATHER) { G8_STAGEA(G8_SA(0, 0), A, c00, c01); G8_STAGEA(G8_SA(0, 1), A, c10, c11); }
    else { G8_STAGEA(G8_SA(0, 0), cA, voffA[0], voffA[1]); G8_STAGEA(G8_SA(0, 1), cA + hstepA, voffA[0], voffA[1]); }
    if (wr == 1) G8_BAR;
    G8_WAIT_V(2); G8_BAR;
    { const char* cB = G8_BK(cB0, cB1, kstep); G8_STAGEB(G8_SB(1, 0), cB);
    if constexpr (Src::GATHER) G8_STAGEA(G8_SA(1, 0), A + kstep, c00, c01); else G8_STAGEA(G8_SA(1, 0), cA + kstep, voffA[0], voffA[1]);
      G8_STAGEB(G8_SB(1, 1), cB + hstepB); }
    G8_WAIT_V(6); G8_BAR;
    for (;;) {
        const bool has_next = S.next(ui + 1, nxt);
        unsigned n00 = c00, n01 = c01, n10 = c10, n11 = c11; const char* nB0 = cB0; const char* nB1 = cB1; const char* nA = cA;
        if (has_next) {
            if constexpr (Src::GATHER) { n00 = X.a_off(nxt, 0, Rr[0]) + Cc[0]; n01 = X.a_off(nxt, 0, Rr[1]) + Cc[1]; n10 = X.a_off(nxt, 1, Rr[0]) + Cc[0]; n11 = X.a_off(nxt, 1, Rr[1]) + Cc[1]; }
            else nA = A + (size_t)nxt.pm * 2 * hstepA;
            nB0 = X.b_ptr(nxt, 0); nB1 = X.b_ptr(nxt, 1);
        }
        for (int t = 0; t < nt; t += 2) {
            const bool last = (t == nt - 2);
            const size_t k1 = (size_t)(t + 1) * kstep;
            const size_t k2 = last ? 0 : (size_t)(t + 2) * kstep, k3 = k2 + kstep;
            const char* b2 = G8_BK(last ? nB0 : cB0, last ? nB1 : cB1, k2); const char* b3 = G8_BK(last ? nB0 : cB0, last ? nB1 : cB1, k3);
            if constexpr (Src::GATHER) {
            const unsigned a00 = last ? n00 : c00, a01 = last ? n01 : c01, a10 = last ? n10 : c10, a11 = last ? n11 : c11;
            G8_LDB(B0, 0, 0); G8_LDB(B1, 0, 1); G8_SCHED; G8_LDA(At, 0, 0); G8_STAGEA(G8_SA(1, 1), A + k1, c10, c11);
            G8_WAIT_V(8); G8_WAIT_L(0); G8_BAR; G8_MMA(0, 0, At, B0); G8_MMA(0, 1, At, B1); G8_BAR; G8_SCHED;
            G8_LDA(At, 0, 1); G8_STAGEB(G8_SB(0, 0), b2); G8_STAGEB(G8_SB(0, 1), b2 + hstepB); G8_STAGEA(G8_SA(0, 0), A + k2, a00, a01);
            G8_WAIT_V(8); G8_WAIT_L(0); G8_BAR; G8_MMA(1, 0, At, B0); G8_MMA(1, 1, At, B1); G8_BAR; G8_SCHED;
            G8_LDB(B0, 1, 0); G8_LDB(B1, 1, 1); G8_SCHED; G8_LDA(At, 1, 0); G8_STAGEA(G8_SA(0, 1), A + k2, a10, a11);
            G8_WAIT_V(8); G8_WAIT_L(0); G8_BAR; G8_MMA(0, 0, At, B0); G8_MMA(0, 1, At, B1); G8_BAR; G8_SCHED;
            G8_LDA(At, 1, 1); G8_STAGEB(G8_SB(1, 0), b3); G8_STAGEB(G8_SB(1, 1), b3 + hstepB); G8_STAGEA(G8_SA(1, 0), A + k3, a00, a01);
            G8_WAIT_V(8); G8_WAIT_L(0); G8_BAR; G8_MMA(1, 0, At, B0); G8_MMA(1, 1, At, B1); G8_BAR; G8_SCHED;
            } else {
            const char* a1 = cA + k1; const char* a2 = (last ? nA : cA) + k2; const char* a3 = a2 + kstep;
            G8_LDB(B0, 0, 0); G8_LDB(B1, 0, 1); G8_SCHED; G8_LDA(At, 0, 0); G8_STAGEA(G8_SA(1, 1), a1 + hstepA, voffA[0], voffA[1]);
            G8_WAIT_V(8); G8_WAIT_L(0); G8_BAR; G8_MMA(0, 0, At, B0); G8_MMA(0, 1, At, B1); G8_BAR; G8_SCHED;
            G8_LDA(At, 0, 1); G8_STAGEB(G8_SB(0, 0), b2); G8_STAGEB(G8_SB(0, 1), b2 + hstepB); G8_STAGEA(G8_SA(0, 0), a2, voffA[0], voffA[1]);
            G8_WAIT_V(8); G8_WAIT_L(0); G8_BAR; G8_MMA(1, 0, At, B0); G8_MMA(1, 1, At, B1); G8_BAR; G8_SCHED;
            G8_LDB(B0, 1, 0); G8_LDB(B1, 1, 1); G8_SCHED; G8_LDA(At, 1, 0); G8_STAGEA(G8_SA(0, 1), a2 + hstepA, voffA[0], voffA[1]);
            G8_WAIT_V(8); G8_WAIT_L(0); G8_BAR; G8_MMA(0, 0, At, B0); G8_MMA(0, 1, At, B1); G8_BAR; G8_SCHED;
            G8_LDA(At, 1, 1); G8_STAGEB(G8_SB(1, 0), b3); G8_STAGEB(G8_SB(1, 1), b3 + hstepB); G8_STAGEA(G8_SA(1, 0), a3, voffA[0], voffA[1]);
            G8_WAIT_V(8); G8_WAIT_L(0); G8_BAR; G8_MMA(1, 0, At, B0); G8_MMA(1, 1, At, B1); G8_BAR; G8_SCHED;
            }
        }
        if (wr == 0) G8_BAR;
        E(acc, cur, wr, wc, fr, fq);
        if (!has_next) break;
#pragma unroll
        for (int a = 0; a < 2; ++a)
#pragma unroll
            for (int b = 0; b < 2; ++b)
#pragma unroll
                for (int m = 0; m < 4; ++m)
#pragma unroll
                    for (int n = 0; n < 2; ++n) acc[a][b][m][n] = (f32x4){0.f, 0.f, 0.f, 0.f};
        cur = nxt; c00 = n00; c01 = n01; c10 = n10; c11 = n11; cB0 = nB0; cB1 = nB1; cA = nA; ++ui;
        if (wr == 1) G8_BAR;
    }
    G8_WAIT_V(0);
    G8_BAR;
#undef G8_SA
#undef G8_SB
#undef G8_STAGEA
#undef G8_STAGEB
#undef G8_BK
#undef G8_LDA
#undef G8_LDB
#undef G8_MMA
#undef G8_WAIT_V
#undef G8_WAIT_L
#undef G8_BAR
#undef G8_SCHED
}
template <class F> struct Epi {
    static constexpr bool PERM = F::PERM;
    F f;
    DI void operator()(const f32x4 (&acc)[2][2][4][2], const Unit& u, int wr, int wc, int fr, int fq) const {
#pragma unroll
        for (int ai = 0; ai < 2; ++ai)
#pragma unroll
            for (int m = 0; m < 4; ++m) {
                const int row = u.pm * BM + ai * HALF + wr * 64 + m * 16 + fr;
                __builtin_amdgcn_sched_barrier(0);
#pragma unroll
                for (int bj = 0; bj < 2; ++bj) {
                    if constexpr (F::PERM) { f.e8(row, u.pn * BM + bj * HALF + wc * 32 + 8 * fq, acc[ai][bj][m][0], acc[ai][bj][m][1], u); }
                    else {
#pragma unroll
                        for (int n = 0; n < 2; ++n) f.e4(row, u.pn * BM + bj * HALF + wc * 32 + 16 * n + 4 * fq, acc[ai][bj][m][n], u);
                    }
                }
            }
    }
};
}

DI void store_bf8(bf16_t* dst, const f32x4& a, const f32x4& b) { u32x4 w; w.x = pk2(a[0], a[1]); w.y = pk2(a[2], a[3]); w.z = pk2(b[0], b[1]); w.w = pk2(b[2], b[3]); *(u32x4*)dst = w; }
DI void rope8(const P& p, int row, int i0, f32x4& a, f32x4& b) {
    const f32x4 c = *(const f32x4*)(p.ropec + (size_t)row * 16 + i0), s = *(const f32x4*)(p.ropes + (size_t)row * 16 + i0);
    f32x4 oa, ob;
    oa[0] = a[0] * c[0] - a[1] * s[0]; oa[1] = a[0] * s[0] + a[1] * c[0]; oa[2] = a[2] * c[1] - a[3] * s[1]; oa[3] = a[2] * s[1] + a[3] * c[1];
    ob[0] = b[0] * c[2] - b[1] * s[2]; ob[1] = b[0] * s[2] + b[1] * c[2]; ob[2] = b[2] * c[3] - b[3] * s[3]; ob[3] = b[2] * s[3] + b[3] * c[3];
    a = oa; b = ob;
}
struct SrcDense {
    static constexpr bool GATHER = false;
    unsigned lda; const char* B; size_t bt;
    DI int ldb(int K) const { return K; }
    DI size_t ksplit() const { return 0; }
    DI unsigned a_off(const g8::Unit&, int, int) const { return 0u; }
    DI const char* b_ptr(const g8::Unit& u, int) const { return B + (size_t)u.pn * bt; }
};
struct SrcGu {
    static constexpr bool GATHER = true;
    unsigned lda; const int* rt; const int* te; const char* B;
    DI int ldb(int K) const { return K; }
    DI size_t ksplit() const { return 0; }
    DI unsigned a_off(const g8::Unit& u, int h, int R) const { const int v = rt[u.pm * 256 + h * 128 + R]; return (unsigned)(v ? v - 1 : 0) * lda; }
    DI const char* b_ptr(const g8::Unit& u, int) const { const int ee = te[u.pm]; const int e = (u.pn < 2) ? (ee & 255) : (ee >> 8); return B + ((size_t)e * 512 + (size_t)(u.pn & 1) * 256) * 1024 * 2; }
};
struct SrcDn {
    static constexpr bool GATHER = false;
    unsigned lda; const int* te; const char* B;
    DI int ldb(int) const { return 256; }
    DI size_t ksplit() const { return 512; }
    DI unsigned a_off(const g8::Unit&, int, int) const { return 0u; }
    DI const char* b_ptr(const g8::Unit& u, int half) const { const int ee = te[u.pm]; const int e = half ? (ee >> 8) : (ee & 255);
        return B + ((size_t)e * 1024 + (size_t)u.pn * 256) * 256 * 2 - (half ? 512 : 0); }
};
struct FIn0 { static constexpr bool PERM = true; const P& p;
    DI void e8(int row, int col, f32x4 a, f32x4 b, const g8::Unit&) const {
        if (col >= 384 && col < 416) { rope8(p, row, (col - 384) >> 1, a, b); store_bf8(p.kpe + (size_t)row * 32 + (col - 384), a, b); }
        else if (col < AB_IN) store_bf8(p.proj + (size_t)row * LD0 + col, a, b);
    } };
struct FUq { static constexpr bool PERM = true; const P& p;
    DI void e8(int row, int col, f32x4 a, f32x4 b, const g8::Unit&) const {
        const float r = p.rq[row] * QSCALE; a = a * r; b = b * r;
        if (((col >> 5) % 3) == 2) rope8(p, row, (col & 31) >> 1, a, b);
        store_bf8(p.q + (size_t)row * 768 + col, a, b);
    } };
struct FUkv { static constexpr bool PERM = true; const P& p;
    DI void e8(int row, int col, f32x4 a, f32x4 b, const g8::Unit&) const {
        const float r = p.rkv[row]; a = a * r; b = b * r;
        if (col < 512) store_bf8(p.kn + (size_t)row * 512 + col, a, b); else store_bf8(p.v + (size_t)row * 512 + (col - 512), a, b);
    } };
struct FOut { static constexpr bool PERM = true; const P& p; int l;
    DI void e8(int row, int col, const f32x4& a, const f32x4& b, const g8::Unit&) const {
        const int bb = row >> 12;
        const float* gp = p.mod + ((size_t)l * 16 + bb) * 6144 + 2048 + col;
        const f32x4 g0 = *(const f32x4*)gp, g1 = *(const f32x4*)(gp + 4);
        f32x4 x0, x1;
        if (l == 0) { const float* xp = p.x + (size_t)row * D + col; x0 = *(const f32x4*)xp; x1 = *(const f32x4*)(xp + 4); }
        else { const u32x4 r = *(const u32x4*)(p.xr + (size_t)row * D + col);
            x0 = (f32x4){__uint_as_float(r.x << 16), __uint_as_float(r.x & 0xffff0000u), __uint_as_float(r.y << 16), __uint_as_float(r.y & 0xffff0000u)};
            x1 = (f32x4){__uint_as_float(r.z << 16), __uint_as_float(r.z & 0xffff0000u), __uint_as_float(r.w << 16), __uint_as_float(r.w & 0xffff0000u)}; }
        store_bf8(p.xr + (size_t)row * D + col, x0 + g0 * a, x1 + g1 * b);
    } };
struct FIn1 { static constexpr bool PERM = true; const P& p;
    DI void e8(int row, int col, f32x4 a, f32x4 b, const g8::Unit&) const {
        if (col < 1024) {
#pragma unroll
            for (int e = 0; e < 4; ++e) { a[e] = gelu_tanh_f(a[e]); b[e] = gelu_tanh_f(b[e]); }
        } else if (col >= 2048 && col < 2304) {
            const float* bg = p.gla_b_g + (col - 2048); f32x4 o0, o1;
#pragma unroll
            for (int e = 0; e < 4; ++e) { o0[e] = log_sigmoid_f(a[e] + bg[e]) * (1.f / 16.f); o1[e] = log_sigmoid_f(b[e] + bg[4 + e]) * (1.f / 16.f); }
            float* dst = p.loga + (size_t)row * 256 + (col - 2048);
            *(f32x4*)dst = o0; *(f32x4*)(dst + 4) = o1;
            return;
        }
        store_bf8(p.proj + (size_t)row * LD1 + col, a, b);
    } };
struct FGu { static constexpr bool PERM = true; const P& p; const float* rw;
    DI void e8(int row, int col, const f32x4& a, const f32x4& b, const g8::Unit&) const {
        const float w = rw[2 * row + (col >> 9)];
        u32x2 o; o.x = pk2(silu_f(a[0]) * a[1] * w, silu_f(a[2]) * a[3] * w); o.y = pk2(silu_f(b[0]) * b[1] * w, silu_f(b[2]) * b[3] * w);
        *(u32x2*)(p.act + (size_t)row * 512 + (col >> 1)) = o;
    } };
struct FNull { static constexpr bool PERM = true;
    DI void e8(int, int, const f32x4& a, const f32x4& b, const g8::Unit&) const { asm volatile("" :: "v"(a[0]), "v"(a[1]), "v"(a[2]), "v"(a[3]), "v"(b[0]), "v"(b[1]), "v"(b[2]), "v"(b[3])); } };
struct FDn { static constexpr bool PERM = true; const P& p;
    DI void e8(int row, int col, const f32x4& a, const f32x4& b, const g8::Unit&) const { store_bf8(p.y + (size_t)row * D + col, a, b); } };

enum { J_IN0 = 0, J_UQ, J_UKV, J_OUT0, J_IN1, J_OUT1, J_GU, J_DN, J_R, J_NUM };
DI float wval(const P& p, int job, int sub, int k, int n) {
    switch (job) {
    case J_IN0: {
        if (n >= AB_IN) return 0.f;
        int src = n;
        if (n >= 384 && n < 416) { const int i = n - 384; src = 384 + (i >> 1) + (i & 1) * 16; }
        return p.ab_w_in[(size_t)k * AB_IN + src];
    }
    case J_UQ: {
        const int h = n / 96, j = n % 96; int src = 96 * h + j;
        if (j >= 64) { const int i = j - 64; src = 96 * h + 64 + (i >> 1) + (i & 1) * 16; }
        return p.w_uq[(size_t)k * 768 + src] * p.q_norm_g[k];
    }
    case J_UKV: {
        int src;
        if (n < 512) { src = 128 * (n >> 6) + (n & 63); } else { const int m = n - 512; src = 128 * (m >> 6) + 64 + (m & 63); }
        return p.w_ukv[(size_t)k * 1024 + src] * p.kv_norm_g[k];
    }
    case J_OUT0: return p.ab_w_out[(size_t)k * 1024 + n];
    case J_IN1: {
        if (n < 2048) return p.cd_w_in[(size_t)k * CD_IN + n];
        if (n < 2304) { const int j = n - 2048; float s = 0.f;
#pragma unroll
            for (int r = 0; r < 16; ++r) s += p.cd_w_in[(size_t)k * CD_IN + 2048 + r] * p.gla_w_g2[r * 256 + j];
            return s; }
        return p.cd_w_in[(size_t)k * CD_IN + 2064 + (n - 2304)];
    }
    case J_OUT1: return p.cd_w_out[(size_t)k * 1024 + n];
    case J_GU: { const int j = n >> 1; const int src = (n & 1) ? 256 + j : j; return p.moe_w_gate_up[((size_t)sub * 1024 + k) * 512 + src]; }
    case J_DN: return p.moe_w_down[((size_t)sub * 256 + k) * 1024 + n];
    case J_R: { if (n < 4) return p.moe_w_group[((size_t)sub * 1024 + k) * 4 + n]; if (n < 36) return p.moe_w_expert[((size_t)sub * 1024 + k) * 32 + (n - 4)]; return 0.f; }
    }
    return 0.f;
}
struct JobInfo { int K, N, nsub; };
DI JobInfo job_info(int job) {
    switch (job) {
    case J_IN0: return {1024, LD0, 1};
    case J_UQ: return {256, 768, 1};
    case J_UKV: return {128, 1024, 1};
    case J_OUT0: return {1024, 1024, 1};
    case J_IN1: return {1024, LD1, 1};
    case J_OUT1: return {1024, 1024, 1};
    case J_GU: return {1024, 512, 64};
    case J_DN: return {256, 1024, 64};
    default: return {1024, 64, 2};
    }
}
constexpr size_t WO_IN0 = 0, WO_UQ = WO_IN0 + (size_t)LD0 * 1024, WO_UKV = WO_UQ + 768 * 256, WO_OUT0 = WO_UKV + 1024 * 128, WO_IN1 = WO_OUT0 + 1024 * 1024,
    WO_OUT1 = WO_IN1 + (size_t)LD1 * 1024, WO_GU = WO_OUT1 + 1024 * 1024, WO_DN = WO_GU + (size_t)64 * 512 * 1024, WO_R = WO_DN + (size_t)64 * 1024 * 256, WO_END = WO_R + 2 * 64 * 1024;
DI size_t job_dst_off(int job) {
    switch (job) {
    case J_IN0: return WO_IN0; case J_UQ: return WO_UQ; case J_UKV: return WO_UKV; case J_OUT0: return WO_OUT0;
    case J_IN1: return WO_IN1; case J_OUT1: return WO_OUT1; case J_GU: return WO_GU; case J_DN: return WO_DN; default: return WO_R;
    }
}
DI void ph_prep(const P& p, LAS unsigned char* lds) {
    const int tid = tid_();
#ifndef PREP_A
#define PREP_A 1
#define PREP_B 1
#define PREP_C 1
#endif
    for (int rep_ = 0; rep_ < PREP_A; ++rep_)
    if (blockIdx.x < 192) {
        LAS float* cact = (LAS float*)lds;
        LAS float* red = cact + 16 * 1024;
        for (int i = tid; i < 16 * 1024; i += NTHR) cact[i] = silu_f(p.c[i]);
        __syncthreads();
        const int col = tid & 63, ks = tid >> 6;
        for (int item = blockIdx.x; item < 192; item += gridDim.x) {
            const int l = item / 96, j = (item % 96) * 64 + col;
            float acc[16];
#pragma unroll
            for (int b = 0; b < 16; ++b) acc[b] = 0.f;
            const float* W = p.adaln_w + (size_t)l * 1024 * 6144 + j;
            for (int k0 = ks * 128; k0 < ks * 128 + 128; k0 += 16) {
                float wv[16];
#pragma unroll
                for (int u = 0; u < 16; ++u) wv[u] = W[(size_t)(k0 + u) * 6144];
#pragma unroll
                for (int u = 0; u < 16; ++u)
#pragma unroll
                    for (int b = 0; b < 16; ++b) acc[b] += cact[b * 1024 + k0 + u] * wv[u];
            }
#pragma unroll
            for (int b = 0; b < 16; ++b) red[(ks * 16 + b) * 64 + col] = acc[b];
            __syncthreads();
            for (int i = tid; i < 1024; i += NTHR) {
                const int b = i >> 6, cc = i & 63; float s = 0.f;
#pragma unroll
                for (int q = 0; q < 8; ++q) s += red[(q * 16 + b) * 64 + cc];
                const int jj = (item % 96) * 64 + cc;
                p.mod[((size_t)l * 16 + b) * 6144 + jj] = s + p.adaln_b[l * 6144 + jj];
            }
            __syncthreads();
        }
    }
    for (int rep_ = 0; rep_ < PREP_B; ++rep_)
    {
        const int lane = tid & 63, wid = tid >> 6;
        LAS float* scr = (LAS float*)lds + wid * (64 * 33);
        int total = 0;
#pragma unroll
        for (int j = 0; j < J_NUM; ++j) { const JobInfo ji = job_info(j); total += (ji.K / 64) * (ji.N / 32) * ji.nsub; }
        for (int item = blockIdx.x * NWAVE + wid; item < total; item += gridDim.x * NWAVE) {
            int job = 0, jstart = 0, accn = 0;
#pragma unroll
            for (int j = 0; j < J_NUM; ++j) { const JobInfo jj = job_info(j); if (item >= accn) { job = j; jstart = accn; } accn += (jj.K / 64) * (jj.N / 32) * jj.nsub; }
#ifndef PREP_JOBREP
#define PREP_JOBREP -1
#endif
            for (int jr_ = 0; jr_ < ((job == PREP_JOBREP) ? 2 : 1); ++jr_) {
            const JobInfo ji = job_info(job);
            int r = item - jstart;
            const int kt = ji.K / 64, nt = ji.N / 32;
            const int sub = r / (kt * nt); r -= sub * kt * nt;
            const int n0 = (r % nt) * 32, k0 = (r / nt) * 64;
            {
                const int n = n0 + (lane & 31);
                const float* cp = nullptr; size_t ldk = 0; const float* gain = nullptr; bool slow = false;
                switch (job) {
                case J_IN0: { if (n < AB_IN) { int src = n; if (n >= 384 && n < 416) { const int i = n - 384; src = 384 + (i >> 1) + (i & 1) * 16; } cp = p.ab_w_in + src; ldk = AB_IN; } } break;
                case J_UQ: { const int h = n / 96, j = n % 96; int src = 96 * h + j; if (j >= 64) { const int i = j - 64; src = 96 * h + 64 + (i >> 1) + (i & 1) * 16; } cp = p.w_uq + src; ldk = 768; gain = p.q_norm_g; } break;
                case J_UKV: { int src; if (n < 512) src = 128 * (n >> 6) + (n & 63); else { const int m = n - 512; src = 128 * (m >> 6) + 64 + (m & 63); } cp = p.w_ukv + src; ldk = 1024; gain = p.kv_norm_g; } break;
                case J_OUT0: cp = p.ab_w_out + n; ldk = 1024; break;
                case J_IN1: { if (n < 2048) { cp = p.cd_w_in + n; ldk = CD_IN; } else if (n < 2304) slow = true; else { cp = p.cd_w_in + 2064 + (n - 2304); ldk = CD_IN; } } break;
                case J_OUT1: cp = p.cd_w_out + n; ldk = 1024; break;
                case J_GU: { const int j = n >> 1; cp = p.moe_w_gate_up + (size_t)sub * 1024 * 512 + ((n & 1) ? 256 + j : j); ldk = 512; } break;
                case J_DN: cp = p.moe_w_down + (size_t)sub * 256 * 1024 + n; ldk = 1024; break;
                default: slow = true; break;
                }
                const int kb = k0 + (lane >> 5);
                if (job == J_IN1 && n0 >= 2048 && n0 < 2304) {
                    float g2[16];
#pragma unroll
                    for (int r2 = 0; r2 < 16; ++r2) g2[r2] = p.gla_w_g2[r2 * 256 + (n - 2048)];
#pragma unroll 4
                    for (int i = 0; i < 32; ++i) { const float* wr = p.cd_w_in + (size_t)(kb + 2 * i) * CD_IN + 2048;
                        const f32x4 a = *(const f32x4*)wr, b = *(const f32x4*)(wr + 4), c = *(const f32x4*)(wr + 8), d = *(const f32x4*)(wr + 12);
                        float v = 0.f;
#pragma unroll
                        for (int e = 0; e < 4; ++e) v += a[e] * g2[e] + b[e] * g2[4 + e] + c[e] * g2[8 + e] + d[e] * g2[12 + e];
                        scr[(2 * i + (lane >> 5)) * 33 + (lane & 31)] = v; }
                } else if (__any(slow)) {
#pragma unroll 8
                    for (int i = 0; i < 32; ++i) scr[(2 * i + (lane >> 5)) * 33 + (lane & 31)] = wval(p, job, sub, kb + 2 * i, n);
                } else {
                    const float* q = cp ? cp + (size_t)kb * ldk : nullptr;
#pragma unroll
                    for (int i = 0; i < 32; ++i) { float v = q ? q[(size_t)(2 * i) * ldk] : 0.f; if (gain) v *= gain[kb + 2 * i]; scr[(2 * i + (lane >> 5)) * 33 + (lane & 31)] = v; }
                }
            }
            asm volatile("s_waitcnt lgkmcnt(0)" ::: "memory");
            bf16_t* dst = p.wt_in0 + job_dst_off(job) + (size_t)sub * ji.K * ji.N;
            const int c = lane & 7;
#pragma unroll
            for (int j = 0; j < 4; ++j) { const int n = (lane >> 3) + 8 * j; const LAS float* sp = scr + (8 * c) * 33 + n;
                u32x4 o; o.x = pk2(sp[0 * 33], sp[1 * 33]); o.y = pk2(sp[2 * 33], sp[3 * 33]); o.z = pk2(sp[4 * 33], sp[5 * 33]); o.w = pk2(sp[6 * 33], sp[7 * 33]);
                *(u32x4*)(dst + (size_t)(n0 + n) * ji.K + k0 + 8 * c) = o; }
            asm volatile("s_waitcnt lgkmcnt(0)" ::: "memory");
            }
        }
    }
    for (int rep_ = 0; rep_ < PREP_C; ++rep_)
    for (int gid = blockIdx.x * NTHR + tid; gid < NTOK * 16; gid += gridDim.x * NTHR) {
        const int tok = gid >> 4, i = gid & 15;
        const float inv = exp2f(-(float)i * (13.287712379549449f / 16.0f));
        float sn, cs; sincosf((float)p.pos[tok] * inv, &sn, &cs);
        p.ropec[gid] = cs; p.ropes[gid] = sn;
    }
}

template <bool F32IN>
DI void ph_norm(const P& p, const void* xin_, const float* g, int l, int which) {
    const int tid = tid_(); const int lane = tid & 63;
    constexpr int R = 4;
    for (int row0 = (blockIdx.x * NWAVE + (tid >> 6)) * R; row0 < NTOK; row0 += gridDim.x * NWAVE * R) {
        const int b = row0 >> 12;
        const float* md = p.mod + ((size_t)l * 16 + b) * 6144 + which * 3072;
        f32x4 v[R][4]; float ss[R];
#pragma unroll
        for (int r = 0; r < R; ++r)
#pragma unroll
            for (int i = 0; i < 4; ++i) {
                if (F32IN) v[r][i] = *(const f32x4*)((const float*)xin_ + (size_t)(row0 + r) * D + i * 256 + lane * 4);
                else { const u32x2 q = *(const u32x2*)((const bf16_t*)xin_ + (size_t)(row0 + r) * D + i * 256 + lane * 4);
                       v[r][i] = (f32x4){__uint_as_float(q.x << 16), __uint_as_float(q.x & 0xffff0000u), __uint_as_float(q.y << 16), __uint_as_float(q.y & 0xffff0000u)}; }
            }
#pragma unroll
        for (int r = 0; r < R; ++r) { float a = 0.f;
#pragma unroll
            for (int i = 0; i < 4; ++i) a += v[r][i][0] * v[r][i][0] + v[r][i][1] * v[r][i][1] + v[r][i][2] * v[r][i][2] + v[r][i][3] * v[r][i][3];
            ss[r] = rsqrtf(wave_sum(a) * (1.f / D) + EPS); }
#pragma unroll
        for (int i = 0; i < 4; ++i) {
            const int c0 = i * 256 + lane * 4;
            const f32x4 gg = *(const f32x4*)(g + c0), sh = *(const f32x4*)(md + c0), sc = *(const f32x4*)(md + 1024 + c0);
#pragma unroll
            for (int r = 0; r < R; ++r) {
                float o[4];
#pragma unroll
                for (int e = 0; e < 4; ++e) o[e] = v[r][i][e] * ss[r] * gg[e] * (1.f + sc[e]) + sh[e];
                u32x2 w; w.x = pk2(o[0], o[1]); w.y = pk2(o[2], o[3]);
                *(u32x2*)(p.xa + (size_t)(row0 + r) * D + c0) = w;
            }
        }
    }
}
DI void ph_rowstat0_conv(const P& p) {
    const int tid = tid_(); const int lane = tid & 63;
    float cw[3][8];
#pragma unroll
    for (int k = 0; k < 3; ++k) { const f32x4 a = *(const f32x4*)(p.conv_w + k * 512 + lane * 8), b = *(const f32x4*)(p.conv_w + k * 512 + lane * 8 + 4);
#pragma unroll
        for (int e = 0; e < 4; ++e) { cw[k][e] = a[e]; cw[k][4 + e] = b[e]; } }
    for (int blk = blockIdx.x * NWAVE + (tid >> 6); blk < NTOK / 16; blk += gridDim.x * NWAVE) {
        const int row0 = blk * 16;
        float u1[8], u2[8];
#pragma unroll
        for (int e = 0; e < 8; ++e) { u1[e] = 0.f; u2[e] = 0.f; }
        if ((row0 & 4095) != 0) {
#pragma unroll
            for (int d = 1; d <= 2; ++d) { const bf16_t* q = p.proj + (size_t)(row0 - d) * LD0; const u32x4 c = *(const u32x4*)(q + 928 + lane * 8), x = *(const u32x4*)(q + 1440 + lane * 8);
#pragma unroll
                for (int e = 0; e < 4; ++e) { const float v0 = __uint_as_float(c[e] << 16) * __uint_as_float(x[e] << 16), v1 = __uint_as_float(c[e] & 0xffff0000u) * __uint_as_float(x[e] & 0xffff0000u);
                    if (d == 1) { u1[2 * e] = v0; u1[2 * e + 1] = v1; } else { u2[2 * e] = v0; u2[2 * e + 1] = v1; } } }
        }
#pragma unroll 4
        for (int i = 0; i < 16; ++i) {
            const int row = row0 + i;
            const bf16_t* r = p.proj + (size_t)row * LD0;
            { const u32x2 a = *(const u32x2*)(r + lane * 4); const unsigned kk = *(const unsigned*)(r + 256 + lane * 2);
              float sq = 0.f, sk = 0.f;
              { const float a0 = __uint_as_float(a.x << 16), a1 = __uint_as_float(a.x & 0xffff0000u), a2 = __uint_as_float(a.y << 16), a3 = __uint_as_float(a.y & 0xffff0000u); sq = a0 * a0 + a1 * a1 + a2 * a2 + a3 * a3; }
              { const float k0 = __uint_as_float(kk << 16), k1 = __uint_as_float(kk & 0xffff0000u); sk = k0 * k0 + k1 * k1; }
              sq = wave_sum(sq); sk = wave_sum(sk);
              if (lane == 0) { p.rq[row] = rsqrtf(sq * (1.f / 256.f) + EPS); p.rkv[row] = rsqrtf(sk * (1.f / 128.f) + EPS); } }
            const u32x4 bg = *(const u32x4*)(r + 416 + lane * 8), c = *(const u32x4*)(r + 928 + lane * 8), x = *(const u32x4*)(r + 1440 + lane * 8);
            u32x4 o;
#pragma unroll
            for (int e = 0; e < 4; ++e) {
                const float v0 = __uint_as_float(c[e] << 16) * __uint_as_float(x[e] << 16), v1 = __uint_as_float(c[e] & 0xffff0000u) * __uint_as_float(x[e] & 0xffff0000u);
                const float y0 = cw[0][2 * e] * u2[2 * e] + cw[1][2 * e] * u1[2 * e] + cw[2][2 * e] * v0;
                const float y1 = cw[0][2 * e + 1] * u2[2 * e + 1] + cw[1][2 * e + 1] * u1[2 * e + 1] + cw[2][2 * e + 1] * v1;
                u2[2 * e] = u1[2 * e]; u2[2 * e + 1] = u1[2 * e + 1]; u1[2 * e] = v0; u1[2 * e + 1] = v1;
                o[e] = pk2(__uint_as_float(bg[e] << 16) * y0, __uint_as_float(bg[e] & 0xffff0000u) * y1);
            }
            *(u32x4*)(p.mix + (size_t)row * D + 512 + lane * 8) = o;
        }
    }
}
constexpr int GL_QS = 72, GL_VS = 144;
constexpr int GX_SEG = 0, GX_QD = 2048, GX_KD = GX_QD + 64 * GL_QS * 2, GX_KE = GX_KD + 64 * GL_QS * 2, GX_V = GX_KE + 64 * GL_QS * 2, GX_END = GX_V + 64 * GL_VS * 2;
DI void ph_stat1x(const P& p, LAS unsigned char* lds) {
    const int tid = tid_(); const int lane = tid & 63, w = __builtin_amdgcn_readfirstlane(tid >> 6), l15 = lane & 15, g = lane >> 4, tq = l15 >> 2, tp = l15 & 3;
    for (int row = blockIdx.x * NWAVE + w; row < NTOK; row += gridDim.x * NWAVE) {
        const u32x4 a = *(const u32x4*)(p.proj + (size_t)row * LD1 + 512 + lane * 8);
        float s = 0.f;
#pragma unroll
        for (int e = 0; e < 4; ++e) { const float v0 = __uint_as_float(a[e] << 16), v1 = __uint_as_float(a[e] & 0xffff0000u); s += v0 * v0 + v1 * v1; }
        s = wave_sum(s);
        if (lane == 0) p.rv[row] = rsqrtf(s * (1.f / 512.f) + EPS);
    }
    for (int it = blockIdx.x; it < (NTOK / 64) * 4; it += gridDim.x) {
        const int h = it & 3, ck = it >> 2;
        const size_t row0 = (size_t)ck * 64;
        float bc[8], qv[8], kv[8];
        { const float* la = p.loga + (row0 + 8 * w) * 256 + h * 64 + lane; const bf16_t* pq = p.proj + (row0 + 8 * w) * LD1 + 1024 + h * 64 + lane;
#pragma unroll
          for (int i = 0; i < 8; ++i) { bc[i] = la[(size_t)i * 256]; qv[i] = bf2f(pq[(size_t)i * LD1]); kv[i] = bf2f(pq[(size_t)i * LD1 + 256]); } }
        u32x4 rvv[2];
#pragma unroll
        for (int i = 0; i < 2; ++i) { const int c = i * 512 + tid; rvv[i] = *(const u32x4*)(p.proj + (row0 + (c >> 4)) * LD1 + 1536 + h * 128 + (c & 15) * 8); }
#pragma unroll
        for (int i = 1; i < 8; ++i) bc[i] += bc[i - 1];
        ((LAS float*)(lds + GX_SEG))[w * 64 + lane] = bc[7];
#pragma unroll
        for (int i = 0; i < 2; ++i) { const int c = i * 512 + tid; *(LAS u32x4*)(lds + GX_V + ((c >> 4) * GL_VS + (c & 15) * 8) * 2) = rvv[i]; }
        __syncthreads();
        float off = 0.f, bl = 0.f;
#pragma unroll
        for (int ww = 0; ww < 8; ++ww) { const float sg = ((const LAS float*)(lds + GX_SEG))[ww * 64 + lane]; bl += sg; off += (ww < w) ? sg : 0.f; }
#pragma unroll
        for (int i = 0; i < 8; ++i) {
            const float x = bc[i] + off, eb = __expf(x);
            const int o = ((8 * w + i) * GL_QS + lane) * 2;
            *(LAS bf16_t*)(lds + GX_QD + o) = f2bf(qv[i] * 0.125f * eb); *(LAS bf16_t*)(lds + GX_KD + o) = f2bf(kv[i] * __builtin_amdgcn_rcpf(eb)); *(LAS bf16_t*)(lds + GX_KE + o) = f2bf(kv[i] * __expf(bl - x));
        }
        if (w == 0) p.gdec[(size_t)ck * 256 + h * 64 + lane] = __expf(bl);
        __syncthreads();
        { const int o = ((tid >> 3) * GL_QS + (tid & 7) * 8) * 2; const size_t go = (row0 + (tid >> 3)) * 256 + h * 64 + (tid & 7) * 8;
          *(u32x4*)(p.gqd + go) = *(const LAS u32x4*)(lds + GX_QD + o); *(u32x4*)(p.gkd + go) = *(const LAS u32x4*)(lds + GX_KD + o); }
        bf16x8 vN[2];
#pragma unroll
        for (int ks = 0; ks < 2; ++ks) {
            const s16x4 lo = vtr(lds + GX_V + ((32 * ks + 8 * g + tq) * GL_VS + 16 * w + 4 * tp) * 2), hi4 = vtr(lds + GX_V + ((32 * ks + 8 * g + 4 + tq) * GL_VS + 16 * w + 4 * tp) * 2);
            vN[ks] = (bf16x8){lo[0], lo[1], lo[2], lo[3], hi4[0], hi4[1], hi4[2], hi4[3]};
        }
        bf16_t* kvo = p.gkv + ((size_t)it * 64) * 128 + 16 * w + l15;
#pragma unroll
        for (int dkt = 0; dkt < 4; ++dkt) {
            f32x4 sc = (f32x4){0.f, 0.f, 0.f, 0.f};
#pragma unroll
            for (int ks = 0; ks < 2; ++ks) {
                const s16x4 lo = vtr(lds + GX_KE + ((32 * ks + 8 * g + tq) * GL_QS + 16 * dkt + 4 * tp) * 2), hi4 = vtr(lds + GX_KE + ((32 * ks + 8 * g + 4 + tq) * GL_QS + 16 * dkt + 4 * tp) * 2);
                const bf16x8 keT = (bf16x8){lo[0], lo[1], lo[2], lo[3], hi4[0], hi4[1], hi4[2], hi4[3]};
                sc = __builtin_amdgcn_mfma_f32_16x16x32_bf16(keT, vN[ks], sc, 0, 0, 0);
            }
#pragma unroll
            for (int j = 0; j < 4; ++j) kvo[(size_t)(16 * dkt + 4 * g + j) * 128] = f2bf(sc[j]);
        }
        __syncthreads();
    }
}
DI void ph_gla_scan(const P& p) {
    const int tid = tid_();
    for (int gid = blockIdx.x * NTHR + tid; gid < 64 * 64 * 32; gid += gridDim.x * NTHR) {
        const int dvq = gid & 31, dk = (gid >> 5) & 63, bh = gid >> 11, b = bh >> 2, h = bh & 3;
        float st[4] = {0.f, 0.f, 0.f, 0.f};
        const size_t e0 = (((size_t)b * 64 * 4 + h) * 64 + dk) * 128 + dvq * 4;
        const float* dc = p.gdec + (size_t)b * 64 * 256 + h * 64 + dk;
#pragma unroll 8
        for (int n = 0; n < 64; ++n) {
            const size_t e = e0 + (size_t)n * (4 * 64 * 128);
            const u32x2 kvv = *(const u32x2*)(p.gkv + e); const float d = dc[(size_t)n * 256];
            u32x2 o; o.x = pk2(st[0], st[1]); o.y = pk2(st[2], st[3]);
            *(u32x2*)(p.gst + e) = o;
            st[0] = st[0] * d + __uint_as_float(kvv.x << 16); st[1] = st[1] * d + __uint_as_float(kvv.x & 0xffff0000u);
            st[2] = st[2] * d + __uint_as_float(kvv.y << 16); st[3] = st[3] * d + __uint_as_float(kvv.y & 0xffff0000u);
        }
    }
}

constexpr int NCLS = 112;
DI void ph_router(const P& p, int l, LAS unsigned char* lds) {
    const int tid = tid_(); const int lane = tid & 63, wid = tid >> 6, fr = lane & 15, fq = lane >> 4;
    LAS float* lg = (LAS float*)lds + wid * (32 * 65);
    const bf16_t* W = p.wt_r + (size_t)l * 64 * 1024;
    LAS int* hist = (LAS int*)(lds + 8 * 32 * 65 * 4);
    if (tid < 128) hist[tid] = 0;
    __syncthreads();
    const size_t o = (size_t)l * NTOK;
    for (int mt = blockIdx.x * NWAVE + wid; mt < NTOK / 32; mt += gridDim.x * NWAVE) {
        const int m0 = mt * 32;
        const bf16_t* ap[2]; const bf16_t* bp[4];
#pragma unroll
        for (int i = 0; i < 2; ++i) ap[i] = p.xa + (size_t)(m0 + 16 * i + fr) * D + fq * 8;
#pragma unroll
        for (int j = 0; j < 4; ++j) bp[j] = W + (size_t)(16 * j + fr) * 1024 + fq * 8;
        f32x4 acc[2][4];
#pragma unroll
        for (int i = 0; i < 2; ++i)
#pragma unroll
            for (int j = 0; j < 4; ++j) acc[i][j] = (f32x4){0.f, 0.f, 0.f, 0.f};
        for (int k = 0; k < 1024; k += 32) {
            bf16x8 a[2], b[4];
#pragma unroll
            for (int i = 0; i < 2; ++i) a[i] = *(const bf16x8*)(ap[i] + k);
#pragma unroll
            for (int j = 0; j < 4; ++j) b[j] = *(const bf16x8*)(bp[j] + k);
#pragma unroll
            for (int i = 0; i < 2; ++i)
#pragma unroll
                for (int j = 0; j < 4; ++j) acc[i][j] = __builtin_amdgcn_mfma_f32_16x16x32_bf16(b[j], a[i], acc[i][j], 0, 0, 0);
        }
#pragma unroll
        for (int i = 0; i < 2; ++i)
#pragma unroll
            for (int j = 0; j < 4; ++j)
#pragma unroll
                for (int e = 0; e < 4; ++e) lg[(16 * i + fr) * 65 + 16 * j + 4 * fq + e] = acc[i][j][e];
        asm volatile("s_waitcnt lgkmcnt(0)" ::: "memory");
        if (lane < 32) {
            const LAS float* r = lg + lane * 65; const int tok = m0 + lane;
            float gl[4]; int gs = 0;
#pragma unroll
            for (int j = 0; j < 4; ++j) gl[j] = r[j] + p.moe_b_group[l * 4 + j];
            float gmax = gl[0];
#pragma unroll
            for (int j = 1; j < 4; ++j) if (gl[j] > gmax) { gmax = gl[j]; gs = j; }
            float den = 0.f;
#pragma unroll
            for (int j = 0; j < 4; ++j) den += __expf(gl[j] - gmax);
            const float pg = 1.f / den;
            float el[8];
#pragma unroll
            for (int j = 0; j < 8; ++j) el[j] = r[4 + gs * 8 + j] + p.moe_b_expert[l * 32 + gs * 8 + j];
            int i1 = 0; float v1 = el[0];
#pragma unroll
            for (int j = 1; j < 8; ++j) if (el[j] > v1) { v1 = el[j]; i1 = j; }
            int i2 = -1; float v2 = -INFINITY;
#pragma unroll
            for (int j = 0; j < 8; ++j) if (j != i1 && el[j] > v2) { v2 = el[j]; i2 = j; }
            const float e2 = __expf(v2 - v1);
            const float w1 = pg / (1.f + e2), w2 = pg * e2 / (1.f + e2);
            const int lo = i1 < i2 ? i1 : i2, hi = i1 < i2 ? i2 : i1;
            const int cls = gs * 28 + (lo * (15 - lo)) / 2 + (hi - lo - 1);
            const int pos = __hip_atomic_fetch_add(hist + cls, 1, __ATOMIC_RELAXED, __HIP_MEMORY_SCOPE_WORKGROUP);
            p.tope[o + tok] = cls; p.toppos[o + tok] = pos;
            p.topw[2 * (o + tok)] = (i1 < i2) ? w1 : w2; p.topw[2 * (o + tok) + 1] = (i1 < i2) ? w2 : w1;
        }
        asm volatile("s_waitcnt lgkmcnt(0)" ::: "memory");
    }
    __syncthreads();
    if (tid < 128) p.whist[((size_t)l * 256 + blockIdx.x) * 128 + tid] = hist[tid];
    __syncthreads();
}
DI void ph_slots(const P& p, int l, LAS unsigned char* lds) {
    LAS int* ss = (LAS int*)lds;
    const int tid = tid_();
    const int G = gridDim.x, bx = blockIdx.x;
    if (tid < 128) {
        int tot = 0, pre = 0;
        for (int w = 0; w < G; ++w) { const int v = p.whist[((size_t)l * 256 + w) * 128 + tid]; tot += v; pre += (w < bx) ? v : 0; }
        ss[384 + tid] = tot; ss[tid] = pre;
    }
    __syncthreads();
    if (tid == 0) {
        int start = 0, tile = 0;
        for (int c = 0; c < NCLS; ++c) { const int nt = (ss[384 + c] + 255) >> 8; ss[c] += start; ss[128 + c] = tile; tile += nt; start += nt * 256; }
        ss[256] = tile;
    }
    __syncthreads();
    if (bx == 0) {
        if (tid < NCLS) {
            const int g = tid / 28; int r = tid % 28, lo = 0; while (r >= 7 - lo) { r -= 7 - lo; ++lo; } const int hi = lo + 1 + r;
            const int code = (g * 8 + lo) | ((g * 8 + hi) << 8);
            const int t0 = ss[128 + tid], t1 = (tid == NCLS - 1) ? ss[256] : ss[128 + tid + 1];
            for (int i = t0; i < t1; ++i) p.tile_e[l * 1024 + i] = code;
        }
        if (tid == 0) p.ntile[l] = ss[256];
    }
    const int lane = tid & 63, wid = tid >> 6;
    if (lane < 32)
    for (int mt = bx * NWAVE + wid; mt < NTOK / 32; mt += G * NWAVE) {
        const int tok = mt * 32 + lane;
        const size_t o = (size_t)l * NTOK + tok;
        const int slot = ss[p.tope[o]] + p.toppos[o];
        p.row_tok[(size_t)l * MAXSLOT + slot] = tok + 1;
        p.topslot[o] = slot;
        *(f32x2_t*)(p.row_w + 2 * ((size_t)l * MAXSLOT + slot)) = *(const f32x2_t*)(p.topw + 2 * o);
    }
    __syncthreads();
}
DI void ph_postnorm(const P& p, int l, int last) {
    const int tid = tid_(); const int lane = tid & 63;
    constexpr int R = 2;
    for (int row0 = (blockIdx.x * NWAVE + (tid >> 6)) * R; row0 < NTOK; row0 += gridDim.x * NWAVE * R) {
        const int b = row0 >> 12;
        const float* g2 = p.mod + ((size_t)l * 16 + b) * 6144 + 5 * 1024;
        int sl[R];
#pragma unroll
        for (int r = 0; r < R; ++r) sl[r] = p.topslot[(size_t)l * NTOK + row0 + r];
        u32x2 yv[R][4], xv[R][4];
#pragma unroll
        for (int r = 0; r < R; ++r)
#pragma unroll
            for (int i = 0; i < 4; ++i) { const int c0 = i * 256 + lane * 4; yv[r][i] = *(const u32x2*)(p.y + (size_t)sl[r] * D + c0); xv[r][i] = *(const u32x2*)(p.xr + (size_t)(row0 + r) * D + c0); }
        f32x4 v[R][4]; float rs[R];
#pragma unroll
        for (int r = 0; r < R; ++r) { float ss = 0.f;
#pragma unroll
            for (int i = 0; i < 4; ++i) {
                const f32x4 gg = *(const f32x4*)(g2 + i * 256 + lane * 4);
                v[r][i][0] = __uint_as_float(xv[r][i].x << 16) + gg[0] * __uint_as_float(yv[r][i].x << 16);
                v[r][i][1] = __uint_as_float(xv[r][i].x & 0xffff0000u) + gg[1] * __uint_as_float(yv[r][i].x & 0xffff0000u);
                v[r][i][2] = __uint_as_float(xv[r][i].y << 16) + gg[2] * __uint_as_float(yv[r][i].y << 16);
                v[r][i][3] = __uint_as_float(xv[r][i].y & 0xffff0000u) + gg[3] * __uint_as_float(yv[r][i].y & 0xffff0000u);
                ss += v[r][i][0] * v[r][i][0] + v[r][i][1] * v[r][i][1] + v[r][i][2] * v[r][i][2] + v[r][i][3] * v[r][i][3];
            }
            rs[r] = rsqrtf(wave_sum(ss) * (1.f / D) + EPS); }
        if (last) {
#pragma unroll
            for (int i = 0; i < 4; ++i) { const int c0 = i * 256 + lane * 4; const f32x4 gg = *(const f32x4*)(p.final_norm_g + c0);
#pragma unroll
                for (int r = 0; r < R; ++r) *(f32x4*)(p.out + (size_t)(row0 + r) * D + c0) = v[r][i] * rs[r] * gg; }
        } else {
            const float* md = p.mod + ((size_t)(l + 1) * 16 + b) * 6144;
            const float* g = p.norm_mix_g + (l + 1) * D;
#pragma unroll
            for (int i = 0; i < 4; ++i) {
                const int c0 = i * 256 + lane * 4;
                const f32x4 gg = *(const f32x4*)(g + c0), sh = *(const f32x4*)(md + c0), sc = *(const f32x4*)(md + 1024 + c0);
#pragma unroll
                for (int r = 0; r < R; ++r) {
                    u32x2 xw; xw.x = pk2(v[r][i][0], v[r][i][1]); xw.y = pk2(v[r][i][2], v[r][i][3]);
                    *(u32x2*)(p.xr + (size_t)(row0 + r) * D + c0) = xw;
                    float oo[4];
#pragma unroll
                    for (int e = 0; e < 4; ++e) oo[e] = v[r][i][e] * rs[r] * gg[e] * (1.f + sc[e]) + sh[e];
                    u32x2 w; w.x = pk2(oo[0], oo[1]); w.y = pk2(oo[2], oo[3]);
                    *(u32x2*)(p.xa + (size_t)(row0 + r) * D + c0) = w;
                }
            }
        }
    }
}

constexpr int AT_KB = 12 * 1024, AT_VB = 8 * 1024, AT_BUF = AT_KB + AT_VB, AT_NSLOT = 4, AT_WS = AT_NSLOT * AT_BUF, AT_OST = AT_WS + 8 * 256, AT_LDS = AT_OST + 8 * 4096;
static_assert(AT_LDS <= 147200, "attention LDS map");
constexpr float AT_THR = 8.f;
DI void attn_unit(const P& p, LAS unsigned char* lds, int b, int h, int qb, int tid) {
    const int lane = tid & 63, wid = __builtin_amdgcn_readfirstlane(tid >> 6), r32 = lane & 31, hi = lane >> 5;
    const size_t rowbase = (size_t)b * SEQ; const int q0 = qb * 256;
    const int NT = 4 * (qb + 1);
    const bf16_t* ksrc = p.kn + (rowbase + lane) * 512 + h * 64 + wid * 8;
    const bf16_t* psrc = p.kpe + (rowbase + lane) * 32 + (wid & 3) * 8;
    const bf16_t* vsrc = p.v + (rowbase + 16 * (wid & 3) + (lane >> 2)) * 512 + h * 64 + (wid >> 2) * 32 + (lane & 3) * 8;
#define AT_LOAD(t, buf) do { \
        __builtin_amdgcn_global_load_lds((const unsigned*)(ksrc + (size_t)(t) * 64 * 512), (LAS unsigned*)(lds + (buf) * AT_BUF + wid * 1024), 16, 0, 0); \
        __builtin_amdgcn_global_load_lds((const unsigned*)(psrc + (size_t)(t) * 64 * 32), (LAS unsigned*)(lds + (buf) * AT_BUF + (8 + (wid & 3)) * 1024), 16, 0, 0);   \
        __builtin_amdgcn_global_load_lds((const unsigned*)(vsrc + (size_t)(t) * 64 * 512), (LAS unsigned*)(lds + (buf) * AT_BUF + AT_KB + wid * 1024), 16, 0, 0); } while (0)
#define AT_RAWBAR() do { asm volatile("s_waitcnt lgkmcnt(0)" ::: "memory"); __builtin_amdgcn_s_barrier(); asm volatile("" ::: "memory"); } while (0)
#define AT_SKIP(t) (((t) - (NT - 4)) >= 0 && 64 * ((t) - (NT - 4)) > wid * 32 + 31)
#define AT_QK(P0, P1, slot) do { const LAS unsigned char* kb_ = lds + (slot) * AT_BUF + koff; P0 = negm; P1 = negm; \
        _Pragma("unroll") for (int d0 = 0; d0 < 6; ++d0) { \
            const bf16x8 k0_ = *(const LAS bf16x8*)(kb_ + d0 * 2048), k1_ = *(const LAS bf16x8*)(kb_ + d0 * 2048 + 512); \
            P0 = __builtin_amdgcn_mfma_f32_32x32x16_bf16(k0_, qr[d0], P0, 0, 0, 0); P1 = __builtin_amdgcn_mfma_f32_32x32x16_bf16(k1_, qr[d0], P1, 0, 0, 0); } } while (0)
    bf16x8 qr[6];
    { const bf16_t* Qw = p.q + (rowbase + q0 + wid * 32 + r32) * 768 + h * 96 + hi * 8;
#pragma unroll
      for (int d0 = 0; d0 < 6; ++d0) qr[d0] = *(const bf16x8*)(Qw + d0 * 16);
      AT_LOAD(0, 0); AT_LOAD(1, 1); AT_LOAD(2, 2);
#pragma unroll
      for (int d0 = 0; d0 < 6; ++d0) asm volatile("" : "+v"(qr[d0])); }
    LAS float* wsf = (LAS float*)(lds + AT_WS) + wid * 64;
    float mhat = 0.f, lsum = 0.f;
    f32x16 o[2], negm, p0, p1, n0, n1;
#pragma unroll
    for (int r = 0; r < 16; ++r) { o[0][r] = 0.f; o[1][r] = 0.f; negm[r] = 0.f; n0[r] = 0.f; n1[r] = 0.f; }
    const int qrel = wid * 32 + r32;
    const int koff = hi * 1024 + r32 * 16;
    const int voff = AT_KB + ((lane >> 4) & 1) * 32 + (lane & 3) * 8 + (4 * hi + ((lane & 15) >> 2)) * 64;
    asm volatile("s_waitcnt vmcnt(0)" ::: "memory");
    AT_RAWBAR();
    AT_QK(p0, p1, 0);
    for (int t = 0; t < NT; ++t) {
        if (t + 2 < NT) asm volatile("s_waitcnt vmcnt(3)" ::: "memory"); else asm volatile("s_waitcnt vmcnt(0)" ::: "memory");
        AT_RAWBAR();
        if (t + 3 < NT) AT_LOAD(t + 3, (t + 3) & 3);
        const bool skip_n = (t + 1 >= NT) || AT_SKIP(t + 1);
        if (!skip_n) AT_QK(n0, n1, (t + 1) & 3);
        if (!AT_SKIP(t)) {
            const int jb = t - (NT - 4);
            if (jb >= 0) {
                const int kbase = 64 * jb + 4 * hi;
#pragma unroll
                for (int r = 0; r < 16; ++r) { const int kv = kbase + (r & 3) + 8 * (r >> 2); if (kv > qrel) p0[r] = -INFINITY; if (kv + 32 > qrel) p1[r] = -INFINITY; }
            }
            float mx;
            { float a = __builtin_fmaxf(__builtin_fmaxf(p0[0], p0[1]), p1[0]), c = __builtin_fmaxf(__builtin_fmaxf(p0[2], p0[3]), p1[1]); a = __builtin_fmaxf(__builtin_fmaxf(a, p1[2]), p1[3]);
#pragma unroll
              for (int r = 4; r < 16; r += 4) { a = __builtin_fmaxf(__builtin_fmaxf(a, p0[r]), p0[r + 1]); c = __builtin_fmaxf(__builtin_fmaxf(c, p0[r + 2]), p0[r + 3]); a = __builtin_fmaxf(__builtin_fmaxf(a, p1[r]), p1[r + 1]); c = __builtin_fmaxf(__builtin_fmaxf(c, p1[r + 2]), p1[r + 3]); }
              mx = __builtin_fmaxf(a, c); }
            { auto rr = __builtin_amdgcn_permlane32_swap(__float_as_uint(mx), __float_as_uint(mx), false, false); mx = fmaxf(__uint_as_float(rr[0]), __uint_as_float(rr[1])); }
            const bool need = (t == 0) || (mx > AT_THR);
            if (__any(need)) {
                const float delta = need ? mx : 0.f;
                mhat += delta;
#pragma unroll
                for (int r = 0; r < 16; ++r) { p0[r] -= delta; p1[r] -= delta; n0[r] -= delta; n1[r] -= delta; negm[r] = -mhat; }
                if (t > 0) {
                    const float alpha = __builtin_amdgcn_exp2f(-delta);
                    lsum *= alpha;
                    if (hi == 0) wsf[r32] = alpha;
                    asm volatile("s_waitcnt lgkmcnt(0)" ::: "memory");
#pragma unroll
                    for (int r = 0; r < 16; ++r) { const float a = wsf[crow(r, hi)]; o[0][r] *= a; o[1][r] *= a; }
                }
            }
            f32x2_t sa = {0.f, 0.f}, sb = {0.f, 0.f};
#pragma unroll
            for (int r = 0; r < 16; r += 2) { p0[r] = __builtin_amdgcn_exp2f(p0[r]); p0[r + 1] = __builtin_amdgcn_exp2f(p0[r + 1]); p1[r] = __builtin_amdgcn_exp2f(p1[r]); p1[r + 1] = __builtin_amdgcn_exp2f(p1[r + 1]);
                sa += (f32x2_t){p0[r], p0[r + 1]}; sb += (f32x2_t){p1[r], p1[r + 1]}; }
            lsum += (sa[0] + sa[1]) + (sb[0] + sb[1]);
            u32x4 pw[4];
#pragma unroll
            for (int j = 0; j < 4; ++j) { pw[0][j] = cvtpk(p0[2 * j], p0[2 * j + 1]); pw[1][j] = cvtpk(p0[8 + 2 * j], p0[8 + 2 * j + 1]); pw[2][j] = cvtpk(p1[2 * j], p1[2 * j + 1]); pw[3][j] = cvtpk(p1[8 + 2 * j], p1[8 + 2 * j + 1]); }
            const LAS unsigned char* vb = lds + (t & 3) * AT_BUF + voff;
#pragma unroll
            for (int d0 = 0; d0 < 2; ++d0)
#pragma unroll
                for (int ks = 0; ks < 4; ++ks) {
                    const s16x4 lo = vtr(vb + d0 * 4096 + ks * 1024), hi4 = vtr(vb + d0 * 4096 + ks * 1024 + 512);
                    const bf16x8 vf = (bf16x8){lo[0], lo[1], lo[2], lo[3], hi4[0], hi4[1], hi4[2], hi4[3]};
                    o[d0] = __builtin_amdgcn_mfma_f32_32x32x16_bf16(__builtin_bit_cast(bf16x8, pw[ks]), vf, o[d0], 0, 0, 0);
                }
        }
        p0 = n0; p1 = n1;
    }
#undef AT_LOAD
#undef AT_QK
#undef AT_SKIP
    { auto rr = __builtin_amdgcn_permlane32_swap(__float_as_uint(lsum), __float_as_uint(lsum), false, false); lsum = __uint_as_float(rr[0]) + __uint_as_float(rr[1]); }
    if (hi == 0) wsf[32 + r32] = lsum;
    asm volatile("s_waitcnt lgkmcnt(0)" ::: "memory");
    LAS bf16_t* stg = (LAS bf16_t*)(lds + AT_OST) + wid * 2048;
#pragma unroll
    for (int r = 0; r < 16; ++r) {
        const int orow = crow(r, hi); const float rl = __builtin_amdgcn_rcpf(wsf[32 + orow]);
        stg[orow * 64 + r32] = f2bf(o[0][r] * rl); stg[orow * 64 + 32 + r32] = f2bf(o[1][r] * rl);
    }
    asm volatile("s_waitcnt lgkmcnt(0)" ::: "memory");
    bf16_t* Ow = p.mix + (rowbase + q0 + wid * 32) * D + h * 64;
#pragma unroll
    for (int i = 0; i < 4; ++i) { const int row = i * 8 + (lane >> 3), ch = lane & 7; const u32x4 v = *(const LAS u32x4*)(stg + row * 64 + ch * 8); *(u32x4*)(Ow + (size_t)row * D + ch * 8) = v; }
    AT_RAWBAR();
#undef AT_RAWBAR
}
DI void ph_attn(const P& p, LAS unsigned char* lds) {
    const int tid = tid_();
    const int G = gridDim.x, bx = blockIdx.x;
    const int vcu = (G % 8 == 0) ? (bx % 8) * (G / 8) + bx / 8 : bx;
    for (int grp = vcu; grp < 256; grp += G) {
        const int bh = grp >> 1, par = grp & 1;
#pragma unroll 1
        for (int i = 0; i < 8; ++i) {
            const int s = 2 * (i >> 1) + par;
            const int qb = (i & 1) ? 15 - s : s;
            attn_unit(p, lds, bh >> 3, bh & 7, qb, tid);
        }
    }
}

constexpr int GZ_QD = 0, GZ_KD = 64 * GL_QS * 2, GZ_V = 2 * GZ_KD, GZ_S = GZ_V + 64 * GL_VS * 2, GZ_BUF = GZ_S + 64 * GL_VS * 2, GZ_PART = 2 * GZ_BUF, GZ_END = GZ_PART + 2 * 8 * 64 * 4;
static_assert(GZ_END <= 147200, "GLA LDS map");
DI void ph_gla_out(const P& p, LAS unsigned char* lds, int tid) {
    const int lane = tid & 63, w = __builtin_amdgcn_readfirstlane(tid >> 6), l15 = lane & 15, g = lane >> 4, tq = l15 >> 2, tp = l15 & 3;
    const int G = gridDim.x, bx = blockIdx.x, NIT = (NTOK / 64) * 4;
    u32x4 rqd, rkd, rvv[2], rss[2];
#define GZ_LOAD(it_) do { const int h_ = (it_) & 3; const size_t row0_ = (size_t)((it_) >> 2) * 64; \
        const size_t o_ = (row0_ + (tid >> 3)) * 256 + h_ * 64 + (tid & 7) * 8; rqd = *(const u32x4*)(p.gqd + o_); rkd = *(const u32x4*)(p.gkd + o_); \
        _Pragma("unroll") for (int i_ = 0; i_ < 2; ++i_) { const int c_ = i_ * 512 + tid; rvv[i_] = *(const u32x4*)(p.proj + (row0_ + (c_ >> 4)) * LD1 + 1536 + h_ * 128 + (c_ & 15) * 8); \
            rss[i_] = *(const u32x4*)(p.gst + ((size_t)(it_) * 64 + (c_ >> 4)) * 128 + (c_ & 15) * 8); } } while (0)
#define GZ_STAGE(buf) do { LAS unsigned char* B_ = lds + (buf) * GZ_BUF; const int o_ = ((tid >> 3) * GL_QS + (tid & 7) * 8) * 2; \
        *(LAS u32x4*)(B_ + GZ_QD + o_) = rqd; *(LAS u32x4*)(B_ + GZ_KD + o_) = rkd; \
        _Pragma("unroll") for (int i_ = 0; i_ < 2; ++i_) { const int c_ = i_ * 512 + tid; const int vo_ = ((c_ >> 4) * GL_VS + (c_ & 15) * 8) * 2; *(LAS u32x4*)(B_ + GZ_V + vo_) = rvv[i_]; *(LAS u32x4*)(B_ + GZ_S + vo_) = rss[i_]; } } while (0)
#define GZ_BAR() do { asm volatile("s_waitcnt lgkmcnt(0)" ::: "memory"); __builtin_amdgcn_s_barrier(); asm volatile("" ::: "memory"); } while (0)
    if (bx < NIT) { GZ_LOAD(bx); GZ_STAGE(0); if (bx + G < NIT) GZ_LOAD(bx + G); }
    int k = 0;
    for (int it = bx; it < NIT; it += G, ++k) {
        const int h = it & 3; const size_t row0 = (size_t)(it >> 2) * 64;
        GZ_BAR();
        if (it + G < NIT) { GZ_STAGE((k + 1) & 1); if (it + 2 * G < NIT) GZ_LOAD(it + 2 * G); }
        const LAS unsigned char* B_ = lds + (k & 1) * GZ_BUF;
        u32x2 grv[4];
#pragma unroll
        for (int tt = 0; tt < 4; ++tt) grv[tt] = *(const u32x2*)(p.proj + (row0 + 16 * tt + l15) * LD1 + 2304 + h * 128 + 16 * w + 4 * g);
        const f32x4 gng = *(const f32x4*)(p.gla_norm_g + h * 128 + 16 * w + 4 * g);
        bf16x8 kdA[4][2];
#pragma unroll
        for (int st = 0; st < 4; ++st)
#pragma unroll
            for (int ks = 0; ks < 2; ++ks) kdA[st][ks] = *(const LAS bf16x8*)(B_ + GZ_KD + ((16 * st + l15) * GL_QS + 32 * ks + 8 * g) * 2);
        bf16x8 vP[2], sA[2];
#pragma unroll
        for (int ks = 0; ks < 2; ++ks) {
            { const s16x4 lo = vtr(B_ + GZ_V + ((32 * ks + 4 * g + tq) * GL_VS + 16 * w + 4 * tp) * 2), hi4 = vtr(B_ + GZ_V + ((32 * ks + 16 + 4 * g + tq) * GL_VS + 16 * w + 4 * tp) * 2);
              vP[ks] = (bf16x8){lo[0], lo[1], lo[2], lo[3], hi4[0], hi4[1], hi4[2], hi4[3]}; }
            { const s16x4 lo = vtr(B_ + GZ_S + ((32 * ks + 8 * g + tq) * GL_VS + 16 * w + 4 * tp) * 2), hi4 = vtr(B_ + GZ_S + ((32 * ks + 8 * g + 4 + tq) * GL_VS + 16 * w + 4 * tp) * 2);
              sA[ks] = (bf16x8){lo[0], lo[1], lo[2], lo[3], hi4[0], hi4[1], hi4[2], hi4[3]}; }
        }
        f32x4 otile[4];
        LAS float* PW = (LAS float*)(lds + GZ_PART) + (k & 1) * 512 + w * 64;
#pragma unroll
        for (int tt = 0; tt < 4; ++tt) {
            bf16x8 qdB[2];
#pragma unroll
            for (int ks = 0; ks < 2; ++ks) qdB[ks] = *(const LAS bf16x8*)(B_ + GZ_QD + ((16 * tt + l15) * GL_QS + 32 * ks + 8 * g) * 2);
            f32x4 at[4];
#pragma unroll
            for (int st = 0; st < 4; ++st) {
                at[st] = (f32x4){0.f, 0.f, 0.f, 0.f};
                if (st <= tt) { at[st] = __builtin_amdgcn_mfma_f32_16x16x32_bf16(kdA[st][0], qdB[0], at[st], 0, 0, 0); at[st] = __builtin_amdgcn_mfma_f32_16x16x32_bf16(kdA[st][1], qdB[1], at[st], 0, 0, 0); }
            }
#pragma unroll
            for (int j = 0; j < 4; ++j) if (4 * g + j > l15) at[tt][j] = 0.f;
            f32x4 ot = (f32x4){0.f, 0.f, 0.f, 0.f};
            ot = __builtin_amdgcn_mfma_f32_16x16x32_bf16(sA[0], qdB[0], ot, 0, 0, 0);
            ot = __builtin_amdgcn_mfma_f32_16x16x32_bf16(sA[1], qdB[1], ot, 0, 0, 0);
            { u32x4 ab; ab.x = pk2(at[0][0], at[0][1]); ab.y = pk2(at[0][2], at[0][3]); ab.z = pk2(at[1][0], at[1][1]); ab.w = pk2(at[1][2], at[1][3]);
              ot = __builtin_amdgcn_mfma_f32_16x16x32_bf16(vP[0], __builtin_bit_cast(bf16x8, ab), ot, 0, 0, 0); }
            if (tt >= 2) { u32x4 ab; ab.x = pk2(at[2][0], at[2][1]); ab.y = pk2(at[2][2], at[2][3]); ab.z = pk2(at[3][0], at[3][1]); ab.w = pk2(at[3][2], at[3][3]);
              ot = __builtin_amdgcn_mfma_f32_16x16x32_bf16(vP[1], __builtin_bit_cast(bf16x8, ab), ot, 0, 0, 0); }
            otile[tt] = ot;
            float ss = ot[0] * ot[0] + ot[1] * ot[1] + ot[2] * ot[2] + ot[3] * ot[3];
            ss += __shfl_xor(ss, 16); ss += __shfl_xor(ss, 32);
            if (g == 0) PW[16 * tt + l15] = ss;
        }
        GZ_BAR();
        const LAS float* PT = (const LAS float*)(lds + GZ_PART) + (k & 1) * 512;
#pragma unroll
        for (int tt = 0; tt < 4; ++tt) {
            float ss = 0.f;
#pragma unroll
            for (int ww = 0; ww < 8; ++ww) ss += PT[ww * 64 + 16 * tt + l15];
            const float r = rsqrtf(ss * (1.f / 128.f) + EPS);
            const float g0 = __uint_as_float(grv[tt].x << 16), g1 = __uint_as_float(grv[tt].x & 0xffff0000u), g2 = __uint_as_float(grv[tt].y << 16), g3 = __uint_as_float(grv[tt].y & 0xffff0000u);
            u32x2 o2; o2.x = pk2(silu_f(g0) * (otile[tt][0] * r * gng[0]), silu_f(g1) * (otile[tt][1] * r * gng[1]));
            o2.y = pk2(silu_f(g2) * (otile[tt][2] * r * gng[2]), silu_f(g3) * (otile[tt][3] * r * gng[3]));
            *(u32x2*)(p.mix + (row0 + 16 * tt + l15) * D + 512 + h * 128 + 16 * w + 4 * g) = o2;
        }
    }
    GZ_BAR();
#undef GZ_LOAD
#undef GZ_STAGE
#undef GZ_BAR
}
constexpr int SG_WS = 136, SG_VS = 144, SG_OS = 132;
constexpr int SG_W = 0, SG_V = 128 * SG_WS * 2, SG_O = SG_V + 128 * SG_VS * 2, SG_END = SG_O + 128 * SG_OS * 4;
static_assert(SG_END <= 147200, "gMLP LDS map");
DI void ph_sg(const P& p, LAS unsigned char* lds) {
    const int tid = tid_();
    const int G = gridDim.x, bx = blockIdx.x;
    const int nG = 0;
#define MIXREP_SG 1
    const int lane = tid & 63, w = __builtin_amdgcn_readfirstlane(tid >> 6), l15 = lane & 15, gq = lane >> 4, tq = l15 >> 2, tp = l15 & 3;
    int cur_g = -1;
    u32x4 rawv[4], uu[4]; float rvs[4];
#define SG_LOADV(u_) do { const int g_ = (u_) >> 9; const size_t r0_ = (size_t)((u_) & 511) * 128; \
        _Pragma("unroll") for (int it = 0; it < 4; ++it) { const int c = it * 512 + tid, s_ = c >> 4, ch = c & 15; rawv[it] = *(const u32x4*)(p.proj + (r0_ + s_) * LD1 + 512 + g_ * 128 + ch * 8); rvs[it] = p.rv[r0_ + s_]; } } while (0)
#define SG_RAWBAR() do { asm volatile("s_waitcnt lgkmcnt(0)" ::: "memory"); __builtin_amdgcn_s_barrier(); asm volatile("" ::: "memory"); } while (0)
    const int u0 = bx - nG, ustep = G - nG;
    for (int rep = 0; rep < MIXREP_SG; ++rep) {
    if (u0 < 2048) SG_LOADV(u0);
    for (int u = u0; u < 2048; u += ustep) {
        const int g = u >> 9, bn = u & 511; const size_t r0 = (size_t)bn * 128;
        if (g != cur_g) {
            cur_g = g;
#pragma unroll
            for (int it = 0; it < 4; ++it) { const int c = it * 512 + tid, t = c >> 4, ch = c & 15; const float* src = p.sg_w_s + ((size_t)g * 128 + t) * 128 + ch * 8;
                const f32x4 a = *(const f32x4*)src, b = *(const f32x4*)(src + 4); float v[8] = {a[0], a[1], a[2], a[3], b[0], b[1], b[2], b[3]};
#pragma unroll
                for (int e = 0; e < 8; ++e) if (ch * 8 + e > t) v[e] = 0.f;
                u32x4 wv; wv.x = pk2(v[0], v[1]); wv.y = pk2(v[2], v[3]); wv.z = pk2(v[4], v[5]); wv.w = pk2(v[6], v[7]);
                *(LAS u32x4*)(lds + SG_W + (t * SG_WS + ch * 8) * 2) = wv; }
        }
#pragma unroll
        for (int it = 0; it < 4; ++it) { const int c = it * 512 + tid, s_ = c >> 4, ch = c & 15; const u32x4 raw = rawv[it]; const float rv = rvs[it];
            u32x4 wv; wv.x = pk2(__uint_as_float(raw.x << 16) * rv, __uint_as_float(raw.x & 0xffff0000u) * rv); wv.y = pk2(__uint_as_float(raw.y << 16) * rv, __uint_as_float(raw.y & 0xffff0000u) * rv);
            wv.z = pk2(__uint_as_float(raw.z << 16) * rv, __uint_as_float(raw.z & 0xffff0000u) * rv); wv.w = pk2(__uint_as_float(raw.w << 16) * rv, __uint_as_float(raw.w & 0xffff0000u) * rv);
            *(LAS u32x4*)(lds + SG_V + (s_ * SG_VS + ch * 8) * 2) = wv; }
        SG_RAWBAR();
#pragma unroll
        for (int it = 0; it < 4; ++it) { const int c = it * 512 + tid; uu[it] = *(const u32x4*)(p.proj + (r0 + (c >> 4)) * LD1 + g * 128 + (c & 15) * 8); }
        if (u + ustep < 2048) SG_LOADV(u + ustep);
        bf16x8 vA[4];
#pragma unroll
        for (int ks = 0; ks < 4; ++ks) {
            const s16x4 lo = vtr(lds + SG_V + ((32 * ks + 8 * gq + tq) * SG_VS + 16 * w + 4 * tp) * 2), hi4 = vtr(lds + SG_V + ((32 * ks + 8 * gq + 4 + tq) * SG_VS + 16 * w + 4 * tp) * 2);
            vA[ks] = (bf16x8){lo[0], lo[1], lo[2], lo[3], hi4[0], hi4[1], hi4[2], hi4[3]};
        }
#pragma unroll
        for (int tt = 0; tt < 8; ++tt) {
            f32x4 acc = (f32x4){0.f, 0.f, 0.f, 0.f};
#pragma unroll
            for (int ks = 0; ks <= tt / 2; ++ks) {
                const bf16x8 wB = *(const LAS bf16x8*)(lds + SG_W + ((16 * tt + l15) * SG_WS + 32 * ks + 8 * gq) * 2);
                acc = __builtin_amdgcn_mfma_f32_16x16x32_bf16(vA[ks], wB, acc, 0, 0, 0);
            }
            *(LAS f32x4*)(lds + SG_O + ((16 * tt + l15) * SG_OS + 16 * w + 4 * gq) * 4) = acc;
        }
        SG_RAWBAR();
#pragma unroll
        for (int it = 0; it < 4; ++it) { const int c = it * 512 + tid, t = c >> 4, ch = c & 15;
            const f32x4 a = *(const LAS f32x4*)(lds + SG_O + (t * SG_OS + ch * 8) * 4), b = *(const LAS f32x4*)(lds + SG_O + (t * SG_OS + ch * 8 + 4) * 4);
            const f32x4 ga = *(const f32x4*)(p.sg_v_norm_g + g * 128 + ch * 8), gb = *(const f32x4*)(p.sg_v_norm_g + g * 128 + ch * 8 + 4);
            const float bs = p.sg_b_s[g * 128 + t];
            const u32x4 ux = uu[it];
            u32x4 o;
            o.x = pk2(__uint_as_float(ux.x << 16) * (a[0] * ga[0] + bs), __uint_as_float(ux.x & 0xffff0000u) * (a[1] * ga[1] + bs));
            o.y = pk2(__uint_as_float(ux.y << 16) * (a[2] * ga[2] + bs), __uint_as_float(ux.y & 0xffff0000u) * (a[3] * ga[3] + bs));
            o.z = pk2(__uint_as_float(ux.z << 16) * (b[0] * gb[0] + bs), __uint_as_float(ux.z & 0xffff0000u) * (b[1] * gb[1] + bs));
            o.w = pk2(__uint_as_float(ux.w << 16) * (b[2] * gb[2] + bs), __uint_as_float(ux.w & 0xffff0000u) * (b[3] * gb[3] + bs));
            *(u32x4*)(p.mix + (r0 + t) * D + g * 128 + ch * 8) = o; }
    }
    SG_RAWBAR();
    }
#undef SG_LOADV
#undef SG_RAWBAR
    __syncthreads();
}

enum { PH_PREP = 0, PH_NORM0, PH_IN0, PH_STAT0, PH_UP0, PH_ATTN, PH_OUT0,
       PH_MOE0  , PH_IN1 = PH_MOE0 + 6, PH_STAT1, PH_SCAN, PH_MIX1, PH_OUT1, PH_MOE1, PH_END = PH_MOE1 + 6 };

typedef __attribute__((address_space(4))) const P* KP;
#if defined(__HIP_DEVICE_COMPILE__)
#define LOADP() ({ KP k_ = kp; asm volatile("" : "+s"(k_)); *k_; })
#else
#define LOADP() (P{})
#endif
__global__ void __launch_bounds__(NTHR, 2) mega(P p_unused, int lo, int hi) {
    (void)p_unused;
    const KP kp = (KP)__builtin_amdgcn_kernarg_segment_ptr();
    extern __shared__ __attribute__((aligned(16))) unsigned char lds_raw[];
    LAS unsigned char* lds = (LAS unsigned char*)lds_raw;
    volatile LAS unsigned* misc = (volatile LAS unsigned*)(lds + LDS_MISC);
    { const int t0 = tid_(); if (t0 < 64) misc[t0] = 0u; }
    __syncthreads();
    XcdBarrier bar; { const P p = LOADP(); bar.bar = p.bar; } bar.x = 0; bar.st = misc + 8;
    if (hi - lo > 1) bar = xcd_barrier_post(bar.bar, misc + 8);
#define IN(k) (lo <= (k) && (k) < hi)
#define SEAM(k) do { if (IN(k) && IN((k) + 1)) xcd_barrier(bar); } while (0)
    const int G = gridDim.x, bx = blockIdx.x;
#ifndef XPROBE
#define XPROBE 0
#endif
#ifndef DUPMASK
#define DUPMASK 0u
#endif
#define PHASE(k, ...) do { if (IN(k)) { __VA_ARGS__ } if (((DUPMASK >> (k)) & 1u) && IN(k)) { xcd_barrier(bar); __VA_ARGS__ } SEAM(k); } while (0)
    PHASE(PH_PREP, const P p = LOADP(); ph_prep(p, lds););
    PHASE(PH_NORM0, const P p = LOADP(); ph_norm<true>(p, p.x, p.norm_mix_g, 0, 0););
    PHASE(PH_IN0,
        const P p = LOADP();
        g8::Order S; S.init(NTOK / 256, LD0 / 256, G, bx);
        SrcDense X{(unsigned)(D * 2), (const char*)p.wt_in0, (size_t)256 * 1024 * 2};
        g8::Epi<FIn0> E{{p}};
        g8::gemm8(lds, (const char*)p.xa, 1024, S, X, E););
    PHASE(PH_STAT0, const P p = LOADP(); ph_rowstat0_conv(p););
    PHASE(PH_UP0,
        const P p = LOADP();
        { g8::Order S; S.init(NTOK / 256, 3, G, bx);
          SrcDense X{(unsigned)(LD0 * 2), (const char*)p.wt_uq, (size_t)256 * 256 * 2};
          g8::Epi<FUq> E{{p}};
          g8::gemm8(lds, (const char*)p.proj, 256, S, X, E); }
        { g8::Order S; S.init(NTOK / 256, 4, G, bx);
          SrcDense X{(unsigned)(LD0 * 2), (const char*)p.wt_ukv, (size_t)256 * 128 * 2};
          g8::Epi<FUkv> E{{p}};
          g8::gemm8(lds, (const char*)(p.proj + 256), 128, S, X, E); });
    PHASE(PH_ATTN, const P p = LOADP(); ph_attn(p, lds););
    PHASE(PH_OUT0,
        const P p = LOADP();
        g8::Order S; S.init(NTOK / 256, 4, G, bx);
        SrcDense X{(unsigned)(D * 2), (const char*)p.wt_out0, (size_t)256 * 1024 * 2};
        g8::Epi<FOut> E{{p, 0}};
        g8::gemm8(lds, (const char*)p.mix, 1024, S, X, E););
#define MOE_PHASES(l, base) do { \
        PHASE((base) + 0, const P p = LOADP(); ph_norm<false>(p, p.xr, p.norm_ffn_g + (l) * D, (l), 1);); \
        PHASE((base) + 1, const P p = LOADP(); ph_router(p, (l), lds);); \
        PHASE((base) + 2, const P p = LOADP(); ph_slots(p, (l), lds);); \
        PHASE((base) + 3, \
            const P p = LOADP(); \
            g8::Order S; S.init(p.ntile[(l)], 4, G, bx, 1); \
            SrcGu X{(unsigned)(D * 2), p.row_tok + (size_t)(l) * MAXSLOT, p.tile_e + (l) * 1024, (const char*)(p.wt_gu + (size_t)(l) * 32 * 512 * 1024)}; \
            g8::Epi<FGu> E{{p, p.row_w + 2 * (size_t)(l) * MAXSLOT}}; \
            g8::gemm8(lds, (const char*)p.xa, 1024, S, X, E);); \
        PHASE((base) + 4, \
            const P p = LOADP(); \
            g8::Order S; S.init(p.ntile[(l)], 4, G, bx, 1); \
            SrcDn X{(unsigned)(512 * 2), p.tile_e + (l) * 1024, (const char*)(p.wt_dn + (size_t)(l) * 32 * 1024 * 256)}; \
            g8::Epi<FDn> E{{p}}; \
            g8::gemm8(lds, (const char*)p.act, 512, S, X, E);); \
        PHASE((base) + 5, const P p = LOADP(); ph_postnorm(p, (l), (l) == 1);); \
    } while (0)
    MOE_PHASES(0, PH_MOE0);
    PHASE(PH_IN1,
        const P p = LOADP();
        g8::Order S; S.init(NTOK / 256, LD1 / 256, G, bx);
        SrcDense X{(unsigned)(D * 2), (const char*)p.wt_in1, (size_t)256 * 1024 * 2};
        g8::Epi<FIn1> E{{p}};
        g8::gemm8(lds, (const char*)p.xa, 1024, S, X, E););
    PHASE(PH_STAT1, const P p = LOADP(); ph_stat1x(p, lds););
    PHASE(PH_SCAN, const P p = LOADP(); ph_gla_scan(p); ph_sg(p, lds););
    PHASE(PH_MIX1, const P p = LOADP(); ph_gla_out(p, lds, tid_()););
    PHASE(PH_OUT1,
        const P p = LOADP();
        g8::Order S; S.init(NTOK / 256, 4, G, bx);
        SrcDense X{(unsigned)(D * 2), (const char*)p.wt_out1, (size_t)256 * 1024 * 2};
        g8::Epi<FOut> E{{p, 1}};
        g8::gemm8(lds, (const char*)p.mix, 1024, S, X, E););
    MOE_PHASES(1, PH_MOE1);
#undef MOE_PHASES
#undef PHASE
#undef IN
#undef SEAM
}

static size_t carve(size_t& off, size_t bytes) { const size_t o = off; off += (bytes + 255) & ~(size_t)255; return o; }

extern "C" void kernel_launch(void* const* d_in, const int* in_sizes, int n_in, void* d_out, int out_size, void* d_ws, size_t ws_size, hipStream_t stream) {
    (void)in_sizes; (void)n_in; (void)out_size;
    P p{};
    const float* const* fi = (const float* const*)d_in;
    p.x = fi[0]; p.c = fi[1]; p.pos = (const int*)d_in[2];
    p.adaln_w = fi[3]; p.adaln_b = fi[4]; p.norm_mix_g = fi[5]; p.norm_ffn_g = fi[6]; p.ab_w_in = fi[7]; p.q_norm_g = fi[8]; p.w_uq = fi[9];
    p.kv_norm_g = fi[10]; p.w_ukv = fi[11]; p.conv_w = fi[12]; p.ab_w_out = fi[13]; p.cd_w_in = fi[14]; p.sg_v_norm_g = fi[15]; p.sg_w_s = fi[16];
    p.sg_b_s = fi[17]; p.gla_w_g2 = fi[18]; p.gla_b_g = fi[19]; p.gla_norm_g = fi[20]; p.cd_w_out = fi[21]; p.moe_w_group = fi[22]; p.moe_b_group = fi[23];
    p.moe_w_expert = fi[24]; p.moe_b_expert = fi[25]; p.moe_w_gate_up = fi[26]; p.moe_w_down = fi[27]; p.final_norm_g = fi[28];
    p.out = (float*)d_out;
    char* ws = (char*)d_ws; size_t off = 0;
    const size_t ctl0 = off;
    p.bar = (unsigned*)(ws + carve(off, (size_t)XCD_BAR_WORDS * 4));
    p.row_tok = (int*)(ws + carve(off, (size_t)2 * MAXSLOT * 4));
    p.row_w = (float*)(ws + carve(off, (size_t)2 * MAXSLOT * 2 * 4));
    const size_t ctl_bytes = off - ctl0;
    p.whist = (int*)(ws + carve(off, (size_t)2 * 256 * 128 * 4));
    p.ntile = (int*)(ws + carve(off, 256));
    p.tile_e = (int*)(ws + carve(off, 2 * 1024 * 4));
    p.tope = (int*)(ws + carve(off, (size_t)4 * NTOK * 4));
    p.toppos = (int*)(ws + carve(off, (size_t)4 * NTOK * 4));
    p.topslot = (int*)(ws + carve(off, (size_t)4 * NTOK * 4));
    p.topw = (float*)(ws + carve(off, (size_t)4 * NTOK * 4));
    p.mod = (float*)(ws + carve(off, (size_t)2 * 16 * 6144 * 4));
    p.ropec = (float*)(ws + carve(off, (size_t)NTOK * 16 * 4));
    p.ropes = (float*)(ws + carve(off, (size_t)NTOK * 16 * 4));
    p.rq = (float*)(ws + carve(off, (size_t)NTOK * 4));
    p.rkv = (float*)(ws + carve(off, (size_t)NTOK * 4));
    p.rv = (float*)(ws + carve(off, (size_t)NTOK * 4));
    p.wt_in0 = (bf16_t*)(ws + carve(off, WO_END * 2));
    p.wt_uq = p.wt_in0 + WO_UQ; p.wt_ukv = p.wt_in0 + WO_UKV; p.wt_out0 = p.wt_in0 + WO_OUT0; p.wt_in1 = p.wt_in0 + WO_IN1; p.wt_out1 = p.wt_in0 + WO_OUT1;
    p.wt_gu = p.wt_in0 + WO_GU; p.wt_dn = p.wt_in0 + WO_DN; p.wt_r = p.wt_in0 + WO_R;
    p.xa = (bf16_t*)(ws + carve(off, (size_t)NTOK * D * 2));
    p.mix = (bf16_t*)(ws + carve(off, (size_t)NTOK * D * 2));
    p.xr = (bf16_t*)(ws + carve(off, (size_t)NTOK * D * 2));
    const size_t r0 = off;
    p.proj = (bf16_t*)(ws + carve(off, (size_t)NTOK * LD1 * 2));
    size_t o2 = r0 + (((size_t)NTOK * LD0 * 2 + 255) & ~(size_t)255);
    p.q = (bf16_t*)(ws + carve(o2, (size_t)NTOK * 768 * 2));
    p.kn = (bf16_t*)(ws + carve(o2, (size_t)NTOK * 512 * 2));
    p.v = (bf16_t*)(ws + carve(o2, (size_t)NTOK * 512 * 2));
    p.kpe = (bf16_t*)(ws + carve(o2, (size_t)NTOK * 32 * 2));
    size_t o3 = off;
    p.loga = (float*)(ws + carve(o3, (size_t)NTOK * 256 * 4));
    p.gqd = (bf16_t*)(ws + carve(o3, (size_t)NTOK * 256 * 2));
    p.gkd = (bf16_t*)(ws + carve(o3, (size_t)NTOK * 256 * 2));
    p.gkv = p.xa;
    p.gst = p.xa + (size_t)(NTOK / 64) * 4 * 64 * 128;
    p.gdec = (float*)(ws + carve(o3, (size_t)(NTOK / 64) * 256 * 4));
    size_t o4 = r0;
    p.act = (bf16_t*)(ws + carve(o4, (size_t)MAXSLOT * 512 * 2));
    p.y = (bf16_t*)(ws + carve(o4, (size_t)MAXSLOT * D * 2));
    if (off > ws_size || o2 > ws_size || o3 > ws_size || o4 > ws_size) return;

    static int grid = 0;
    if (grid == 0) {
        int dev = 0, cus = 0;
        if (hipGetDevice(&dev) != hipSuccess || hipDeviceGetAttribute(&cus, hipDeviceAttributeMultiprocessorCount, dev) != hipSuccess) { grid = -1; return; }
        if (hipFuncSetAttribute((const void*)mega, hipFuncAttributeMaxDynamicSharedMemorySize, LDS_BYTES) != hipSuccess) { grid = -1; return; }
        grid = cus;
    }
    if (grid < 0) return;
    (void)hipMemsetAsync(ws + ctl0, 0, ctl_bytes, stream);
#define RUN(a, b) hipLaunchKernelGGL(mega, dim3(grid), dim3(NTHR), LDS_BYTES, stream, p, (a), (b))
    RUN(PH_PREP, PH_END);
#undef RUN
}
```

```cpp
#include <hip/hip_runtime.h>
#include <stdint.h>
#include <math.h>

typedef unsigned short bf16_t;
typedef short bf16x8 __attribute__((ext_vector_type(8)));
typedef float f32x4 __attribute__((ext_vector_type(4)));
typedef unsigned u32x2 __attribute__((ext_vector_type(2)));
typedef unsigned u32x4 __attribute__((ext_vector_type(4)));
#define DI __device__ __forceinline__
#define LAS __attribute__((address_space(3)))

constexpr int D = 1024, NB = 16, SEQ = 4096, NTOK = NB * SEQ;
constexpr float EPS = 1e-6f;
constexpr int AB_IN = 1952, CD_IN = 2576;
constexpr int LD0 = 2048, LD1 = 2816;
constexpr int DEXP = 256;
constexpr int MAXSLOT = NTOK + 128 * 256;
constexpr float QSCALE = 0.10206207261596577f * 1.4426950408889634f;
constexpr int NTHR = 512, NWAVE = 8;
constexpr int LDS_BYTES = 147456, LDS_MISC = LDS_BYTES - 256;

DI int tid_() { int t = threadIdx.x; asm volatile("" : "+v"(t)); return t; }
DI float bf2f(bf16_t v) { return __uint_as_float(((unsigned)v) << 16); }
DI bf16_t f2bf(float f) { unsigned u = __float_as_uint(f); return (bf16_t)((u + 0x7fffu + ((u >> 16) & 1u)) >> 16); }
DI unsigned pk2(float lo, float hi) { return (unsigned)f2bf(lo) | ((unsigned)f2bf(hi) << 16); }
DI float wave_sum(float v) {
#pragma unroll
    for (int o = 32; o >= 1; o >>= 1) v += __shfl_xor(v, o);
    return v;
}
typedef float f32x16 __attribute__((ext_vector_type(16)));
typedef short s16x4 __attribute__((ext_vector_type(4)));
typedef short v4i16_t __attribute__((ext_vector_type(4)));
typedef float f32x2_t __attribute__((ext_vector_type(2))); typedef __bf16 bf16x2_t __attribute__((ext_vector_type(2)));
DI unsigned cvtpk(float lo, float hi) { f32x2_t v = {lo, hi}; bf16x2_t b = __builtin_convertvector(v, bf16x2_t); return __builtin_bit_cast(unsigned, b); }
DI int crow(int r, int hi) { return (r & 3) + 8 * (r >> 2) + 4 * hi; }
DI s16x4 vtr(const LAS unsigned char* p) { return __builtin_bit_cast(s16x4, __builtin_amdgcn_ds_read_tr16_b64_v4i16((LAS v4i16_t*)p)); }
DI float silu_f(float v) { return v / (1.f + __expf(-v)); }
DI float gelu_tanh_f(float v) { const float u = 1.5957691216057308f * (v + 0.044715f * v * v * v); return v * __builtin_amdgcn_rcpf(1.f + __expf(-u)); }
DI float log_sigmoid_f(float z) { return fminf(z, 0.f) - __logf(1.f + __expf(-fabsf(z))); }

struct P {
    const float *x, *c; const int* pos;
    const float *adaln_w, *adaln_b, *norm_mix_g, *norm_ffn_g, *ab_w_in, *q_norm_g, *w_uq, *kv_norm_g, *w_ukv, *conv_w, *ab_w_out,
        *cd_w_in, *sg_v_norm_g, *sg_w_s, *sg_b_s, *gla_w_g2, *gla_b_g, *gla_norm_g, *cd_w_out,
        *moe_w_group, *moe_b_group, *moe_w_expert, *moe_b_expert, *moe_w_gate_up, *moe_w_down, *final_norm_g;
    float* out;
    bf16_t *wt_in0, *wt_uq, *wt_ukv, *wt_out0, *wt_in1, *wt_out1, *wt_gu, *wt_dn, *wt_r;
    float *mod, *ropec, *ropes;
    bf16_t *xa, *xr, *proj, *q, *kn, *v, *kpe, *mix, *act, *y;
    float *rq, *rkv, *rv, *loga, *gdec, *topw, *row_w;
    bf16_t *gqd, *gkd, *gkv, *gst;
    int *tope, *toppos, *topslot, *whist, *ntile, *tile_e, *row_tok;
    unsigned* bar;
};

#define XB_TMO      128
#define XB_XCNT(j)  (256  + 64 * (j))
#define XB_XSUB(j)  (1280 + 64 * (j))
#define XB_XGEN(j)  (2304 + 64 * (j))
#define XB_TOP      3328
#define XB_TOPGEN   3392
#define XCD_BAR_WORDS 3456
#define XB_SPIN_CAP (1u << 18)
__device__ __forceinline__ unsigned xb_ld(unsigned* p)              { return __hip_atomic_load(p, __ATOMIC_RELAXED, __HIP_MEMORY_SCOPE_AGENT); }
__device__ __forceinline__ unsigned xb_add(unsigned* p, unsigned v) { return __hip_atomic_fetch_add(p, v, __ATOMIC_RELAXED, __HIP_MEMORY_SCOPE_AGENT); }
__device__ __forceinline__ unsigned xb_xcc_id() { return (unsigned)__builtin_amdgcn_s_getreg((3 << 11) | 20) & 0xFu; }
#define XB_SPIN(cond, bar) do { unsigned _sp = 0; while (cond) { __builtin_amdgcn_s_sleep(1); \
    if ((++_sp & 255u) == 0u) { if (xb_ld(&(bar)[XB_TMO])) break; if (_sp > XB_SPIN_CAP) { atomicAdd(&(bar)[XB_TMO], 1u); break; } } } } while (0)
struct XcdBarrier { unsigned* bar; unsigned x; volatile LAS unsigned* st; };
__device__ __forceinline__ XcdBarrier xcd_barrier_post(unsigned* bar, volatile LAS unsigned* st) {
    XcdBarrier b; b.bar = bar; b.x = xb_xcc_id(); b.st = st;
    if (threadIdx.x == 0) (void)xb_add(&bar[XB_XCNT(b.x)], 1u);
    return b;
}
__device__ __forceinline__ void xcd_barrier_complete(unsigned* bar, unsigned x, unsigned& nloc, unsigned& nx) {
    const unsigned G = gridDim.x * gridDim.y * gridDim.z;
    unsigned sum, cnt, mine, sp = 0u;
    for (;;) {
        sum = 0u; cnt = 0u; mine = 0u;
#pragma unroll
        for (unsigned j = 0; j < 16; ++j) { const unsigned c = xb_ld(&bar[XB_XCNT(j)]); sum += c; cnt += (c > 0u) ? 1u : 0u; mine = (j == x) ? c : mine; }
        if (sum == G) break;
        __builtin_amdgcn_s_sleep(1);
        if ((++sp & 255u) == 0u) { if (xb_ld(&bar[XB_TMO])) break; if (sp > XB_SPIN_CAP) { atomicAdd(&bar[XB_TMO], 1u); break; } }
    }
    nloc = mine > 0u ? mine : 1u; nx = cnt > 0u ? cnt : 1u;
}
__device__ __forceinline__ void xcd_barrier(const XcdBarrier& b) {
    asm volatile("s_waitcnt vmcnt(0)" ::: "memory");
    __syncthreads();
    if (threadIdx.x == 0) {
        unsigned* bar = b.bar;
        __builtin_amdgcn_s_waitcnt(0);
        unsigned nloc = b.st[0], nx = b.st[1];
        if (nloc == 0u) { xcd_barrier_complete(bar, b.x, nloc, nx); b.st[0] = nloc; b.st[1] = nx; }
        const unsigned old = xb_add(&bar[XB_XSUB(b.x)], 1u);
        const unsigned gen = old / nloc;
        if (old + 1u == (gen + 1u) * nloc) {
            __builtin_amdgcn_fence(__ATOMIC_RELEASE, "agent");
            asm volatile("s_waitcnt vmcnt(0)" ::: "memory");
            const unsigned og = xb_add(&bar[XB_TOP], 1u);
            const unsigned tg = og / nx;
            if (og + 1u == (tg + 1u) * nx) xb_add(&bar[XB_TOPGEN], 1u);
            else XB_SPIN(xb_ld(&bar[XB_TOPGEN]) == tg, bar);
            __builtin_amdgcn_fence(__ATOMIC_ACQUIRE, "agent");
            xb_add(&bar[XB_XGEN(b.x)], 1u);
            asm volatile("s_waitcnt vmcnt(0)" ::: "memory");
        } else {
            XB_SPIN(xb_ld(&bar[XB_XGEN(b.x)]) == gen, bar);
            __builtin_amdgcn_fence(__ATOMIC_ACQUIRE, "agent");
            asm volatile("s_waitcnt vmcnt(0)" ::: "memory");
        }
    }
    __syncthreads();
}

namespace g8 {
constexpr int BM = 256, BK = 64, HALF = 128, HTB = HALF * BK * 2, NXCD = 8, WGM = 8;
__host__ __device__ __forceinline__ int lds_byte(int r, int c) { const int st = (r >> 4) * 2 + (c >> 5), rr = r & 15, cc = c & 31, ob = rr * 64 + cc * 2; return st * 1024 + (ob ^ (((ob >> 9) & 1) << 5)); }
__host__ __device__ __forceinline__ void stage_rc(int b, int& R, int& C) { const int st = b / 1024, sb = b % 1024, swz = sb ^ (((sb >> 9) & 1) << 5); R = (st >> 1) * 16 + swz / 64; C = (st & 1) * 32 + (swz % 64) / 2; }
__host__ __device__ __forceinline__ int perm32(int rho) { const int n = rho >> 4, i = rho & 15; return 8 * (i >> 2) + 4 * n + (i & 3); }
struct Unit { int pm, pn; };
struct Order {
    int nM, nN, nwg, G, c, pnfast;
    DI void init(int nM_, int nN_, int G_, int c_, int pnfast_ = 0) { nM = nM_; nN = nN_; nwg = nM * nN; G = G_; c = c_; pnfast = pnfast_; }
    DI bool next(int i, Unit& u) const {
        const long L = (long)i * G + c; if (L >= nwg) return false;
        int wgid = (int)L; { const int q = nwg / NXCD, r = nwg % NXCD, xcd = wgid % NXCD, off = wgid / NXCD; wgid = (xcd < r ? xcd * (q + 1) : r * (q + 1) + (xcd - r) * q) + off; }
        if (pnfast) { u.pm = wgid / nN; u.pn = wgid % nN; return true; }
        const int nig = WGM * nN, gid = wgid / nig, fm = gid * WGM, gsz = (nM - fm) < WGM ? (nM - fm) : WGM;
        u.pm = fm + ((wgid % nig) % gsz); u.pn = (wgid % nig) / gsz; return true;
    }
};
template <class Epi, class Src>
__device__ __forceinline__ void gemm8(LAS unsigned char* lds, const char* A, int K_, const Order& S, const Src& X, const Epi& E) {
    int K = K_;
    int tid = threadIdx.x; asm volatile("" : "+v"(tid));
    const int wid = __builtin_amdgcn_readfirstlane(tid >> 6), lane = tid & 63, wr = wid >> 2, wc = wid & 3, fr = lane & 15, fq = lane >> 4;
    asm volatile("" : "+s"(K));
    const int nt = K / BK;
    int Rr[2], Cc[2]; unsigned voffA[2], voffB[2];
#pragma unroll
    for (int i = 0; i < 2; ++i) { int R, C; stage_rc(tid * 16 + i * 8192, R, C); Rr[i] = R; Cc[i] = C * 2; const int Rb = Epi::PERM ? ((R & ~31) + perm32(R & 31)) : R;
        voffA[i] = (unsigned)R * X.lda + (unsigned)C * 2u; voffB[i] = (unsigned)(Rb * X.ldb(K) + C) * 2u; }
    const size_t kstep = (size_t)(BK * 2);
    const size_t hstepB = (size_t)HALF * X.ldb(K) * 2;
    const size_t ksplit = X.ksplit();
    const size_t hstepA = (size_t)HALF * X.lda;
    const unsigned ldsw = (unsigned)wid * 1024u;
    const int aoff = lds_byte(wr * 64 + fr, fq * 8), boff = lds_byte(wc * 32 + fr, fq * 8);
#define G8_SA(b, h) (((b) * 2 + (h)) * HTB)
#define G8_SB(b, h) ((4 + (b) * 2 + (h)) * HTB)
#define G8_STAGEB(bufoff, gbase) do { _Pragma("unroll") for (int _i = 0; _i < 2; ++_i) \
        __builtin_amdgcn_global_load_lds((const unsigned*)((const char*)(gbase) + voffB[_i]), (LAS unsigned*)(lds + (bufoff) + ldsw + _i * 8192), 16, 0, 0); } while (0)
#define G8_STAGEA(bufoff, ub, o0, o1) do { \
        __builtin_amdgcn_global_load_lds((const unsigned*)((const char*)(ub) + (o0)), (LAS unsigned*)(lds + (bufoff) + ldsw), 16, 0, 0); \
        __builtin_amdgcn_global_load_lds((const unsigned*)((const char*)(ub) + (o1)), (LAS unsigned*)(lds + (bufoff) + ldsw + 8192), 16, 0, 0); } while (0)
#define G8_LDA(dst, b, h) do { _Pragma("unroll") for (int m = 0; m < 4; ++m) _Pragma("unroll") for (int k = 0; k < 2; ++k) dst[m][k] = *(const LAS bf16x8*)(lds + G8_SA(b, h) + aoff + m * 2048 + k * 1024); } while (0)
#define G8_LDB(dst, b, h) do { _Pragma("unroll") for (int n = 0; n < 2; ++n) _Pragma("unroll") for (int k = 0; k < 2; ++k) dst[n][k] = *(const LAS bf16x8*)(lds + G8_SB(b, h) + boff + n * 2048 + k * 1024); } while (0)
#define G8_MMA(ai, bj, At, Bt) do { __builtin_amdgcn_s_setprio(1); _Pragma("unroll") for (int m = 0; m < 4; ++m) _Pragma("unroll") for (int n = 0; n < 2; ++n) _Pragma("unroll") for (int k = 0; k < 2; ++k) \
        acc[ai][bj][m][n] = __builtin_amdgcn_mfma_f32_16x16x32_bf16(Bt[n][k], At[m][k], acc[ai][bj][m][n], 0, 0, 0); __builtin_amdgcn_s_setprio(0); } while (0)
#define G8_WAIT_V(n) asm volatile("s_waitcnt vmcnt(" #n ")" ::: "memory")
#define G8_WAIT_L(n) asm volatile("s_waitcnt lgkmcnt(" #n ")" ::: "memory")
#define G8_BAR __builtin_amdgcn_s_barrier()
#define G8_SCHED __builtin_amdgcn_sched_barrier(0)
    Unit cur, nxt; int ui = 0;
    if (!S.next(0, cur)) return;
    f32x4 acc[2][2][4][2];
#pragma unroll
    for (int a = 0; a < 2; ++a)
#pragma unroll
        for (int b = 0; b < 2; ++b)
#pragma unroll
            for (int m = 0; m < 4; ++m)
#pragma unroll
                for (int n = 0; n < 2; ++n) acc[a][b][m][n] = (f32x4){0.f, 0.f, 0.f, 0.f};
    bf16x8 At[4][2], B0[2][2], B1[2][2];
    unsigned c00 = 0, c01 = 0, c10 = 0, c11 = 0; const char* cA = A;
    if constexpr (Src::GATHER) { c00 = X.a_off(cur, 0, Rr[0]) + Cc[0]; c01 = X.a_off(cur, 0, Rr[1]) + Cc[1]; c10 = X.a_off(cur, 1, Rr[0]) + Cc[0]; c11 = X.a_off(cur, 1, Rr[1]) + Cc[1]; }
    else cA = A + (size_t)cur.pm * 2 * hstepA;
    const char* cB0 = X.b_ptr(cur, 0); const char* cB1 = X.b_ptr(cur, 1);
#define G8_BK(b0_, b1_, kb_) (((size_t)(kb_) < ksplit ? (b0_) : (b1_)) + (kb_))
    { const char* cB = G8_BK(cB0, cB1, 0); G8_STAGEB(G8_SB(0, 0), cB); G8_STAGEB(G8_SB(0, 1), cB + hstepB); }
    if constexpr (Src::GATHER) { G8_STAGEA(G8_SA(0, 0), A, c00, c01); G8_STAGEA(G8_SA(0, 1), A, c10, c11); }
    else { G8_STAGEA(G8_SA(0, 0), cA, voffA[0], voffA[1]); G8_STAGEA(G8_SA(0, 1), cA + hstepA, voffA[0], voffA[1]); }
    if (wr == 1) G8_BAR;
    G8_WAIT_V(2); G8_BAR;
    { const char* cB = G8_BK(cB0, cB1, kstep); G8_STAGEB(G8_SB(1, 0), cB);
    if constexpr (Src::GATHER) G8_STAGEA(G8_SA(1, 0), A + kstep, c00, c01); else G8_STAGEA(G8_SA(1, 0), cA + kstep, voffA[0], voffA[1]);
      G8_STAGEB(G8_SB(1, 1), cB + hstepB); }
    G8_WAIT_V(6); G8_BAR;
    for (;;) {
        const bool has_next = S.next(ui + 1, nxt);
        unsigned n00 = c00, n01 = c01, n10 = c10, n11 = c11; const char* nB0 = cB0; const char* nB1 = cB1; const char* nA = cA;
        if (has_next) {
            if constexpr (Src::GATHER) { n00 = X.a_off(nxt, 0, Rr[0]) + Cc[0]; n01 = X.a_off(nxt, 0, Rr[1]) + Cc[1]; n10 = X.a_off(nxt, 1, Rr[0]) + Cc[0]; n11 = X.a_off(nxt, 1, Rr[1]) + Cc[1]; }
            else nA = A + (size_t)nxt.pm * 2 * hstepA;
            nB0 = X.b_ptr(nxt, 0); nB1 = X.b_ptr(nxt, 1);
        }
        for (int t = 0; t < nt; t += 2) {
            const bool last = (t == nt - 2);
            const size_t k1 = (size_t)(t + 1) * kstep;
            const size_t k2 = last ? 0 : (size_t)(t + 2) * kstep, k3 = k2 + kstep;
            const char* b2 = G8_BK(last ? nB0 : cB0, last ? nB1 : cB1, k2); const char* b3 = G8_BK(last ? nB0 : cB0, last ? nB1 : cB1, k3);
            if constexpr (Src::GATHER) {
            const unsigned a00 = last ? n00 : c00, a01 = last ? n01 : c01, a10 = last ? n10 : c10, a11 = last ? n11 : c11;
            G8_LDB(B0, 0, 0); G8_LDB(B1, 0, 1); G8_SCHED; G8_LDA(At, 0, 0); G8_STAGEA(G8_SA(1, 1), A + k1, c10, c11);
            G8_WAIT_V(8); G8_WAIT_L(0); G8_BAR; G8_MMA(0, 0, At, B0); G8_MMA(0, 1, At, B1); G8_BAR; G8_SCHED;
            G8_LDA(At, 0, 1); G8_STAGEB(G8_SB(0, 0), b2); G8_STAGEB(G8_SB(0, 1), b2 + hstepB); G8_STAGEA(G8_SA(0, 0), A + k2, a00, a01);
            G8_WAIT_V(8); G8_WAIT_L(0); G8_BAR; G8_MMA(1, 0, At, B0); G8_MMA(1, 1, At, B1); G8_BAR; G8_SCHED;
            G8_LDB(B0, 1, 0); G8_LDB(B1, 1, 1); G8_SCHED; G8_LDA(At, 1, 0); G8_STAGEA(G8_SA(0, 1), A + k2, a10, a11);
            G8_WAIT_V(8); G8_WAIT_L(0); G8_BAR; G8_MMA(0, 0, At, B0); G8_MMA(0, 1, At, B1); G8_BAR; G8_SCHED;
            G8_LDA(At, 1, 1); G8_STAGEB(G8_SB(1, 0), b3); G8_STAGEB(G8_SB(1, 1), b3 + hstepB); G8_STAGEA(G8_SA(1, 0), A + k3, a00, a01);
            G8_WAIT_V(8); G8_WAIT_L(0); G8_BAR; G8_MMA(1, 0, At, B0); G8_MMA(1, 1, At, B1); G8_BAR; G8_SCHED;
            } else {
            const char* a1 = cA + k1; const char* a2 = (last ? nA : cA) + k2; const char* a3 = a2 + kstep;
            G8_LDB(B0, 0, 0); G8_LDB(B1, 0, 1); G8_SCHED; G8_LDA(At, 0, 0); G8_STAGEA(G8_SA(1, 1), a1 + hstepA, voffA[0], voffA[1]);
            G8_WAIT_V(8); G8_WAIT_L(0); G8_BAR; G8_MMA(0, 0, At, B0); G8_MMA(0, 1, At, B1); G8_BAR; G8_SCHED;
            G8_LDA(At, 0, 1); G8_STAGEB(G8_SB(0, 0), b2); G8_STAGEB(G8_SB(0, 1), b2 + hstepB); G8_STAGEA(G8_SA(0, 0), a2, voffA[0], voffA[1]);
            G8_WAIT_V(8); G8_WAIT_L(0); G8_BAR; G8_MMA(1, 0, At, B0); G8_MMA(1, 1, At, B1); G8_BAR; G8_SCHED;
            G8_LDB(B0, 1, 0); G8_LDB(B1, 1, 1); G8_SCHED; G8_LDA(At, 1, 0); G8_STAGEA(G8_SA(0, 1), a2 + hstepA, voffA[0], voffA[1]);
            G8_WAIT_V(8); G8_WAIT_L(0); G8_BAR; G8_MMA(0, 0, At, B0); G8_MMA(0, 1, At, B1); G8_BAR; G8_SCHED;
            G8_LDA(At, 1, 1); G8_STAGEB(G8_SB(1, 0), b3); G8_STAGEB(G8_SB(1, 1), b3 + hstepB); G8_STAGEA(G8_SA(1, 0), a3, voffA[0], voffA[1]);
            G8_WAIT_V(8); G8_WAIT_L(0); G8_BAR; G8_MMA(1, 0, At, B0); G8_MMA(1, 1, At, B1); G8_BAR; G8_SCHED;
            }
        }
        if (wr == 0) G8_BAR;
        E(acc, cur, wr, wc, fr, fq);
        if (!has_next) break;
#pragma unroll
        for (int a = 0; a < 2; ++a)
#pragma unroll
            for (int b = 0; b < 2; ++b)
#pragma unroll
                for (int m = 0; m < 4; ++m)
#pragma unroll
                    for (int n = 0; n < 2; ++n) acc[a][b][m][n] = (f32x4){0.f, 0.f, 0.f, 0.f};
        cur = nxt; c00 = n00; c01 = n01; c10 = n10; c11 = n11; cB0 = nB0; cB1 = nB1; cA = nA; ++ui;
        if (wr == 1) G8_BAR;
    }
    G8_WAIT_V(0);
    G8_BAR;
#undef G8_SA
#undef G8_SB
#undef G8_STAGEA
#undef G8_STAGEB
#undef G8_BK
#undef G8_LDA
#undef G8_LDB
#undef G8_MMA
#undef G8_WAIT_V
#undef G8_WAIT_L
#undef G8_BAR
#undef G8_SCHED
}
template <class F> struct Epi {
    static constexpr bool PERM = F::PERM;
    F f;
    DI void operator()(const f32x4 (&acc)[2][2][4][2], const Unit& u, int wr, int wc, int fr, int fq) const {
#pragma unroll
        for (int ai = 0; ai < 2; ++ai)
#pragma unroll
            for (int m = 0; m < 4; ++m) {
                const int row = u.pm * BM + ai * HALF + wr * 64 + m * 16 + fr;
                if ((m % F::FENCE) == 0) __builtin_amdgcn_sched_barrier(0);
#pragma unroll
                for (int bj = 0; bj < 2; ++bj) {
                    if constexpr (F::PERM) { f.e8(row, u.pn * BM + bj * HALF + wc * 32 + 8 * fq, acc[ai][bj][m][0], acc[ai][bj][m][1], u); }
                    else {
#pragma unroll
                        for (int n = 0; n < 2; ++n) f.e4(row, u.pn * BM + bj * HALF + wc * 32 + 16 * n + 4 * fq, acc[ai][bj][m][n], u);
                    }
                }
            }
    }
};
}

DI void store_bf8(bf16_t* dst, const f32x4& a, const f32x4& b) { u32x4 w; w.x = pk2(a[0], a[1]); w.y = pk2(a[2], a[3]); w.z = pk2(b[0], b[1]); w.w = pk2(b[2], b[3]); *(u32x4*)dst = w; }
DI void rope8(const P& p, int row, int i0, f32x4& a, f32x4& b) {
    const f32x4 c = *(const f32x4*)(p.ropec + (size_t)row * 16 + i0), s = *(const f32x4*)(p.ropes + (size_t)row * 16 + i0);
    f32x4 oa, ob;
    oa[0] = a[0] * c[0] - a[1] * s[0]; oa[1] = a[0] * s[0] + a[1] * c[0]; oa[2] = a[2] * c[1] - a[3] * s[1]; oa[3] = a[2] * s[1] + a[3] * c[1];
    ob[0] = b[0] * c[2] - b[1] * s[2]; ob[1] = b[0] * s[2] + b[1] * c[2]; ob[2] = b[2] * c[3] - b[3] * s[3]; ob[3] = b[2] * s[3] + b[3] * c[3];
    a = oa; b = ob;
}
struct SrcDense {
    static constexpr bool GATHER = false;
    unsigned lda; const char* B; size_t bt;
    DI int ldb(int K) const { return K; }
    DI size_t ksplit() const { return 0; }
    DI unsigned a_off(const g8::Unit&, int, int) const { return 0u; }
    DI const char* b_ptr(const g8::Unit& u, int) const { return B + (size_t)u.pn * bt; }
};
struct SrcGu {
    static constexpr bool GATHER = true;
    unsigned lda; const int* rt; const int* te; const char* B;
    DI int ldb(int K) const { return K; }
    DI size_t ksplit() const { return 0; }
    DI unsigned a_off(const g8::Unit& u, int h, int R) const { const int v = rt[u.pm * 256 + h * 128 + R]; return (unsigned)(v ? v - 1 : 0) * lda; }
    DI const char* b_ptr(const g8::Unit& u, int) const { const int ee = te[u.pm]; const int e = (u.pn < 2) ? (ee & 255) : (ee >> 8); return B + ((size_t)e * 512 + (size_t)(u.pn & 1) * 256) * 1024 * 2; }
};
struct SrcDn {
    static constexpr bool GATHER = false;
    unsigned lda; const int* te; const char* B;
    DI int ldb(int) const { return 256; }
    DI size_t ksplit() const { return 512; }
    DI unsigned a_off(const g8::Unit&, int, int) const { return 0u; }
    DI const char* b_ptr(const g8::Unit& u, int half) const { const int ee = te[u.pm]; const int e = half ? (ee >> 8) : (ee & 255);
        return B + ((size_t)e * 1024 + (size_t)u.pn * 256) * 256 * 2 - (half ? 512 : 0); }
};
struct FIn0 { static constexpr bool PERM = true; static constexpr int FENCE = 2; const P& p;
    DI void e8(int row, int col, f32x4 a, f32x4 b, const g8::Unit&) const {
        if (col >= 384 && col < 416) { rope8(p, row, (col - 384) >> 1, a, b); store_bf8(p.kpe + (size_t)row * 32 + (col - 384), a, b); }
        else if (col < AB_IN) store_bf8(p.proj + (size_t)row * LD0 + col, a, b);
    } };
struct FUq { static constexpr bool PERM = true; static constexpr int FENCE = 2; const P& p;
    DI void e8(int row, int col, f32x4 a, f32x4 b, const g8::Unit&) const {
        const float r = p.rq[row] * QSCALE; a = a * r; b = b * r;
        if (((col >> 5) % 3) == 2) rope8(p, row, (col & 31) >> 1, a, b);
        store_bf8(p.q + (size_t)row * 768 + col, a, b);
    } };
struct FUkv { static constexpr bool PERM = true; static constexpr int FENCE = 2; const P& p;
    DI void e8(int row, int col, f32x4 a, f32x4 b, const g8::Unit&) const {
        const float r = p.rkv[row]; a = a * r; b = b * r;
        if (col < 512) store_bf8(p.kn + (size_t)row * 512 + col, a, b); else store_bf8(p.v + (size_t)row * 512 + (col - 512), a, b);
    } };
struct FOut { static constexpr bool PERM = true; static constexpr int FENCE = 2; const P& p; int l;
    DI void e8(int row, int col, const f32x4& a, const f32x4& b, const g8::Unit&) const {
        const int bb = row >> 12;
        const float* gp = p.mod + ((size_t)l * 16 + bb) * 6144 + 2048 + col;
        const f32x4 g0 = *(const f32x4*)gp, g1 = *(const f32x4*)(gp + 4);
        f32x4 x0, x1;
        if (l == 0) { const float* xp = p.x + (size_t)row * D + col; x0 = *(const f32x4*)xp; x1 = *(const f32x4*)(xp + 4); }
        else { const u32x4 r = *(const u32x4*)(p.xr + (size_t)row * D + col);
            x0 = (f32x4){__uint_as_float(r.x << 16), __uint_as_float(r.x & 0xffff0000u), __uint_as_float(r.y << 16), __uint_as_float(r.y & 0xffff0000u)};
            x1 = (f32x4){__uint_as_float(r.z << 16), __uint_as_float(r.z & 0xffff0000u), __uint_as_float(r.w << 16), __uint_as_float(r.w & 0xffff0000u)}; }
        store_bf8(p.xr + (size_t)row * D + col, x0 + g0 * a, x1 + g1 * b);
    } };
struct FIn1 { static constexpr bool PERM = true; static constexpr int FENCE = 2; const P& p;
    DI void e8(int row, int col, f32x4 a, f32x4 b, const g8::Unit&) const {
        if (col < 1024) {
#pragma unroll
            for (int e = 0; e < 4; ++e) { a[e] = gelu_tanh_f(a[e]); b[e] = gelu_tanh_f(b[e]); }
        } else if (col >= 2048 && col < 2304) {
            const float* bg = p.gla_b_g + (col - 2048); f32x4 o0, o1;
#pragma unroll
            for (int e = 0; e < 4; ++e) { o0[e] = log_sigmoid_f(a[e] + bg[e]) * (1.f / 16.f); o1[e] = log_sigmoid_f(b[e] + bg[4 + e]) * (1.f / 16.f); }
            float* dst = p.loga + (size_t)row * 256 + (col - 2048);
            *(f32x4*)dst = o0; *(f32x4*)(dst + 4) = o1;
            return;
        }
        store_bf8(p.proj + (size_t)row * LD1 + col, a, b);
    } };
struct FGu { static constexpr bool PERM = true; static constexpr int FENCE = 2; const P& p; const float* rw;
    DI void e8(int row, int col, const f32x4& a, const f32x4& b, const g8::Unit&) const {
        const float w = rw[2 * row + (col >> 9)];
        u32x2 o; o.x = pk2(silu_f(a[0]) * a[1] * w, silu_f(a[2]) * a[3] * w); o.y = pk2(silu_f(b[0]) * b[1] * w, silu_f(b[2]) * b[3] * w);
        *(u32x2*)(p.act + (size_t)row * 512 + (col >> 1)) = o;
    } };
struct FNull { static constexpr bool PERM = true; static constexpr int FENCE = 2;
    DI void e8(int, int, const f32x4& a, const f32x4& b, const g8::Unit&) const { asm volatile("" :: "v"(a[0]), "v"(a[1]), "v"(a[2]), "v"(a[3]), "v"(b[0]), "v"(b[1]), "v"(b[2]), "v"(b[3])); } };
struct FDn { static constexpr bool PERM = true; static constexpr int FENCE = 2; const P& p;
    DI void e8(int row, int col, const f32x4& a, const f32x4& b, const g8::Unit&) const { store_bf8(p.y + (size_t)row * D + col, a, b); } };

enum { J_IN0 = 0, J_UQ, J_UKV, J_OUT0, J_IN1, J_OUT1, J_GU, J_DN, J_R, J_NUM };
DI float wval(const P& p, int job, int sub, int k, int n) {
    switch (job) {
    case J_IN0: {
        if (n >= AB_IN) return 0.f;
        int src = n;
        if (n >= 384 && n < 416) { const int i = n - 384; src = 384 + (i >> 1) + (i & 1) * 16; }
        return p.ab_w_in[(size_t)k * AB_IN + src];
    }
    case J_UQ: {
        const int h = n / 96, j = n % 96; int src = 96 * h + j;
        if (j >= 64) { const int i = j - 64; src = 96 * h + 64 + (i >> 1) + (i & 1) * 16; }
        return p.w_uq[(size_t)k * 768 + src] * p.q_norm_g[k];
    }
    case J_UKV: {
        int src;
        if (n < 512) { src = 128 * (n >> 6) + (n & 63); } else { const int m = n - 512; src = 128 * (m >> 6) + 64 + (m & 63); }
        return p.w_ukv[(size_t)k * 1024 + src] * p.kv_norm_g[k];
    }
    case J_OUT0: return p.ab_w_out[(size_t)k * 1024 + n];
    case J_IN1: {
        if (n < 2048) return p.cd_w_in[(size_t)k * CD_IN + n];
        if (n < 2304) { const int j = n - 2048; float s = 0.f;
#pragma unroll
            for (int r = 0; r < 16; ++r) s += p.cd_w_in[(size_t)k * CD_IN + 2048 + r] * p.gla_w_g2[r * 256 + j];
            return s; }
        return p.cd_w_in[(size_t)k * CD_IN + 2064 + (n - 2304)];
    }
    case J_OUT1: return p.cd_w_out[(size_t)k * 1024 + n];
    case J_GU: { const int j = n >> 1; const int src = (n & 1) ? 256 + j : j; return p.moe_w_gate_up[((size_t)sub * 1024 + k) * 512 + src]; }
    case J_DN: return p.moe_w_down[((size_t)sub * 256 + k) * 1024 + n];
    case J_R: { if (n < 4) return p.moe_w_group[((size_t)sub * 1024 + k) * 4 + n]; if (n < 36) return p.moe_w_expert[((size_t)sub * 1024 + k) * 32 + (n - 4)]; return 0.f; }
    }
    return 0.f;
}
struct JobInfo { int K, N, nsub; };
DI JobInfo job_info(int job) {
    switch (job) {
    case J_IN0: return {1024, LD0, 1};
    case J_UQ: return {256, 768, 1};
    case J_UKV: return {128, 1024, 1};
    case J_OUT0: return {1024, 1024, 1};
    case J_IN1: return {1024, LD1, 1};
    case J_OUT1: return {1024, 1024, 1};
    case J_GU: return {1024, 512, 64};
    case J_DN: return {256, 1024, 64};
    default: return {1024, 64, 2};
    }
}
constexpr size_t WO_IN0 = 0, WO_UQ = WO_IN0 + (size_t)LD0 * 1024, WO_UKV = WO_UQ + 768 * 256, WO_OUT0 = WO_UKV + 1024 * 128, WO_IN1 = WO_OUT0 + 1024 * 1024,
    WO_OUT1 = WO_IN1 + (size_t)LD1 * 1024, WO_GU = WO_OUT1 + 1024 * 1024, WO_DN = WO_GU + (size_t)64 * 512 * 1024, WO_R = WO_DN + (size_t)64 * 1024 * 256, WO_END = WO_R + 2 * 64 * 1024;
DI size_t job_dst_off(int job) {
    switch (job) {
    case J_IN0: return WO_IN0; case J_UQ: return WO_UQ; case J_UKV: return WO_UKV; case J_OUT0: return WO_OUT0;
    case J_IN1: return WO_IN1; case J_OUT1: return WO_OUT1; case J_GU: return WO_GU; case J_DN: return WO_DN; default: return WO_R;
    }
}
DI void ph_prep(const P& p, LAS unsigned char* lds) {
    const int tid = tid_();
#ifndef PREP_A
#define PREP_A 1
#define PREP_B 1
#define PREP_C 1
#endif
    for (int rep_ = 0; rep_ < PREP_A; ++rep_)
    if (blockIdx.x < 192) {
        LAS float* cact = (LAS float*)lds;
        LAS float* red = cact + 16 * 1024;
        for (int i = tid; i < 16 * 1024; i += NTHR) cact[i] = silu_f(p.c[i]);
        __syncthreads();
        const int col = tid & 63, ks = tid >> 6;
        for (int item = blockIdx.x; item < 192; item += gridDim.x) {
            const int l = item / 96, j = (item % 96) * 64 + col;
            float acc[16];
#pragma unroll
            for (int b = 0; b < 16; ++b) acc[b] = 0.f;
            const float* W = p.adaln_w + (size_t)l * 1024 * 6144 + j;
            for (int k0 = ks * 128; k0 < ks * 128 + 128; k0 += 16) {
                float wv[16];
#pragma unroll
                for (int u = 0; u < 16; ++u) wv[u] = W[(size_t)(k0 + u) * 6144];
#pragma unroll
                for (int u = 0; u < 16; ++u)
#pragma unroll
                    for (int b = 0; b < 16; ++b) acc[b] += cact[b * 1024 + k0 + u] * wv[u];
            }
#pragma unroll
            for (int b = 0; b < 16; ++b) red[(ks * 16 + b) * 64 + col] = acc[b];
            __syncthreads();
            for (int i = tid; i < 1024; i += NTHR) {
                const int b = i >> 6, cc = i & 63; float s = 0.f;
#pragma unroll
                for (int q = 0; q < 8; ++q) s += red[(q * 16 + b) * 64 + cc];
                const int jj = (item % 96) * 64 + cc;
                p.mod[((size_t)l * 16 + b) * 6144 + jj] = s + p.adaln_b[l * 6144 + jj];
            }
            __syncthreads();
        }
    }
    for (int rep_ = 0; rep_ < PREP_B; ++rep_)
    {
        const int lane = tid & 63, wid = tid >> 6;
        LAS float* scr = (LAS float*)(lds + wid * (64 * 72 * 2));
        int total = 0;
#pragma unroll
        for (int j = 0; j < J_NUM; ++j) { const JobInfo ji = job_info(j); total += (j == J_GU || j == J_DN) ? 0 : (ji.K / 64) * (ji.N / 32) * ji.nsub; }
        for (int item = blockIdx.x * NWAVE + wid; item < total; item += gridDim.x * NWAVE) {
            int job = 0, jstart = 0, accn = 0;
#pragma unroll
            for (int j = 0; j < J_NUM; ++j) { const JobInfo jj = job_info(j); if (j == J_GU || j == J_DN) continue; if (item >= accn) { job = j; jstart = accn; } accn += (jj.K / 64) * (jj.N / 32) * jj.nsub; }
#ifndef PREP_JOBREP
#define PREP_JOBREP -1
#endif
            for (int jr_ = 0; jr_ < ((job == PREP_JOBREP) ? 2 : 1); ++jr_) {
            const JobInfo ji = job_info(job);
            int r = item - jstart;
            const int kt = ji.K / 64, nt = ji.N / 32;
            const int sub = r / (kt * nt); r -= sub * kt * nt;
            const int n0 = (r % nt) * 32, k0 = (r / nt) * 64;
            {
                const int n = n0 + (lane & 31);
                const float* cp = nullptr; size_t ldk = 0; const float* gain = nullptr; bool slow = false;
                switch (job) {
                case J_IN0: { if (n < AB_IN) { int src = n; if (n >= 384 && n < 416) { const int i = n - 384; src = 384 + (i >> 1) + (i & 1) * 16; } cp = p.ab_w_in + src; ldk = AB_IN; } } break;
                case J_UQ: { const int h = n / 96, j = n % 96; int src = 96 * h + j; if (j >= 64) { const int i = j - 64; src = 96 * h + 64 + (i >> 1) + (i & 1) * 16; } cp = p.w_uq + src; ldk = 768; gain = p.q_norm_g; } break;
                case J_UKV: { int src; if (n < 512) src = 128 * (n >> 6) + (n & 63); else { const int m = n - 512; src = 128 * (m >> 6) + 64 + (m & 63); } cp = p.w_ukv + src; ldk = 1024; gain = p.kv_norm_g; } break;
                case J_OUT0: cp = p.ab_w_out + n; ldk = 1024; break;
                case J_IN1: { if (n < 2048) { cp = p.cd_w_in + n; ldk = CD_IN; } else if (n < 2304) slow = true; else { cp = p.cd_w_in + 2064 + (n - 2304); ldk = CD_IN; } } break;
                case J_OUT1: cp = p.cd_w_out + n; ldk = 1024; break;
                case J_GU: { const int j = n >> 1; cp = p.moe_w_gate_up + (size_t)sub * 1024 * 512 + ((n & 1) ? 256 + j : j); ldk = 512; } break;
                case J_DN: cp = p.moe_w_down + (size_t)sub * 256 * 1024 + n; ldk = 1024; break;
                default: slow = true; break;
                }
                const int kb = k0 + (lane >> 5);
                if (job == J_IN1 && n0 >= 2048 && n0 < 2304) {
                    float g2[16];
#pragma unroll
                    for (int r2 = 0; r2 < 16; ++r2) g2[r2] = p.gla_w_g2[r2 * 256 + (n - 2048)];
#pragma unroll 4
                    for (int i = 0; i < 32; ++i) { const float* wr = p.cd_w_in + (size_t)(kb + 2 * i) * CD_IN + 2048;
                        const f32x4 a = *(const f32x4*)wr, b = *(const f32x4*)(wr + 4), c = *(const f32x4*)(wr + 8), d = *(const f32x4*)(wr + 12);
                        float v = 0.f;
#pragma unroll
                        for (int e = 0; e < 4; ++e) v += a[e] * g2[e] + b[e] * g2[4 + e] + c[e] * g2[8 + e] + d[e] * g2[12 + e];
                        scr[(2 * i + (lane >> 5)) * 33 + (lane & 31)] = v; }
                } else if (__any(slow)) {
#pragma unroll 8
                    for (int i = 0; i < 32; ++i) scr[(2 * i + (lane >> 5)) * 33 + (lane & 31)] = wval(p, job, sub, kb + 2 * i, n);
                } else {
                    const float* q = cp ? cp + (size_t)kb * ldk : nullptr;
#pragma unroll
                    for (int i = 0; i < 32; ++i) { float v = q ? q[(size_t)(2 * i) * ldk] : 0.f; if (gain) v *= gain[kb + 2 * i]; scr[(2 * i + (lane >> 5)) * 33 + (lane & 31)] = v; }
                }
            }
            asm volatile("s_waitcnt lgkmcnt(0)" ::: "memory");
            bf16_t* dst = p.wt_in0 + job_dst_off(job) + (size_t)sub * ji.K * ji.N;
            const int c = lane & 7;
#pragma unroll
            for (int j = 0; j < 4; ++j) { const int n = (lane >> 3) + 8 * j; const LAS float* sp = scr + (8 * c) * 33 + n;
                u32x4 o; o.x = pk2(sp[0 * 33], sp[1 * 33]); o.y = pk2(sp[2 * 33], sp[3 * 33]); o.z = pk2(sp[4 * 33], sp[5 * 33]); o.w = pk2(sp[6 * 33], sp[7 * 33]);
                *(u32x4*)(dst + (size_t)(n0 + n) * ji.K + k0 + 8 * c) = o; }
            asm volatile("s_waitcnt lgkmcnt(0)" ::: "memory");
            }
        }
    }
    for (int rep_ = 0; rep_ < PREP_B; ++rep_)
    {
        const int lane = tid & 63, wid = tid >> 6, g = lane >> 4, i15 = lane & 15, tq = i15 >> 2, tp = i15 & 3;
        LAS unsigned char* tl = lds + wid * (64 * 72 * 2);
        for (int item = blockIdx.x * NWAVE + wid; item < 8192 + 4096; item += gridDim.x * NWAVE) {
            const float* src; bf16_t* dst; int ld, Kd, k0, c0; bool gu;
            if (item < 8192) { const int sub = item >> 7, rr = item & 127; k0 = (rr >> 3) * 64; c0 = (rr & 7) * 64; ld = 512; Kd = 1024; gu = true;
                src = p.moe_w_gate_up + ((size_t)sub * 1024 + k0) * 512 + c0; dst = p.wt_gu + (size_t)sub * 512 * 1024; }
            else { const int r = item - 8192; const int sub = r >> 6, rr = r & 63; k0 = (rr >> 4) * 64; c0 = (rr & 15) * 64; ld = 1024; Kd = 256; gu = false;
                src = p.moe_w_down + ((size_t)sub * 256 + k0) * 1024 + c0; dst = p.wt_dn + (size_t)sub * 1024 * 256; }
            f32x4 v[16];
#pragma unroll
            for (int i = 0; i < 16; ++i) v[i] = *(const f32x4*)(src + (size_t)(4 * i + g) * ld + 4 * i15);
#pragma unroll
            for (int i = 0; i < 16; ++i) { u32x2 w; w.x = pk2(v[i][0], v[i][1]); w.y = pk2(v[i][2], v[i][3]); *(LAS u32x2*)(tl + ((4 * i + g) * 72 + 4 * i15) * 2) = w; }
            asm volatile("s_waitcnt lgkmcnt(0)" ::: "memory");
#pragma unroll
            for (int ps = 0; ps < 8; ++ps) {
                const int cb = 16 * (ps & 3), ch = (ps >> 2) * 4 + g;
                const s16x4 lo = vtr(tl + ((8 * ch + tq) * 72 + cb + 4 * tp) * 2), hi4 = vtr(tl + ((8 * ch + 4 + tq) * 72 + cb + 4 * tp) * 2);
                const int c = c0 + cb + i15;
                const int n = gu ? ((c < 256) ? 2 * c : 2 * (c - 256) + 1) : c;
                u32x4 o; o.x = (unsigned)(unsigned short)lo[0] | ((unsigned)(unsigned short)lo[1] << 16); o.y = (unsigned)(unsigned short)lo[2] | ((unsigned)(unsigned short)lo[3] << 16);
                o.z = (unsigned)(unsigned short)hi4[0] | ((unsigned)(unsigned short)hi4[1] << 16); o.w = (unsigned)(unsigned short)hi4[2] | ((unsigned)(unsigned short)hi4[3] << 16);
                *(u32x4*)(dst + (size_t)n * Kd + k0 + 8 * ch) = o;
            }
            asm volatile("s_waitcnt lgkmcnt(0)" ::: "memory");
        }
    }
    for (int rep_ = 0; rep_ < PREP_C; ++rep_)
    for (int gid = blockIdx.x * NTHR + tid; gid < NTOK * 16; gid += gridDim.x * NTHR) {
        const int tok = gid >> 4, i = gid & 15;
        const float inv = exp2f(-(float)i * (13.287712379549449f / 16.0f));
        float sn, cs; sincosf((float)p.pos[tok] * inv, &sn, &cs);
        p.ropec[gid] = cs; p.ropes[gid] = sn;
    }
}

template <bool F32IN>
DI void ph_norm(const P& p, const void* xin_, const float* g, int l, int which) {
    const int tid = tid_(); const int lane = tid & 63;
    constexpr int R = 4;
    for (int row0 = (blockIdx.x * NWAVE + (tid >> 6)) * R; row0 < NTOK; row0 += gridDim.x * NWAVE * R) {
        const int b = row0 >> 12;
        const float* md = p.mod + ((size_t)l * 16 + b) * 6144 + which * 3072;
        f32x4 v[R][4]; float ss[R];
#pragma unroll
        for (int r = 0; r < R; ++r)
#pragma unroll
            for (int i = 0; i < 4; ++i) {
                if (F32IN) v[r][i] = *(const f32x4*)((const float*)xin_ + (size_t)(row0 + r) * D + i * 256 + lane * 4);
                else { const u32x2 q = *(const u32x2*)((const bf16_t*)xin_ + (size_t)(row0 + r) * D + i * 256 + lane * 4);
                       v[r][i] = (f32x4){__uint_as_float(q.x << 16), __uint_as_float(q.x & 0xffff0000u), __uint_as_float(q.y << 16), __uint_as_float(q.y & 0xffff0000u)}; }
            }
#pragma unroll
        for (int r = 0; r < R; ++r) { float a = 0.f;
#pragma unroll
            for (int i = 0; i < 4; ++i) a += v[r][i][0] * v[r][i][0] + v[r][i][1] * v[r][i][1] + v[r][i][2] * v[r][i][2] + v[r][i][3] * v[r][i][3];
            ss[r] = rsqrtf(wave_sum(a) * (1.f / D) + EPS); }
#pragma unroll
        for (int i = 0; i < 4; ++i) {
            const int c0 = i * 256 + lane * 4;
            const f32x4 gg = *(const f32x4*)(g + c0), sh = *(const f32x4*)(md + c0), sc = *(const f32x4*)(md + 1024 + c0);
#pragma unroll
            for (int r = 0; r < R; ++r) {
                float o[4];
#pragma unroll
                for (int e = 0; e < 4; ++e) o[e] = v[r][i][e] * ss[r] * gg[e] * (1.f + sc[e]) + sh[e];
                u32x2 w; w.x = pk2(o[0], o[1]); w.y = pk2(o[2], o[3]);
                *(u32x2*)(p.xa + (size_t)(row0 + r) * D + c0) = w;
            }
        }
    }
}
DI void ph_rowstat0_conv(const P& p) {
    const int tid = tid_(); const int lane = tid & 63;
    float cw[3][8];
#pragma unroll
    for (int k = 0; k < 3; ++k) { const f32x4 a = *(const f32x4*)(p.conv_w + k * 512 + lane * 8), b = *(const f32x4*)(p.conv_w + k * 512 + lane * 8 + 4);
#pragma unroll
        for (int e = 0; e < 4; ++e) { cw[k][e] = a[e]; cw[k][4 + e] = b[e]; } }
    for (int blk = blockIdx.x * NWAVE + (tid >> 6); blk < NTOK / 16; blk += gridDim.x * NWAVE) {
        const int row0 = blk * 16;
        float u1[8], u2[8];
#pragma unroll
        for (int e = 0; e < 8; ++e) { u1[e] = 0.f; u2[e] = 0.f; }
        if ((row0 & 4095) != 0) {
#pragma unroll
            for (int d = 1; d <= 2; ++d) { const bf16_t* q = p.proj + (size_t)(row0 - d) * LD0; const u32x4 c = *(const u32x4*)(q + 928 + lane * 8), x = *(const u32x4*)(q + 1440 + lane * 8);
#pragma unroll
                for (int e = 0; e < 4; ++e) { const float v0 = __uint_as_float(c[e] << 16) * __uint_as_float(x[e] << 16), v1 = __uint_as_float(c[e] & 0xffff0000u) * __uint_as_float(x[e] & 0xffff0000u);
                    if (d == 1) { u1[2 * e] = v0; u1[2 * e + 1] = v1; } else { u2[2 * e] = v0; u2[2 * e + 1] = v1; } } }
        }
#pragma unroll 4
        for (int i = 0; i < 16; ++i) {
            const int row = row0 + i;
            const bf16_t* r = p.proj + (size_t)row * LD0;
            { const u32x2 a = *(const u32x2*)(r + lane * 4); const unsigned kk = *(const unsigned*)(r + 256 + lane * 2);
              float sq = 0.f, sk = 0.f;
              { const float a0 = __uint_as_float(a.x << 16), a1 = __uint_as_float(a.x & 0xffff0000u), a2 = __uint_as_float(a.y << 16), a3 = __uint_as_float(a.y & 0xffff0000u); sq = a0 * a0 + a1 * a1 + a2 * a2 + a3 * a3; }
              { const float k0 = __uint_as_float(kk << 16), k1 = __uint_as_float(kk & 0xffff0000u); sk = k0 * k0 + k1 * k1; }
              sq = wave_sum(sq); sk = wave_sum(sk);
              if (lane == 0) { p.rq[row] = rsqrtf(sq * (1.f / 256.f) + EPS); p.rkv[row] = rsqrtf(sk * (1.f / 128.f) + EPS); } }
            const u32x4 bg = *(const u32x4*)(r + 416 + lane * 8), c = *(const u32x4*)(r + 928 + lane * 8), x = *(const u32x4*)(r + 1440 + lane * 8);
            u32x4 o;
#pragma unroll
            for (int e = 0; e < 4; ++e) {
                const float v0 = __uint_as_float(c[e] << 16) * __uint_as_float(x[e] << 16), v1 = __uint_as_float(c[e] & 0xffff0000u) * __uint_as_float(x[e] & 0xffff0000u);
                const float y0 = cw[0][2 * e] * u2[2 * e] + cw[1][2 * e] * u1[2 * e] + cw[2][2 * e] * v0;
                const float y1 = cw[0][2 * e + 1] * u2[2 * e + 1] + cw[1][2 * e + 1] * u1[2 * e + 1] + cw[2][2 * e + 1] * v1;
                u2[2 * e] = u1[2 * e]; u2[2 * e + 1] = u1[2 * e + 1]; u1[2 * e] = v0; u1[2 * e + 1] = v1;
                o[e] = pk2(__uint_as_float(bg[e] << 16) * y0, __uint_as_float(bg[e] & 0xffff0000u) * y1);
            }
            *(u32x4*)(p.mix + (size_t)row * D + 512 + lane * 8) = o;
        }
    }
}
constexpr int GL_QS = 72, GL_VS = 144;
constexpr int GX_SEG = 0, GX_QD = 2048, GX_KD = GX_QD + 64 * GL_QS * 2, GX_KE = GX_KD + 64 * GL_QS * 2, GX_V = GX_KE + 64 * GL_QS * 2, GX_END = GX_V + 64 * GL_VS * 2;
DI void ph_stat1x(const P& p, LAS unsigned char* lds) {
    const int tid = tid_(); const int lane = tid & 63, w = __builtin_amdgcn_readfirstlane(tid >> 6), l15 = lane & 15, g = lane >> 4, tq = l15 >> 2, tp = l15 & 3;
    for (int row = blockIdx.x * NWAVE + w; row < NTOK; row += gridDim.x * NWAVE) {
        const u32x4 a = *(const u32x4*)(p.proj + (size_t)row * LD1 + 512 + lane * 8);
        float s = 0.f;
#pragma unroll
        for (int e = 0; e < 4; ++e) { const float v0 = __uint_as_float(a[e] << 16), v1 = __uint_as_float(a[e] & 0xffff0000u); s += v0 * v0 + v1 * v1; }
        s = wave_sum(s);
        if (lane == 0) p.rv[row] = rsqrtf(s * (1.f / 512.f) + EPS);
    }
    float nbc[8]; bf16_t nq[8], nk[8]; u32x4 nrv[2];
#define GX_LOAD(it_) do { const int h_ = (it_) & 3; const size_t row0_ = (size_t)((it_) >> 2) * 64; \
        const float* la_ = p.loga + (row0_ + 8 * w) * 256 + h_ * 64 + lane; const bf16_t* pq_ = p.proj + (row0_ + 8 * w) * LD1 + 1024 + h_ * 64 + lane; \
        _Pragma("unroll") for (int i = 0; i < 8; ++i) { nbc[i] = la_[(size_t)i * 256]; nq[i] = pq_[(size_t)i * LD1]; nk[i] = pq_[(size_t)i * LD1 + 256]; } \
        _Pragma("unroll") for (int i = 0; i < 2; ++i) { const int c = i * 512 + tid; nrv[i] = *(const u32x4*)(p.proj + (row0_ + (c >> 4)) * LD1 + 1536 + h_ * 128 + (c & 15) * 8); } } while (0)
#define GX_BAR() do { asm volatile("s_waitcnt lgkmcnt(0)" ::: "memory"); __builtin_amdgcn_s_barrier(); asm volatile("" ::: "memory"); } while (0)
    if ((int)blockIdx.x < (NTOK / 64) * 4) GX_LOAD(blockIdx.x);
    for (int it = blockIdx.x; it < (NTOK / 64) * 4; it += gridDim.x) {
        const int h = it & 3, ck = it >> 2;
        const size_t row0 = (size_t)ck * 64;
        float bc[8], qv[8], kv[8]; u32x4 rvv[2];
#pragma unroll
        for (int i = 0; i < 8; ++i) { bc[i] = nbc[i]; qv[i] = bf2f(nq[i]); kv[i] = bf2f(nk[i]); }
        rvv[0] = nrv[0]; rvv[1] = nrv[1];
        if (it + (int)gridDim.x < (NTOK / 64) * 4) GX_LOAD(it + gridDim.x);
#pragma unroll
        for (int i = 1; i < 8; ++i) bc[i] += bc[i - 1];
        ((LAS float*)(lds + GX_SEG))[w * 64 + lane] = bc[7];
#pragma unroll
        for (int i = 0; i < 2; ++i) { const int c = i * 512 + tid; *(LAS u32x4*)(lds + GX_V + ((c >> 4) * GL_VS + (c & 15) * 8) * 2) = rvv[i]; }
        GX_BAR();
        float off = 0.f, bl = 0.f;
#pragma unroll
        for (int ww = 0; ww < 8; ++ww) { const float sg = ((const LAS float*)(lds + GX_SEG))[ww * 64 + lane]; bl += sg; off += (ww < w) ? sg : 0.f; }
#pragma unroll
        for (int i = 0; i < 8; ++i) {
            const float x = bc[i] + off, eb = __expf(x);
            const int o = ((8 * w + i) * GL_QS + lane) * 2;
            *(LAS bf16_t*)(lds + GX_QD + o) = f2bf(qv[i] * 0.125f * eb); *(LAS bf16_t*)(lds + GX_KD + o) = f2bf(kv[i] * __builtin_amdgcn_rcpf(eb)); *(LAS bf16_t*)(lds + GX_KE + o) = f2bf(kv[i] * __expf(bl - x));
        }
        if (w == 0) p.gdec[(size_t)ck * 256 + h * 64 + lane] = __expf(bl);
        GX_BAR();
        { const int o = ((tid >> 3) * GL_QS + (tid & 7) * 8) * 2; const size_t go = (row0 + (tid >> 3)) * 256 + h * 64 + (tid & 7) * 8;
          *(u32x4*)(p.gqd + go) = *(const LAS u32x4*)(lds + GX_QD + o); *(u32x4*)(p.gkd + go) = *(const LAS u32x4*)(lds + GX_KD + o); }
        bf16x8 vN[2];
#pragma unroll
        for (int ks = 0; ks < 2; ++ks) {
            const s16x4 lo = vtr(lds + GX_V + ((32 * ks + 8 * g + tq) * GL_VS + 16 * w + 4 * tp) * 2), hi4 = vtr(lds + GX_V + ((32 * ks + 8 * g + 4 + tq) * GL_VS + 16 * w + 4 * tp) * 2);
            vN[ks] = (bf16x8){lo[0], lo[1], lo[2], lo[3], hi4[0], hi4[1], hi4[2], hi4[3]};
        }
        bf16_t* kvo = p.gkv + ((size_t)it * 64) * 128 + 16 * w + l15;
#pragma unroll
        for (int dkt = 0; dkt < 4; ++dkt) {
            f32x4 sc = (f32x4){0.f, 0.f, 0.f, 0.f};
#pragma unroll
            for (int ks = 0; ks < 2; ++ks) {
                const s16x4 lo = vtr(lds + GX_KE + ((32 * ks + 8 * g + tq) * GL_QS + 16 * dkt + 4 * tp) * 2), hi4 = vtr(lds + GX_KE + ((32 * ks + 8 * g + 4 + tq) * GL_QS + 16 * dkt + 4 * tp) * 2);
                const bf16x8 keT = (bf16x8){lo[0], lo[1], lo[2], lo[3], hi4[0], hi4[1], hi4[2], hi4[3]};
                sc = __builtin_amdgcn_mfma_f32_16x16x32_bf16(keT, vN[ks], sc, 0, 0, 0);
            }
#pragma unroll
            for (int j = 0; j < 4; ++j) kvo[(size_t)(16 * dkt + 4 * g + j) * 128] = f2bf(sc[j]);
        }
        GX_BAR();
    }
#undef GX_LOAD
#undef GX_BAR
}
DI void ph_gla_scan(const P& p) {
    const int tid = tid_();
    for (int gid = blockIdx.x * NTHR + tid; gid < 64 * 64 * 32; gid += gridDim.x * NTHR) {
        const int dvq = gid & 31, dk = (gid >> 5) & 63, bh = gid >> 11, b = bh >> 2, h = bh & 3;
        float st[4] = {0.f, 0.f, 0.f, 0.f};
        const size_t e0 = (((size_t)b * 64 * 4 + h) * 64 + dk) * 128 + dvq * 4;
        const float* dc = p.gdec + (size_t)b * 64 * 256 + h * 64 + dk;
#pragma unroll 8
        for (int n = 0; n < 64; ++n) {
            const size_t e = e0 + (size_t)n * (4 * 64 * 128);
            const u32x2 kvv = *(const u32x2*)(p.gkv + e); const float d = dc[(size_t)n * 256];
            u32x2 o; o.x = pk2(st[0], st[1]); o.y = pk2(st[2], st[3]);
            *(u32x2*)(p.gst + e) = o;
            st[0] = st[0] * d + __uint_as_float(kvv.x << 16); st[1] = st[1] * d + __uint_as_float(kvv.x & 0xffff0000u);
            st[2] = st[2] * d + __uint_as_float(kvv.y << 16); st[3] = st[3] * d + __uint_as_float(kvv.y & 0xffff0000u);
        }
    }
}

constexpr int NCLS = 112;
DI void ph_router(const P& p, int l, LAS unsigned char* lds) {
    const int tid = tid_(); const int lane = tid & 63, wid = tid >> 6, fr = lane & 15, fq = lane >> 4;
    LAS float* lg = (LAS float*)lds + wid * (32 * 65);
    const bf16_t* W = p.wt_r + (size_t)l * 64 * 1024;
    LAS int* hist = (LAS int*)(lds + 8 * 32 * 65 * 4);
    if (tid < 128) hist[tid] = 0;
    __syncthreads();
    const size_t o = (size_t)l * NTOK;
    for (int mt = blockIdx.x * NWAVE + wid; mt < NTOK / 32; mt += gridDim.x * NWAVE) {
        const int m0 = mt * 32;
        const bf16_t* ap[2]; const bf16_t* bp[4];
#pragma unroll
        for (int i = 0; i < 2; ++i) ap[i] = p.xa + (size_t)(m0 + 16 * i + fr) * D + fq * 8;
#pragma unroll
        for (int j = 0; j < 4; ++j) bp[j] = W + (size_t)(16 * j + fr) * 1024 + fq * 8;
        f32x4 acc[2][4];
#pragma unroll
        for (int i = 0; i < 2; ++i)
#pragma unroll
            for (int j = 0; j < 4; ++j) acc[i][j] = (f32x4){0.f, 0.f, 0.f, 0.f};
        for (int k = 0; k < 1024; k += 32) {
            bf16x8 a[2], b[4];
#pragma unroll
            for (int i = 0; i < 2; ++i) a[i] = *(const bf16x8*)(ap[i] + k);
#pragma unroll
            for (int j = 0; j < 4; ++j) b[j] = *(const bf16x8*)(bp[j] + k);
#pragma unroll
            for (int i = 0; i < 2; ++i)
#pragma unroll
                for (int j = 0; j < 4; ++j) acc[i][j] = __builtin_amdgcn_mfma_f32_16x16x32_bf16(b[j], a[i], acc[i][j], 0, 0, 0);
        }
#pragma unroll
        for (int i = 0; i < 2; ++i)
#pragma unroll
            for (int j = 0; j < 4; ++j)
#pragma unroll
                for (int e = 0; e < 4; ++e) lg[(16 * i + fr) * 65 + 16 * j + 4 * fq + e] = acc[i][j][e];
        asm volatile("s_waitcnt lgkmcnt(0)" ::: "memory");
        if (lane < 32) {
            const LAS float* r = lg + lane * 65; const int tok = m0 + lane;
            float gl[4]; int gs = 0;
#pragma unroll
            for (int j = 0; j < 4; ++j) gl[j] = r[j] + p.moe_b_group[l * 4 + j];
            float gmax = gl[0];
#pragma unroll
            for (int j = 1; j < 4; ++j) if (gl[j] > gmax) { gmax = gl[j]; gs = j; }
            float den = 0.f;
#pragma unroll
            for (int j = 0; j < 4; ++j) den += __expf(gl[j] - gmax);
            const float pg = 1.f / den;
            float el[8];
#pragma unroll
            for (int j = 0; j < 8; ++j) el[j] = r[4 + gs * 8 + j] + p.moe_b_expert[l * 32 + gs * 8 + j];
            int i1 = 0; float v1 = el[0];
#pragma unroll
            for (int j = 1; j < 8; ++j) if (el[j] > v1) { v1 = el[j]; i1 = j; }
            int i2 = -1; float v2 = -INFINITY;
#pragma unroll
            for (int j = 0; j < 8; ++j) if (j != i1 && el[j] > v2) { v2 = el[j]; i2 = j; }
            const float e2 = __expf(v2 - v1);
            const float w1 = pg / (1.f + e2), w2 = pg * e2 / (1.f + e2);
            const int lo = i1 < i2 ? i1 : i2, hi = i1 < i2 ? i2 : i1;
            const int cls = gs * 28 + (lo * (15 - lo)) / 2 + (hi - lo - 1);
            const int pos = __hip_atomic_fetch_add(hist + cls, 1, __ATOMIC_RELAXED, __HIP_MEMORY_SCOPE_WORKGROUP);
            p.tope[o + tok] = cls; p.toppos[o + tok] = pos;
            p.topw[2 * (o + tok)] = (i1 < i2) ? w1 : w2; p.topw[2 * (o + tok) + 1] = (i1 < i2) ? w2 : w1;
        }
        asm volatile("s_waitcnt lgkmcnt(0)" ::: "memory");
    }
    __syncthreads();
    if (tid < 128) p.whist[((size_t)l * 256 + blockIdx.x) * 128 + tid] = hist[tid];
    __syncthreads();
}
DI void ph_slots(const P& p, int l, LAS unsigned char* lds) {
    LAS int* ss = (LAS int*)lds;
    const int tid = tid_();
    const int G = gridDim.x, bx = blockIdx.x;
    if (tid < 128) {
        int tot = 0, pre = 0;
        for (int w = 0; w < G; ++w) { const int v = p.whist[((size_t)l * 256 + w) * 128 + tid]; tot += v; pre += (w < bx) ? v : 0; }
        ss[384 + tid] = tot; ss[tid] = pre;
    }
    __syncthreads();
    if (tid == 0) {
        int start = 0, tile = 0;
        for (int c = 0; c < NCLS; ++c) { const int nt = (ss[384 + c] + 255) >> 8; ss[c] += start; ss[128 + c] = tile; tile += nt; start += nt * 256; }
        ss[256] = tile;
    }
    __syncthreads();
    if (bx == 0) {
        if (tid < NCLS) {
            const int g = tid / 28; int r = tid % 28, lo = 0; while (r >= 7 - lo) { r -= 7 - lo; ++lo; } const int hi = lo + 1 + r;
            const int code = (g * 8 + lo) | ((g * 8 + hi) << 8);
            const int t0 = ss[128 + tid], t1 = (tid == NCLS - 1) ? ss[256] : ss[128 + tid + 1];
            for (int i = t0; i < t1; ++i) p.tile_e[l * 1024 + i] = code;
        }
        if (tid == 0) p.ntile[l] = ss[256];
    }
    const int lane = tid & 63, wid = tid >> 6;
    if (lane < 32)
    for (int mt = bx * NWAVE + wid; mt < NTOK / 32; mt += G * NWAVE) {
        const int tok = mt * 32 + lane;
        const size_t o = (size_t)l * NTOK + tok;
        const int slot = ss[p.tope[o]] + p.toppos[o];
        p.row_tok[(size_t)l * MAXSLOT + slot] = tok + 1;
        p.topslot[o] = slot;
        *(f32x2_t*)(p.row_w + 2 * ((size_t)l * MAXSLOT + slot)) = *(const f32x2_t*)(p.topw + 2 * o);
    }
    __syncthreads();
}
DI void ph_postnorm(const P& p, int l, int last) {
    const int tid = tid_(); const int lane = tid & 63;
    constexpr int R = 2;
    for (int row0 = (blockIdx.x * NWAVE + (tid >> 6)) * R; row0 < NTOK; row0 += gridDim.x * NWAVE * R) {
        const int b = row0 >> 12;
        const float* g2 = p.mod + ((size_t)l * 16 + b) * 6144 + 5 * 1024;
        int sl[R];
#pragma unroll
        for (int r = 0; r < R; ++r) sl[r] = p.topslot[(size_t)l * NTOK + row0 + r];
        u32x2 yv[R][4], xv[R][4];
#pragma unroll
        for (int r = 0; r < R; ++r)
#pragma unroll
            for (int i = 0; i < 4; ++i) { const int c0 = i * 256 + lane * 4; yv[r][i] = *(const u32x2*)(p.y + (size_t)sl[r] * D + c0); xv[r][i] = *(const u32x2*)(p.xr + (size_t)(row0 + r) * D + c0); }
        f32x4 v[R][4]; float rs[R];
#pragma unroll
        for (int r = 0; r < R; ++r) { float ss = 0.f;
#pragma unroll
            for (int i = 0; i < 4; ++i) {
                const f32x4 gg = *(const f32x4*)(g2 + i * 256 + lane * 4);
                v[r][i][0] = __uint_as_float(xv[r][i].x << 16) + gg[0] * __uint_as_float(yv[r][i].x << 16);
                v[r][i][1] = __uint_as_float(xv[r][i].x & 0xffff0000u) + gg[1] * __uint_as_float(yv[r][i].x & 0xffff0000u);
                v[r][i][2] = __uint_as_float(xv[r][i].y << 16) + gg[2] * __uint_as_float(yv[r][i].y << 16);
                v[r][i][3] = __uint_as_float(xv[r][i].y & 0xffff0000u) + gg[3] * __uint_as_float(yv[r][i].y & 0xffff0000u);
                ss += v[r][i][0] * v[r][i][0] + v[r][i][1] * v[r][i][1] + v[r][i][2] * v[r][i][2] + v[r][i][3] * v[r][i][3];
            }
            rs[r] = rsqrtf(wave_sum(ss) * (1.f / D) + EPS); }
        if (last) {
#pragma unroll
            for (int i = 0; i < 4; ++i) { const int c0 = i * 256 + lane * 4; const f32x4 gg = *(const f32x4*)(p.final_norm_g + c0);
#pragma unroll
                for (int r = 0; r < R; ++r) *(f32x4*)(p.out + (size_t)(row0 + r) * D + c0) = v[r][i] * rs[r] * gg; }
        } else {
            const float* md = p.mod + ((size_t)(l + 1) * 16 + b) * 6144;
            const float* g = p.norm_mix_g + (l + 1) * D;
#pragma unroll
            for (int i = 0; i < 4; ++i) {
                const int c0 = i * 256 + lane * 4;
                const f32x4 gg = *(const f32x4*)(g + c0), sh = *(const f32x4*)(md + c0), sc = *(const f32x4*)(md + 1024 + c0);
#pragma unroll
                for (int r = 0; r < R; ++r) {
                    u32x2 xw; xw.x = pk2(v[r][i][0], v[r][i][1]); xw.y = pk2(v[r][i][2], v[r][i][3]);
                    *(u32x2*)(p.xr + (size_t)(row0 + r) * D + c0) = xw;
                    float oo[4];
#pragma unroll
                    for (int e = 0; e < 4; ++e) oo[e] = v[r][i][e] * rs[r] * gg[e] * (1.f + sc[e]) + sh[e];
                    u32x2 w; w.x = pk2(oo[0], oo[1]); w.y = pk2(oo[2], oo[3]);
                    *(u32x2*)(p.xa + (size_t)(row0 + r) * D + c0) = w;
                }
            }
        }
    }
}

constexpr int AT_KB = 12 * 1024, AT_VB = 8 * 1024, AT_BUF = AT_KB + AT_VB, AT_NSLOT = 4, AT_WS = AT_NSLOT * AT_BUF, AT_OST = AT_WS + 8 * 256, AT_LDS = AT_OST + 8 * 4096;
static_assert(AT_LDS <= 147200, "attention LDS map");
constexpr float AT_THR = 8.f;
DI void attn_unit(const P& p, LAS unsigned char* lds, int b, int h, int qb, int tid) {
    const int lane = tid & 63, wid = __builtin_amdgcn_readfirstlane(tid >> 6), r32 = lane & 31, hi = lane >> 5;
    const size_t rowbase = (size_t)b * SEQ; const int q0 = qb * 512;
    const int NT = 8 * (qb + 1);
    const bf16_t* ksrc = p.kn + (rowbase + lane) * 512 + h * 64 + wid * 8;
    const bf16_t* psrc = p.kpe + (rowbase + lane) * 32 + (wid & 3) * 8;
    const bf16_t* vsrc = p.v + (rowbase + 16 * (wid & 3) + (lane >> 2)) * 512 + h * 64 + (wid >> 2) * 32 + (lane & 3) * 8;
#define AT_LOAD(t, buf) do { \
        __builtin_amdgcn_global_load_lds((const unsigned*)(ksrc + (size_t)(t) * 64 * 512), (LAS unsigned*)(lds + (buf) * AT_BUF + wid * 1024), 16, 0, 0); \
        __builtin_amdgcn_global_load_lds((const unsigned*)(psrc + (size_t)(t) * 64 * 32), (LAS unsigned*)(lds + (buf) * AT_BUF + (8 + (wid & 3)) * 1024), 16, 0, 0);   \
        __builtin_amdgcn_global_load_lds((const unsigned*)(vsrc + (size_t)(t) * 64 * 512), (LAS unsigned*)(lds + (buf) * AT_BUF + AT_KB + wid * 1024), 16, 0, 0); } while (0)
#define AT_RAWBAR() do { asm volatile("s_waitcnt lgkmcnt(0)" ::: "memory"); __builtin_amdgcn_s_barrier(); asm volatile("" ::: "memory"); } while (0)
    bf16x8 qr[2][6];
    { const bf16_t* Qw = p.q + (rowbase + q0 + wid * 64 + r32) * 768 + h * 96 + hi * 8;
#pragma unroll
      for (int bl = 0; bl < 2; ++bl)
#pragma unroll
        for (int d0 = 0; d0 < 6; ++d0) qr[bl][d0] = *(const bf16x8*)(Qw + (size_t)bl * 32 * 768 + d0 * 16);
      AT_LOAD(0, 0); AT_LOAD(1, 1); AT_LOAD(2, 2);
#pragma unroll
      for (int bl = 0; bl < 2; ++bl)
#pragma unroll
        for (int d0 = 0; d0 < 6; ++d0) asm volatile("" : "+v"(qr[bl][d0])); }
    LAS float* wsf = (LAS float*)(lds + AT_WS) + wid * 64;
    float mhat[2] = {0.f, 0.f}, lsum[2] = {0.f, 0.f};
    f32x16 o[2][2];
#pragma unroll
    for (int r = 0; r < 16; ++r) { o[0][0][r] = 0.f; o[0][1][r] = 0.f; o[1][0][r] = 0.f; o[1][1][r] = 0.f; }
    const int koff = hi * 1024 + r32 * 16;
    const int voff = AT_KB + ((lane >> 4) & 1) * 32 + (lane & 3) * 8 + (4 * hi + ((lane & 15) >> 2)) * 64;
    for (int t = 0; t < NT; ++t) {
        if (t + 2 < NT) asm volatile("s_waitcnt vmcnt(6)" ::: "memory"); else if (t + 1 < NT) asm volatile("s_waitcnt vmcnt(3)" ::: "memory"); else asm volatile("s_waitcnt vmcnt(0)" ::: "memory");
        AT_RAWBAR();
        if (t + 3 < NT) AT_LOAD(t + 3, (t + 3) & 3);
        const int jb = t - (NT - 8);
        const bool sk0 = jb >= 0 && 64 * jb > wid * 64 + 31, sk1 = jb >= 0 && 64 * jb > wid * 64 + 63;
        if (sk1) continue;
        const LAS unsigned char* kb = lds + (t & 3) * AT_BUF + koff;
        const LAS unsigned char* vb = lds + (t & 3) * AT_BUF + voff;
        f32x16 p00, p01, p10, p11;
#pragma unroll
        for (int d0 = 0; d0 < 6; ++d0) {
            const bf16x8 k0 = *(const LAS bf16x8*)(kb + d0 * 2048), k1 = *(const LAS bf16x8*)(kb + d0 * 2048 + 512);
            if (d0 == 0) {
                p10 = __builtin_amdgcn_mfma_f32_32x32x16_bf16(k0, qr[1][0], (f32x16){0.f, 0.f, 0.f, 0.f, 0.f, 0.f, 0.f, 0.f, 0.f, 0.f, 0.f, 0.f, 0.f, 0.f, 0.f, 0.f}, 0, 0, 0);
                p11 = __builtin_amdgcn_mfma_f32_32x32x16_bf16(k1, qr[1][0], (f32x16){0.f, 0.f, 0.f, 0.f, 0.f, 0.f, 0.f, 0.f, 0.f, 0.f, 0.f, 0.f, 0.f, 0.f, 0.f, 0.f}, 0, 0, 0);
                if (!sk0) { p00 = __builtin_amdgcn_mfma_f32_32x32x16_bf16(k0, qr[0][0], (f32x16){0.f, 0.f, 0.f, 0.f, 0.f, 0.f, 0.f, 0.f, 0.f, 0.f, 0.f, 0.f, 0.f, 0.f, 0.f, 0.f}, 0, 0, 0);
                            p01 = __builtin_amdgcn_mfma_f32_32x32x16_bf16(k1, qr[0][0], (f32x16){0.f, 0.f, 0.f, 0.f, 0.f, 0.f, 0.f, 0.f, 0.f, 0.f, 0.f, 0.f, 0.f, 0.f, 0.f, 0.f}, 0, 0, 0); }
            } else {
                p10 = __builtin_amdgcn_mfma_f32_32x32x16_bf16(k0, qr[1][d0], p10, 0, 0, 0); p11 = __builtin_amdgcn_mfma_f32_32x32x16_bf16(k1, qr[1][d0], p11, 0, 0, 0);
                if (!sk0) { p00 = __builtin_amdgcn_mfma_f32_32x32x16_bf16(k0, qr[0][d0], p00, 0, 0, 0); p01 = __builtin_amdgcn_mfma_f32_32x32x16_bf16(k1, qr[0][d0], p01, 0, 0, 0); }
            }
        }
        u32x4 pw[2][4];
#define AT_SOFTMAX(bl, P0, P1) do { \
            if (jb >= 0) { const int kbase = 64 * jb + 4 * hi; const int qrel = wid * 64 + (bl) * 32 + r32; \
                _Pragma("unroll") for (int r = 0; r < 16; ++r) { const int kv = kbase + (r & 3) + 8 * (r >> 2); if (kv > qrel) P0[r] = -INFINITY; if (kv + 32 > qrel) P1[r] = -INFINITY; } } \
            float mx; { float a_ = __builtin_fmaxf(__builtin_fmaxf(P0[0], P0[1]), P1[0]), c_ = __builtin_fmaxf(__builtin_fmaxf(P0[2], P0[3]), P1[1]); a_ = __builtin_fmaxf(__builtin_fmaxf(a_, P1[2]), P1[3]); \
                _Pragma("unroll") for (int r = 4; r < 16; r += 4) { a_ = __builtin_fmaxf(__builtin_fmaxf(a_, P0[r]), P0[r + 1]); c_ = __builtin_fmaxf(__builtin_fmaxf(c_, P0[r + 2]), P0[r + 3]); a_ = __builtin_fmaxf(__builtin_fmaxf(a_, P1[r]), P1[r + 1]); c_ = __builtin_fmaxf(__builtin_fmaxf(c_, P1[r + 2]), P1[r + 3]); } \
                mx = __builtin_fmaxf(a_, c_); } \
            { auto rr_ = __builtin_amdgcn_permlane32_swap(__float_as_uint(mx), __float_as_uint(mx), false, false); mx = fmaxf(__uint_as_float(rr_[0]), __uint_as_float(rr_[1])); } \
            const bool need_ = (t == 0) || (mx > mhat[bl] + AT_THR); \
            if (__any(need_)) { const float mnew_ = need_ ? mx : mhat[bl]; const float dl_ = mhat[bl] - mnew_; mhat[bl] = mnew_; \
                if (t > 0) { const float alpha_ = __builtin_amdgcn_exp2f(dl_); lsum[bl] *= alpha_; if (hi == 0) wsf[r32] = alpha_; asm volatile("s_waitcnt lgkmcnt(0)" ::: "memory"); \
                    _Pragma("unroll") for (int r = 0; r < 16; ++r) { const float a_ = wsf[crow(r, hi)]; o[bl][0][r] *= a_; o[bl][1][r] *= a_; } } } \
            f32x2_t sa_ = {0.f, 0.f}, sb_ = {0.f, 0.f}; const float mh_ = mhat[bl]; \
            _Pragma("unroll") for (int r = 0; r < 16; r += 2) { P0[r] = __builtin_amdgcn_exp2f(P0[r] - mh_); P0[r + 1] = __builtin_amdgcn_exp2f(P0[r + 1] - mh_); P1[r] = __builtin_amdgcn_exp2f(P1[r] - mh_); P1[r + 1] = __builtin_amdgcn_exp2f(P1[r + 1] - mh_); \
                sa_ += (f32x2_t){P0[r], P0[r + 1]}; sb_ += (f32x2_t){P1[r], P1[r + 1]}; } \
            lsum[bl] += (sa_[0] + sa_[1]) + (sb_[0] + sb_[1]); \
            _Pragma("unroll") for (int j = 0; j < 4; ++j) { pw[bl][0][j] = cvtpk(P0[2 * j], P0[2 * j + 1]); pw[bl][1][j] = cvtpk(P0[8 + 2 * j], P0[8 + 2 * j + 1]); pw[bl][2][j] = cvtpk(P1[2 * j], P1[2 * j + 1]); pw[bl][3][j] = cvtpk(P1[8 + 2 * j], P1[8 + 2 * j + 1]); } } while (0)
        AT_SOFTMAX(1, p10, p11);
        if (!sk0) AT_SOFTMAX(0, p00, p01);
#pragma unroll
        for (int d0 = 0; d0 < 2; ++d0)
#pragma unroll
            for (int ks = 0; ks < 4; ++ks) {
                const s16x4 lo = vtr(vb + d0 * 4096 + ks * 1024), hi4 = vtr(vb + d0 * 4096 + ks * 1024 + 512);
                const bf16x8 vf = (bf16x8){lo[0], lo[1], lo[2], lo[3], hi4[0], hi4[1], hi4[2], hi4[3]};
                o[1][d0] = __builtin_amdgcn_mfma_f32_32x32x16_bf16(__builtin_bit_cast(bf16x8, pw[1][ks]), vf, o[1][d0], 0, 0, 0);
                if (!sk0) o[0][d0] = __builtin_amdgcn_mfma_f32_32x32x16_bf16(__builtin_bit_cast(bf16x8, pw[0][ks]), vf, o[0][d0], 0, 0, 0);
            }
    }
#undef AT_LOAD
#undef AT_SOFTMAX
    LAS bf16_t* stg = (LAS bf16_t*)(lds + AT_OST) + wid * 2048;
#pragma unroll
    for (int bl = 0; bl < 2; ++bl) {
        float ls = lsum[bl];
        { auto rr = __builtin_amdgcn_permlane32_swap(__float_as_uint(ls), __float_as_uint(ls), false, false); ls = __uint_as_float(rr[0]) + __uint_as_float(rr[1]); }
        if (hi == 0) wsf[32 + r32] = ls;
        asm volatile("s_waitcnt lgkmcnt(0)" ::: "memory");
#pragma unroll
        for (int r = 0; r < 16; ++r) {
            const int orow = crow(r, hi); const float rl = __builtin_amdgcn_rcpf(wsf[32 + orow]);
            stg[orow * 64 + r32] = f2bf(o[bl][0][r] * rl); stg[orow * 64 + 32 + r32] = f2bf(o[bl][1][r] * rl);
        }
        asm volatile("s_waitcnt lgkmcnt(0)" ::: "memory");
        bf16_t* Ow = p.mix + (rowbase + q0 + wid * 64 + bl * 32) * D + h * 64;
#pragma unroll
        for (int i = 0; i < 4; ++i) { const int row = i * 8 + (lane >> 3), ch = lane & 7; const u32x4 v = *(const LAS u32x4*)(stg + row * 64 + ch * 8); *(u32x4*)(Ow + (size_t)row * D + ch * 8) = v; }
        asm volatile("s_waitcnt lgkmcnt(0)" ::: "memory");
    }
    AT_RAWBAR();
#undef AT_RAWBAR
}
DI void ph_attn(const P& p, LAS unsigned char* lds) {
    const int G = gridDim.x, bx = blockIdx.x;
    const int vcu = (G % 8 == 0) ? (bx % 8) * (G / 8) + bx / 8 : bx;
#pragma unroll 1
    for (int u = vcu * 4; u < 1024; u += ((u & 3) == 3) ? (G * 4 - 3) : 1) {
        const int grp = u >> 2, i = u & 3;
        const int bh = grp >> 1, par = grp & 1;
        const int s = 2 * (i >> 1) + par;
        const int qb = (i & 1) ? 7 - s : s;
        attn_unit(p, lds, bh >> 3, bh & 7, qb, tid_());
    }
}

constexpr int GZ_QD = 0, GZ_KD = 64 * GL_QS * 2, GZ_V = 2 * GZ_KD, GZ_S = GZ_V + 64 * GL_VS * 2, GZ_BUF = GZ_S + 64 * GL_VS * 2, GZ_PART = 2 * GZ_BUF, GZ_END = GZ_PART + 2 * 8 * 64 * 4;
static_assert(GZ_END <= 147200, "GLA LDS map");
DI void ph_gla_out(const P& p, LAS unsigned char* lds, int tid) {
    const int lane = tid & 63, w = __builtin_amdgcn_readfirstlane(tid >> 6), l15 = lane & 15, g = lane >> 4, tq = l15 >> 2, tp = l15 & 3;
    const int G = gridDim.x, bx = blockIdx.x, NIT = (NTOK / 64) * 4;
    u32x4 rqd, rkd, rvv[2], rss[2];
#define GZ_LOAD(it_) do { const int h_ = (it_) & 3; const size_t row0_ = (size_t)((it_) >> 2) * 64; \
        const size_t o_ = (row0_ + (tid >> 3)) * 256 + h_ * 64 + (tid & 7) * 8; rqd = *(const u32x4*)(p.gqd + o_); rkd = *(const u32x4*)(p.gkd + o_); \
        _Pragma("unroll") for (int i_ = 0; i_ < 2; ++i_) { const int c_ = i_ * 512 + tid; rvv[i_] = *(const u32x4*)(p.proj + (row0_ + (c_ >> 4)) * LD1 + 1536 + h_ * 128 + (c_ & 15) * 8); \
            rss[i_] = *(const u32x4*)(p.gst + ((size_t)(it_) * 64 + (c_ >> 4)) * 128 + (c_ & 15) * 8); } } while (0)
#define GZ_STAGE(buf) do { LAS unsigned char* B_ = lds + (buf) * GZ_BUF; const int o_ = ((tid >> 3) * GL_QS + (tid & 7) * 8) * 2; \
        *(LAS u32x4*)(B_ + GZ_QD + o_) = rqd; *(LAS u32x4*)(B_ + GZ_KD + o_) = rkd; \
        _Pragma("unroll") for (int i_ = 0; i_ < 2; ++i_) { const int c_ = i_ * 512 + tid; const int vo_ = ((c_ >> 4) * GL_VS + (c_ & 15) * 8) * 2; *(LAS u32x4*)(B_ + GZ_V + vo_) = rvv[i_]; *(LAS u32x4*)(B_ + GZ_S + vo_) = rss[i_]; } } while (0)
#define GZ_BAR() do { asm volatile("s_waitcnt lgkmcnt(0)" ::: "memory"); __builtin_amdgcn_s_barrier(); asm volatile("" ::: "memory"); } while (0)
    if (bx < NIT) { GZ_LOAD(bx); GZ_STAGE(0); if (bx + G < NIT) GZ_LOAD(bx + G); }
    int k = 0;
    for (int it = bx; it < NIT; it += G, ++k) {
        const int h = it & 3; const size_t row0 = (size_t)(it >> 2) * 64;
        GZ_BAR();
        if (it + G < NIT) { GZ_STAGE((k + 1) & 1); if (it + 2 * G < NIT) GZ_LOAD(it + 2 * G); }
        const LAS unsigned char* B_ = lds + (k & 1) * GZ_BUF;
        u32x2 grv[4];
#pragma unroll
        for (int tt = 0; tt < 4; ++tt) grv[tt] = *(const u32x2*)(p.proj + (row0 + 16 * tt + l15) * LD1 + 2304 + h * 128 + 16 * w + 4 * g);
        const f32x4 gng = *(const f32x4*)(p.gla_norm_g + h * 128 + 16 * w + 4 * g);
        bf16x8 kdA[4][2];
#pragma unroll
        for (int st = 0; st < 4; ++st)
#pragma unroll
            for (int ks = 0; ks < 2; ++ks) kdA[st][ks] = *(const LAS bf16x8*)(B_ + GZ_KD + ((16 * st + l15) * GL_QS + 32 * ks + 8 * g) * 2);
        bf16x8 vP[2], sA[2];
#pragma unroll
        for (int ks = 0; ks < 2; ++ks) {
            { const s16x4 lo = vtr(B_ + GZ_V + ((32 * ks + 4 * g + tq) * GL_VS + 16 * w + 4 * tp) * 2), hi4 = vtr(B_ + GZ_V + ((32 * ks + 16 + 4 * g + tq) * GL_VS + 16 * w + 4 * tp) * 2);
              vP[ks] = (bf16x8){lo[0], lo[1], lo[2], lo[3], hi4[0], hi4[1], hi4[2], hi4[3]}; }
            { const s16x4 lo = vtr(B_ + GZ_S + ((32 * ks + 8 * g + tq) * GL_VS + 16 * w + 4 * tp) * 2), hi4 = vtr(B_ + GZ_S + ((32 * ks + 8 * g + 4 + tq) * GL_VS + 16 * w + 4 * tp) * 2);
              sA[ks] = (bf16x8){lo[0], lo[1], lo[2], lo[3], hi4[0], hi4[1], hi4[2], hi4[3]}; }
        }
        f32x4 otile[4];
        LAS float* PW = (LAS float*)(lds + GZ_PART) + (k & 1) * 512 + w * 64;
#pragma unroll
        for (int tt = 0; tt < 4; ++tt) {
            bf16x8 qdB[2];
#pragma unroll
            for (int ks = 0; ks < 2; ++ks) qdB[ks] = *(const LAS bf16x8*)(B_ + GZ_QD + ((16 * tt + l15) * GL_QS + 32 * ks + 8 * g) * 2);
            f32x4 at[4];
#pragma unroll
            for (int st = 0; st < 4; ++st) {
                at[st] = (f32x4){0.f, 0.f, 0.f, 0.f};
                if (st <= tt) { at[st] = __builtin_amdgcn_mfma_f32_16x16x32_bf16(kdA[st][0], qdB[0], at[st], 0, 0, 0); at[st] = __builtin_amdgcn_mfma_f32_16x16x32_bf16(kdA[st][1], qdB[1], at[st], 0, 0, 0); }
            }
#pragma unroll
            for (int j = 0; j < 4; ++j) if (4 * g + j > l15) at[tt][j] = 0.f;
            f32x4 ot = (f32x4){0.f, 0.f, 0.f, 0.f};
            ot = __builtin_amdgcn_mfma_f32_16x16x32_bf16(sA[0], qdB[0], ot, 0, 0, 0);
            ot = __builtin_amdgcn_mfma_f32_16x16x32_bf16(sA[1], qdB[1], ot, 0, 0, 0);
            { u32x4 ab; ab.x = pk2(at[0][0], at[0][1]); ab.y = pk2(at[0][2], at[0][3]); ab.z = pk2(at[1][0], at[1][1]); ab.w = pk2(at[1][2], at[1][3]);
              ot = __builtin_amdgcn_mfma_f32_16x16x32_bf16(vP[0], __builtin_bit_cast(bf16x8, ab), ot, 0, 0, 0); }
            if (tt >= 2) { u32x4 ab; ab.x = pk2(at[2][0], at[2][1]); ab.y = pk2(at[2][2], at[2][3]); ab.z = pk2(at[3][0], at[3][1]); ab.w = pk2(at[3][2], at[3][3]);
              ot = __builtin_amdgcn_mfma_f32_16x16x32_bf16(vP[1], __builtin_bit_cast(bf16x8, ab), ot, 0, 0, 0); }
            otile[tt] = ot;
            float ss = ot[0] * ot[0] + ot[1] * ot[1] + ot[2] * ot[2] + ot[3] * ot[3];
            ss += __shfl_xor(ss, 16); ss += __shfl_xor(ss, 32);
            if (g == 0) PW[16 * tt + l15] = ss;
        }
        GZ_BAR();
        const LAS float* PT = (const LAS float*)(lds + GZ_PART) + (k & 1) * 512;
#pragma unroll
        for (int tt = 0; tt < 4; ++tt) {
            float ss = 0.f;
#pragma unroll
            for (int ww = 0; ww < 8; ++ww) ss += PT[ww * 64 + 16 * tt + l15];
            const float r = rsqrtf(ss * (1.f / 128.f) + EPS);
            const float g0 = __uint_as_float(grv[tt].x << 16), g1 = __uint_as_float(grv[tt].x & 0xffff0000u), g2 = __uint_as_float(grv[tt].y << 16), g3 = __uint_as_float(grv[tt].y & 0xffff0000u);
            u32x2 o2; o2.x = pk2(silu_f(g0) * (otile[tt][0] * r * gng[0]), silu_f(g1) * (otile[tt][1] * r * gng[1]));
            o2.y = pk2(silu_f(g2) * (otile[tt][2] * r * gng[2]), silu_f(g3) * (otile[tt][3] * r * gng[3]));
            *(u32x2*)(p.mix + (row0 + 16 * tt + l15) * D + 512 + h * 128 + 16 * w + 4 * g) = o2;
        }
    }
    GZ_BAR();
#undef GZ_LOAD
#undef GZ_STAGE
#undef GZ_BAR
}
constexpr int SG_WS = 136, SG_VS = 144, SG_OS = 132;
constexpr int SG_W = 0, SG_V = 128 * SG_WS * 2, SG_O = SG_V + 128 * SG_VS * 2, SG_END = SG_O + 128 * SG_OS * 4;
static_assert(SG_END <= 147200, "gMLP LDS map");
DI void ph_sg(const P& p, LAS unsigned char* lds) {
    const int tid = tid_();
    const int G = gridDim.x, bx = blockIdx.x;
    const int nG = 0;
#define MIXREP_SG 1
    const int lane = tid & 63, w = __builtin_amdgcn_readfirstlane(tid >> 6), l15 = lane & 15, gq = lane >> 4, tq = l15 >> 2, tp = l15 & 3;
    int cur_g = -1;
    u32x4 rawv[4], uu[4]; float rvs[4];
#define SG_LOADV(u_) do { const int g_ = (u_) >> 9; const size_t r0_ = (size_t)((u_) & 511) * 128; \
        _Pragma("unroll") for (int it = 0; it < 4; ++it) { const int c = it * 512 + tid, s_ = c >> 4, ch = c & 15; rawv[it] = *(const u32x4*)(p.proj + (r0_ + s_) * LD1 + 512 + g_ * 128 + ch * 8); rvs[it] = p.rv[r0_ + s_]; } } while (0)
#define SG_RAWBAR() do { asm volatile("s_waitcnt lgkmcnt(0)" ::: "memory"); __builtin_amdgcn_s_barrier(); asm volatile("" ::: "memory"); } while (0)
    const int u0 = bx - nG, ustep = G - nG;
    for (int rep = 0; rep < MIXREP_SG; ++rep) {
    if (u0 < 2048) SG_LOADV(u0);
    for (int u = u0; u < 2048; u += ustep) {
        const int g = u >> 9, bn = u & 511; const size_t r0 = (size_t)bn * 128;
        if (g != cur_g) {
            cur_g = g;
#pragma unroll
            for (int it = 0; it < 4; ++it) { const int c = it * 512 + tid, t = c >> 4, ch = c & 15; const float* src = p.sg_w_s + ((size_t)g * 128 + t) * 128 + ch * 8;
                const f32x4 a = *(const f32x4*)src, b = *(const f32x4*)(src + 4); float v[8] = {a[0], a[1], a[2], a[3], b[0], b[1], b[2], b[3]};
#pragma unroll
                for (int e = 0; e < 8; ++e) if (ch * 8 + e > t) v[e] = 0.f;
                u32x4 wv; wv.x = pk2(v[0], v[1]); wv.y = pk2(v[2], v[3]); wv.z = pk2(v[4], v[5]); wv.w = pk2(v[6], v[7]);
                *(LAS u32x4*)(lds + SG_W + (t * SG_WS + ch * 8) * 2) = wv; }
        }
#pragma unroll
        for (int it = 0; it < 4; ++it) { const int c = it * 512 + tid, s_ = c >> 4, ch = c & 15; const u32x4 raw = rawv[it]; const float rv = rvs[it];
            u32x4 wv; wv.x = pk2(__uint_as_float(raw.x << 16) * rv, __uint_as_float(raw.x & 0xffff0000u) * rv); wv.y = pk2(__uint_as_float(raw.y << 16) * rv, __uint_as_float(raw.y & 0xffff0000u) * rv);
            wv.z = pk2(__uint_as_float(raw.z << 16) * rv, __uint_as_float(raw.z & 0xffff0000u) * rv); wv.w = pk2(__uint_as_float(raw.w << 16) * rv, __uint_as_float(raw.w & 0xffff0000u) * rv);
            *(LAS u32x4*)(lds + SG_V + (s_ * SG_VS + ch * 8) * 2) = wv; }
        SG_RAWBAR();
#pragma unroll
        for (int it = 0; it < 4; ++it) { const int c = it * 512 + tid; uu[it] = *(const u32x4*)(p.proj + (r0 + (c >> 4)) * LD1 + g * 128 + (c & 15) * 8); }
        if (u + ustep < 2048) SG_LOADV(u + ustep);
        bf16x8 vA[4];
#pragma unroll
        for (int ks = 0; ks < 4; ++ks) {
            const s16x4 lo = vtr(lds + SG_V + ((32 * ks + 8 * gq + tq) * SG_VS + 16 * w + 4 * tp) * 2), hi4 = vtr(lds + SG_V + ((32 * ks + 8 * gq + 4 + tq) * SG_VS + 16 * w + 4 * tp) * 2);
            vA[ks] = (bf16x8){lo[0], lo[1], lo[2], lo[3], hi4[0], hi4[1], hi4[2], hi4[3]};
        }
#pragma unroll
        for (int tt = 0; tt < 8; ++tt) {
            f32x4 acc = (f32x4){0.f, 0.f, 0.f, 0.f};
#pragma unroll
            for (int ks = 0; ks <= tt / 2; ++ks) {
                const bf16x8 wB = *(const LAS bf16x8*)(lds + SG_W + ((16 * tt + l15) * SG_WS + 32 * ks + 8 * gq) * 2);
                acc = __builtin_amdgcn_mfma_f32_16x16x32_bf16(vA[ks], wB, acc, 0, 0, 0);
            }
            *(LAS f32x4*)(lds + SG_O + ((16 * tt + l15) * SG_OS + 16 * w + 4 * gq) * 4) = acc;
        }
        SG_RAWBAR();
#pragma unroll
        for (int it = 0; it < 4; ++it) { const int c = it * 512 + tid, t = c >> 4, ch = c & 15;
            const f32x4 a = *(const LAS f32x4*)(lds + SG_O + (t * SG_OS + ch * 8) * 4), b = *(const LAS f32x4*)(lds + SG_O + (t * SG_OS + ch * 8 + 4) * 4);
            const f32x4 ga = *(const f32x4*)(p.sg_v_norm_g + g * 128 + ch * 8), gb = *(const f32x4*)(p.sg_v_norm_g + g * 128 + ch * 8 + 4);
            const float bs = p.sg_b_s[g * 128 + t];
            const u32x4 ux = uu[it];
            u32x4 o;
            o.x = pk2(__uint_as_float(ux.x << 16) * (a[0] * ga[0] + bs), __uint_as_float(ux.x & 0xffff0000u) * (a[1] * ga[1] + bs));
            o.y = pk2(__uint_as_float(ux.y << 16) * (a[2] * ga[2] + bs), __uint_as_float(ux.y & 0xffff0000u) * (a[3] * ga[3] + bs));
            o.z = pk2(__uint_as_float(ux.z << 16) * (b[0] * gb[0] + bs), __uint_as_float(ux.z & 0xffff0000u) * (b[1] * gb[1] + bs));
            o.w = pk2(__uint_as_float(ux.w << 16) * (b[2] * gb[2] + bs), __uint_as_float(ux.w & 0xffff0000u) * (b[3] * gb[3] + bs));
            *(u32x4*)(p.mix + (r0 + t) * D + g * 128 + ch * 8) = o; }
    }
    SG_RAWBAR();
    }
#undef SG_LOADV
#undef SG_RAWBAR
    __syncthreads();
}

enum { PH_PREP = 0, PH_NORM0, PH_IN0, PH_STAT0, PH_UP0, PH_ATTN, PH_OUT0,
       PH_MOE0  , PH_IN1 = PH_MOE0 + 6, PH_STAT1, PH_SCAN, PH_MIX1, PH_OUT1, PH_MOE1, PH_END = PH_MOE1 + 6 };

typedef __attribute__((address_space(4))) const P* KP;
#if defined(__HIP_DEVICE_COMPILE__)
#define LOADP() ({ KP k_ = kp; asm volatile("" : "+s"(k_)); *k_; })
#else
#define LOADP() (P{})
#endif
__global__ void __launch_bounds__(NTHR, 2) mega(P p_unused, int lo, int hi) {
    (void)p_unused;
    const KP kp = (KP)__builtin_amdgcn_kernarg_segment_ptr();
    extern __shared__ __attribute__((aligned(16))) unsigned char lds_raw[];
    LAS unsigned char* lds = (LAS unsigned char*)lds_raw;
    volatile LAS unsigned* misc = (volatile LAS unsigned*)(lds + LDS_MISC);
    { const int t0 = tid_(); if (t0 < 64) misc[t0] = 0u; }
    __syncthreads();
    XcdBarrier bar; { const P p = LOADP(); bar.bar = p.bar; } bar.x = 0; bar.st = misc + 8;
    if (hi - lo > 1) bar = xcd_barrier_post(bar.bar, misc + 8);
#define IN(k) (lo <= (k) && (k) < hi)
#define SEAM(k) do { if (IN(k) && IN((k) + 1)) xcd_barrier(bar); } while (0)
    const int G = gridDim.x, bx = blockIdx.x;
#ifndef XPROBE
#define XPROBE 0
#endif
#ifndef DUPMASK
#define DUPMASK 0u
#endif
#define PHASE(k, ...) do { if (IN(k)) { __VA_ARGS__ } if (((DUPMASK >> (k)) & 1u) && IN(k)) { xcd_barrier(bar); __VA_ARGS__ } SEAM(k); } while (0)
    PHASE(PH_PREP, const P p = LOADP(); ph_prep(p, lds););
    PHASE(PH_NORM0, const P p = LOADP(); ph_norm<true>(p, p.x, p.norm_mix_g, 0, 0););
    PHASE(PH_IN0,
        const P p = LOADP();
        g8::Order S; S.init(NTOK / 256, LD0 / 256, G, bx);
        SrcDense X{(unsigned)(D * 2), (const char*)p.wt_in0, (size_t)256 * 1024 * 2};
        g8::Epi<FIn0> E{{p}};
        g8::gemm8(lds, (const char*)p.xa, 1024, S, X, E););
    PHASE(PH_STAT0, const P p = LOADP(); ph_rowstat0_conv(p););
    PHASE(PH_UP0,
        const P p = LOADP();
        { g8::Order S; S.init(NTOK / 256, 3, G, bx);
          SrcDense X{(unsigned)(LD0 * 2), (const char*)p.wt_uq, (size_t)256 * 256 * 2};
          g8::Epi<FUq> E{{p}};
          g8::gemm8(lds, (const char*)p.proj, 256, S, X, E); }
        { g8::Order S; S.init(NTOK / 256, 4, G, bx);
          SrcDense X{(unsigned)(LD0 * 2), (const char*)p.wt_ukv, (size_t)256 * 128 * 2};
          g8::Epi<FUkv> E{{p}};
          g8::gemm8(lds, (const char*)(p.proj + 256), 128, S, X, E); });
    PHASE(PH_ATTN, const P p = LOADP(); ph_attn(p, lds););
    PHASE(PH_OUT0,
        const P p = LOADP();
        g8::Order S; S.init(NTOK / 256, 4, G, bx);
        SrcDense X{(unsigned)(D * 2), (const char*)p.wt_out0, (size_t)256 * 1024 * 2};
        g8::Epi<FOut> E{{p, 0}};
        g8::gemm8(lds, (const char*)p.mix, 1024, S, X, E);
        if (XPROBE == 3) { xcd_barrier(bar); g8::Epi<FNull> E2{{}}; g8::gemm8(lds, (const char*)p.mix, 1024, S, X, E2); });
#define MOE_PHASES(l, base) do { \
        PHASE((base) + 0, const P p = LOADP(); ph_norm<false>(p, p.xr, p.norm_ffn_g + (l) * D, (l), 1);); \
        PHASE((base) + 1, const P p = LOADP(); ph_router(p, (l), lds);); \
        PHASE((base) + 2, const P p = LOADP(); ph_slots(p, (l), lds);); \
        PHASE((base) + 3, \
            const P p = LOADP(); \
            g8::Order S; S.init(p.ntile[(l)], 4, G, bx, 1); \
            SrcGu X{(unsigned)(D * 2), p.row_tok + (size_t)(l) * MAXSLOT, p.tile_e + (l) * 1024, (const char*)(p.wt_gu + (size_t)(l) * 32 * 512 * 1024)}; \
            g8::Epi<FGu> E{{p, p.row_w + 2 * (size_t)(l) * MAXSLOT}}; \
            g8::gemm8(lds, (const char*)p.xa, 1024, S, X, E);); \
        PHASE((base) + 4, \
            const P p = LOADP(); \
            g8::Order S; S.init(p.ntile[(l)], 4, G, bx, 1); \
            SrcDn X{(unsigned)(512 * 2), p.tile_e + (l) * 1024, (const char*)(p.wt_dn + (size_t)(l) * 32 * 1024 * 256)}; \
            g8::Epi<FDn> E{{p}}; \
            g8::gemm8(lds, (const char*)p.act, 512, S, X, E);); \
        PHASE((base) + 5, const P p = LOADP(); ph_postnorm(p, (l), (l) == 1);); \
    } while (0)
    MOE_PHASES(0, PH_MOE0);
    PHASE(PH_IN1,
        const P p = LOADP();
        g8::Order S; S.init(NTOK / 256, LD1 / 256, G, bx);
        SrcDense X{(unsigned)(D * 2), (const char*)p.wt_in1, (size_t)256 * 1024 * 2};
        g8::Epi<FIn1> E{{p}};
        g8::gemm8(lds, (const char*)p.xa, 1024, S, X, E););
    PHASE(PH_STAT1, const P p = LOADP(); ph_stat1x(p, lds););
    PHASE(PH_SCAN, const P p = LOADP(); ph_gla_scan(p); ph_sg(p, lds););
    PHASE(PH_MIX1, const P p = LOADP(); ph_gla_out(p, lds, tid_()););
    PHASE(PH_OUT1,
        const P p = LOADP();
        g8::Order S; S.init(NTOK / 256, 4, G, bx);
        SrcDense X{(unsigned)(D * 2), (const char*)p.wt_out1, (size_t)256 * 1024 * 2};
        g8::Epi<FOut> E{{p, 1}};
        g8::gemm8(lds, (const char*)p.mix, 1024, S, X, E););
    MOE_PHASES(1, PH_MOE1);
#undef MOE_PHASES
#undef PHASE
#undef IN
#undef SEAM
}

static size_t carve(size_t& off, size_t bytes) { const size_t o = off; off += (bytes + 255) & ~(size_t)255; return o; }

extern "C" void kernel_launch(void* const* d_in, const int* in_sizes, int n_in, void* d_out, int out_size, void* d_ws, size_t ws_size, hipStream_t stream) {
    (void)in_sizes; (void)n_in; (void)out_size;
    P p{};
    const float* const* fi = (const float* const*)d_in;
    p.x = fi[0]; p.c = fi[1]; p.pos = (const int*)d_in[2];
    p.adaln_w = fi[3]; p.adaln_b = fi[4]; p.norm_mix_g = fi[5]; p.norm_ffn_g = fi[6]; p.ab_w_in = fi[7]; p.q_norm_g = fi[8]; p.w_uq = fi[9];
    p.kv_norm_g = fi[10]; p.w_ukv = fi[11]; p.conv_w = fi[12]; p.ab_w_out = fi[13]; p.cd_w_in = fi[14]; p.sg_v_norm_g = fi[15]; p.sg_w_s = fi[16];
    p.sg_b_s = fi[17]; p.gla_w_g2 = fi[18]; p.gla_b_g = fi[19]; p.gla_norm_g = fi[20]; p.cd_w_out = fi[21]; p.moe_w_group = fi[22]; p.moe_b_group = fi[23];
    p.moe_w_expert = fi[24]; p.moe_b_expert = fi[25]; p.moe_w_gate_up = fi[26]; p.moe_w_down = fi[27]; p.final_norm_g = fi[28];
    p.out = (float*)d_out;
    char* ws = (char*)d_ws; size_t off = 0;
    const size_t ctl0 = off;
    p.bar = (unsigned*)(ws + carve(off, (size_t)XCD_BAR_WORDS * 4));
    p.row_tok = (int*)(ws + carve(off, (size_t)2 * MAXSLOT * 4));
    p.row_w = (float*)(ws + carve(off, (size_t)2 * MAXSLOT * 2 * 4));
    const size_t ctl_bytes = off - ctl0;
    p.whist = (int*)(ws + carve(off, (size_t)2 * 256 * 128 * 4));
    p.ntile = (int*)(ws + carve(off, 256));
    p.tile_e = (int*)(ws + carve(off, 2 * 1024 * 4));
    p.tope = (int*)(ws + carve(off, (size_t)4 * NTOK * 4));
    p.toppos = (int*)(ws + carve(off, (size_t)4 * NTOK * 4));
    p.topslot = (int*)(ws + carve(off, (size_t)4 * NTOK * 4));
    p.topw = (float*)(ws + carve(off, (size_t)4 * NTOK * 4));
    p.mod = (float*)(ws + carve(off, (size_t)2 * 16 * 6144 * 4));
    p.ropec = (float*)(ws + carve(off, (size_t)NTOK * 16 * 4));
    p.ropes = (float*)(ws + carve(off, (size_t)NTOK * 16 * 4));
    p.rq = (float*)(ws + carve(off, (size_t)NTOK * 4));
    p.rkv = (float*)(ws + carve(off, (size_t)NTOK * 4));
    p.rv = (float*)(ws + carve(off, (size_t)NTOK * 4));
    p.wt_in0 = (bf16_t*)(ws + carve(off, WO_END * 2));
    p.wt_uq = p.wt_in0 + WO_UQ; p.wt_ukv = p.wt_in0 + WO_UKV; p.wt_out0 = p.wt_in0 + WO_OUT0; p.wt_in1 = p.wt_in0 + WO_IN1; p.wt_out1 = p.wt_in0 + WO_OUT1;
    p.wt_gu = p.wt_in0 + WO_GU; p.wt_dn = p.wt_in0 + WO_DN; p.wt_r = p.wt_in0 + WO_R;
    p.xa = (bf16_t*)(ws + carve(off, (size_t)NTOK * D * 2));
    p.mix = (bf16_t*)(ws + carve(off, (size_t)NTOK * D * 2));
    p.xr = (bf16_t*)(ws + carve(off, (size_t)NTOK * D * 2));
    const size_t r0 = off;
    p.proj = (bf16_t*)(ws + carve(off, (size_t)NTOK * LD1 * 2));
    size_t o2 = r0 + (((size_t)NTOK * LD0 * 2 + 255) & ~(size_t)255);
    p.q = (bf16_t*)(ws + carve(o2, (size_t)NTOK * 768 * 2));
    p.kn = (bf16_t*)(ws + carve(o2, (size_t)NTOK * 512 * 2));
    p.v = (bf16_t*)(ws + carve(o2, (size_t)NTOK * 512 * 2));
    p.kpe = (bf16_t*)(ws + carve(o2, (size_t)NTOK * 32 * 2));
    size_t o3 = off;
    p.loga = (float*)(ws + carve(o3, (size_t)NTOK * 256 * 4));
    p.gqd = (bf16_t*)(ws + carve(o3, (size_t)NTOK * 256 * 2));
    p.gkd = (bf16_t*)(ws + carve(o3, (size_t)NTOK * 256 * 2));
    p.gkv = p.xa;
    p.gst = p.xa + (size_t)(NTOK / 64) * 4 * 64 * 128;
    p.gdec = (float*)(ws + carve(o3, (size_t)(NTOK / 64) * 256 * 4));
    size_t o4 = r0;
    p.act = (bf16_t*)(ws + carve(o4, (size_t)MAXSLOT * 512 * 2));
    p.y = (bf16_t*)(ws + carve(o4, (size_t)MAXSLOT * D * 2));
    if (off > ws_size || o2 > ws_size || o3 > ws_size || o4 > ws_size) return;

    static int grid = 0;
    if (grid == 0) {
        int dev = 0, cus = 0;
        if (hipGetDevice(&dev) != hipSuccess || hipDeviceGetAttribute(&cus, hipDeviceAttributeMultiprocessorCount, dev) != hipSuccess) { grid = -1; return; }
        if (hipFuncSetAttribute((const void*)mega, hipFuncAttributeMaxDynamicSharedMemorySize, LDS_BYTES) != hipSuccess) { grid = -1; return; }
        grid = cus < 256 ? cus : 256;
    }
    if (grid < 0) return;
    (void)hipMemsetAsync(ws + ctl0, 0, ctl_bytes, stream);
#define RUN(a, b) hipLaunchKernelGGL(mega, dim3(grid), dim3(NTHR), LDS_BYTES, stream, p, (a), (b))
    RUN(PH_PREP, PH_END);
#undef RUN
}
```

```cpp
#include <hip/hip_runtime.h>
#include <stdint.h>
#include <math.h>

typedef unsigned short bf16_t;
typedef short bf16x8 __attribute__((ext_vector_type(8)));
typedef float f32x4 __attribute__((ext_vector_type(4)));
typedef unsigned u32x2 __attribute__((ext_vector_type(2)));
typedef unsigned u32x4 __attribute__((ext_vector_type(4)));
#define DI __device__ __forceinline__
#define LAS __attribute__((address_space(3)))

constexpr int D = 1024, NB = 16, SEQ = 4096, NTOK = NB * SEQ;
constexpr float EPS = 1e-6f;
constexpr int AB_IN = 1952, CD_IN = 2576;
constexpr int LD0 = 2048, LD1 = 2816;
constexpr int DEXP = 256;
constexpr int MAXSLOT = NTOK + 128 * 256;
constexpr float QSCALE = 0.10206207261596577f * 1.4426950408889634f;
constexpr int NTHR = 512, NWAVE = 8;
constexpr int LDS_BYTES = 147456, LDS_MISC = LDS_BYTES - 256;

constexpr int LDS_WTAB = 147456 - 512;
DI int hw_slot_() { return (int)(__builtin_amdgcn_s_getreg((6 << 11) | 4) & 63u); }
DI int lane_() { return (int)__builtin_amdgcn_mbcnt_hi(~0u, __builtin_amdgcn_mbcnt_lo(~0u, 0u)); }
DI int tid_() {
    const int w = __builtin_amdgcn_readfirstlane(*(const LAS int*)(size_t)(LDS_WTAB + 4 * hw_slot_()));
    int t = w * 64 + lane_();
    asm volatile("" : "+v"(t)); return t;
}
DI float bf2f(bf16_t v) { return __uint_as_float(((unsigned)v) << 16); }
DI bf16_t f2bf(float f) { return __builtin_bit_cast(bf16_t, (__bf16)f); }
typedef float f32x2_t __attribute__((ext_vector_type(2))); typedef __bf16 bf16x2_t __attribute__((ext_vector_type(2)));
DI unsigned cvtpk(float lo, float hi) { f32x2_t v = {lo, hi}; bf16x2_t b = __builtin_convertvector(v, bf16x2_t); return __builtin_bit_cast(unsigned, b); }
DI unsigned pk2(float lo, float hi) { return cvtpk(lo, hi); }
DI float wave_sum(float v) {
#pragma unroll
    for (int o = 32; o >= 1; o >>= 1) v += __shfl_xor(v, o);
    return v;
}
typedef float f32x16 __attribute__((ext_vector_type(16)));
typedef short s16x4 __attribute__((ext_vector_type(4)));
typedef short v4i16_t __attribute__((ext_vector_type(4)));
DI int crow(int r, int hi) { return (r & 3) + 8 * (r >> 2) + 4 * hi; }
DI s16x4 vtr(const LAS unsigned char* p) { return __builtin_bit_cast(s16x4, __builtin_amdgcn_ds_read_tr16_b64_v4i16((LAS v4i16_t*)p)); }
DI float silu_f(float v) { return v * __builtin_amdgcn_rcpf(1.f + __builtin_amdgcn_exp2f(-1.4426950408889634f * v)); }
DI float gelu_tanh_f(float v) { const float u = 1.5957691216057308f * (v + 0.044715f * v * v * v); return v * __builtin_amdgcn_rcpf(1.f + __expf(-u)); }
DI float log_sigmoid_f(float z) { return fminf(z, 0.f) - __logf(1.f + __expf(-fabsf(z))); }

struct P {
    const float *x, *c; const int* pos;
    const float *adaln_w, *adaln_b, *norm_mix_g, *norm_ffn_g, *ab_w_in, *q_norm_g, *w_uq, *kv_norm_g, *w_ukv, *conv_w, *ab_w_out,
        *cd_w_in, *sg_v_norm_g, *sg_w_s, *sg_b_s, *gla_w_g2, *gla_b_g, *gla_norm_g, *cd_w_out,
        *moe_w_group, *moe_b_group, *moe_w_expert, *moe_b_expert, *moe_w_gate_up, *moe_w_down, *final_norm_g;
    float* out;
    bf16_t *wt_in0, *wt_uq, *wt_ukv, *wt_out0, *wt_in1, *wt_out1, *wt_gu, *wt_dn, *wt_r;
    float *mod, *ropec, *ropes;
    bf16_t *xa, *xr, *proj, *q, *kn, *v, *kpe, *mix, *act, *y;
    float *rq, *rkv, *rv, *loga, *gdec, *topw, *row_w;
    bf16_t *gqd, *gkd, *gkv, *gst;
    int *tope, *toppos, *topslot, *whist, *ntile, *tile_e, *row_tok;
    unsigned* bar;
};

#define XB_TMO      128
#define XB_XCNT(j)  (256  + 64 * (j))
#define XB_XSUB(j)  (1280 + 64 * (j))
#define XB_XGEN(j)  (2304 + 64 * (j))
#define XB_TOP      3328
#define XB_TOPGEN   3392
#define XCD_BAR_WORDS 3456
#define XB_SPIN_CAP (1u << 18)
__device__ __forceinline__ unsigned xb_ld(unsigned* p)              { return __hip_atomic_load(p, __ATOMIC_RELAXED, __HIP_MEMORY_SCOPE_AGENT); }
__device__ __forceinline__ unsigned xb_add(unsigned* p, unsigned v) { return __hip_atomic_fetch_add(p, v, __ATOMIC_RELAXED, __HIP_MEMORY_SCOPE_AGENT); }
__device__ __forceinline__ unsigned xb_xcc_id() { return (unsigned)__builtin_amdgcn_s_getreg((3 << 11) | 20) & 0xFu; }
#define XB_SPIN(cond, bar) do { unsigned _sp = 0; while (cond) { __builtin_amdgcn_s_sleep(1); \
    if ((++_sp & 255u) == 0u) { if (xb_ld(&(bar)[XB_TMO])) break; if (_sp > XB_SPIN_CAP) { atomicAdd(&(bar)[XB_TMO], 1u); break; } } } } while (0)
struct XcdBarrier { unsigned* bar; unsigned x; volatile LAS unsigned* st; };
__device__ __forceinline__ XcdBarrier xcd_barrier_post(unsigned* bar, volatile LAS unsigned* st) {
    XcdBarrier b; b.bar = bar; b.x = xb_xcc_id(); b.st = st;
    if (threadIdx.x == 0) (void)xb_add(&bar[XB_XCNT(b.x)], 1u);
    return b;
}
__device__ __forceinline__ void xcd_barrier_complete(unsigned* bar, unsigned x, unsigned& nloc, unsigned& nx) {
    const unsigned G = gridDim.x * gridDim.y * gridDim.z;
    unsigned sum, cnt, mine, sp = 0u;
    for (;;) {
        sum = 0u; cnt = 0u; mine = 0u;
#pragma unroll
        for (unsigned j = 0; j < 16; ++j) { const unsigned c = xb_ld(&bar[XB_XCNT(j)]); sum += c; cnt += (c > 0u) ? 1u : 0u; mine = (j == x) ? c : mine; }
        if (sum == G) break;
        __builtin_amdgcn_s_sleep(1);
        if ((++sp & 255u) == 0u) { if (xb_ld(&bar[XB_TMO])) break; if (sp > XB_SPIN_CAP) { atomicAdd(&bar[XB_TMO], 1u); break; } }
    }
    nloc = mine > 0u ? mine : 1u; nx = cnt > 0u ? cnt : 1u;
}
__device__ __forceinline__ void xcd_barrier(const XcdBarrier& b) {
    asm volatile("s_waitcnt vmcnt(0)" ::: "memory");
    __syncthreads();
    if (tid_() == 0) {
        unsigned* bar = b.bar;
        __builtin_amdgcn_s_waitcnt(0);
        unsigned nloc = b.st[0], nx = b.st[1];
        if (nloc == 0u) { xcd_barrier_complete(bar, b.x, nloc, nx); b.st[0] = nloc; b.st[1] = nx; }
        const unsigned old = xb_add(&bar[XB_XSUB(b.x)], 1u);
        const unsigned gen = old / nloc;
        if (old + 1u == (gen + 1u) * nloc) {
            __builtin_amdgcn_fence(__ATOMIC_RELEASE, "agent");
            asm volatile("s_waitcnt vmcnt(0)" ::: "memory");
            const unsigned og = xb_add(&bar[XB_TOP], 1u);
            const unsigned tg = og / nx;
            if (og + 1u == (tg + 1u) * nx) xb_add(&bar[XB_TOPGEN], 1u);
            else XB_SPIN(xb_ld(&bar[XB_TOPGEN]) == tg, bar);
            __builtin_amdgcn_fence(__ATOMIC_ACQUIRE, "agent");
            xb_add(&bar[XB_XGEN(b.x)], 1u);
            asm volatile("s_waitcnt vmcnt(0)" ::: "memory");
        } else {
            XB_SPIN(xb_ld(&bar[XB_XGEN(b.x)]) == gen, bar);
            __builtin_amdgcn_fence(__ATOMIC_ACQUIRE, "agent");
            asm volatile("s_waitcnt vmcnt(0)" ::: "memory");
        }
    }
    __syncthreads();
}

namespace g8 {
constexpr int BM = 256, BK = 64, HALF = 128, HTB = HALF * BK * 2, NXCD = 8, WGM = 8;
__host__ __device__ __forceinline__ int lds_byte(int r, int c) { const int st = (r >> 4) * 2 + (c >> 5), rr = r & 15, cc = c & 31, ob = rr * 64 + cc * 2; return st * 1024 + (ob ^ (((ob >> 9) & 1) << 5)); }
__host__ __device__ __forceinline__ void stage_rc(int b, int& R, int& C) { const int st = b / 1024, sb = b % 1024, swz = sb ^ (((sb >> 9) & 1) << 5); R = (st >> 1) * 16 + swz / 64; C = (st & 1) * 32 + (swz % 64) / 2; }
__host__ __device__ __forceinline__ int perm32(int rho) { const int n = rho >> 4, i = rho & 15; return 8 * (i >> 2) + 4 * n + (i & 3); }
struct Unit { int pm, pn; };
struct Order {
    int nM, nN, nwg, G, c, pnfast;
    DI void init(int nM_, int nN_, int G_, int c_, int pnfast_ = 0) { nM = nM_; nN = nN_; nwg = nM * nN; G = G_; c = c_; pnfast = pnfast_; }
    DI bool next(int i, Unit& u) const {
        const long L = (long)i * G + c; if (L >= nwg) return false;
        int wgid = (int)L; { const int q = nwg / NXCD, r = nwg % NXCD, xcd = wgid % NXCD, off = wgid / NXCD; wgid = (xcd < r ? xcd * (q + 1) : r * (q + 1) + (xcd - r) * q) + off; }
        if (pnfast) { u.pm = wgid / nN; u.pn = wgid % nN; return true; }
        const int nig = WGM * nN, gid = wgid / nig, fm = gid * WGM, gsz = (nM - fm) < WGM ? (nM - fm) : WGM;
        u.pm = fm + ((wgid % nig) % gsz); u.pn = (wgid % nig) / gsz; return true;
    }
};
template <class Epi, class Src>
__device__ __forceinline__ void gemm8(LAS unsigned char* lds, const char* A, int K_, const Order& S, const Src& X, const Epi& E, int stagger = 0) {
    int K = K_;
    const int tid = tid_();
    const int wid = __builtin_amdgcn_readfirstlane(tid >> 6), lane = tid & 63, wr = wid >> 2, wc = wid & 3, fr = lane & 15, fq = lane >> 4;
    asm volatile("" : "+s"(K));
    const int nt = K / BK;
    int Rr[2], Cc[2]; unsigned voffA[2], voffB[2];
#pragma unroll
    for (int i = 0; i < 2; ++i) { int R, C; stage_rc(tid * 16 + i * 8192, R, C); Rr[i] = R; Cc[i] = C * 2; const int Rb = Epi::PERM ? ((R & ~31) + perm32(R & 31)) : R;
        voffA[i] = (unsigned)R * X.lda + (unsigned)C * 2u; voffB[i] = (unsigned)(Rb * X.ldb(K) + C) * 2u; }
    const size_t kstep = (size_t)(BK * 2);
    const size_t hstepB = (size_t)HALF * X.ldb(K) * 2;
    const size_t ksplit = X.ksplit();
    const size_t hstepA = (size_t)HALF * X.lda;
    const unsigned ldsw = (unsigned)wid * 1024u;
    const int aoff = lds_byte(wr * 64 + fr, fq * 8), boff = lds_byte(wc * 32 + fr, fq * 8);
#define G8_SA(b, h) (((b) * 2 + (h)) * HTB)
#define G8_SB(b, h) ((4 + (b) * 2 + (h)) * HTB)
#define G8_STAGEB(bufoff, gbase) do { _Pragma("unroll") for (int _i = 0; _i < 2; ++_i) \
        __builtin_amdgcn_global_load_lds((const unsigned*)((const char*)(gbase) + voffB[_i]), (LAS unsigned*)(lds + (bufoff) + ldsw + _i * 8192), 16, 0, 0); } while (0)
#define G8_STAGEA(bufoff, ub, o0, o1) do { \
        __builtin_amdgcn_global_load_lds((const unsigned*)((const char*)(ub) + (o0)), (LAS unsigned*)(lds + (bufoff) + ldsw), 16, 0, 0); \
        __builtin_amdgcn_global_load_lds((const unsigned*)((const char*)(ub) + (o1)), (LAS unsigned*)(lds + (bufoff) + ldsw + 8192), 16, 0, 0); } while (0)
#define G8_LDA(dst, b, h) do { _Pragma("unroll") for (int m = 0; m < 4; ++m) _Pragma("unroll") for (int k = 0; k < 2; ++k) dst[m][k] = *(const LAS bf16x8*)(lds + G8_SA(b, h) + aoff + m * 2048 + k * 1024); } while (0)
#define G8_LDB(dst, b, h) do { _Pragma("unroll") for (int n = 0; n < 2; ++n) _Pragma("unroll") for (int k = 0; k < 2; ++k) dst[n][k] = *(const LAS bf16x8*)(lds + G8_SB(b, h) + boff + n * 2048 + k * 1024); } while (0)
#define G8_MMA(ai, bj, At, Bt) do { __builtin_amdgcn_s_setprio(1); _Pragma("unroll") for (int m = 0; m < 4; ++m) _Pragma("unroll") for (int n = 0; n < 2; ++n) _Pragma("unroll") for (int k = 0; k < 2; ++k) \
        acc[ai][bj][m][n] = __builtin_amdgcn_mfma_f32_16x16x32_bf16(Bt[n][k], At[m][k], acc[ai][bj][m][n], 0, 0, 0); __builtin_amdgcn_s_setprio(0); } while (0)
#define G8_WAIT_V(n) asm volatile("s_waitcnt vmcnt(" #n ")" ::: "memory")
#define G8_WAIT_L(n) asm volatile("s_waitcnt lgkmcnt(" #n ")" ::: "memory")
#define G8_BAR __builtin_amdgcn_s_barrier()
#define G8_SCHED __builtin_amdgcn_sched_barrier(0)
    Unit cur, nxt; int ui = 0;
    if (!S.next(0, cur)) return;
    if (stagger) {
        const unsigned long long t0_ = __builtin_amdgcn_s_memrealtime(), d_ = (unsigned long long)(S.c & 3) * (unsigned)stagger;
        while (__builtin_amdgcn_s_memrealtime() - t0_ < d_) __builtin_amdgcn_s_sleep(8);
    }
    f32x4 acc[2][2][4][2];
#pragma unroll
    for (int a = 0; a < 2; ++a)
#pragma unroll
        for (int b = 0; b < 2; ++b)
#pragma unroll
            for (int m = 0; m < 4; ++m)
#pragma unroll
                for (int n = 0; n < 2; ++n) acc[a][b][m][n] = (f32x4){0.f, 0.f, 0.f, 0.f};
    bf16x8 At[4][2], B0[2][2], B1[2][2];
    unsigned c00 = 0, c01 = 0, c10 = 0, c11 = 0; const char* cA = A;
    if constexpr (Src::GATHER) { c00 = X.a_off(cur, 0, Rr[0]) + Cc[0]; c01 = X.a_off(cur, 0, Rr[1]) + Cc[1]; c10 = X.a_off(cur, 1, Rr[0]) + Cc[0]; c11 = X.a_off(cur, 1, Rr[1]) + Cc[1]; }
    else cA = A + (size_t)cur.pm * 2 * hstepA;
    const char* cB0 = X.b_ptr(cur, 0); const char* cB1 = X.b_ptr(cur, 1);
#define G8_BK(b0_, b1_, kb_) (((size_t)(kb_) < ksplit ? (b0_) : (b1_)) + (kb_))
    { const char* cB = G8_BK(cB0, cB1, 0); G8_STAGEB(G8_SB(0, 0), cB); G8_STAGEB(G8_SB(0, 1), cB + hstepB); }
    if constexpr (Src::GATHER) { G8_STAGEA(G8_SA(0, 0), A, c00, c01); G8_STAGEA(G8_SA(0, 1), A, c10, c11); }
    else { G8_STAGEA(G8_SA(0, 0), cA, voffA[0], voffA[1]); G8_STAGEA(G8_SA(0, 1), cA + hstepA, voffA[0], voffA[1]); }
    if (wr == 1) G8_BAR;
    G8_WAIT_V(2); G8_BAR;
    { const char* cB = G8_BK(cB0, cB1, kstep); G8_STAGEB(G8_SB(1, 0), cB);
    if constexpr (Src::GATHER) G8_STAGEA(G8_SA(1, 0), A + kstep, c00, c01); else G8_STAGEA(G8_SA(1, 0), cA + kstep, voffA[0], voffA[1]);
      G8_STAGEB(G8_SB(1, 1), cB + hstepB); }
    G8_WAIT_V(6); G8_BAR;
    for (;;) {
        const bool has_next = S.next(ui + 1, nxt);
        unsigned n00 = c00, n01 = c01, n10 = c10, n11 = c11; const char* nB0 = cB0; const char* nB1 = cB1; const char* nA = cA;
        if (has_next) {
            if constexpr (Src::GATHER) { n00 = X.a_off(nxt, 0, Rr[0]) + Cc[0]; n01 = X.a_off(nxt, 0, Rr[1]) + Cc[1]; n10 = X.a_off(nxt, 1, Rr[0]) + Cc[0]; n11 = X.a_off(nxt, 1, Rr[1]) + Cc[1]; }
            else nA = A + (size_t)nxt.pm * 2 * hstepA;
            nB0 = X.b_ptr(nxt, 0); nB1 = X.b_ptr(nxt, 1);
        }
        for (int t = 0; t < nt; t += 2) {
            const bool last = (t == nt - 2);
            const size_t k1 = (size_t)(t + 1) * kstep;
            const size_t k2 = last ? 0 : (size_t)(t + 2) * kstep, k3 = k2 + kstep;
            const char* b2 = G8_BK(last ? nB0 : cB0, last ? nB1 : cB1, k2); const char* b3 = G8_BK(last ? nB0 : cB0, last ? nB1 : cB1, k3);
            if constexpr (Src::GATHER) {
            const unsigned a00 = last ? n00 : c00, a01 = last ? n01 : c01, a10 = last ? n10 : c10, a11 = last ? n11 : c11;
            G8_LDB(B0, 0, 0); G8_LDB(B1, 0, 1); G8_SCHED; G8_LDA(At, 0, 0); G8_STAGEA(G8_SA(1, 1), A + k1, c10, c11);
            G8_WAIT_V(8); G8_WAIT_L(0); G8_BAR; G8_MMA(0, 0, At, B0); G8_MMA(0, 1, At, B1); G8_BAR; G8_SCHED;
            G8_LDA(At, 0, 1); G8_STAGEB(G8_SB(0, 0), b2); G8_STAGEB(G8_SB(0, 1), b2 + hstepB); G8_STAGEA(G8_SA(0, 0), A + k2, a00, a01);
            G8_WAIT_V(8); G8_WAIT_L(0); G8_BAR; G8_MMA(1, 0, At, B0); G8_MMA(1, 1, At, B1); G8_BAR; G8_SCHED;
            G8_LDB(B0, 1, 0); G8_LDB(B1, 1, 1); G8_SCHED; G8_LDA(At, 1, 0); G8_STAGEA(G8_SA(0, 1), A + k2, a10, a11);
            G8_WAIT_V(8); G8_WAIT_L(0); G8_BAR; G8_MMA(0, 0, At, B0); G8_MMA(0, 1, At, B1); G8_BAR; G8_SCHED;
            G8_LDA(At, 1, 1); G8_STAGEB(G8_SB(1, 0), b3); G8_STAGEB(G8_SB(1, 1), b3 + hstepB); G8_STAGEA(G8_SA(1, 0), A + k3, a00, a01);
            G8_WAIT_V(8); G8_WAIT_L(0); G8_BAR; G8_MMA(1, 0, At, B0); G8_MMA(1, 1, At, B1); G8_BAR; G8_SCHED;
            } else {
            const char* a1 = cA + k1; const char* a2 = (last ? nA : cA) + k2; const char* a3 = a2 + kstep;
            G8_LDB(B0, 0, 0); G8_LDB(B1, 0, 1); G8_SCHED; G8_LDA(At, 0, 0); G8_STAGEA(G8_SA(1, 1), a1 + hstepA, voffA[0], voffA[1]);
            G8_WAIT_V(8); G8_WAIT_L(0); G8_BAR; G8_MMA(0, 0, At, B0); G8_MMA(0, 1, At, B1); G8_BAR; G8_SCHED;
            G8_LDA(At, 0, 1); G8_STAGEB(G8_SB(0, 0), b2); G8_STAGEB(G8_SB(0, 1), b2 + hstepB); G8_STAGEA(G8_SA(0, 0), a2, voffA[0], voffA[1]);
            G8_WAIT_V(8); G8_WAIT_L(0); G8_BAR; G8_MMA(1, 0, At, B0); G8_MMA(1, 1, At, B1); G8_BAR; G8_SCHED;
            G8_LDB(B0, 1, 0); G8_LDB(B1, 1, 1); G8_SCHED; G8_LDA(At, 1, 0); G8_STAGEA(G8_SA(0, 1), a2 + hstepA, voffA[0], voffA[1]);
            G8_WAIT_V(8); G8_WAIT_L(0); G8_BAR; G8_MMA(0, 0, At, B0); G8_MMA(0, 1, At, B1); G8_BAR; G8_SCHED;
            G8_LDA(At, 1, 1); G8_STAGEB(G8_SB(1, 0), b3); G8_STAGEB(G8_SB(1, 1), b3 + hstepB); G8_STAGEA(G8_SA(1, 0), a3, voffA[0], voffA[1]);
            G8_WAIT_V(8); G8_WAIT_L(0); G8_BAR; G8_MMA(1, 0, At, B0); G8_MMA(1, 1, At, B1); G8_BAR; G8_SCHED;
            }
        }
        if (wr == 0) G8_BAR;
        E(acc, cur, wr, wc, fr, fq);
        if (!has_next) break;
#pragma unroll
        for (int a = 0; a < 2; ++a)
#pragma unroll
            for (int b = 0; b < 2; ++b)
#pragma unroll
                for (int m = 0; m < 4; ++m)
#pragma unroll
                    for (int n = 0; n < 2; ++n) acc[a][b][m][n] = (f32x4){0.f, 0.f, 0.f, 0.f};
        cur = nxt; c00 = n00; c01 = n01; c10 = n10; c11 = n11; cB0 = nB0; cB1 = nB1; cA = nA; ++ui;
        if (wr == 1) G8_BAR;
    }
    G8_WAIT_V(0);
    G8_BAR;
#undef G8_SA
#undef G8_SB
#undef G8_STAGEA
#undef G8_STAGEB
#undef G8_BK
#undef G8_LDA
#undef G8_LDB
#undef G8_MMA
#undef G8_WAIT_V
#undef G8_WAIT_L
#undef G8_BAR
#undef G8_SCHED
}
#define EPI_FOR _Pragma("unroll") for (int ai = 0; ai < 2; ++ai) _Pragma("unroll") for (int m = 0; m < 4; ++m)
#define EPI_ROW const int ro = ai * 128 + m * 16; if (m == 0) __builtin_amdgcn_sched_barrier(0); f32x4 a = acc[ai][BJ][m][0], b = acc[ai][BJ][m][1]; (void)ro;
template <class F> struct Epi {
    static constexpr bool PERM = true;
    F f;
    DI void operator()(const f32x4 (&acc)[2][2][4][2], const Unit& u, int wr, int wc, int fr, int fq) const {
        const int row0 = u.pm * BM + wr * 64 + fr, col0 = u.pn * BM + wc * 32 + 8 * fq;
        f.template blk<0>(acc, row0, col0, u);
        f.template blk<1>(acc, row0, col0 + HALF, u);
    }
};
}

DI void store_bf8(bf16_t* dst, const f32x4& a, const f32x4& b) { u32x4 w; w.x = pk2(a[0], a[1]); w.y = pk2(a[2], a[3]); w.z = pk2(b[0], b[1]); w.w = pk2(b[2], b[3]); *(u32x4*)dst = w; }
DI void rope8(const P& p, int row, int i0, f32x4& a, f32x4& b) {
    const f32x4 c = *(const f32x4*)(p.ropec + (size_t)row * 16 + i0), s = *(const f32x4*)(p.ropes + (size_t)row * 16 + i0);
    f32x4 oa, ob;
    oa[0] = a[0] * c[0] - a[1] * s[0]; oa[1] = a[0] * s[0] + a[1] * c[0]; oa[2] = a[2] * c[1] - a[3] * s[1]; oa[3] = a[2] * s[1] + a[3] * c[1];
    ob[0] = b[0] * c[2] - b[1] * s[2]; ob[1] = b[0] * s[2] + b[1] * c[2]; ob[2] = b[2] * c[3] - b[3] * s[3]; ob[3] = b[2] * s[3] + b[3] * c[3];
    a = oa; b = ob;
}
struct SrcDense {
    static constexpr bool GATHER = false;
    unsigned lda; const char* B; size_t bt;
    DI int ldb(int K) const { return K; }
    DI size_t ksplit() const { return 0; }
    DI unsigned a_off(const g8::Unit&, int, int) const { return 0u; }
    DI const char* b_ptr(const g8::Unit& u, int) const { return B + (size_t)u.pn * bt; }
};
struct SrcGu {
    static constexpr bool GATHER = true;
    unsigned lda; const int* rt; const int* te; const char* B;
    DI int ldb(int K) const { return K; }
    DI size_t ksplit() const { return 0; }
    DI unsigned a_off(const g8::Unit& u, int h, int R) const { const int v = rt[u.pm * 256 + h * 128 + R]; return (unsigned)(v ? v - 1 : 0) * lda; }
    DI const char* b_ptr(const g8::Unit& u, int) const { const int ee = te[u.pm]; const int e = (u.pn < 2) ? (ee & 255) : (ee >> 8); return B + ((size_t)e * 512 + (size_t)(u.pn & 1) * 256) * 1024 * 2; }
};
struct SrcDn {
    static constexpr bool GATHER = false;
    unsigned lda; const int* te; const char* B;
    DI int ldb(int) const { return 256; }
    DI size_t ksplit() const { return 512; }
    DI unsigned a_off(const g8::Unit&, int, int) const { return 0u; }
    DI const char* b_ptr(const g8::Unit& u, int half) const { const int ee = te[u.pm]; const int e = half ? (ee >> 8) : (ee & 255);
        return B + ((size_t)e * 1024 + (size_t)u.pn * 256) * 256 * 2 - (half ? 512 : 0); }
};
typedef const f32x4 (&AccRef)[2][2][4][2];
using g8::Unit;
struct FIn0 { const P& p;
    template <int BJ> DI void blk(AccRef acc, int row0, int col, const Unit&) const {
        if (col >= 384 && col < 416) { bf16_t* d = p.kpe + (size_t)row0 * 32 + (col - 384);
            EPI_FOR { EPI_ROW rope8(p, row0 + ro, (col - 384) >> 1, a, b); store_bf8(d + (size_t)ro * 32, a, b); } }
        else if (col < 928) { bf16_t* d = p.proj + (size_t)row0 * LD0 + col;
            EPI_FOR { EPI_ROW store_bf8(d + (size_t)ro * LD0, a, b); } }
        else if (col < AB_IN) { bf16_t* d = p.proj + (size_t)row0 * LD0 + 928 + ((col - 928) >> 1);
            EPI_FOR { EPI_ROW u32x2 w; w.x = pk2(a[0] * a[1], a[2] * a[3]); w.y = pk2(b[0] * b[1], b[2] * b[3]); *(u32x2*)(d + (size_t)ro * LD0) = w; } }
    } };
struct FUq { const P& p;
    template <int BJ> DI void blk(AccRef acc, int row0, int col, const Unit&) const {
        const bool rope = ((col >> 5) % 3) == 2; bf16_t* d = p.q + (size_t)row0 * 768 + col; const float* rq = p.rq + row0;
        EPI_FOR { EPI_ROW const float r = rq[ro] * QSCALE; a = a * r; b = b * r; if (rope) rope8(p, row0 + ro, (col & 31) >> 1, a, b); store_bf8(d + (size_t)ro * 768, a, b); }
    } };
struct FUkv { const P& p;
    template <int BJ> DI void blk(AccRef acc, int row0, int col, const Unit&) const {
        bf16_t* d = (col < 512) ? p.kn + (size_t)row0 * 512 + col : p.v + (size_t)row0 * 512 + (col - 512); const float* rk = p.rkv + row0;
        EPI_FOR { EPI_ROW const float r = rk[ro]; store_bf8(d + (size_t)ro * 512, a * r, b * r); }
    } };
struct FOut { const P& p; int l;
    template <int BJ> DI void blk(AccRef acc, int row0, int col, const Unit&) const {
        const float* gp = p.mod + ((size_t)l * 16 + (row0 >> 12)) * 6144 + 2048 + col;
        const f32x4 g0 = *(const f32x4*)gp, g1 = *(const f32x4*)(gp + 4);
        bf16_t* d = p.xr + (size_t)row0 * D + col; const float* xp = p.x + (size_t)row0 * D + col;
        EPI_FOR { EPI_ROW f32x4 x0, x1;
            if (l == 0) { x0 = *(const f32x4*)(xp + (size_t)ro * D); x1 = *(const f32x4*)(xp + (size_t)ro * D + 4); }
            else { const u32x4 r = *(const u32x4*)(d + (size_t)ro * D);
                x0 = (f32x4){__uint_as_float(r.x << 16), __uint_as_float(r.x & 0xffff0000u), __uint_as_float(r.y << 16), __uint_as_float(r.y & 0xffff0000u)};
                x1 = (f32x4){__uint_as_float(r.z << 16), __uint_as_float(r.z & 0xffff0000u), __uint_as_float(r.w << 16), __uint_as_float(r.w & 0xffff0000u)}; }
            store_bf8(d + (size_t)ro * D, x0 + g0 * a, x1 + g1 * b); }
    } };
struct FIn1 { const P& p;
    template <int BJ> DI void blk(AccRef acc, int row0, int col, const Unit&) const {
        if (col >= 2048 && col < 2304) {
            const float* bg = p.gla_b_g + (col - 2048); const f32x4 b0 = *(const f32x4*)bg, b1 = *(const f32x4*)(bg + 4);
            float* d = p.loga + (size_t)row0 * 256 + (col - 2048);
            EPI_FOR { EPI_ROW f32x4 o0, o1;
#pragma unroll
                for (int e = 0; e < 4; ++e) { o0[e] = log_sigmoid_f(a[e] + b0[e]) * (1.f / 16.f); o1[e] = log_sigmoid_f(b[e] + b1[e]) * (1.f / 16.f); }
                *(f32x4*)(d + (size_t)ro * 256) = o0; *(f32x4*)(d + (size_t)ro * 256 + 4) = o1; }
        } else {
            bf16_t* d = p.proj + (size_t)row0 * LD1 + col;
            if (col < 1024) { EPI_FOR { EPI_ROW
#pragma unroll
                for (int e = 0; e < 4; ++e) { a[e] = gelu_tanh_f(a[e]); b[e] = gelu_tanh_f(b[e]); }
                store_bf8(d + (size_t)ro * LD1, a, b); } }
            else { EPI_FOR { EPI_ROW store_bf8(d + (size_t)ro * LD1, a, b); } }
        }
    } };
struct FGu { const P& p; const float* rw;
    template <int BJ> DI void blk(AccRef acc, int row0, int col, const Unit&) const {
        const float* wp = rw + 2 * (size_t)row0 + (col >> 9); bf16_t* d = p.act + (size_t)row0 * 512 + (col >> 1);
        EPI_FOR { EPI_ROW const float w = wp[2 * ro];
            u32x2 o; o.x = pk2(silu_f(a[0]) * a[1] * w, silu_f(a[2]) * a[3] * w); o.y = pk2(silu_f(b[0]) * b[1] * w, silu_f(b[2]) * b[3] * w);
            *(u32x2*)(d + (size_t)ro * 512) = o; }
    } };
struct FNull {
    template <int BJ> DI void blk(AccRef acc, int, int, const Unit&) const { EPI_FOR { EPI_ROW asm volatile("" :: "v"(a[0]), "v"(a[1]), "v"(a[2]), "v"(a[3]), "v"(b[0]), "v"(b[1]), "v"(b[2]), "v"(b[3])); } } };
struct FDn { const P& p;
    template <int BJ> DI void blk(AccRef acc, int row0, int col, const Unit&) const {
        bf16_t* d = p.y + (size_t)row0 * D + col;
        EPI_FOR { EPI_ROW store_bf8(d + (size_t)ro * D, a, b); }
    } };

enum { J_IN0 = 0, J_UQ, J_UKV, J_OUT0, J_IN1, J_OUT1, J_GU, J_DN, J_R, J_NUM };
DI float wval(const P& p, int job, int sub, int k, int n) {
    switch (job) {
    case J_IN0: {
        if (n >= AB_IN) return 0.f;
        int src = n;
        if (n >= 384 && n < 416) { const int i = n - 384; src = 384 + (i >> 1) + (i & 1) * 16; }
        else if (n >= 928) { const int i = n - 928; src = ((i & 1) ? 1440 : 928) + (i >> 1); }
        return p.ab_w_in[(size_t)k * AB_IN + src];
    }
    case J_UQ: {
        const int h = n / 96, j = n % 96; int src = 96 * h + j;
        if (j >= 64) { const int i = j - 64; src = 96 * h + 64 + (i >> 1) + (i & 1) * 16; }
        return p.w_uq[(size_t)k * 768 + src] * p.q_norm_g[k];
    }
    case J_UKV: {
        int src;
        if (n < 512) { src = 128 * (n >> 6) + (n & 63); } else { const int m = n - 512; src = 128 * (m >> 6) + 64 + (m & 63); }
        return p.w_ukv[(size_t)k * 1024 + src] * p.kv_norm_g[k];
    }
    case J_OUT0: return p.ab_w_out[(size_t)k * 1024 + n];
    case J_IN1: {
        if (n < 2048) return p.cd_w_in[(size_t)k * CD_IN + n];
        if (n < 2304) { const int j = n - 2048; float s = 0.f;
#pragma unroll
            for (int r = 0; r < 16; ++r) s += p.cd_w_in[(size_t)k * CD_IN + 2048 + r] * p.gla_w_g2[r * 256 + j];
            return s; }
        return p.cd_w_in[(size_t)k * CD_IN + 2064 + (n - 2304)];
    }
    case J_OUT1: return p.cd_w_out[(size_t)k * 1024 + n];
    case J_GU: { const int j = n >> 1; const int src = (n & 1) ? 256 + j : j; return p.moe_w_gate_up[((size_t)sub * 1024 + k) * 512 + src]; }
    case J_DN: return p.moe_w_down[((size_t)sub * 256 + k) * 1024 + n];
    case J_R: { if (n < 4) return p.moe_w_group[((size_t)sub * 1024 + k) * 4 + n]; if (n < 36) return p.moe_w_expert[((size_t)sub * 1024 + k) * 32 + (n - 4)]; return 0.f; }
    }
    return 0.f;
}
struct JobInfo { int K, N, nsub; };
DI JobInfo job_info(int job) {
    switch (job) {
    case J_IN0: return {1024, LD0, 1};
    case J_UQ: return {256, 768, 1};
    case J_UKV: return {128, 1024, 1};
    case J_OUT0: return {1024, 1024, 1};
    case J_IN1: return {1024, LD1, 1};
    case J_OUT1: return {1024, 1024, 1};
    case J_GU: return {1024, 512, 64};
    case J_DN: return {256, 1024, 64};
    default: return {1024, 64, 2};
    }
}
constexpr size_t WO_IN0 = 0, WO_UQ = WO_IN0 + (size_t)LD0 * 1024, WO_UKV = WO_UQ + 768 * 256, WO_OUT0 = WO_UKV + 1024 * 128, WO_IN1 = WO_OUT0 + 1024 * 1024,
    WO_OUT1 = WO_IN1 + (size_t)LD1 * 1024, WO_GU = WO_OUT1 + 1024 * 1024, WO_DN = WO_GU + (size_t)64 * 512 * 1024, WO_R = WO_DN + (size_t)64 * 1024 * 256, WO_END = WO_R + 2 * 64 * 1024;
DI size_t job_dst_off(int job) {
    switch (job) {
    case J_IN0: return WO_IN0; case J_UQ: return WO_UQ; case J_UKV: return WO_UKV; case J_OUT0: return WO_OUT0;
    case J_IN1: return WO_IN1; case J_OUT1: return WO_OUT1; case J_GU: return WO_GU; case J_DN: return WO_DN; default: return WO_R;
    }
}
DI void ph_prep(const P& p, LAS unsigned char* lds) {
    const int tid = tid_();
#ifndef PREP_A
#define PREP_A 1
#define PREP_B 1
#define PREP_C 1
#endif
    for (int rep_ = 0; rep_ < PREP_A; ++rep_)
    if (blockIdx.x < 192) {
        LAS float* cact = (LAS float*)lds;
        LAS float* red = cact + 16 * 1024;
        for (int i = tid; i < 16 * 1024; i += NTHR) cact[i] = silu_f(p.c[i]);
        __syncthreads();
        const int col = tid & 63, ks = tid >> 6;
        for (int item = blockIdx.x; item < 192; item += gridDim.x) {
            const int l = item / 96, j = (item % 96) * 64 + col;
            float acc[16];
#pragma unroll
            for (int b = 0; b < 16; ++b) acc[b] = 0.f;
            const float* W = p.adaln_w + (size_t)l * 1024 * 6144 + j;
            for (int k0 = ks * 128; k0 < ks * 128 + 128; k0 += 16) {
                float wv[16];
#pragma unroll
                for (int u = 0; u < 16; ++u) wv[u] = W[(size_t)(k0 + u) * 6144];
#pragma unroll
                for (int u = 0; u < 16; ++u)
#pragma unroll
                    for (int b = 0; b < 16; ++b) acc[b] += cact[b * 1024 + k0 + u] * wv[u];
            }
#pragma unroll
            for (int b = 0; b < 16; ++b) red[(ks * 16 + b) * 64 + col] = acc[b];
            __syncthreads();
            for (int i = tid; i < 1024; i += NTHR) {
                const int b = i >> 6, cc = i & 63; float s = 0.f;
#pragma unroll
                for (int q = 0; q < 8; ++q) s += red[(q * 16 + b) * 64 + cc];
                const int jj = (item % 96) * 64 + cc;
                p.mod[((size_t)l * 16 + b) * 6144 + jj] = s + p.adaln_b[l * 6144 + jj];
            }
            __syncthreads();
        }
    }
    for (int rep_ = 0; rep_ < PREP_B; ++rep_)
    {
        const int lane = tid & 63, wid = tid >> 6;
        LAS float* scr = (LAS float*)(lds + wid * (64 * 72 * 2));
        int total = 0;
#pragma unroll
        for (int j = 0; j < J_NUM; ++j) { const JobInfo ji = job_info(j); total += (j == J_GU || j == J_DN) ? 0 : (ji.K / 64) * (ji.N / 32) * ji.nsub; }
        for (int item = blockIdx.x * NWAVE + wid; item < total; item += gridDim.x * NWAVE) {
            int job = 0, jstart = 0, accn = 0;
#pragma unroll
            for (int j = 0; j < J_NUM; ++j) { const JobInfo jj = job_info(j); if (j == J_GU || j == J_DN) continue; if (item >= accn) { job = j; jstart = accn; } accn += (jj.K / 64) * (jj.N / 32) * jj.nsub; }
#ifndef PREP_JOBREP
#define PREP_JOBREP -1
#endif
            for (int jr_ = 0; jr_ < ((job == PREP_JOBREP) ? 2 : 1); ++jr_) {
            const JobInfo ji = job_info(job);
            int r = item - jstart;
            const int kt = ji.K / 64, nt = ji.N / 32;
            const int sub = r / (kt * nt); r -= sub * kt * nt;
            const int n0 = (r % nt) * 32, k0 = (r / nt) * 64;
            {
                const int n = n0 + (lane & 31);
                const float* cp = nullptr; size_t ldk = 0; const float* gain = nullptr; bool slow = false;
                switch (job) {
                case J_IN0: { if (n < AB_IN) { int src = n; if (n >= 384 && n < 416) { const int i = n - 384; src = 384 + (i >> 1) + (i & 1) * 16; } else if (n >= 928) { const int i = n - 928; src = ((i & 1) ? 1440 : 928) + (i >> 1); } cp = p.ab_w_in + src; ldk = AB_IN; } } break;
                case J_UQ: { const int h = n / 96, j = n % 96; int src = 96 * h + j; if (j >= 64) { const int i = j - 64; src = 96 * h + 64 + (i >> 1) + (i & 1) * 16; } cp = p.w_uq + src; ldk = 768; gain = p.q_norm_g; } break;
                case J_UKV: { int src; if (n < 512) src = 128 * (n >> 6) + (n & 63); else { const int m = n - 512; src = 128 * (m >> 6) + 64 + (m & 63); } cp = p.w_ukv + src; ldk = 1024; gain = p.kv_norm_g; } break;
                case J_OUT0: cp = p.ab_w_out + n; ldk = 1024; break;
                case J_IN1: { if (n < 2048) { cp = p.cd_w_in + n; ldk = CD_IN; } else if (n < 2304) slow = true; else { cp = p.cd_w_in + 2064 + (n - 2304); ldk = CD_IN; } } break;
                case J_OUT1: cp = p.cd_w_out + n; ldk = 1024; break;
                case J_GU: { const int j = n >> 1; cp = p.moe_w_gate_up + (size_t)sub * 1024 * 512 + ((n & 1) ? 256 + j : j); ldk = 512; } break;
                case J_DN: cp = p.moe_w_down + (size_t)sub * 256 * 1024 + n; ldk = 1024; break;
                default: slow = true; break;
                }
                const int kb = k0 + (lane >> 5);
                if (job == J_IN1 && n0 >= 2048 && n0 < 2304) {
                    float g2[16];
#pragma unroll
                    for (int r2 = 0; r2 < 16; ++r2) g2[r2] = p.gla_w_g2[r2 * 256 + (n - 2048)];
#pragma unroll 4
                    for (int i = 0; i < 32; ++i) { const float* wr = p.cd_w_in + (size_t)(kb + 2 * i) * CD_IN + 2048;
                        const f32x4 a = *(const f32x4*)wr, b = *(const f32x4*)(wr + 4), c = *(const f32x4*)(wr + 8), d = *(const f32x4*)(wr + 12);
                        float v = 0.f;
#pragma unroll
                        for (int e = 0; e < 4; ++e) v += a[e] * g2[e] + b[e] * g2[4 + e] + c[e] * g2[8 + e] + d[e] * g2[12 + e];
                        scr[(2 * i + (lane >> 5)) * 33 + (lane & 31)] = v; }
                } else if (__any(slow)) {
#pragma unroll 8
                    for (int i = 0; i < 32; ++i) scr[(2 * i + (lane >> 5)) * 33 + (lane & 31)] = wval(p, job, sub, kb + 2 * i, n);
                } else {
                    const float* q = cp ? cp + (size_t)kb * ldk : nullptr;
#pragma unroll
                    for (int i = 0; i < 32; ++i) { float v = q ? q[(size_t)(2 * i) * ldk] : 0.f; if (gain) v *= gain[kb + 2 * i]; scr[(2 * i + (lane >> 5)) * 33 + (lane & 31)] = v; }
                }
            }
            asm volatile("s_waitcnt lgkmcnt(0)" ::: "memory");
            bf16_t* dst = p.wt_in0 + job_dst_off(job) + (size_t)sub * ji.K * ji.N;
            const int c = lane & 7;
#pragma unroll
            for (int j = 0; j < 4; ++j) { const int n = (lane >> 3) + 8 * j; const LAS float* sp = scr + (8 * c) * 33 + n;
                u32x4 o; o.x = pk2(sp[0 * 33], sp[1 * 33]); o.y = pk2(sp[2 * 33], sp[3 * 33]); o.z = pk2(sp[4 * 33], sp[5 * 33]); o.w = pk2(sp[6 * 33], sp[7 * 33]);
                *(u32x4*)(dst + (size_t)(n0 + n) * ji.K + k0 + 8 * c) = o; }
            asm volatile("s_waitcnt lgkmcnt(0)" ::: "memory");
            }
        }
    }
    for (int rep_ = 0; rep_ < PREP_B; ++rep_)
    {
        const int lane = tid & 63, wid = tid >> 6, g = lane >> 4, i15 = lane & 15, tq = i15 >> 2, tp = i15 & 3;
        LAS unsigned char* tl = lds + wid * (64 * 72 * 2);
        for (int item = blockIdx.x * NWAVE + wid; item < 8192 + 4096; item += gridDim.x * NWAVE) {
            const float* src; bf16_t* dst; int ld, Kd, k0, c0; bool gu;
            if (item < 8192) { const int sub = item >> 7, rr = item & 127; k0 = (rr >> 3) * 64; c0 = (rr & 7) * 64; ld = 512; Kd = 1024; gu = true;
                src = p.moe_w_gate_up + ((size_t)sub * 1024 + k0) * 512 + c0; dst = p.wt_gu + (size_t)sub * 512 * 1024; }
            else { const int r = item - 8192; const int sub = r >> 6, rr = r & 63; k0 = (rr >> 4) * 64; c0 = (rr & 15) * 64; ld = 1024; Kd = 256; gu = false;
                src = p.moe_w_down + ((size_t)sub * 256 + k0) * 1024 + c0; dst = p.wt_dn + (size_t)sub * 1024 * 256; }
            f32x4 v[16];
#pragma unroll
            for (int i = 0; i < 16; ++i) v[i] = *(const f32x4*)(src + (size_t)(4 * i + g) * ld + 4 * i15);
#pragma unroll
            for (int i = 0; i < 16; ++i) { u32x2 w; w.x = pk2(v[i][0], v[i][1]); w.y = pk2(v[i][2], v[i][3]); *(LAS u32x2*)(tl + ((4 * i + g) * 72 + 4 * i15) * 2) = w; }
            asm volatile("s_waitcnt lgkmcnt(0)" ::: "memory");
#pragma unroll
            for (int ps = 0; ps < 8; ++ps) {
                const int cb = 16 * (ps & 3), ch = (ps >> 2) * 4 + g;
                const s16x4 lo = vtr(tl + ((8 * ch + tq) * 72 + cb + 4 * tp) * 2), hi4 = vtr(tl + ((8 * ch + 4 + tq) * 72 + cb + 4 * tp) * 2);
                const int c = c0 + cb + i15;
                const int n = gu ? ((c < 256) ? 2 * c : 2 * (c - 256) + 1) : c;
                u32x4 o; o.x = (unsigned)(unsigned short)lo[0] | ((unsigned)(unsigned short)lo[1] << 16); o.y = (unsigned)(unsigned short)lo[2] | ((unsigned)(unsigned short)lo[3] << 16);
                o.z = (unsigned)(unsigned short)hi4[0] | ((unsigned)(unsigned short)hi4[1] << 16); o.w = (unsigned)(unsigned short)hi4[2] | ((unsigned)(unsigned short)hi4[3] << 16);
                *(u32x4*)(dst + (size_t)n * Kd + k0 + 8 * ch) = o;
            }
            asm volatile("s_waitcnt lgkmcnt(0)" ::: "memory");
        }
    }
    for (int rep_ = 0; rep_ < PREP_C; ++rep_)
    for (int gid = blockIdx.x * NTHR + tid; gid < NTOK * 16; gid += gridDim.x * NTHR) {
        const int tok = gid >> 4, i = gid & 15;
        const float inv = exp2f(-(float)i * (13.287712379549449f / 16.0f));
        float sn, cs; sincosf((float)p.pos[tok] * inv, &sn, &cs);
        p.ropec[gid] = cs; p.ropes[gid] = sn;
    }
}

template <bool F32IN>
DI void ph_norm(const P& p, const void* xin_, const float* g, int l, int which) {
    const int tid = tid_(); const int lane = tid & 63;
    constexpr int R = 4;
    for (int row0 = (blockIdx.x * NWAVE + (tid >> 6)) * R; row0 < NTOK; row0 += gridDim.x * NWAVE * R) {
        const int b = row0 >> 12;
        const float* md = p.mod + ((size_t)l * 16 + b) * 6144 + which * 3072;
        f32x4 v[R][4]; float ss[R];
#pragma unroll
        for (int r = 0; r < R; ++r)
#pragma unroll
            for (int i = 0; i < 4; ++i) {
                if (F32IN) v[r][i] = *(const f32x4*)((const float*)xin_ + (size_t)(row0 + r) * D + i * 256 + lane * 4);
                else { const u32x2 q = *(const u32x2*)((const bf16_t*)xin_ + (size_t)(row0 + r) * D + i * 256 + lane * 4);
                       v[r][i] = (f32x4){__uint_as_float(q.x << 16), __uint_as_float(q.x & 0xffff0000u), __uint_as_float(q.y << 16), __uint_as_float(q.y & 0xffff0000u)}; }
            }
#pragma unroll
        for (int r = 0; r < R; ++r) { float a = 0.f;
#pragma unroll
            for (int i = 0; i < 4; ++i) a += v[r][i][0] * v[r][i][0] + v[r][i][1] * v[r][i][1] + v[r][i][2] * v[r][i][2] + v[r][i][3] * v[r][i][3];
            ss[r] = rsqrtf(wave_sum(a) * (1.f / D) + EPS); }
#pragma unroll
        for (int i = 0; i < 4; ++i) {
            const int c0 = i * 256 + lane * 4;
            const f32x4 gg = *(const f32x4*)(g + c0), sh = *(const f32x4*)(md + c0), sc = *(const f32x4*)(md + 1024 + c0);
#pragma unroll
            for (int r = 0; r < R; ++r) {
                float o[4];
#pragma unroll
                for (int e = 0; e < 4; ++e) o[e] = v[r][i][e] * ss[r] * gg[e] * (1.f + sc[e]) + sh[e];
                u32x2 w; w.x = pk2(o[0], o[1]); w.y = pk2(o[2], o[3]);
                *(u32x2*)(p.xa + (size_t)(row0 + r) * D + c0) = w;
            }
        }
    }
}
DI void ph_rowstat0_conv(const P& p) {
    const int tid = tid_(); const int lane = tid & 63;
    float cw[3][8];
#pragma unroll
    for (int k = 0; k < 3; ++k) { const f32x4 a = *(const f32x4*)(p.conv_w + k * 512 + lane * 8), b = *(const f32x4*)(p.conv_w + k * 512 + lane * 8 + 4);
#pragma unroll
        for (int e = 0; e < 4; ++e) { cw[k][e] = a[e]; cw[k][4 + e] = b[e]; } }
    for (int blk = blockIdx.x * NWAVE + (tid >> 6); blk < NTOK / 16; blk += gridDim.x * NWAVE) {
        const int row0 = blk * 16;
        float u1[8], u2[8];
#pragma unroll
        for (int e = 0; e < 8; ++e) { u1[e] = 0.f; u2[e] = 0.f; }
        if ((row0 & 4095) != 0) {
#pragma unroll
            for (int d = 1; d <= 2; ++d) { const bf16_t* q = p.proj + (size_t)(row0 - d) * LD0; const u32x4 c = *(const u32x4*)(q + 928 + lane * 8);
#pragma unroll
                for (int e = 0; e < 4; ++e) { const float v0 = __uint_as_float(c[e] << 16), v1 = __uint_as_float(c[e] & 0xffff0000u);
                    if (d == 1) { u1[2 * e] = v0; u1[2 * e + 1] = v1; } else { u2[2 * e] = v0; u2[2 * e + 1] = v1; } } }
        }
#pragma unroll 4
        for (int i = 0; i < 16; ++i) {
            const int row = row0 + i;
            const bf16_t* r = p.proj + (size_t)row * LD0;
            { const u32x2 a = *(const u32x2*)(r + lane * 4); const unsigned kk = *(const unsigned*)(r + 256 + lane * 2);
              float sq = 0.f, sk = 0.f;
              { const float a0 = __uint_as_float(a.x << 16), a1 = __uint_as_float(a.x & 0xffff0000u), a2 = __uint_as_float(a.y << 16), a3 = __uint_as_float(a.y & 0xffff0000u); sq = a0 * a0 + a1 * a1 + a2 * a2 + a3 * a3; }
              { const float k0 = __uint_as_float(kk << 16), k1 = __uint_as_float(kk & 0xffff0000u); sk = k0 * k0 + k1 * k1; }
              sq = wave_sum(sq); sk = wave_sum(sk);
              if (lane == 0) { p.rq[row] = rsqrtf(sq * (1.f / 256.f) + EPS); p.rkv[row] = rsqrtf(sk * (1.f / 128.f) + EPS); } }
            const u32x4 bg = *(const u32x4*)(r + 416 + lane * 8), c = *(const u32x4*)(r + 928 + lane * 8);
            u32x4 o;
#pragma unroll
            for (int e = 0; e < 4; ++e) {
                const float v0 = __uint_as_float(c[e] << 16), v1 = __uint_as_float(c[e] & 0xffff0000u);
                const float y0 = cw[0][2 * e] * u2[2 * e] + cw[1][2 * e] * u1[2 * e] + cw[2][2 * e] * v0;
                const float y1 = cw[0][2 * e + 1] * u2[2 * e + 1] + cw[1][2 * e + 1] * u1[2 * e + 1] + cw[2][2 * e + 1] * v1;
                u2[2 * e] = u1[2 * e]; u2[2 * e + 1] = u1[2 * e + 1]; u1[2 * e] = v0; u1[2 * e + 1] = v1;
                o[e] = pk2(__uint_as_float(bg[e] << 16) * y0, __uint_as_float(bg[e] & 0xffff0000u) * y1);
            }
            *(u32x4*)(p.mix + (size_t)row * D + 512 + lane * 8) = o;
        }
    }
}
constexpr int GL_QS = 72, GL_VS = 144;
constexpr int GX_SEG = 0, GX_QD = 2048, GX_KD = GX_QD + 64 * GL_QS * 2, GX_KE = GX_KD + 64 * GL_QS * 2, GX_V = GX_KE + 64 * GL_QS * 2, GX_END = GX_V + 64 * GL_VS * 2;
DI void ph_stat1x(const P& p, LAS unsigned char* lds) {
    const int tid = tid_(); const int lane = tid & 63, w = __builtin_amdgcn_readfirstlane(tid >> 6), l15 = lane & 15, g = lane >> 4, tq = l15 >> 2, tp = l15 & 3;
    for (int row = blockIdx.x * NWAVE + w; row < NTOK; row += gridDim.x * NWAVE) {
        const u32x4 a = *(const u32x4*)(p.proj + (size_t)row * LD1 + 512 + lane * 8);
        float s = 0.f;
#pragma unroll
        for (int e = 0; e < 4; ++e) { const float v0 = __uint_as_float(a[e] << 16), v1 = __uint_as_float(a[e] & 0xffff0000u); s += v0 * v0 + v1 * v1; }
        s = wave_sum(s);
        if (lane == 0) p.rv[row] = rsqrtf(s * (1.f / 512.f) + EPS);
    }
    float nbc[8]; bf16_t nq[8], nk[8]; u32x4 nrv[2];
#define GX_LOAD(it_) do { const int h_ = (it_) & 3; const size_t row0_ = (size_t)((it_) >> 2) * 64; \
        const float* la_ = p.loga + (row0_ + 8 * w) * 256 + h_ * 64 + lane; const bf16_t* pq_ = p.proj + (row0_ + 8 * w) * LD1 + 1024 + h_ * 64 + lane; \
        _Pragma("unroll") for (int i = 0; i < 8; ++i) { nbc[i] = la_[(size_t)i * 256]; nq[i] = pq_[(size_t)i * LD1]; nk[i] = pq_[(size_t)i * LD1 + 256]; } \
        _Pragma("unroll") for (int i = 0; i < 2; ++i) { const int c = i * 512 + tid; nrv[i] = *(const u32x4*)(p.proj + (row0_ + (c >> 4)) * LD1 + 1536 + h_ * 128 + (c & 15) * 8); } } while (0)
#define GX_BAR() do { asm volatile("s_waitcnt lgkmcnt(0)" ::: "memory"); __builtin_amdgcn_s_barrier(); asm volatile("" ::: "memory"); } while (0)
    if ((int)blockIdx.x < (NTOK / 64) * 4) GX_LOAD(blockIdx.x);
    for (int it = blockIdx.x; it < (NTOK / 64) * 4; it += gridDim.x) {
        const int h = it & 3, ck = it >> 2;
        const size_t row0 = (size_t)ck * 64;
        float bc[8], qv[8], kv[8]; u32x4 rvv[2];
#pragma unroll
        for (int i = 0; i < 8; ++i) { bc[i] = nbc[i]; qv[i] = bf2f(nq[i]); kv[i] = bf2f(nk[i]); }
        rvv[0] = nrv[0]; rvv[1] = nrv[1];
        if (it + (int)gridDim.x < (NTOK / 64) * 4) GX_LOAD(it + gridDim.x);
#pragma unroll
        for (int i = 1; i < 8; ++i) bc[i] += bc[i - 1];
        ((LAS float*)(lds + GX_SEG))[w * 64 + lane] = bc[7];
#pragma unroll
        for (int i = 0; i < 2; ++i) { const int c = i * 512 + tid; *(LAS u32x4*)(lds + GX_V + ((c >> 4) * GL_VS + (c & 15) * 8) * 2) = rvv[i]; }
        GX_BAR();
        float off = 0.f, bl = 0.f;
#pragma unroll
        for (int ww = 0; ww < 8; ++ww) { const float sg = ((const LAS float*)(lds + GX_SEG))[ww * 64 + lane]; bl += sg; off += (ww < w) ? sg : 0.f; }
#pragma unroll
        for (int i = 0; i < 8; ++i) {
            const float x = bc[i] + off, eb = __expf(x);
            const int o = ((8 * w + i) * GL_QS + lane) * 2;
            *(LAS bf16_t*)(lds + GX_QD + o) = f2bf(qv[i] * 0.125f * eb); *(LAS bf16_t*)(lds + GX_KD + o) = f2bf(kv[i] * __builtin_amdgcn_rcpf(eb)); *(LAS bf16_t*)(lds + GX_KE + o) = f2bf(kv[i] * __expf(bl - x));
        }
        if (w == 0) p.gdec[(size_t)ck * 256 + h * 64 + lane] = __expf(bl);
        GX_BAR();
        { const int o = ((tid >> 3) * GL_QS + (tid & 7) * 8) * 2; const size_t go = (row0 + (tid >> 3)) * 256 + h * 64 + (tid & 7) * 8;
          *(u32x4*)(p.gqd + go) = *(const LAS u32x4*)(lds + GX_QD + o); *(u32x4*)(p.gkd + go) = *(const LAS u32x4*)(lds + GX_KD + o); }
        bf16x8 vN[2];
#pragma unroll
        for (int ks = 0; ks < 2; ++ks) {
            const s16x4 lo = vtr(lds + GX_V + ((32 * ks + 8 * g + tq) * GL_VS + 16 * w + 4 * tp) * 2), hi4 = vtr(lds + GX_V + ((32 * ks + 8 * g + 4 + tq) * GL_VS + 16 * w + 4 * tp) * 2);
            vN[ks] = (bf16x8){lo[0], lo[1], lo[2], lo[3], hi4[0], hi4[1], hi4[2], hi4[3]};
        }
        bf16_t* kvo = p.gkv + ((size_t)it * 64) * 128 + 16 * w + l15;
#pragma unroll
        for (int dkt = 0; dkt < 4; ++dkt) {
            f32x4 sc = (f32x4){0.f, 0.f, 0.f, 0.f};
#pragma unroll
            for (int ks = 0; ks < 2; ++ks) {
                const s16x4 lo = vtr(lds + GX_KE + ((32 * ks + 8 * g + tq) * GL_QS + 16 * dkt + 4 * tp) * 2), hi4 = vtr(lds + GX_KE + ((32 * ks + 8 * g + 4 + tq) * GL_QS + 16 * dkt + 4 * tp) * 2);
                const bf16x8 keT = (bf16x8){lo[0], lo[1], lo[2], lo[3], hi4[0], hi4[1], hi4[2], hi4[3]};
                sc = __builtin_amdgcn_mfma_f32_16x16x32_bf16(keT, vN[ks], sc, 0, 0, 0);
            }
#pragma unroll
            for (int j = 0; j < 4; ++j) kvo[(size_t)(16 * dkt + 4 * g + j) * 128] = f2bf(sc[j]);
        }
        GX_BAR();
    }
#undef GX_LOAD
#undef GX_BAR
}
DI void ph_gla_scan(const P& p) {
    const int tid = tid_();
    for (int gid = blockIdx.x * NTHR + tid; gid < 64 * 64 * 32; gid += gridDim.x * NTHR) {
        const int dvq = gid & 31, dk = (gid >> 5) & 63, bh = gid >> 11, b = bh >> 2, h = bh & 3;
        float st[4] = {0.f, 0.f, 0.f, 0.f};
        const size_t e0 = (((size_t)b * 64 * 4 + h) * 64 + dk) * 128 + dvq * 4;
        const float* dc = p.gdec + (size_t)b * 64 * 256 + h * 64 + dk;
#pragma unroll 8
        for (int n = 0; n < 64; ++n) {
            const size_t e = e0 + (size_t)n * (4 * 64 * 128);
            const u32x2 kvv = *(const u32x2*)(p.gkv + e); const float d = dc[(size_t)n * 256];
            u32x2 o; o.x = pk2(st[0], st[1]); o.y = pk2(st[2], st[3]);
            *(u32x2*)(p.gst + e) = o;
            st[0] = st[0] * d + __uint_as_float(kvv.x << 16); st[1] = st[1] * d + __uint_as_float(kvv.x & 0xffff0000u);
            st[2] = st[2] * d + __uint_as_float(kvv.y << 16); st[3] = st[3] * d + __uint_as_float(kvv.y & 0xffff0000u);
        }
    }
}

constexpr int NCLS = 112;
DI void ph_router(const P& p, int l, LAS unsigned char* lds) {
    const int tid = tid_(); const int lane = tid & 63, wid = tid >> 6, fr = lane & 15, fq = lane >> 4;
    LAS float* lg = (LAS float*)lds + wid * (32 * 65);
    const bf16_t* W = p.wt_r + (size_t)l * 64 * 1024;
    LAS int* hist = (LAS int*)(lds + 8 * 32 * 65 * 4);
    if (tid < 128) hist[tid] = 0;
    __syncthreads();
    const size_t o = (size_t)l * NTOK;
    for (int mt = blockIdx.x * NWAVE + wid; mt < NTOK / 32; mt += gridDim.x * NWAVE) {
        const int m0 = mt * 32;
        const bf16_t* ap[2]; const bf16_t* bp[4];
#pragma unroll
        for (int i = 0; i < 2; ++i) ap[i] = p.xa + (size_t)(m0 + 16 * i + fr) * D + fq * 8;
#pragma unroll
        for (int j = 0; j < 4; ++j) bp[j] = W + (size_t)(16 * j + fr) * 1024 + fq * 8;
        f32x4 acc[2][4];
#pragma unroll
        for (int i = 0; i < 2; ++i)
#pragma unroll
            for (int j = 0; j < 4; ++j) acc[i][j] = (f32x4){0.f, 0.f, 0.f, 0.f};
        for (int k = 0; k < 1024; k += 32) {
            bf16x8 a[2], b[4];
#pragma unroll
            for (int i = 0; i < 2; ++i) a[i] = *(const bf16x8*)(ap[i] + k);
#pragma unroll
            for (int j = 0; j < 4; ++j) b[j] = *(const bf16x8*)(bp[j] + k);
#pragma unroll
            for (int i = 0; i < 2; ++i)
#pragma unroll
                for (int j = 0; j < 4; ++j) acc[i][j] = __builtin_amdgcn_mfma_f32_16x16x32_bf16(b[j], a[i], acc[i][j], 0, 0, 0);
        }
#pragma unroll
        for (int i = 0; i < 2; ++i)
#pragma unroll
            for (int j = 0; j < 4; ++j)
#pragma unroll
                for (int e = 0; e < 4; ++e) lg[(16 * i + fr) * 65 + 16 * j + 4 * fq + e] = acc[i][j][e];
        asm volatile("s_waitcnt lgkmcnt(0)" ::: "memory");
        if (lane < 32) {
            const LAS float* r = lg + lane * 65; const int tok = m0 + lane;
            float gl[4]; int gs = 0;
#pragma unroll
            for (int j = 0; j < 4; ++j) gl[j] = r[j] + p.moe_b_group[l * 4 + j];
            float gmax = gl[0];
#pragma unroll
            for (int j = 1; j < 4; ++j) if (gl[j] > gmax) { gmax = gl[j]; gs = j; }
            float den = 0.f;
#pragma unroll
            for (int j = 0; j < 4; ++j) den += __expf(gl[j] - gmax);
            const float pg = 1.f / den;
            float el[8];
#pragma unroll
            for (int j = 0; j < 8; ++j) el[j] = r[4 + gs * 8 + j] + p.moe_b_expert[l * 32 + gs * 8 + j];
            int i1 = 0; float v1 = el[0];
#pragma unroll
            for (int j = 1; j < 8; ++j) if (el[j] > v1) { v1 = el[j]; i1 = j; }
            int i2 = -1; float v2 = -INFINITY;
#pragma unroll
            for (int j = 0; j < 8; ++j) if (j != i1 && el[j] > v2) { v2 = el[j]; i2 = j; }
            const float e2 = __expf(v2 - v1);
            const float w1 = pg / (1.f + e2), w2 = pg * e2 / (1.f + e2);
            const int lo = i1 < i2 ? i1 : i2, hi = i1 < i2 ? i2 : i1;
            const int cls = gs * 28 + (lo * (15 - lo)) / 2 + (hi - lo - 1);
            const int pos = __hip_atomic_fetch_add(hist + cls, 1, __ATOMIC_RELAXED, __HIP_MEMORY_SCOPE_WORKGROUP);
            p.tope[o + tok] = cls; p.toppos[o + tok] = pos;
            p.topw[2 * (o + tok)] = (i1 < i2) ? w1 : w2; p.topw[2 * (o + tok) + 1] = (i1 < i2) ? w2 : w1;
        }
        asm volatile("s_waitcnt lgkmcnt(0)" ::: "memory");
    }
    __syncthreads();
    if (tid < 128) p.whist[((size_t)l * 256 + blockIdx.x) * 128 + tid] = hist[tid];
    __syncthreads();
}
DI void ph_slots(const P& p, int l, LAS unsigned char* lds) {
    LAS int* ss = (LAS int*)lds;
    const int tid = tid_();
    const int G = gridDim.x, bx = blockIdx.x;
    if (tid < 128) {
        int tot = 0, pre = 0;
        for (int w = 0; w < G; ++w) { const int v = p.whist[((size_t)l * 256 + w) * 128 + tid]; tot += v; pre += (w < bx) ? v : 0; }
        ss[384 + tid] = tot; ss[tid] = pre;
    }
    __syncthreads();
    if (tid == 0) {
        int start = 0, tile = 0;
        for (int c = 0; c < NCLS; ++c) { const int nt = (ss[384 + c] + 255) >> 8; ss[c] += start; ss[128 + c] = tile; tile += nt; start += nt * 256; }
        ss[256] = tile;
    }
    __syncthreads();
    if (bx == 0) {
        if (tid < NCLS) {
            const int g = tid / 28; int r = tid % 28, lo = 0; while (r >= 7 - lo) { r -= 7 - lo; ++lo; } const int hi = lo + 1 + r;
            const int code = (g * 8 + lo) | ((g * 8 + hi) << 8);
            const int t0 = ss[128 + tid], t1 = (tid == NCLS - 1) ? ss[256] : ss[128 + tid + 1];
            for (int i = t0; i < t1; ++i) p.tile_e[l * 1024 + i] = code;
        }
        if (tid == 0) p.ntile[l] = ss[256];
    }
    const int lane = tid & 63, wid = tid >> 6;
    if (lane < 32)
    for (int mt = bx * NWAVE + wid; mt < NTOK / 32; mt += G * NWAVE) {
        const int tok = mt * 32 + lane;
        const size_t o = (size_t)l * NTOK + tok;
        const int slot = ss[p.tope[o]] + p.toppos[o];
        p.row_tok[(size_t)l * MAXSLOT + slot] = tok + 1;
        p.topslot[o] = slot;
        *(f32x2_t*)(p.row_w + 2 * ((size_t)l * MAXSLOT + slot)) = *(const f32x2_t*)(p.topw + 2 * o);
    }
    __syncthreads();
}
DI void ph_postnorm(const P& p, int l, int last) {
    const int tid = tid_(); const int lane = tid & 63;
    constexpr int R = 2;
    for (int row0 = (blockIdx.x * NWAVE + (tid >> 6)) * R; row0 < NTOK; row0 += gridDim.x * NWAVE * R) {
        const int b = row0 >> 12;
        const float* g2 = p.mod + ((size_t)l * 16 + b) * 6144 + 5 * 1024;
        int sl[R];
#pragma unroll
        for (int r = 0; r < R; ++r) sl[r] = p.topslot[(size_t)l * NTOK + row0 + r];
        u32x2 yv[R][4], xv[R][4];
#pragma unroll
        for (int r = 0; r < R; ++r)
#pragma unroll
            for (int i = 0; i < 4; ++i) { const int c0 = i * 256 + lane * 4; yv[r][i] = *(const u32x2*)(p.y + (size_t)sl[r] * D + c0); xv[r][i] = *(const u32x2*)(p.xr + (size_t)(row0 + r) * D + c0); }
        f32x4 v[R][4]; float rs[R];
#pragma unroll
        for (int r = 0; r < R; ++r) { float ss = 0.f;
#pragma unroll
            for (int i = 0; i < 4; ++i) {
                const f32x4 gg = *(const f32x4*)(g2 + i * 256 + lane * 4);
                v[r][i][0] = __uint_as_float(xv[r][i].x << 16) + gg[0] * __uint_as_float(yv[r][i].x << 16);
                v[r][i][1] = __uint_as_float(xv[r][i].x & 0xffff0000u) + gg[1] * __uint_as_float(yv[r][i].x & 0xffff0000u);
                v[r][i][2] = __uint_as_float(xv[r][i].y << 16) + gg[2] * __uint_as_float(yv[r][i].y << 16);
                v[r][i][3] = __uint_as_float(xv[r][i].y & 0xffff0000u) + gg[3] * __uint_as_float(yv[r][i].y & 0xffff0000u);
                ss += v[r][i][0] * v[r][i][0] + v[r][i][1] * v[r][i][1] + v[r][i][2] * v[r][i][2] + v[r][i][3] * v[r][i][3];
            }
            rs[r] = rsqrtf(wave_sum(ss) * (1.f / D) + EPS); }
        if (last) {
#pragma unroll
            for (int i = 0; i < 4; ++i) { const int c0 = i * 256 + lane * 4; const f32x4 gg = *(const f32x4*)(p.final_norm_g + c0);
#pragma unroll
                for (int r = 0; r < R; ++r) *(f32x4*)(p.out + (size_t)(row0 + r) * D + c0) = v[r][i] * rs[r] * gg; }
        } else {
            const float* md = p.mod + ((size_t)(l + 1) * 16 + b) * 6144;
            const float* g = p.norm_mix_g + (l + 1) * D;
#pragma unroll
            for (int i = 0; i < 4; ++i) {
                const int c0 = i * 256 + lane * 4;
                const f32x4 gg = *(const f32x4*)(g + c0), sh = *(const f32x4*)(md + c0), sc = *(const f32x4*)(md + 1024 + c0);
#pragma unroll
                for (int r = 0; r < R; ++r) {
                    u32x2 xw; xw.x = pk2(v[r][i][0], v[r][i][1]); xw.y = pk2(v[r][i][2], v[r][i][3]);
                    *(u32x2*)(p.xr + (size_t)(row0 + r) * D + c0) = xw;
                    float oo[4];
#pragma unroll
                    for (int e = 0; e < 4; ++e) oo[e] = v[r][i][e] * rs[r] * gg[e] * (1.f + sc[e]) + sh[e];
                    u32x2 w; w.x = pk2(oo[0], oo[1]); w.y = pk2(oo[2], oo[3]);
                    *(u32x2*)(p.xa + (size_t)(row0 + r) * D + c0) = w;
                }
            }
        }
    }
}

namespace at2 {
using bf16=bf16_t;
constexpr int SEQ=4096,D=64,DM=1024,QP=768,KP=512,PP=32;
constexpr int NW=8,QBLK=32,QB=QBLK*NW,KVBLK=64,NQB=SEQ/QB;
#define SBAR() __builtin_amdgcn_sched_barrier(0)
__device__ __forceinline__ void cmask(f32x16&p0,f32x16&p1,int jb,int qrel,int hi){
  const float NEG=-INFINITY; int kb=64*jb+4*hi;
  #pragma unroll
  for(int r=0;r<16;++r){int kv=kb+(r&3)+8*(r>>2); if(kv>qrel)p0[r]=NEG; if(kv+32>qrel)p1[r]=NEG;}
}

constexpr int NSLOT=3, SLOTB=8192;
constexpr int LDS_K=0, LDS_V=NSLOT*SLOTB, LDS_P=2*NSLOT*SLOTB, PSLOTB=4096, LDS_WS=LDS_P+4*PSLOTB, LDS_OST=LDS_WS+NW*64*4, LDS_BYTES=LDS_OST+NW*4096;
__device__ __forceinline__ void glds16(const void*gsrc,unsigned lds_dst){unsigned keep;
  asm volatile("s_mov_b32 %0, m0\n\ts_mov_b32 m0, %2\n\ts_nop 0\n\tglobal_load_lds_dwordx4 %1, off\n\ts_mov_b32 m0, %0":"=&s"(keep):"v"(gsrc),"s"(lds_dst):"memory");}
__device__ __forceinline__ float max3f(float a,float b,float c){float r;asm("v_max3_f32 %0, %1, %2, %3":"=v"(r):"v"(a),"v"(b),"v"(c));return r;}
__device__ __forceinline__ float max2f(float a,float b){float r;asm("v_max_f32_e32 %0, %1, %2":"=v"(r):"v"(a),"v"(b));return r;}
__device__ __forceinline__ float fadd_s(float a,float b){float r;asm("v_add_f32_e32 %0, %1, %2":"=v"(r):"v"(a),"v"(b));return r;}
__device__ __forceinline__ float fsub_s(float a,float b){float r;asm("v_sub_f32_e32 %0, %1, %2":"=v"(r):"v"(a),"v"(b));return r;}
__device__ __forceinline__ unsigned cvtpk_s(float lo,float hi){return cvtpk(lo,hi);}
#define WAIT_BAR(N) asm volatile("s_waitcnt vmcnt(" #N ") lgkmcnt(0)\n\ts_barrier":::"memory")

__device__ __forceinline__ void qkt(f32x16&p0,f32x16&p1,const char*Kslot,const char*Pslot,const bf16x8*qr,const f32x16&negm,int r32,int hi){
  const char*kb=Kslot+hi*1024+r32*16; const char*pb=Pslot+hi*1024+r32*16;
  #pragma unroll
  for(int d0=0;d0<6;++d0){
    const char*src=(d0<4)?kb+d0*2048:pb+(d0-4)*2048;
    const bf16x8 b0=*reinterpret_cast<const bf16x8*>(src);
    const bf16x8 b1=*reinterpret_cast<const bf16x8*>(src+512);
    if(d0==0){p0=__builtin_amdgcn_mfma_f32_32x32x16_bf16(b0,qr[0],negm,0,0,0);p1=__builtin_amdgcn_mfma_f32_32x32x16_bf16(b1,qr[0],negm,0,0,0);}
    else{p0=__builtin_amdgcn_mfma_f32_32x32x16_bf16(b0,qr[d0],p0,0,0,0);p1=__builtin_amdgcn_mfma_f32_32x32x16_bf16(b1,qr[d0],p1,0,0,0);}}
}
typedef __attribute__((address_space(3))) const char* lds_cptr;
__device__ __forceinline__ void kload8(bf16x8*kf,lds_cptr kp){
  kf[0]=*(const __attribute__((address_space(3))) bf16x8*)(kp);      kf[1]=*(const __attribute__((address_space(3))) bf16x8*)(kp+512);
  kf[2]=*(const __attribute__((address_space(3))) bf16x8*)(kp+2048); kf[3]=*(const __attribute__((address_space(3))) bf16x8*)(kp+2560);
  kf[4]=*(const __attribute__((address_space(3))) bf16x8*)(kp+4096); kf[5]=*(const __attribute__((address_space(3))) bf16x8*)(kp+4608);
  kf[6]=*(const __attribute__((address_space(3))) bf16x8*)(kp+6144); kf[7]=*(const __attribute__((address_space(3))) bf16x8*)(kp+6656);
}
__device__ __forceinline__ void kload2(bf16x8*kf,lds_cptr kp,int j){ kf[2*j]=*(const __attribute__((address_space(3))) bf16x8*)(kp+j*2048); kf[2*j+1]=*(const __attribute__((address_space(3))) bf16x8*)(kp+j*2048+512); }
__device__ __forceinline__ s16x4 vtr(lds_cptr p){ return __builtin_bit_cast(s16x4,__builtin_amdgcn_ds_read_tr16_b64_v4i16((__attribute__((address_space(3))) v4i16_t*)p)); }
__device__ __forceinline__ float rowmax(const f32x16&p0,const f32x16&p1){
  float a=max3f(p0[0],p0[1],p1[0]),b=max3f(p0[2],p0[3],p1[1]);a=max3f(a,p1[2],p1[3]);
  #pragma unroll
  for(int r=4;r<16;r+=4){a=max3f(a,p0[r],p0[r+1]);b=max3f(b,p0[r+2],p0[r+3]);a=max3f(a,p1[r],p1[r+1]);b=max3f(b,p1[r+2],p1[r+3]);}
  const float m=max2f(a,b);
  auto rr=__builtin_amdgcn_permlane32_swap(__float_as_uint(m),__float_as_uint(m),false,false);
  return max2f(__uint_as_float(rr[0]),__uint_as_float(rr[1]));
}
__device__ __forceinline__ void pv(f32x16*o,int vb,bf16x8 pa0,bf16x8 pa1,bf16x8 pa2,bf16x8 pa3){
  #pragma unroll
  for(int d0=0;d0<2;++d0){s16x4 lo[4],hi[4];
    #pragma unroll
    for(int ks=0;ks<4;++ks){
      asm volatile("ds_read_b64_tr_b16 %0,%1 offset:%c2":"=&v"(lo[ks]):"v"(vb),"i"(d0*4096+ks*1024):"memory");
      asm volatile("ds_read_b64_tr_b16 %0,%1 offset:%c2":"=&v"(hi[ks]):"v"(vb),"i"(d0*4096+ks*1024+512):"memory");}
    asm volatile("s_waitcnt lgkmcnt(0)":::"memory");SBAR();
    #define PK(k) (bf16x8){lo[k][0],lo[k][1],lo[k][2],lo[k][3],hi[k][0],hi[k][1],hi[k][2],hi[k][3]}
    o[d0]=__builtin_amdgcn_mfma_f32_32x32x16_bf16(pa0,PK(0),o[d0],0,0,0);
    o[d0]=__builtin_amdgcn_mfma_f32_32x32x16_bf16(pa1,PK(1),o[d0],0,0,0);
    o[d0]=__builtin_amdgcn_mfma_f32_32x32x16_bf16(pa2,PK(2),o[d0],0,0,0);
    o[d0]=__builtin_amdgcn_mfma_f32_32x32x16_bf16(pa3,PK(3),o[d0],0,0,0);
    #undef PK
  }
}

#ifndef ATTN_STORE16
#define ATTN_STORE16(p,v) (*(u32x4*)(p)=(v))
#endif
template<int THRL> __device__ __forceinline__ void attn_unit(int tid,int b,int h,int qb,const bf16*Q,const bf16*__restrict__ K,const bf16*__restrict__ V,const bf16*__restrict__ KPE,bf16*O,char*shm){
  const int lane=tid&63,r32=lane&31,hi=lane>>5; const int wid=__builtin_amdgcn_readfirstlane(tid>>6);
  const long rowbase=(long)b*SEQ; const int q0=qb*QB;
  const bf16*Qw=Q+(rowbase+q0+wid*QBLK)*QP+h*96;
  const bf16*Kh=K+rowbase*KP+h*D,*Vh=V+rowbase*KP+h*D;
  const unsigned lds0=(unsigned)(uintptr_t)shm;
  float*wsf=(float*)(shm+LDS_WS)+wid*64;
  const bf16*ksrc=Kh+(long)lane*KP+wid*8;
  const bf16*vsrc=Vh+(long)(16*(wid&3)+(lane>>2))*KP+(wid>>2)*32+(lane&3)*8;
  const bf16*psrc=KPE+(rowbase+lane)*PP+(wid&3)*8;
  const unsigned kdst=lds0+LDS_K+wid*1024, vdst=lds0+LDS_V+wid*1024, pdst=lds0+LDS_P+(wid&3)*1024;
  #define DMA_K(t,slot) do{ glds16(ksrc+(long)(t)*KVBLK*KP,(unsigned)__builtin_amdgcn_readfirstlane(kdst+(slot))); glds16(psrc+(long)(t)*KVBLK*PP,(unsigned)__builtin_amdgcn_readfirstlane(pdst+((t)&3)*PSLOTB)); }while(0)
  #define DMA_V(t,slot) glds16(vsrc+(long)(t)*KVBLK*KP,(unsigned)__builtin_amdgcn_readfirstlane(vdst+(slot)))
  const int vb0=(int)(lds0+LDS_V)+((lane>>4)&1)*32+(lane&3)*8+(4*hi+((lane&15)>>2))*64;
  const char*Kbase=shm+LDS_K; bf16x8 kf[8];
  const lds_cptr shm3=(lds_cptr)shm; const lds_cptr kp0=shm3+LDS_K+hi*1024+r32*16; const lds_cptr pp0=shm3+LDS_P+hi*1024+r32*16; const lds_cptr vp0=shm3+LDS_V+((lane>>4)&1)*32+(lane&3)*8+(4*hi+((lane&15)>>2))*64;
  const int NT=(q0+QB)/KVBLK;
  DMA_K(0,0);DMA_V(0,0);DMA_K(1,SLOTB);
  bf16x8 qr[6];
  #pragma unroll
  for(int d0=0;d0<6;++d0)qr[d0]=*reinterpret_cast<const bf16x8*>(&Qw[(long)r32*QP+d0*16+hi*8]);
  float mhat=0.f,l_reg=0.f;f32x16 o[2],negm; { float z_; asm volatile("v_mov_b32 %0, 0":"=v"(z_));
    _Pragma("unroll") for(int r=0;r<16;++r){o[0][r]=z_;o[1][r]=z_;negm[r]=z_;} } asm volatile("":"+v"(negm));
  const int qrel=wid*QBLK+r32;
  #define CMASK(P0,P1,t) do{int jb_=(t)-(NT-4); if(jb_>=0)cmask(P0,P1,jb_,qrel,hi);}while(0)
  bool resc=false;
  #define START(P0,P1) do{ const float rm=rowmax(P0,P1); resc=false; \
    { const float dl=rm; mhat=fadd_s(mhat,dl); \
      _Pragma("unroll") for(int r=0;r<16;++r){P0[r]=fsub_s(P0[r],dl);P1[r]=fsub_s(P1[r],dl);} \
      _Pragma("unroll") for(int r=0;r<16;++r)negm[r]=-mhat; asm volatile("":"+v"(negm)); } \
    _Pragma("unroll") for(int r=0;r<16;++r)P0[r]=__builtin_amdgcn_exp2f(P0[r]); }while(0)
  #define RESC() do{ if(resc){ asm volatile("s_waitcnt lgkmcnt(0)":::"memory"); \
      _Pragma("unroll") for(int d_=0;d_<2;++d_) _Pragma("unroll") for(int r=0;r<16;++r)o[d_][r]*=wsf[crow(r,hi)]; } }while(0)
  f32x16 pA0,pA1,pB0,pB1;
  int sl_prev=0,sl_cur=0,sl_next=SLOTB;
  #define ROT() do{sl_prev=sl_cur;sl_cur=sl_next;sl_next=(sl_next==(NSLOT-1)*SLOTB)?0:sl_next+SLOTB;}while(0)
  DMA_K(2,2*SLOTB);
  WAIT_BAR(4);
  qkt(pA0,pA1,Kbase,shm+LDS_P,qr,negm,r32,hi);asm volatile("s_nop 15\n\ts_nop 7":"+v"(pA0),"+v"(pA1));CMASK(pA0,pA1,0);
  START(pA0,pA1);
  _Pragma("unroll") for(int r=0;r<16;++r)pA1[r]=__builtin_amdgcn_exp2f(pA1[r]);
  WAIT_BAR(0);
  DMA_K(3,0);DMA_V(1,SLOTB);
  ROT();
  kload8(kf,kp0+sl_cur);
  WAIT_BAR(3);
  s16x4 vlo[8],vhi[8]; u32x4 pw0,pw1,pw2,pw3;
  #define PKW(P,B) cvtpk_s(P[B],P[B+1])
  #define PAF(k) __builtin_bit_cast(bf16x8,pw##k)
  #define VFR(i) (bf16x8){vlo[i][0],vlo[i][1],vlo[i][2],vlo[i][3],vhi[i][0],vhi[i][1],vhi[i][2],vhi[i][3]}
  #define PIN(x) asm volatile("":"+v"(x))
  #define MX3(a,b,c) __builtin_fmaxf(__builtin_fmaxf((a),(b)),(c))
  #define GAPA(MF,A0,A1,A2,A3,W0,W1,PW) do{ MF; sacc+=A0; sacc+=A1; sacc+=A2; sacc+=A3; PIN(sacc); W0; W1; PIN(PW); SBAR(); }while(0)
  #define EX(v) __builtin_amdgcn_exp2f(v)
  #define GAPB(MF,X,B) do{ MF; X[B]=EX(X[B]); X[B+1]=EX(X[B+1]); X[B+2]=EX(X[B+2]); X[B+3]=EX(X[B+3]); PIN(X); SBAR(); }while(0)
  #define VRD(i) do{ vlo[i]=vtr(vp_+(((i)>>2)*4096+((i)&3)*1024)); vhi[i]=vtr(vp_+(((i)>>2)*4096+((i)&3)*1024+512)); }while(0)
  #define KRD(G,j) do{ if(G){ kload2(kf,kp0+sl_next,j); SBAR(); } }while(0)
  #define STEP(C0,C1,P0,P1,t,GK,GV,GL) do{ SBAR(); \
    const lds_cptr vp_=vp0+sl_prev; const lds_cptr pq_=pp0+((t)&3)*PSLOTB; \
    const bf16x8 kq0=*(const __attribute__((address_space(3))) bf16x8*)(pq_), kq1=*(const __attribute__((address_space(3))) bf16x8*)(pq_+512), kq2=*(const __attribute__((address_space(3))) bf16x8*)(pq_+2048), kq3=*(const __attribute__((address_space(3))) bf16x8*)(pq_+2560); SBAR(); \
    VRD(0); SBAR(); float sacc=(P0[0]+P0[1]); \
    GAPA(C0=__builtin_amdgcn_mfma_f32_32x32x16_bf16(kf[0],qr[0],negm,0,0,0), P0[2],P0[3],P0[4],P0[5],     pw0[0]=PKW(P0,0), pw0[1]=PKW(P0,2), pw0); \
    VRD(4); SBAR(); GAPA(C1=__builtin_amdgcn_mfma_f32_32x32x16_bf16(kf[1],qr[0],negm,0,0,0), P0[6],P0[7],P0[8],P0[9],     pw0[2]=PKW(P0,4), pw0[3]=PKW(P0,6), pw0); \
    VRD(1); SBAR(); GAPA(C0=__builtin_amdgcn_mfma_f32_32x32x16_bf16(kf[2],qr[1],C0,0,0,0),   P0[10],P0[11],P0[12],P0[13], pw1[0]=PKW(P0,8), pw1[1]=PKW(P0,10), pw1); \
    VRD(5); SBAR(); GAPA(C1=__builtin_amdgcn_mfma_f32_32x32x16_bf16(kf[3],qr[1],C1,0,0,0),   P0[14],P0[15],P1[0],P1[1],   pw1[2]=PKW(P0,12),pw1[3]=PKW(P0,14), pw1); \
    VRD(2); SBAR(); GAPA(C0=__builtin_amdgcn_mfma_f32_32x32x16_bf16(kf[4],qr[2],C0,0,0,0),   P1[2],P1[3],P1[4],P1[5],     pw2[0]=PKW(P1,0), pw2[1]=PKW(P1,2), pw2); \
    VRD(6); SBAR(); GAPA(C1=__builtin_amdgcn_mfma_f32_32x32x16_bf16(kf[5],qr[2],C1,0,0,0),   P1[6],P1[7],P1[8],P1[9],     pw2[2]=PKW(P1,4), pw2[3]=PKW(P1,6), pw2); \
    VRD(3); SBAR(); GAPA(C0=__builtin_amdgcn_mfma_f32_32x32x16_bf16(kf[6],qr[3],C0,0,0,0),   P1[10],P1[11],P1[12],P1[13], pw3[0]=PKW(P1,8), pw3[1]=PKW(P1,10), pw3); \
    VRD(7); SBAR(); GAPA(C1=__builtin_amdgcn_mfma_f32_32x32x16_bf16(kf[7],qr[3],C1,0,0,0),   P1[14],P1[15],0.f,0.f,       pw3[2]=PKW(P1,12),pw3[3]=PKW(P1,14), pw3); \
    C0=__builtin_amdgcn_mfma_f32_32x32x16_bf16(kq0,qr[4],C0,0,0,0); C1=__builtin_amdgcn_mfma_f32_32x32x16_bf16(kq1,qr[4],C1,0,0,0); \
    C0=__builtin_amdgcn_mfma_f32_32x32x16_bf16(kq2,qr[5],C0,0,0,0); C1=__builtin_amdgcn_mfma_f32_32x32x16_bf16(kq3,qr[5],C1,0,0,0); SBAR(); \
    l_reg+=sacc; \
    if(GK){DMA_K((t)+3,sl_cur);} if(GV){DMA_V((t)+1,sl_next);} \
    CMASK(C0,C1,t); \
    { float a=MX3(C0[0],C0[1],C1[0]),b=MX3(C0[2],C0[3],C1[1]); a=MX3(a,C1[2],C1[3]); \
      _Pragma("unroll") for(int r=4;r<16;r+=4){a=MX3(a,C0[r],C0[r+1]);b=MX3(b,C0[r+2],C0[r+3]);a=MX3(a,C1[r],C1[r+1]);b=MX3(b,C1[r+2],C1[r+3]);} \
      float rm=__builtin_fmaxf(a,b); { auto rr=__builtin_amdgcn_permlane32_swap(__float_as_uint(rm),__float_as_uint(rm),false,false); rm=__builtin_fmaxf(__uint_as_float(rr[0]),__uint_as_float(rr[1])); } \
      resc=false; \
      if(__builtin_expect(__any(rm>(float)THRL),0)){ const float dl=__builtin_fmaxf(rm,0.f); mhat+=dl; \
        _Pragma("unroll") for(int r=0;r<16;++r){C0[r]-=dl;C1[r]-=dl;} \
        _Pragma("unroll") for(int r=0;r<16;++r)negm[r]=-mhat; asm volatile("":"+v"(negm)); \
        const float f=__builtin_amdgcn_exp2f(-dl); l_reg*=f; if(hi==0)wsf[r32]=f; resc=true; } } \
    SBAR(); \
    GAPB(o[0]=__builtin_amdgcn_mfma_f32_32x32x16_bf16(PAF(0),VFR(0),o[0],0,0,0), C0,0); \
    GAPB(o[1]=__builtin_amdgcn_mfma_f32_32x32x16_bf16(PAF(0),VFR(4),o[1],0,0,0), C0,4); \
    KRD(GL,0); GAPB(o[0]=__builtin_amdgcn_mfma_f32_32x32x16_bf16(PAF(1),VFR(1),o[0],0,0,0), C0,8); \
    KRD(GL,1); GAPB(o[1]=__builtin_amdgcn_mfma_f32_32x32x16_bf16(PAF(1),VFR(5),o[1],0,0,0), C0,12); \
    KRD(GL,2); GAPB(o[0]=__builtin_amdgcn_mfma_f32_32x32x16_bf16(PAF(2),VFR(2),o[0],0,0,0), C1,0); \
    KRD(GL,3); GAPB(o[1]=__builtin_amdgcn_mfma_f32_32x32x16_bf16(PAF(2),VFR(6),o[1],0,0,0), C1,4); \
    GAPB(o[0]=__builtin_amdgcn_mfma_f32_32x32x16_bf16(PAF(3),VFR(3),o[0],0,0,0), C1,8); \
    GAPB(o[1]=__builtin_amdgcn_mfma_f32_32x32x16_bf16(PAF(3),VFR(7),o[1],0,0,0), C1,12); \
    }while(0)
  int t=1;
  #undef CMASK
  #define CMASK(P0,P1,t) do{}while(0)
  for(;t+5<NT;t+=2){
    STEP(pB0,pB1,pA0,pA1,t,true,true,true);     WAIT_BAR(3); RESC(); ROT();
    STEP(pA0,pA1,pB0,pB1,t+1,true,true,true);   WAIT_BAR(3); RESC(); ROT();
  }
  #undef CMASK
  #define CMASK(P0,P1,t) do{int jb_=(t)-(NT-4); if(jb_>=0)cmask(P0,P1,jb_,qrel,hi);}while(0)
  #define ENDW(tt) do{ if((tt)+3<NT){WAIT_BAR(3);} else if((tt)+2<NT){WAIT_BAR(1);} else {WAIT_BAR(0);} }while(0)
  for(;t+1<NT;t+=2){
    STEP(pB0,pB1,pA0,pA1,t,(t+3<NT),(t+1<NT),(t+1<NT));       ENDW(t);   RESC(); ROT();
    STEP(pA0,pA1,pB0,pB1,t+1,(t+4<NT),(t+2<NT),(t+2<NT));     ENDW(t+1); RESC(); ROT();
  }
  STEP(pB0,pB1,pA0,pA1,NT-1,false,false,false); RESC();
  { float sacc=pB0[0]+pB0[1]; _Pragma("unroll") for(int r=2;r<16;++r)sacc+=pB0[r]; _Pragma("unroll") for(int r=0;r<16;++r)sacc+=pB1[r]; l_reg+=sacc;
    pw0=(u32x4){PKW(pB0,0),PKW(pB0,2),PKW(pB0,4),PKW(pB0,6)};pw1=(u32x4){PKW(pB0,8),PKW(pB0,10),PKW(pB0,12),PKW(pB0,14)};pw2=(u32x4){PKW(pB1,0),PKW(pB1,2),PKW(pB1,4),PKW(pB1,6)};pw3=(u32x4){PKW(pB1,8),PKW(pB1,10),PKW(pB1,12),PKW(pB1,14)};
    SBAR(); pv(o,vb0+sl_cur,PAF(0),PAF(1),PAF(2),PAF(3)); }
  #undef PKW
  #undef PAF
  #undef VFR
  #undef PIN
  #undef MX3
  #undef GAPA
  #undef GAPB
  #undef EX
  #undef VRD
  #undef KRD
  #undef STEP
  #undef ENDW
  {auto rr=__builtin_amdgcn_permlane32_swap(__float_as_uint(l_reg),__float_as_uint(l_reg),false,false);l_reg=__uint_as_float(rr[0])+__uint_as_float(rr[1]);}
  if(hi==0)wsf[32+r32]=l_reg;asm volatile("s_waitcnt lgkmcnt(0)":::"memory");
  float rli[16];
  #pragma unroll
  for(int r=0;r<16;++r)rli[r]=__builtin_amdgcn_rcpf(wsf[32+crow(r,hi)]);
  bf16*Ow=O+(rowbase+q0+wid*QBLK)*DM+h*D;
  { bf16*stg=(bf16*)(shm+LDS_OST)+wid*2048;
    #pragma unroll
    for(int r=0;r<16;++r){const int orow=crow(r,hi);
      #pragma unroll
      for(int d0=0;d0<2;++d0)stg[orow*64+d0*32+r32]=f2bf(o[d0][r]*rli[r]);}
    asm volatile("s_waitcnt lgkmcnt(0)":::"memory");
    #pragma unroll
    for(int i=0;i<4;++i){const int row=i*8+(lane>>3),ch=lane&7; const u32x4 v=*(const u32x4*)(stg+row*64+ch*8); ATTN_STORE16(Ow+(long)row*DM+ch*8,v);} }
  asm volatile("s_waitcnt lgkmcnt(0)\n\ts_barrier":::"memory");
  #undef DMA_K
  #undef DMA_V
  #undef CMASK
  #undef START
  #undef RESC
  #undef ROT
}
#undef SBAR
#undef WAIT_BAR
}

static_assert(at2::LDS_BYTES <= LDS_WTAB, "attention LDS map");
DI void ph_attn(const P& p, LAS unsigned char* lds) {
    const int G = gridDim.x, bx = blockIdx.x;
    const int vcu = (G % 8 == 0) ? (bx % 8) * (G / 8) + bx / 8 : bx;
#pragma unroll 1
    for (int u = vcu * 8; u < 2048; u += ((u & 7) == 7) ? (G * 8 - 7) : 1) {
        const int grp = u >> 3, i = u & 7;
        const int bh = grp >> 1, par = grp & 1;
        const int s = 2 * (i >> 1) + par;
        const int qb = (i & 1) ? 15 - s : s;
        at2::attn_unit<8>(tid_(), bh >> 3, bh & 7, qb, p.q, p.kn, p.v, p.kpe, p.mix, (char*)lds);
    }
}

constexpr int GZ_QD = 0, GZ_KD = 64 * GL_QS * 2, GZ_V = 2 * GZ_KD, GZ_S = GZ_V + 64 * GL_VS * 2, GZ_BUF = GZ_S + 64 * GL_VS * 2, GZ_PART = 2 * GZ_BUF, GZ_END = GZ_PART + 2 * 8 * 64 * 4;
static_assert(GZ_END <= LDS_WTAB, "GLA LDS map");
DI void ph_gla_out(const P& p, LAS unsigned char* lds, int tid) {
    const int lane = tid & 63, w = __builtin_amdgcn_readfirstlane(tid >> 6), l15 = lane & 15, g = lane >> 4, tq = l15 >> 2, tp = l15 & 3;
    const int G = gridDim.x, bx = blockIdx.x, NIT = (NTOK / 64) * 4;
    u32x4 rqd, rkd, rvv[2], rss[2];
#define GZ_LOAD(it_) do { const int h_ = (it_) & 3; const size_t row0_ = (size_t)((it_) >> 2) * 64; \
        const size_t o_ = (row0_ + (tid >> 3)) * 256 + h_ * 64 + (tid & 7) * 8; rqd = *(const u32x4*)(p.gqd + o_); rkd = *(const u32x4*)(p.gkd + o_); \
        _Pragma("unroll") for (int i_ = 0; i_ < 2; ++i_) { const int c_ = i_ * 512 + tid; rvv[i_] = *(const u32x4*)(p.proj + (row0_ + (c_ >> 4)) * LD1 + 1536 + h_ * 128 + (c_ & 15) * 8); \
            rss[i_] = *(const u32x4*)(p.gst + ((size_t)(it_) * 64 + (c_ >> 4)) * 128 + (c_ & 15) * 8); } } while (0)
#define GZ_STAGE(buf) do { LAS unsigned char* B_ = lds + (buf) * GZ_BUF; const int o_ = ((tid >> 3) * GL_QS + (tid & 7) * 8) * 2; \
        *(LAS u32x4*)(B_ + GZ_QD + o_) = rqd; *(LAS u32x4*)(B_ + GZ_KD + o_) = rkd; \
        _Pragma("unroll") for (int i_ = 0; i_ < 2; ++i_) { const int c_ = i_ * 512 + tid; const int vo_ = ((c_ >> 4) * GL_VS + (c_ & 15) * 8) * 2; *(LAS u32x4*)(B_ + GZ_V + vo_) = rvv[i_]; *(LAS u32x4*)(B_ + GZ_S + vo_) = rss[i_]; } } while (0)
#define GZ_BAR() do { asm volatile("s_waitcnt lgkmcnt(0)" ::: "memory"); __builtin_amdgcn_s_barrier(); asm volatile("" ::: "memory"); } while (0)
    if (bx < NIT) { GZ_LOAD(bx); GZ_STAGE(0); if (bx + G < NIT) GZ_LOAD(bx + G); }
    int k = 0;
    for (int it = bx; it < NIT; it += G, ++k) {
        const int h = it & 3; const size_t row0 = (size_t)(it >> 2) * 64;
        GZ_BAR();
        if (it + G < NIT) { GZ_STAGE((k + 1) & 1); if (it + 2 * G < NIT) GZ_LOAD(it + 2 * G); }
        const LAS unsigned char* B_ = lds + (k & 1) * GZ_BUF;
        u32x2 grv[4];
#pragma unroll
        for (int tt = 0; tt < 4; ++tt) grv[tt] = *(const u32x2*)(p.proj + (row0 + 16 * tt + l15) * LD1 + 2304 + h * 128 + 16 * w + 4 * g);
        const f32x4 gng = *(const f32x4*)(p.gla_norm_g + h * 128 + 16 * w + 4 * g);
        bf16x8 kdA[4][2];
#pragma unroll
        for (int st = 0; st < 4; ++st)
#pragma unroll
            for (int ks = 0; ks < 2; ++ks) kdA[st][ks] = *(const LAS bf16x8*)(B_ + GZ_KD + ((16 * st + l15) * GL_QS + 32 * ks + 8 * g) * 2);
        bf16x8 vP[2], sA[2];
#pragma unroll
        for (int ks = 0; ks < 2; ++ks) {
            { const s16x4 lo = vtr(B_ + GZ_V + ((32 * ks + 4 * g + tq) * GL_VS + 16 * w + 4 * tp) * 2), hi4 = vtr(B_ + GZ_V + ((32 * ks + 16 + 4 * g + tq) * GL_VS + 16 * w + 4 * tp) * 2);
              vP[ks] = (bf16x8){lo[0], lo[1], lo[2], lo[3], hi4[0], hi4[1], hi4[2], hi4[3]}; }
            { const s16x4 lo = vtr(B_ + GZ_S + ((32 * ks + 8 * g + tq) * GL_VS + 16 * w + 4 * tp) * 2), hi4 = vtr(B_ + GZ_S + ((32 * ks + 8 * g + 4 + tq) * GL_VS + 16 * w + 4 * tp) * 2);
              sA[ks] = (bf16x8){lo[0], lo[1], lo[2], lo[3], hi4[0], hi4[1], hi4[2], hi4[3]}; }
        }
        f32x4 otile[4];
        LAS float* PW = (LAS float*)(lds + GZ_PART) + (k & 1) * 512 + w * 64;
#pragma unroll
        for (int tt = 0; tt < 4; ++tt) {
            bf16x8 qdB[2];
#pragma unroll
            for (int ks = 0; ks < 2; ++ks) qdB[ks] = *(const LAS bf16x8*)(B_ + GZ_QD + ((16 * tt + l15) * GL_QS + 32 * ks + 8 * g) * 2);
            f32x4 at[4];
#pragma unroll
            for (int st = 0; st < 4; ++st) {
                at[st] = (f32x4){0.f, 0.f, 0.f, 0.f};
                if (st <= tt) { at[st] = __builtin_amdgcn_mfma_f32_16x16x32_bf16(kdA[st][0], qdB[0], at[st], 0, 0, 0); at[st] = __builtin_amdgcn_mfma_f32_16x16x32_bf16(kdA[st][1], qdB[1], at[st], 0, 0, 0); }
            }
#pragma unroll
            for (int j = 0; j < 4; ++j) if (4 * g + j > l15) at[tt][j] = 0.f;
            f32x4 ot = (f32x4){0.f, 0.f, 0.f, 0.f};
            ot = __builtin_amdgcn_mfma_f32_16x16x32_bf16(sA[0], qdB[0], ot, 0, 0, 0);
            ot = __builtin_amdgcn_mfma_f32_16x16x32_bf16(sA[1], qdB[1], ot, 0, 0, 0);
            { u32x4 ab; ab.x = pk2(at[0][0], at[0][1]); ab.y = pk2(at[0][2], at[0][3]); ab.z = pk2(at[1][0], at[1][1]); ab.w = pk2(at[1][2], at[1][3]);
              ot = __builtin_amdgcn_mfma_f32_16x16x32_bf16(vP[0], __builtin_bit_cast(bf16x8, ab), ot, 0, 0, 0); }
            if (tt >= 2) { u32x4 ab; ab.x = pk2(at[2][0], at[2][1]); ab.y = pk2(at[2][2], at[2][3]); ab.z = pk2(at[3][0], at[3][1]); ab.w = pk2(at[3][2], at[3][3]);
              ot = __builtin_amdgcn_mfma_f32_16x16x32_bf16(vP[1], __builtin_bit_cast(bf16x8, ab), ot, 0, 0, 0); }
            otile[tt] = ot;
            float ss = ot[0] * ot[0] + ot[1] * ot[1] + ot[2] * ot[2] + ot[3] * ot[3];
            ss += __shfl_xor(ss, 16); ss += __shfl_xor(ss, 32);
            if (g == 0) PW[16 * tt + l15] = ss;
        }
        GZ_BAR();
        const LAS float* PT = (const LAS float*)(lds + GZ_PART) + (k & 1) * 512;
#pragma unroll
        for (int tt = 0; tt < 4; ++tt) {
            float ss = 0.f;
#pragma unroll
            for (int ww = 0; ww < 8; ++ww) ss += PT[ww * 64 + 16 * tt + l15];
            const float r = rsqrtf(ss * (1.f / 128.f) + EPS);
            const float g0 = __uint_as_float(grv[tt].x << 16), g1 = __uint_as_float(grv[tt].x & 0xffff0000u), g2 = __uint_as_float(grv[tt].y << 16), g3 = __uint_as_float(grv[tt].y & 0xffff0000u);
            u32x2 o2; o2.x = pk2(silu_f(g0) * (otile[tt][0] * r * gng[0]), silu_f(g1) * (otile[tt][1] * r * gng[1]));
            o2.y = pk2(silu_f(g2) * (otile[tt][2] * r * gng[2]), silu_f(g3) * (otile[tt][3] * r * gng[3]));
            *(u32x2*)(p.mix + (row0 + 16 * tt + l15) * D + 512 + h * 128 + 16 * w + 4 * g) = o2;
        }
    }
    GZ_BAR();
#undef GZ_LOAD
#undef GZ_STAGE
#undef GZ_BAR
}
constexpr int SG_WS = 136, SG_VS = 144, SG_OS = 132;
constexpr int SG_W = 0, SG_V = 128 * SG_WS * 2, SG_O = SG_V + 128 * SG_VS * 2, SG_END = SG_O + 128 * SG_OS * 4;
static_assert(SG_END <= LDS_WTAB, "gMLP LDS map");
DI void ph_sg(const P& p, LAS unsigned char* lds) {
    const int tid = tid_();
    const int G = gridDim.x, bx = blockIdx.x;
    const int nG = 0;
#define MIXREP_SG 1
    const int lane = tid & 63, w = __builtin_amdgcn_readfirstlane(tid >> 6), l15 = lane & 15, gq = lane >> 4, tq = l15 >> 2, tp = l15 & 3;
    int cur_g = -1;
    u32x4 rawv[4], uu[4]; float rvs[4];
#define SG_LOADV(u_) do { const int g_ = (u_) >> 9; const size_t r0_ = (size_t)((u_) & 511) * 128; \
        _Pragma("unroll") for (int it = 0; it < 4; ++it) { const int c = it * 512 + tid, s_ = c >> 4, ch = c & 15; rawv[it] = *(const u32x4*)(p.proj + (r0_ + s_) * LD1 + 512 + g_ * 128 + ch * 8); rvs[it] = p.rv[r0_ + s_]; } } while (0)
#define SG_RAWBAR() do { asm volatile("s_waitcnt lgkmcnt(0)" ::: "memory"); __builtin_amdgcn_s_barrier(); asm volatile("" ::: "memory"); } while (0)
    const int u0 = bx - nG, ustep = G - nG;
    for (int rep = 0; rep < MIXREP_SG; ++rep) {
    if (u0 < 2048) SG_LOADV(u0);
    for (int u = u0; u < 2048; u += ustep) {
        const int g = u >> 9, bn = u & 511; const size_t r0 = (size_t)bn * 128;
        if (g != cur_g) {
            cur_g = g;
#pragma unroll
            for (int it = 0; it < 4; ++it) { const int c = it * 512 + tid, t = c >> 4, ch = c & 15; const float* src = p.sg_w_s + ((size_t)g * 128 + t) * 128 + ch * 8;
                const f32x4 a = *(const f32x4*)src, b = *(const f32x4*)(src + 4); float v[8] = {a[0], a[1], a[2], a[3], b[0], b[1], b[2], b[3]};
#pragma unroll
                for (int e = 0; e < 8; ++e) if (ch * 8 + e > t) v[e] = 0.f;
                u32x4 wv; wv.x = pk2(v[0], v[1]); wv.y = pk2(v[2], v[3]); wv.z = pk2(v[4], v[5]); wv.w = pk2(v[6], v[7]);
                *(LAS u32x4*)(lds + SG_W + (t * SG_WS + ch * 8) * 2) = wv; }
        }
#pragma unroll
        for (int it = 0; it < 4; ++it) { const int c = it * 512 + tid, s_ = c >> 4, ch = c & 15; const u32x4 raw = rawv[it]; const float rv = rvs[it];
            u32x4 wv; wv.x = pk2(__uint_as_float(raw.x << 16) * rv, __uint_as_float(raw.x & 0xffff0000u) * rv); wv.y = pk2(__uint_as_float(raw.y << 16) * rv, __uint_as_float(raw.y & 0xffff0000u) * rv);
            wv.z = pk2(__uint_as_float(raw.z << 16) * rv, __uint_as_float(raw.z & 0xffff0000u) * rv); wv.w = pk2(__uint_as_float(raw.w << 16) * rv, __uint_as_float(raw.w & 0xffff0000u) * rv);
            *(LAS u32x4*)(lds + SG_V + (s_ * SG_VS + ch * 8) * 2) = wv; }
        SG_RAWBAR();
#pragma unroll
        for (int it = 0; it < 4; ++it) { const int c = it * 512 + tid; uu[it] = *(const u32x4*)(p.proj + (r0 + (c >> 4)) * LD1 + g * 128 + (c & 15) * 8); }
        if (u + ustep < 2048) SG_LOADV(u + ustep);
        bf16x8 vA[4];
#pragma unroll
        for (int ks = 0; ks < 4; ++ks) {
            const s16x4 lo = vtr(lds + SG_V + ((32 * ks + 8 * gq + tq) * SG_VS + 16 * w + 4 * tp) * 2), hi4 = vtr(lds + SG_V + ((32 * ks + 8 * gq + 4 + tq) * SG_VS + 16 * w + 4 * tp) * 2);
            vA[ks] = (bf16x8){lo[0], lo[1], lo[2], lo[3], hi4[0], hi4[1], hi4[2], hi4[3]};
        }
#pragma unroll
        for (int tt = 0; tt < 8; ++tt) {
            f32x4 acc = (f32x4){0.f, 0.f, 0.f, 0.f};
#pragma unroll
            for (int ks = 0; ks <= tt / 2; ++ks) {
                const bf16x8 wB = *(const LAS bf16x8*)(lds + SG_W + ((16 * tt + l15) * SG_WS + 32 * ks + 8 * gq) * 2);
                acc = __builtin_amdgcn_mfma_f32_16x16x32_bf16(vA[ks], wB, acc, 0, 0, 0);
            }
            *(LAS f32x4*)(lds + SG_O + ((16 * tt + l15) * SG_OS + 16 * w + 4 * gq) * 4) = acc;
        }
        SG_RAWBAR();
#pragma unroll
        for (int it = 0; it < 4; ++it) { const int c = it * 512 + tid, t = c >> 4, ch = c & 15;
            const f32x4 a = *(const LAS f32x4*)(lds + SG_O + (t * SG_OS + ch * 8) * 4), b = *(const LAS f32x4*)(lds + SG_O + (t * SG_OS + ch * 8 + 4) * 4);
            const f32x4 ga = *(const f32x4*)(p.sg_v_norm_g + g * 128 + ch * 8), gb = *(const f32x4*)(p.sg_v_norm_g + g * 128 + ch * 8 + 4);
            const float bs = p.sg_b_s[g * 128 + t];
            const u32x4 ux = uu[it];
            u32x4 o;
            o.x = pk2(__uint_as_float(ux.x << 16) * (a[0] * ga[0] + bs), __uint_as_float(ux.x & 0xffff0000u) * (a[1] * ga[1] + bs));
            o.y = pk2(__uint_as_float(ux.y << 16) * (a[2] * ga[2] + bs), __uint_as_float(ux.y & 0xffff0000u) * (a[3] * ga[3] + bs));
            o.z = pk2(__uint_as_float(ux.z << 16) * (b[0] * gb[0] + bs), __uint_as_float(ux.z & 0xffff0000u) * (b[1] * gb[1] + bs));
            o.w = pk2(__uint_as_float(ux.w << 16) * (b[2] * gb[2] + bs), __uint_as_float(ux.w & 0xffff0000u) * (b[3] * gb[3] + bs));
            *(u32x4*)(p.mix + (r0 + t) * D + g * 128 + ch * 8) = o; }
    }
    SG_RAWBAR();
    }
#undef SG_LOADV
#undef SG_RAWBAR
    __syncthreads();
}

enum { PH_PREP = 0, PH_NORM0, PH_IN0, PH_STAT0, PH_UP0, PH_ATTN, PH_OUT0,
       PH_MOE0  , PH_IN1 = PH_MOE0 + 6, PH_STAT1, PH_SCAN, PH_MIX1, PH_OUT1, PH_MOE1, PH_END = PH_MOE1 + 6 };

typedef __attribute__((address_space(4))) const P* KP;
#if defined(__HIP_DEVICE_COMPILE__)
#define LOADP() ({ KP k_ = kp; asm volatile("" : "+s"(k_)); *k_; })
#else
#define LOADP() (P{})
#endif
__global__ void __launch_bounds__(NTHR, 2) mega(P p_unused, int lo, int hi) {
    (void)p_unused;
    const KP kp = (KP)__builtin_amdgcn_kernarg_segment_ptr();
    extern __shared__ __attribute__((aligned(16))) unsigned char lds_raw[];
    LAS unsigned char* lds = (LAS unsigned char*)lds_raw;
    volatile LAS unsigned* misc = (volatile LAS unsigned*)(lds + LDS_MISC);
    { const int t0 = threadIdx.x; if (t0 < 64) misc[t0] = 0u; if ((t0 & 63) == 0) *(LAS int*)(size_t)(LDS_WTAB + 4 * hw_slot_()) = t0 >> 6; }
    __syncthreads();
    XcdBarrier bar; { const P p = LOADP(); bar.bar = p.bar; } bar.x = 0; bar.st = misc + 8;
    if (hi - lo > 1) bar = xcd_barrier_post(bar.bar, misc + 8);
#define IN(k) (lo <= (k) && (k) < hi)
#define SEAM(k) do { if (IN(k) && IN((k) + 1)) xcd_barrier(bar); } while (0)
    const int G = gridDim.x, bx = blockIdx.x;
#ifndef XPROBE
#define XPROBE 0
#endif
#ifndef STAGGER
#define STAGGER 0
#endif
#ifndef DUPMASK
#define DUPMASK 0u
#endif
#define PHASE(k, ...) do { if (IN(k)) { __VA_ARGS__ } if (((DUPMASK >> (k)) & 1u) && IN(k)) { xcd_barrier(bar); __VA_ARGS__ } SEAM(k); } while (0)
    PHASE(PH_PREP, const P p = LOADP(); ph_prep(p, lds););
    PHASE(PH_NORM0, const P p = LOADP(); ph_norm<true>(p, p.x, p.norm_mix_g, 0, 0););
    PHASE(PH_IN0,
        const P p = LOADP();
        g8::Order S; S.init(NTOK / 256, LD0 / 256, G, bx);
        SrcDense X{(unsigned)(D * 2), (const char*)p.wt_in0, (size_t)256 * 1024 * 2};
        g8::Epi<FIn0> E{{p}};
        g8::gemm8(lds, (const char*)p.xa, 1024, S, X, E););
    PHASE(PH_STAT0, const P p = LOADP(); ph_rowstat0_conv(p););
    PHASE(PH_UP0,
        const P p = LOADP();
        { g8::Order S; S.init(NTOK / 256, 3, G, bx);
          SrcDense X{(unsigned)(LD0 * 2), (const char*)p.wt_uq, (size_t)256 * 256 * 2};
          g8::Epi<FUq> E{{p}};
          g8::gemm8(lds, (const char*)p.proj, 256, S, X, E); }
        { g8::Order S; S.init(NTOK / 256, 4, G, bx);
          SrcDense X{(unsigned)(LD0 * 2), (const char*)p.wt_ukv, (size_t)256 * 128 * 2};
          g8::Epi<FUkv> E{{p}};
          g8::gemm8(lds, (const char*)(p.proj + 256), 128, S, X, E); });
    PHASE(PH_ATTN, const P p = LOADP(); ph_attn(p, lds););
    PHASE(PH_OUT0,
        const P p = LOADP();
        g8::Order S; S.init(NTOK / 256, 4, G, bx);
        SrcDense X{(unsigned)(D * 2), (const char*)p.wt_out0, (size_t)256 * 1024 * 2};
        g8::Epi<FOut> E{{p, 0}};
        g8::gemm8(lds, (const char*)p.mix, 1024, S, X, E, STAGGER);
        if (XPROBE == 3) { xcd_barrier(bar); g8::Epi<FNull> E2{{}}; g8::gemm8(lds, (const char*)p.mix, 1024, S, X, E2); });
#define MOE_PHASES(l, base) do { \
        PHASE((base) + 0, const P p = LOADP(); ph_norm<false>(p, p.xr, p.norm_ffn_g + (l) * D, (l), 1);); \
        PHASE((base) + 1, const P p = LOADP(); ph_router(p, (l), lds);); \
        PHASE((base) + 2, const P p = LOADP(); ph_slots(p, (l), lds);); \
        PHASE((base) + 3, \
            const P p = LOADP(); \
            g8::Order S; S.init(p.ntile[(l)], 4, G, bx, 1); \
            SrcGu X{(unsigned)(D * 2), p.row_tok + (size_t)(l) * MAXSLOT, p.tile_e + (l) * 1024, (const char*)(p.wt_gu + (size_t)(l) * 32 * 512 * 1024)}; \
            g8::Epi<FGu> E{{p, p.row_w + 2 * (size_t)(l) * MAXSLOT}}; \
            g8::gemm8(lds, (const char*)p.xa, 1024, S, X, E);); \
        PHASE((base) + 4, \
            const P p = LOADP(); \
            g8::Order S; S.init(p.ntile[(l)], 4, G, bx, 1); \
            SrcDn X{(unsigned)(512 * 2), p.tile_e + (l) * 1024, (const char*)(p.wt_dn + (size_t)(l) * 32 * 1024 * 256)}; \
            g8::Epi<FDn> E{{p}}; \
            g8::gemm8(lds, (const char*)p.act, 512, S, X, E);); \
        PHASE((base) + 5, const P p = LOADP(); ph_postnorm(p, (l), (l) == 1);); \
    } while (0)
    MOE_PHASES(0, PH_MOE0);
    PHASE(PH_IN1,
        const P p = LOADP();
        g8::Order S; S.init(NTOK / 256, LD1 / 256, G, bx);
        SrcDense X{(unsigned)(D * 2), (const char*)p.wt_in1, (size_t)256 * 1024 * 2};
        g8::Epi<FIn1> E{{p}};
        g8::gemm8(lds, (const char*)p.xa, 1024, S, X, E););
    PHASE(PH_STAT1, const P p = LOADP(); ph_stat1x(p, lds););
    PHASE(PH_SCAN, const P p = LOADP(); ph_gla_scan(p); ph_sg(p, lds););
    PHASE(PH_MIX1, const P p = LOADP(); ph_gla_out(p, lds, tid_()););
    PHASE(PH_OUT1,
        const P p = LOADP();
        g8::Order S; S.init(NTOK / 256, 4, G, bx);
        SrcDense X{(unsigned)(D * 2), (const char*)p.wt_out1, (size_t)256 * 1024 * 2};
        g8::Epi<FOut> E{{p, 1}};
        g8::gemm8(lds, (const char*)p.mix, 1024, S, X, E, STAGGER););
    MOE_PHASES(1, PH_MOE1);
#undef MOE_PHASES
#undef PHASE
#undef IN
#undef SEAM
}

static size_t carve(size_t& off, size_t bytes) { const size_t o = off; off += (bytes + 255) & ~(size_t)255; return o; }

extern "C" void kernel_launch(void* const* d_in, const int* in_sizes, int n_in, void* d_out, int out_size, void* d_ws, size_t ws_size, hipStream_t stream) {
    (void)in_sizes; (void)n_in; (void)out_size;
    P p{};
    const float* const* fi = (const float* const*)d_in;
    p.x = fi[0]; p.c = fi[1]; p.pos = (const int*)d_in[2];
    p.adaln_w = fi[3]; p.adaln_b = fi[4]; p.norm_mix_g = fi[5]; p.norm_ffn_g = fi[6]; p.ab_w_in = fi[7]; p.q_norm_g = fi[8]; p.w_uq = fi[9];
    p.kv_norm_g = fi[10]; p.w_ukv = fi[11]; p.conv_w = fi[12]; p.ab_w_out = fi[13]; p.cd_w_in = fi[14]; p.sg_v_norm_g = fi[15]; p.sg_w_s = fi[16];
    p.sg_b_s = fi[17]; p.gla_w_g2 = fi[18]; p.gla_b_g = fi[19]; p.gla_norm_g = fi[20]; p.cd_w_out = fi[21]; p.moe_w_group = fi[22]; p.moe_b_group = fi[23];
    p.moe_w_expert = fi[24]; p.moe_b_expert = fi[25]; p.moe_w_gate_up = fi[26]; p.moe_w_down = fi[27]; p.final_norm_g = fi[28];
    p.out = (float*)d_out;
    char* ws = (char*)d_ws; size_t off = 0;
    const size_t ctl0 = off;
    p.bar = (unsigned*)(ws + carve(off, (size_t)XCD_BAR_WORDS * 4));
    p.row_tok = (int*)(ws + carve(off, (size_t)2 * MAXSLOT * 4));
    p.row_w = (float*)(ws + carve(off, (size_t)2 * MAXSLOT * 2 * 4));
    const size_t ctl_bytes = off - ctl0;
    p.whist = (int*)(ws + carve(off, (size_t)2 * 256 * 128 * 4));
    p.ntile = (int*)(ws + carve(off, 256));
    p.tile_e = (int*)(ws + carve(off, 2 * 1024 * 4));
    p.tope = (int*)(ws + carve(off, (size_t)4 * NTOK * 4));
    p.toppos = (int*)(ws + carve(off, (size_t)4 * NTOK * 4));
    p.topslot = (int*)(ws + carve(off, (size_t)4 * NTOK * 4));
    p.topw = (float*)(ws + carve(off, (size_t)4 * NTOK * 4));
    p.mod = (float*)(ws + carve(off, (size_t)2 * 16 * 6144 * 4));
    p.ropec = (float*)(ws + carve(off, (size_t)NTOK * 16 * 4));
    p.ropes = (float*)(ws + carve(off, (size_t)NTOK * 16 * 4));
    p.rq = (float*)(ws + carve(off, (size_t)NTOK * 4));
    p.rkv = (float*)(ws + carve(off, (size_t)NTOK * 4));
    p.rv = (float*)(ws + carve(off, (size_t)NTOK * 4));
    p.wt_in0 = (bf16_t*)(ws + carve(off, WO_END * 2));
    p.wt_uq = p.wt_in0 + WO_UQ; p.wt_ukv = p.wt_in0 + WO_UKV; p.wt_out0 = p.wt_in0 + WO_OUT0; p.wt_in1 = p.wt_in0 + WO_IN1; p.wt_out1 = p.wt_in0 + WO_OUT1;
    p.wt_gu = p.wt_in0 + WO_GU; p.wt_dn = p.wt_in0 + WO_DN; p.wt_r = p.wt_in0 + WO_R;
    p.xa = (bf16_t*)(ws + carve(off, (size_t)NTOK * D * 2));
    p.mix = (bf16_t*)(ws + carve(off, (size_t)NTOK * D * 2));
    p.xr = (bf16_t*)(ws + carve(off, (size_t)NTOK * D * 2));
    const size_t r0 = off;
    p.proj = (bf16_t*)(ws + carve(off, (size_t)NTOK * LD1 * 2));
    size_t o2 = r0 + (((size_t)NTOK * LD0 * 2 + 255) & ~(size_t)255);
    p.q = (bf16_t*)(ws + carve(o2, (size_t)NTOK * 768 * 2));
    p.kn = (bf16_t*)(ws + carve(o2, (size_t)NTOK * 512 * 2));
    p.v = (bf16_t*)(ws + carve(o2, (size_t)NTOK * 512 * 2));
    p.kpe = (bf16_t*)(ws + carve(o2, (size_t)NTOK * 32 * 2));
    size_t o3 = off;
    p.loga = (float*)(ws + carve(o3, (size_t)NTOK * 256 * 4));
    p.gqd = (bf16_t*)(ws + carve(o3, (size_t)NTOK * 256 * 2));
    p.gkd = (bf16_t*)(ws + carve(o3, (size_t)NTOK * 256 * 2));
    p.gkv = p.xa;
    p.gst = p.xa + (size_t)(NTOK / 64) * 4 * 64 * 128;
    p.gdec = (float*)(ws + carve(o3, (size_t)(NTOK / 64) * 256 * 4));
    size_t o4 = r0;
    p.act = (bf16_t*)(ws + carve(o4, (size_t)MAXSLOT * 512 * 2));
    p.y = (bf16_t*)(ws + carve(o4, (size_t)MAXSLOT * D * 2));
    if (off > ws_size || o2 > ws_size || o3 > ws_size || o4 > ws_size) return;

    static int grid = 0;
    if (grid == 0) {
        int dev = 0, cus = 0;
        if (hipGetDevice(&dev) != hipSuccess || hipDeviceGetAttribute(&cus, hipDeviceAttributeMultiprocessorCount, dev) != hipSuccess) { grid = -1; return; }
        if (hipFuncSetAttribute((const void*)mega, hipFuncAttributeMaxDynamicSharedMemorySize, LDS_BYTES) != hipSuccess) { grid = -1; return; }
        grid = cus < 256 ? cus : 256;
    }
    if (grid < 0) return;
    (void)hipMemsetAsync(ws + ctl0, 0, ctl_bytes, stream);
#define RUN(a, b) hipLaunchKernelGGL(mega, dim3(grid), dim3(NTHR), LDS_BYTES, stream, p, (a), (b))
    RUN(PH_PREP, PH_END);
#undef RUN
}
```

```cpp
#include <hip/hip_runtime.h>
#include <stdint.h>
#include <math.h>

typedef unsigned short bf16_t;
typedef short bf16x8 __attribute__((ext_vector_type(8)));
typedef float f32x4 __attribute__((ext_vector_type(4)));
typedef unsigned u32x2 __attribute__((ext_vector_type(2)));
typedef unsigned u32x4 __attribute__((ext_vector_type(4)));
#define DI __device__ __forceinline__
#define LAS __attribute__((address_space(3)))

constexpr int D = 1024, NB = 16, SEQ = 4096, NTOK = NB * SEQ;
constexpr float EPS = 1e-6f;
constexpr int AB_IN = 1952, CD_IN = 2576;
constexpr int LD0 = 2048, LD1 = 2816;
constexpr int DEXP = 256;
constexpr int MAXSLOT = NTOK + 128 * 256;
constexpr float QSCALE = 0.10206207261596577f * 1.4426950408889634f;
constexpr int NTHR = 512, NWAVE = 8;
constexpr int LDS_BYTES = 147456, LDS_MISC = LDS_BYTES - 256;

constexpr int LDS_WTAB = 147456 - 512;
DI int hw_slot_() { return (int)(__builtin_amdgcn_s_getreg((6 << 11) | 4) & 63u); }
DI int lane_() { return (int)__builtin_amdgcn_mbcnt_hi(~0u, __builtin_amdgcn_mbcnt_lo(~0u, 0u)); }
DI int tid_() {
    const int w = __builtin_amdgcn_readfirstlane(*(const LAS int*)(size_t)(LDS_WTAB + 4 * hw_slot_()));
    int t = w * 64 + lane_();
    asm volatile("" : "+v"(t)); return t;
}
DI float bf2f(bf16_t v) { return __uint_as_float(((unsigned)v) << 16); }
DI bf16_t f2bf(float f) { return __builtin_bit_cast(bf16_t, (__bf16)f); }
typedef float f32x2_t __attribute__((ext_vector_type(2))); typedef __bf16 bf16x2_t __attribute__((ext_vector_type(2)));
DI unsigned cvtpk(float lo, float hi) { f32x2_t v = {lo, hi}; bf16x2_t b = __builtin_convertvector(v, bf16x2_t); return __builtin_bit_cast(unsigned, b); }
DI unsigned pk2(float lo, float hi) { return cvtpk(lo, hi); }
DI float wave_sum(float v) {
#pragma unroll
    for (int o = 32; o >= 1; o >>= 1) v += __shfl_xor(v, o);
    return v;
}
typedef float f32x16 __attribute__((ext_vector_type(16)));
typedef short s16x4 __attribute__((ext_vector_type(4)));
typedef short v4i16_t __attribute__((ext_vector_type(4)));
DI int crow(int r, int hi) { return (r & 3) + 8 * (r >> 2) + 4 * hi; }
DI s16x4 vtr(const LAS unsigned char* p) { return __builtin_bit_cast(s16x4, __builtin_amdgcn_ds_read_tr16_b64_v4i16((LAS v4i16_t*)p)); }
DI float silu_f(float v) { return v * __builtin_amdgcn_rcpf(1.f + __builtin_amdgcn_exp2f(-1.4426950408889634f * v)); }
DI float gelu_tanh_f(float v) { const float t = v * v; const float e = __builtin_amdgcn_exp2f(v * (-2.3022082f - 0.10294324f * t)); return v * __builtin_amdgcn_rcpf(1.f + e); }
DI float log_sigmoid_f(float z) { return fminf(z, 0.f) - 0.6931471805599453f * __builtin_amdgcn_logf(1.f + __builtin_amdgcn_exp2f(-1.4426950408889634f * fabsf(z))); }

struct P {
    const float *x, *c; const int* pos;
    const float *adaln_w, *adaln_b, *norm_mix_g, *norm_ffn_g, *ab_w_in, *q_norm_g, *w_uq, *kv_norm_g, *w_ukv, *conv_w, *ab_w_out,
        *cd_w_in, *sg_v_norm_g, *sg_w_s, *sg_b_s, *gla_w_g2, *gla_b_g, *gla_norm_g, *cd_w_out,
        *moe_w_group, *moe_b_group, *moe_w_expert, *moe_b_expert, *moe_w_gate_up, *moe_w_down, *final_norm_g;
    float* out;
    bf16_t *wt_in0, *wt_uq, *wt_ukv, *wt_out0, *wt_in1, *wt_out1, *wt_gu, *wt_dn, *wt_r;
    float *mod, *ropec, *ropes;
    bf16_t *xa, *xr, *proj, *q, *kn, *v, *kpe, *mix, *act, *y;
    float *rq, *rkv, *rsp, *rv, *rvp, *gdec, *topw, *row_w;
    bf16_t *gqd, *gkd, *gkv, *gst, *loga;
    int *tope, *toppos, *topslot, *whist, *ntile, *tile_e, *row_tok;
    unsigned* bar;
};

#define XB_TMO      128
#define XB_XCNT(j)  (256  + 64 * (j))
#define XB_XSUB(j)  (1280 + 64 * (j))
#define XB_XGEN(j)  (2304 + 64 * (j))
#define XB_TOP      3328
#define XB_TOPGEN   3392
#define XCD_BAR_WORDS 3456
#define XB_SPIN_CAP (1u << 18)
__device__ __forceinline__ unsigned xb_ld(unsigned* p)              { return __hip_atomic_load(p, __ATOMIC_RELAXED, __HIP_MEMORY_SCOPE_AGENT); }
__device__ __forceinline__ unsigned xb_add(unsigned* p, unsigned v) { return __hip_atomic_fetch_add(p, v, __ATOMIC_RELAXED, __HIP_MEMORY_SCOPE_AGENT); }
__device__ __forceinline__ unsigned xb_xcc_id() { return (unsigned)__builtin_amdgcn_s_getreg((3 << 11) | 20) & 0xFu; }
#define XB_SPIN(cond, bar) do { unsigned _sp = 0; while (cond) { __builtin_amdgcn_s_sleep(1); \
    if ((++_sp & 255u) == 0u) { if (xb_ld(&(bar)[XB_TMO])) break; if (_sp > XB_SPIN_CAP) { atomicAdd(&(bar)[XB_TMO], 1u); break; } } } } while (0)
struct XcdBarrier { unsigned* bar; unsigned x; volatile LAS unsigned* st; };
__device__ __forceinline__ XcdBarrier xcd_barrier_post(unsigned* bar, volatile LAS unsigned* st) {
    XcdBarrier b; b.bar = bar; b.x = xb_xcc_id(); b.st = st;
    if (threadIdx.x == 0) (void)xb_add(&bar[XB_XCNT(b.x)], 1u);
    return b;
}
__device__ __forceinline__ void xcd_barrier_complete(unsigned* bar, unsigned x, unsigned& nloc, unsigned& nx) {
    const unsigned G = gridDim.x * gridDim.y * gridDim.z;
    unsigned sum, cnt, mine, sp = 0u;
    for (;;) {
        sum = 0u; cnt = 0u; mine = 0u;
#pragma unroll
        for (unsigned j = 0; j < 16; ++j) { const unsigned c = xb_ld(&bar[XB_XCNT(j)]); sum += c; cnt += (c > 0u) ? 1u : 0u; mine = (j == x) ? c : mine; }
        if (sum == G) break;
        __builtin_amdgcn_s_sleep(1);
        if ((++sp & 255u) == 0u) { if (xb_ld(&bar[XB_TMO])) break; if (sp > XB_SPIN_CAP) { atomicAdd(&bar[XB_TMO], 1u); break; } }
    }
    nloc = mine > 0u ? mine : 1u; nx = cnt > 0u ? cnt : 1u;
}
__device__ __forceinline__ void xcd_barrier(const XcdBarrier& b) {
    asm volatile("s_waitcnt vmcnt(0)" ::: "memory");
    __syncthreads();
    if (tid_() == 0) {
        unsigned* bar = b.bar;
        __builtin_amdgcn_s_waitcnt(0);
        unsigned nloc = b.st[0], nx = b.st[1];
        if (nloc == 0u) { xcd_barrier_complete(bar, b.x, nloc, nx); b.st[0] = nloc; b.st[1] = nx; }
        const unsigned old = xb_add(&bar[XB_XSUB(b.x)], 1u);
        const unsigned gen = old / nloc;
        if (old + 1u == (gen + 1u) * nloc) {
            __builtin_amdgcn_fence(__ATOMIC_RELEASE, "agent");
            asm volatile("s_waitcnt vmcnt(0)" ::: "memory");
            const unsigned og = xb_add(&bar[XB_TOP], 1u);
            const unsigned tg = og / nx;
            if (og + 1u == (tg + 1u) * nx) xb_add(&bar[XB_TOPGEN], 1u);
            else XB_SPIN(xb_ld(&bar[XB_TOPGEN]) == tg, bar);
            __builtin_amdgcn_fence(__ATOMIC_ACQUIRE, "agent");
            xb_add(&bar[XB_XGEN(b.x)], 1u);
            asm volatile("s_waitcnt vmcnt(0)" ::: "memory");
        } else {
            XB_SPIN(xb_ld(&bar[XB_XGEN(b.x)]) == gen, bar);
            __builtin_amdgcn_fence(__ATOMIC_ACQUIRE, "agent");
            asm volatile("s_waitcnt vmcnt(0)" ::: "memory");
        }
    }
    __syncthreads();
}

namespace g8 {
constexpr int BM = 256, BK = 64, HALF = 128, HTB = HALF * BK * 2, NXCD = 8, WGM = 8;
__host__ __device__ __forceinline__ int lds_byte(int r, int c) { const int st = (r >> 4) * 2 + (c >> 5), rr = r & 15, cc = c & 31, ob = rr * 64 + cc * 2; return st * 1024 + (ob ^ (((ob >> 9) & 1) << 5)); }
__host__ __device__ __forceinline__ void stage_rc(int b, int& R, int& C) { const int st = b / 1024, sb = b % 1024, swz = sb ^ (((sb >> 9) & 1) << 5); R = (st >> 1) * 16 + swz / 64; C = (st & 1) * 32 + (swz % 64) / 2; }
__host__ __device__ __forceinline__ int perm32(int rho) { const int n = rho >> 4, i = rho & 15; return 8 * (i >> 2) + 4 * n + (i & 3); }
struct Unit { int pm, pn; };
struct Order {
    int nM, nN, nwg, G, c, pnfast;
    DI void init(int nM_, int nN_, int G_, int c_, int pnfast_ = 0) { nM = nM_; nN = nN_; nwg = nM * nN; G = G_; c = c_; pnfast = pnfast_; }
    DI bool next(int i, Unit& u) const {
        const long L = (long)i * G + c; if (L >= nwg) return false;
        int wgid = (int)L; { const int q = nwg / NXCD, r = nwg % NXCD, xcd = wgid % NXCD, off = wgid / NXCD; wgid = (xcd < r ? xcd * (q + 1) : r * (q + 1) + (xcd - r) * q) + off; }
        if (pnfast) { u.pm = wgid / nN; u.pn = wgid % nN; return true; }
        const int nig = WGM * nN, gid = wgid / nig, fm = gid * WGM, gsz = (nM - fm) < WGM ? (nM - fm) : WGM;
        u.pm = fm + ((wgid % nig) % gsz); u.pn = (wgid % nig) / gsz; return true;
    }
};
template <class Epi, class Src>
__device__ __forceinline__ void gemm8(LAS unsigned char* lds, const char* A, int K_, const Order& S, const Src& X, const Epi& E, int stagger = 0) {
    int K = K_;
    const int tid = tid_();
    const int wid = __builtin_amdgcn_readfirstlane(tid >> 6), lane = tid & 63, wr = wid >> 2, wc = wid & 3, fr = lane & 15, fq = lane >> 4;
    asm volatile("" : "+s"(K));
    const int nt = K / BK;
    int Rr[2], Cc[2]; unsigned voffA[2], voffB[2];
#pragma unroll
    for (int i = 0; i < 2; ++i) { int R, C; stage_rc(tid * 16 + i * 8192, R, C); Rr[i] = R; Cc[i] = C * 2; const int Rb = Epi::PERM ? ((R & ~31) + perm32(R & 31)) : R;
        voffA[i] = (unsigned)R * X.lda + (unsigned)C * 2u; voffB[i] = (unsigned)(Rb * X.ldb(K) + C) * 2u; }
    const size_t kstep = (size_t)(BK * 2);
    const size_t hstepB = (size_t)HALF * X.ldb(K) * 2;
    const size_t ksplit = X.ksplit();
    const size_t hstepA = (size_t)HALF * X.lda;
    const unsigned ldsw = (unsigned)wid * 1024u;
    const int aoff = lds_byte(wr * 64 + fr, fq * 8), boff = lds_byte(wc * 32 + fr, fq * 8);
#define G8_SA(b, h) (((b) * 2 + (h)) * HTB)
#define G8_SB(b, h) ((4 + (b) * 2 + (h)) * HTB)
#define G8_STAGEB(bufoff, gbase) do { _Pragma("unroll") for (int _i = 0; _i < 2; ++_i) \
        __builtin_amdgcn_global_load_lds((const unsigned*)((const char*)(gbase) + voffB[_i]), (LAS unsigned*)(lds + (bufoff) + ldsw + _i * 8192), 16, 0, 0); } while (0)
#define G8_STAGEA(bufoff, ub, o0, o1) do { \
        __builtin_amdgcn_global_load_lds((const unsigned*)((const char*)(ub) + (o0)), (LAS unsigned*)(lds + (bufoff) + ldsw), 16, 0, 0); \
        __builtin_amdgcn_global_load_lds((const unsigned*)((const char*)(ub) + (o1)), (LAS unsigned*)(lds + (bufoff) + ldsw + 8192), 16, 0, 0); } while (0)
#define G8_LDA(dst, b, h) do { _Pragma("unroll") for (int m = 0; m < 4; ++m) _Pragma("unroll") for (int k = 0; k < 2; ++k) dst[m][k] = *(const LAS bf16x8*)(lds + G8_SA(b, h) + aoff + m * 2048 + k * 1024); } while (0)
#define G8_LDB(dst, b, h) do { _Pragma("unroll") for (int n = 0; n < 2; ++n) _Pragma("unroll") for (int k = 0; k < 2; ++k) dst[n][k] = *(const LAS bf16x8*)(lds + G8_SB(b, h) + boff + n * 2048 + k * 1024); } while (0)
#define G8_MMA(ai, bj, At, Bt) do { __builtin_amdgcn_s_setprio(1); _Pragma("unroll") for (int m = 0; m < 4; ++m) _Pragma("unroll") for (int n = 0; n < 2; ++n) _Pragma("unroll") for (int k = 0; k < 2; ++k) \
        acc[ai][bj][m][n] = __builtin_amdgcn_mfma_f32_16x16x32_bf16(Bt[n][k], At[m][k], acc[ai][bj][m][n], 0, 0, 0); __builtin_amdgcn_s_setprio(0); } while (0)
#define G8_WAIT_V(n) asm volatile("s_waitcnt vmcnt(" #n ")" ::: "memory")
#define G8_WAIT_L(n) asm volatile("s_waitcnt lgkmcnt(" #n ")" ::: "memory")
#define G8_BAR __builtin_amdgcn_s_barrier()
#define G8_SCHED __builtin_amdgcn_sched_barrier(0)
    Unit cur, nxt; int ui = 0;
    if (!S.next(0, cur)) return;
    if (stagger) {
        const unsigned long long t0_ = __builtin_amdgcn_s_memrealtime(), d_ = (unsigned long long)(S.c & 3) * (unsigned)stagger;
        while (__builtin_amdgcn_s_memrealtime() - t0_ < d_) __builtin_amdgcn_s_sleep(8);
    }
    f32x4 acc[2][2][4][2];
#pragma unroll
    for (int a = 0; a < 2; ++a)
#pragma unroll
        for (int b = 0; b < 2; ++b)
#pragma unroll
            for (int m = 0; m < 4; ++m)
#pragma unroll
                for (int n = 0; n < 2; ++n) acc[a][b][m][n] = (f32x4){0.f, 0.f, 0.f, 0.f};
    bf16x8 At[4][2], B0[2][2], B1[2][2];
    unsigned c00 = 0, c01 = 0, c10 = 0, c11 = 0; const char* cA = A;
    if constexpr (Src::GATHER) { c00 = X.a_off(cur, 0, Rr[0]) + Cc[0]; c01 = X.a_off(cur, 0, Rr[1]) + Cc[1]; c10 = X.a_off(cur, 1, Rr[0]) + Cc[0]; c11 = X.a_off(cur, 1, Rr[1]) + Cc[1]; }
    else cA = A + (size_t)cur.pm * 2 * hstepA;
    const char* cB0 = X.b_ptr(cur, 0); const char* cB1 = X.b_ptr(cur, 1);
#define G8_BK(b0_, b1_, kb_) (((size_t)(kb_) < ksplit ? (b0_) : (b1_)) + (kb_))
    { const char* cB = G8_BK(cB0, cB1, 0); G8_STAGEB(G8_SB(0, 0), cB); G8_STAGEB(G8_SB(0, 1), cB + hstepB); }
    if constexpr (Src::GATHER) { G8_STAGEA(G8_SA(0, 0), A, c00, c01); G8_STAGEA(G8_SA(0, 1), A, c10, c11); }
    else { G8_STAGEA(G8_SA(0, 0), cA, voffA[0], voffA[1]); G8_STAGEA(G8_SA(0, 1), cA + hstepA, voffA[0], voffA[1]); }
    if (wr == 1) G8_BAR;
    G8_WAIT_V(2); G8_BAR;
    { const char* cB = G8_BK(cB0, cB1, kstep); G8_STAGEB(G8_SB(1, 0), cB);
    if constexpr (Src::GATHER) G8_STAGEA(G8_SA(1, 0), A + kstep, c00, c01); else G8_STAGEA(G8_SA(1, 0), cA + kstep, voffA[0], voffA[1]);
      G8_STAGEB(G8_SB(1, 1), cB + hstepB); }
    G8_WAIT_V(6); G8_BAR;
    for (;;) {
        const bool has_next = S.next(ui + 1, nxt);
        unsigned n00 = c00, n01 = c01, n10 = c10, n11 = c11; const char* nB0 = cB0; const char* nB1 = cB1; const char* nA = cA;
        if (has_next) {
            if constexpr (Src::GATHER) { n00 = X.a_off(nxt, 0, Rr[0]) + Cc[0]; n01 = X.a_off(nxt, 0, Rr[1]) + Cc[1]; n10 = X.a_off(nxt, 1, Rr[0]) + Cc[0]; n11 = X.a_off(nxt, 1, Rr[1]) + Cc[1]; }
            else nA = A + (size_t)nxt.pm * 2 * hstepA;
            nB0 = X.b_ptr(nxt, 0); nB1 = X.b_ptr(nxt, 1);
        }
        for (int t = 0; t < nt; t += 2) {
            const bool last = (t == nt - 2);
            const size_t k1 = (size_t)(t + 1) * kstep;
            const size_t k2 = last ? 0 : (size_t)(t + 2) * kstep, k3 = k2 + kstep;
            const char* b2 = G8_BK(last ? nB0 : cB0, last ? nB1 : cB1, k2); const char* b3 = G8_BK(last ? nB0 : cB0, last ? nB1 : cB1, k3);
            if constexpr (Src::GATHER) {
            const unsigned a00 = last ? n00 : c00, a01 = last ? n01 : c01, a10 = last ? n10 : c10, a11 = last ? n11 : c11;
            G8_LDB(B0, 0, 0); G8_LDB(B1, 0, 1); G8_SCHED; G8_LDA(At, 0, 0); G8_STAGEA(G8_SA(1, 1), A + k1, c10, c11);
            G8_WAIT_V(8); G8_WAIT_L(0); G8_BAR; G8_MMA(0, 0, At, B0); G8_MMA(0, 1, At, B1); G8_BAR; G8_SCHED;
            G8_LDA(At, 0, 1); G8_STAGEB(G8_SB(0, 0), b2); G8_STAGEB(G8_SB(0, 1), b2 + hstepB); G8_STAGEA(G8_SA(0, 0), A + k2, a00, a01);
            G8_WAIT_V(8); G8_WAIT_L(0); G8_BAR; G8_MMA(1, 0, At, B0); G8_MMA(1, 1, At, B1); G8_BAR; G8_SCHED;
            G8_LDB(B0, 1, 0); G8_LDB(B1, 1, 1); G8_SCHED; G8_LDA(At, 1, 0); G8_STAGEA(G8_SA(0, 1), A + k2, a10, a11);
            G8_WAIT_V(8); G8_WAIT_L(0); G8_BAR; G8_MMA(0, 0, At, B0); G8_MMA(0, 1, At, B1); G8_BAR; G8_SCHED;
            G8_LDA(At, 1, 1); G8_STAGEB(G8_SB(1, 0), b3); G8_STAGEB(G8_SB(1, 1), b3 + hstepB); G8_STAGEA(G8_SA(1, 0), A + k3, a00, a01);
            G8_WAIT_V(8); G8_WAIT_L(0); G8_BAR; G8_MMA(1, 0, At, B0); G8_MMA(1, 1, At, B1); G8_BAR; G8_SCHED;
            } else {
            const char* a1 = cA + k1; const char* a2 = (last ? nA : cA) + k2; const char* a3 = a2 + kstep;
            G8_LDB(B0, 0, 0); G8_LDB(B1, 0, 1); G8_SCHED; G8_LDA(At, 0, 0); G8_STAGEA(G8_SA(1, 1), a1 + hstepA, voffA[0], voffA[1]);
            G8_WAIT_V(8); G8_WAIT_L(0); G8_BAR; G8_MMA(0, 0, At, B0); G8_MMA(0, 1, At, B1); G8_BAR; G8_SCHED;
            G8_LDA(At, 0, 1); G8_STAGEB(G8_SB(0, 0), b2); G8_STAGEB(G8_SB(0, 1), b2 + hstepB); G8_STAGEA(G8_SA(0, 0), a2, voffA[0], voffA[1]);
            G8_WAIT_V(8); G8_WAIT_L(0); G8_BAR; G8_MMA(1, 0, At, B0); G8_MMA(1, 1, At, B1); G8_BAR; G8_SCHED;
            G8_LDB(B0, 1, 0); G8_LDB(B1, 1, 1); G8_SCHED; G8_LDA(At, 1, 0); G8_STAGEA(G8_SA(0, 1), a2 + hstepA, voffA[0], voffA[1]);
            G8_WAIT_V(8); G8_WAIT_L(0); G8_BAR; G8_MMA(0, 0, At, B0); G8_MMA(0, 1, At, B1); G8_BAR; G8_SCHED;
            G8_LDA(At, 1, 1); G8_STAGEB(G8_SB(1, 0), b3); G8_STAGEB(G8_SB(1, 1), b3 + hstepB); G8_STAGEA(G8_SA(1, 0), a3, voffA[0], voffA[1]);
            G8_WAIT_V(8); G8_WAIT_L(0); G8_BAR; G8_MMA(1, 0, At, B0); G8_MMA(1, 1, At, B1); G8_BAR; G8_SCHED;
            }
        }
        if (wr == 0) G8_BAR;
        E(acc, cur, wr, wc, fr, fq);
        if (!has_next) break;
#pragma unroll
        for (int a = 0; a < 2; ++a)
#pragma unroll
            for (int b = 0; b < 2; ++b)
#pragma unroll
                for (int m = 0; m < 4; ++m)
#pragma unroll
                    for (int n = 0; n < 2; ++n) acc[a][b][m][n] = (f32x4){0.f, 0.f, 0.f, 0.f};
        cur = nxt; c00 = n00; c01 = n01; c10 = n10; c11 = n11; cB0 = nB0; cB1 = nB1; cA = nA; ++ui;
        if (wr == 1) G8_BAR;
    }
    G8_WAIT_V(0);
    G8_BAR;
#undef G8_SA
#undef G8_SB
#undef G8_STAGEA
#undef G8_STAGEB
#undef G8_BK
#undef G8_LDA
#undef G8_LDB
#undef G8_MMA
#undef G8_WAIT_V
#undef G8_WAIT_L
#undef G8_BAR
#undef G8_SCHED
}
#define EPI_FOR _Pragma("unroll") for (int ai = 0; ai < 2; ++ai) _Pragma("unroll") for (int m = 0; m < 4; ++m)
#define EPI_ROW const int ro = ai * 128 + m * 16; if ((m & 1) == 0) __builtin_amdgcn_sched_barrier(0); f32x4 a = acc[ai][BJ][m][0], b = acc[ai][BJ][m][1]; (void)ro;
template <class F> struct Epi {
    static constexpr bool PERM = true;
    F f;
    DI void operator()(const f32x4 (&acc)[2][2][4][2], const Unit& u, int wr, int wc, int fr, int fq) const {
        const int row0 = u.pm * BM + wr * 64 + fr, col0 = u.pn * BM + wc * 32 + 8 * fq;
        f.template blk<0>(acc, row0, col0, u);
        f.template blk<1>(acc, row0, col0 + HALF, u);
    }
};
}

DI void store_bf8(bf16_t* dst, const f32x4& a, const f32x4& b) { u32x4 w; w.x = pk2(a[0], a[1]); w.y = pk2(a[2], a[3]); w.z = pk2(b[0], b[1]); w.w = pk2(b[2], b[3]); *(u32x4*)dst = w; }
DI void rope8v(const f32x4& c, const f32x4& s, f32x4& a, f32x4& b) {
    f32x4 oa, ob;
    oa[0] = a[0] * c[0] - a[1] * s[0]; oa[1] = a[0] * s[0] + a[1] * c[0]; oa[2] = a[2] * c[1] - a[3] * s[1]; oa[3] = a[2] * s[1] + a[3] * c[1];
    ob[0] = b[0] * c[2] - b[1] * s[2]; ob[1] = b[0] * s[2] + b[1] * c[2]; ob[2] = b[2] * c[3] - b[3] * s[3]; ob[3] = b[2] * s[3] + b[3] * c[3];
    a = oa; b = ob;
}
DI void rope8(const P& p, int row, int i0, f32x4& a, f32x4& b) {
    const f32x4 c = *(const f32x4*)(p.ropec + (size_t)row * 16 + i0), s = *(const f32x4*)(p.ropes + (size_t)row * 16 + i0);
    f32x4 oa, ob;
    oa[0] = a[0] * c[0] - a[1] * s[0]; oa[1] = a[0] * s[0] + a[1] * c[0]; oa[2] = a[2] * c[1] - a[3] * s[1]; oa[3] = a[2] * s[1] + a[3] * c[1];
    ob[0] = b[0] * c[2] - b[1] * s[2]; ob[1] = b[0] * s[2] + b[1] * c[2]; ob[2] = b[2] * c[3] - b[3] * s[3]; ob[3] = b[2] * s[3] + b[3] * c[3];
    a = oa; b = ob;
}
struct SrcDense {
    static constexpr bool GATHER = false;
    unsigned lda; const char* B; size_t bt;
    DI int ldb(int K) const { return K; }
    DI size_t ksplit() const { return 0; }
    DI unsigned a_off(const g8::Unit&, int, int) const { return 0u; }
    DI const char* b_ptr(const g8::Unit& u, int) const { return B + (size_t)u.pn * bt; }
};
struct SrcGu {
    static constexpr bool GATHER = true;
    unsigned lda; const int* rt; const int* te; const char* B;
    DI int ldb(int K) const { return K; }
    DI size_t ksplit() const { return 0; }
    DI unsigned a_off(const g8::Unit& u, int h, int R) const { const int v = rt[u.pm * 256 + h * 128 + R]; return (unsigned)(v ? v - 1 : 0) * lda; }
    DI const char* b_ptr(const g8::Unit& u, int) const { const int ee = te[u.pm]; const int e = (u.pn < 2) ? (ee & 255) : (ee >> 8); return B + ((size_t)e * 512 + (size_t)(u.pn & 1) * 256) * 1024 * 2; }
};
struct SrcDn {
    static constexpr bool GATHER = false;
    unsigned lda; const int* te; const char* B;
    DI int ldb(int) const { return 256; }
    DI size_t ksplit() const { return 512; }
    DI unsigned a_off(const g8::Unit&, int, int) const { return 0u; }
    DI const char* b_ptr(const g8::Unit& u, int half) const { const int ee = te[u.pm]; const int e = half ? (ee >> 8) : (ee & 255);
        return B + ((size_t)e * 1024 + (size_t)u.pn * 256) * 256 * 2 - (half ? 512 : 0); }
};
typedef const f32x4 (&AccRef)[2][2][4][2];
using g8::Unit;
struct FIn0 { const P& p;
    template <int BJ> DI void blk(AccRef acc, int row0, int col, const Unit&) const {
        if (col >= 384 && col < 416) { bf16_t* d = p.kpe + (size_t)row0 * 32 + (col - 384);
            const int i0 = (col - 384) >> 1;
#pragma unroll
            for (int ai = 0; ai < 2; ++ai) {
                f32x4 cs[4], sn[4];
#pragma unroll
                for (int m = 0; m < 4; ++m) { const size_t rr = (size_t)(row0 + ai * 128 + m * 16) * 16 + i0; cs[m] = *(const f32x4*)(p.ropec + rr); sn[m] = *(const f32x4*)(p.ropes + rr); }
                __builtin_amdgcn_sched_barrier(0);
#pragma unroll
                for (int m = 0; m < 4; ++m) { const int ro = ai * 128 + m * 16; f32x4 a = acc[ai][BJ][m][0], b = acc[ai][BJ][m][1]; rope8v(cs[m], sn[m], a, b); store_bf8(d + (size_t)ro * 32, a, b); }
                __builtin_amdgcn_sched_barrier(0);
            } }
        else if (col < 384) { bf16_t* d = p.proj + (size_t)row0 * LD0 + col;
            float* pp = p.rsp + (size_t)row0 * 16 + (col >> 5);
            EPI_FOR { EPI_ROW store_bf8(d + (size_t)ro * LD0, a, b);
                float ss = (a[0] * a[0] + a[1] * a[1]) + (a[2] * a[2] + a[3] * a[3]) + (b[0] * b[0] + b[1] * b[1]) + (b[2] * b[2] + b[3] * b[3]);
                ss += __shfl_xor(ss, 16); ss += __shfl_xor(ss, 32);
                if ((col & 31) < 8) pp[(size_t)ro * 16] = ss; } }
        else if (col < 928) { bf16_t* d = p.proj + (size_t)row0 * LD0 + col;
            EPI_FOR { EPI_ROW store_bf8(d + (size_t)ro * LD0, a, b); } }
        else if (col < AB_IN) { bf16_t* d = p.proj + (size_t)row0 * LD0 + 928 + ((col - 928) >> 1);
            EPI_FOR { EPI_ROW u32x2 w; w.x = pk2(a[0] * a[1], a[2] * a[3]); w.y = pk2(b[0] * b[1], b[2] * b[3]); *(u32x2*)(d + (size_t)ro * LD0) = w; } }
    } };
struct FUq { const P& p;
    template <int BJ> DI void blk(AccRef acc, int row0, int col, const Unit&) const {
        const bool rope = ((col >> 5) % 3) == 2; bf16_t* d = p.q + (size_t)row0 * 768 + col; const float* rq = p.rq + row0;
        float rs[8];
#pragma unroll
        for (int q = 0; q < 8; ++q) rs[q] = rq[(q >> 2) * 128 + (q & 3) * 16];
        __builtin_amdgcn_sched_barrier(0);
        if (rope) {
            const int i0 = (col & 31) >> 1;
#pragma unroll
            for (int ai = 0; ai < 2; ++ai) {
                f32x4 cs[4], sn[4];
#pragma unroll
                for (int m = 0; m < 4; ++m) { const size_t rr = (size_t)(row0 + ai * 128 + m * 16) * 16 + i0; cs[m] = *(const f32x4*)(p.ropec + rr); sn[m] = *(const f32x4*)(p.ropes + rr); }
                __builtin_amdgcn_sched_barrier(0);
#pragma unroll
                for (int m = 0; m < 4; ++m) { const int ro = ai * 128 + m * 16; const float r = rs[ai * 4 + m] * QSCALE; f32x4 a = acc[ai][BJ][m][0] * r, b = acc[ai][BJ][m][1] * r;
                    rope8v(cs[m], sn[m], a, b); store_bf8(d + (size_t)ro * 768, a, b); }
                __builtin_amdgcn_sched_barrier(0);
            }
        } else {
            EPI_FOR { EPI_ROW const float r = rs[ai * 4 + m] * QSCALE; a = a * r; b = b * r; store_bf8(d + (size_t)ro * 768, a, b); }
        }
    } };
struct FUkv { const P& p;
    template <int BJ> DI void blk(AccRef acc, int row0, int col, const Unit&) const {
        bf16_t* d = (col < 512) ? p.kn + (size_t)row0 * 512 + col : p.v + (size_t)row0 * 512 + (col - 512); const float* rk = p.rkv + row0;
        float rs[8];
#pragma unroll
        for (int q = 0; q < 8; ++q) rs[q] = rk[(q >> 2) * 128 + (q & 3) * 16];
        __builtin_amdgcn_sched_barrier(0);
        EPI_FOR { EPI_ROW const float r = rs[ai * 4 + m]; store_bf8(d + (size_t)ro * 512, a * r, b * r); }
    } };
struct FOut { const P& p; int l;
    template <int BJ> DI void blk(AccRef acc, int row0, int col, const Unit&) const {
        const float* gp = p.mod + ((size_t)l * 16 + (row0 >> 12)) * 6144 + 2048 + col;
        const f32x4 g0 = *(const f32x4*)gp, g1 = *(const f32x4*)(gp + 4);
        bf16_t* d = p.xr + (size_t)row0 * D + col; const float* xp = p.x + (size_t)row0 * D + col;
        __builtin_amdgcn_sched_barrier(0);
        if (l == 0) {
            f32x4 xs[8][2];
#pragma unroll
            for (int q = 0; q < 8; ++q) { const int ro = (q >> 2) * 128 + (q & 3) * 16; xs[q][0] = *(const f32x4*)(xp + (size_t)ro * D); xs[q][1] = *(const f32x4*)(xp + (size_t)ro * D + 4); }
            __builtin_amdgcn_sched_barrier(0);
#pragma unroll
            for (int q = 0; q < 8; ++q) { const int ro = (q >> 2) * 128 + (q & 3) * 16; const f32x4 a = acc[q >> 2][BJ][q & 3][0], b = acc[q >> 2][BJ][q & 3][1];
                store_bf8(d + (size_t)ro * D, xs[q][0] + g0 * a, xs[q][1] + g1 * b); }
        } else {
            u32x4 rs[8];
#pragma unroll
            for (int q = 0; q < 8; ++q) { const int ro = (q >> 2) * 128 + (q & 3) * 16; rs[q] = *(const u32x4*)(d + (size_t)ro * D); }
            __builtin_amdgcn_sched_barrier(0);
#pragma unroll
            for (int q = 0; q < 8; ++q) { const int ro = (q >> 2) * 128 + (q & 3) * 16; const f32x4 a = acc[q >> 2][BJ][q & 3][0], b = acc[q >> 2][BJ][q & 3][1]; const u32x4 r = rs[q];
                const f32x4 x0 = (f32x4){__uint_as_float(r.x << 16), __uint_as_float(r.x & 0xffff0000u), __uint_as_float(r.y << 16), __uint_as_float(r.y & 0xffff0000u)};
                const f32x4 x1 = (f32x4){__uint_as_float(r.z << 16), __uint_as_float(r.z & 0xffff0000u), __uint_as_float(r.w << 16), __uint_as_float(r.w & 0xffff0000u)};
                store_bf8(d + (size_t)ro * D, x0 + g0 * a, x1 + g1 * b); }
        }
        __builtin_amdgcn_sched_barrier(0);
    } };
struct FIn1 { const P& p;
    template <int BJ> DI void blk(AccRef acc, int row0, int col, const Unit&) const {
        if (col >= 2048 && col < 2304) {
            const float* bg = p.gla_b_g + (col - 2048); const f32x4 b0 = *(const f32x4*)bg, b1 = *(const f32x4*)(bg + 4);
            bf16_t* d = p.loga + (size_t)row0 * 256 + (col - 2048);
            EPI_FOR { EPI_ROW f32x4 o0, o1;
#pragma unroll
                for (int e = 0; e < 4; ++e) { o0[e] = log_sigmoid_f(a[e] + b0[e]) * (1.f / 16.f); o1[e] = log_sigmoid_f(b[e] + b1[e]) * (1.f / 16.f); }
                store_bf8(d + (size_t)ro * 256, o0, o1); }
        } else {
            bf16_t* d = p.proj + (size_t)row0 * LD1 + col;
            if (col < 512) { EPI_FOR { EPI_ROW
#pragma unroll
                for (int e = 0; e < 4; ++e) { a[e] = gelu_tanh_f(a[e]); b[e] = gelu_tanh_f(b[e]); }
                store_bf8(d + (size_t)ro * LD1, a, b); } }
            else if (col < 1024) {
                float* pp = p.rvp + (size_t)row0 * 16 + ((col - 512) >> 5);
                EPI_FOR { EPI_ROW float ss = 0.f;
#pragma unroll
                for (int e = 0; e < 4; ++e) { a[e] = gelu_tanh_f(a[e]); b[e] = gelu_tanh_f(b[e]); ss += a[e] * a[e] + b[e] * b[e]; }
                store_bf8(d + (size_t)ro * LD1, a, b);
                ss += __shfl_xor(ss, 16); ss += __shfl_xor(ss, 32);
                if ((col & 31) < 8) pp[(size_t)ro * 16] = ss; } }
            else { EPI_FOR { EPI_ROW store_bf8(d + (size_t)ro * LD1, a, b); } }
        }
    } };
struct FGu { const P& p; const float* rw;
    template <int BJ> DI void blk(AccRef acc, int row0, int col, const Unit&) const {
        const float* wp = rw + 2 * (size_t)row0 + (col >> 9); bf16_t* d = p.act + (size_t)row0 * 512 + (col >> 1);
        float ws[8];
#pragma unroll
        for (int q = 0; q < 8; ++q) ws[q] = wp[2 * ((q >> 2) * 128 + (q & 3) * 16)];
        __builtin_amdgcn_sched_barrier(0);
        EPI_FOR { EPI_ROW const float w = ws[ai * 4 + m];
            u32x2 o; o.x = pk2(silu_f(a[0]) * a[1] * w, silu_f(a[2]) * a[3] * w); o.y = pk2(silu_f(b[0]) * b[1] * w, silu_f(b[2]) * b[3] * w);
            *(u32x2*)(d + (size_t)ro * 512) = o; }
    } };
struct FNull {
    template <int BJ> DI void blk(AccRef acc, int, int, const Unit&) const { EPI_FOR { EPI_ROW asm volatile("" :: "v"(a[0]), "v"(a[1]), "v"(a[2]), "v"(a[3]), "v"(b[0]), "v"(b[1]), "v"(b[2]), "v"(b[3])); } } };
struct FDn { const P& p; const int* rt; int l;
    template <int BJ> DI void blk(AccRef acc, int row0, int col, const Unit&) const {
        int tk[8];
#pragma unroll
        for (int q = 0; q < 8; ++q) tk[q] = rt[row0 + (q >> 2) * 128 + (q & 3) * 16];
        __builtin_amdgcn_sched_barrier(0);
        u32x4 xs[8]; f32x4 g0[4], g1[4];
#pragma unroll
        for (int q = 0; q < 8; ++q) { const int t = tk[q]; xs[q] = *(const u32x4*)(p.xr + (size_t)(t ? t - 1 : 0) * D + col); }
#pragma unroll
        for (int ai = 0; ai < 2; ++ai) {
#pragma unroll
            for (int m = 0; m < 4; ++m) { const int t = tk[ai * 4 + m]; const int tt = t ? t - 1 : 0;
                const float* gp = p.mod + ((size_t)l * 16 + (tt >> 12)) * 6144 + 5 * 1024 + col; g0[m] = *(const f32x4*)gp; g1[m] = *(const f32x4*)(gp + 4); }
            __builtin_amdgcn_sched_barrier(0);
#pragma unroll
            for (int m = 0; m < 4; ++m) { const int t = tk[ai * 4 + m];
                if (t) { const u32x4 r = xs[ai * 4 + m]; const f32x4 a = acc[ai][BJ][m][0], b = acc[ai][BJ][m][1];
                    const f32x4 x0 = (f32x4){__uint_as_float(r.x << 16), __uint_as_float(r.x & 0xffff0000u), __uint_as_float(r.y << 16), __uint_as_float(r.y & 0xffff0000u)};
                    const f32x4 x1 = (f32x4){__uint_as_float(r.z << 16), __uint_as_float(r.z & 0xffff0000u), __uint_as_float(r.w << 16), __uint_as_float(r.w & 0xffff0000u)};
                    store_bf8(p.xr + (size_t)(t - 1) * D + col, x0 + g0[m] * a, x1 + g1[m] * b); } }
            __builtin_amdgcn_sched_barrier(0);
        }
    } };

enum { J_IN0 = 0, J_UQ, J_UKV, J_OUT0, J_IN1, J_OUT1, J_GU, J_DN, J_R, J_NUM };
DI float wval(const P& p, int job, int sub, int k, int n) {
    switch (job) {
    case J_IN0: {
        if (n >= AB_IN) return 0.f;
        int src = n;
        if (n >= 384 && n < 416) { const int i = n - 384; src = 384 + (i >> 1) + (i & 1) * 16; }
        else if (n >= 928) { const int i = n - 928; src = ((i & 1) ? 1440 : 928) + (i >> 1); }
        return p.ab_w_in[(size_t)k * AB_IN + src];
    }
    case J_UQ: {
        const int h = n / 96, j = n % 96; int src = 96 * h + j;
        if (j >= 64) { const int i = j - 64; src = 96 * h + 64 + (i >> 1) + (i & 1) * 16; }
        return p.w_uq[(size_t)k * 768 + src] * p.q_norm_g[k];
    }
    case J_UKV: {
        int src;
        if (n < 512) { src = 128 * (n >> 6) + (n & 63); } else { const int m = n - 512; src = 128 * (m >> 6) + 64 + (m & 63); }
        return p.w_ukv[(size_t)k * 1024 + src] * p.kv_norm_g[k];
    }
    case J_OUT0: return p.ab_w_out[(size_t)k * 1024 + n];
    case J_IN1: {
        if (n < 2048) return p.cd_w_in[(size_t)k * CD_IN + n];
        if (n < 2304) { const int j = n - 2048; float s = 0.f;
#pragma unroll
            for (int r = 0; r < 16; ++r) s += p.cd_w_in[(size_t)k * CD_IN + 2048 + r] * p.gla_w_g2[r * 256 + j];
            return s; }
        return p.cd_w_in[(size_t)k * CD_IN + 2064 + (n - 2304)];
    }
    case J_OUT1: return p.cd_w_out[(size_t)k * 1024 + n];
    case J_GU: { const int j = n >> 1; const int src = (n & 1) ? 256 + j : j; return p.moe_w_gate_up[((size_t)sub * 1024 + k) * 512 + src]; }
    case J_DN: return p.moe_w_down[((size_t)sub * 256 + k) * 1024 + n];
    case J_R: { if (n < 4) return p.moe_w_group[((size_t)sub * 1024 + k) * 4 + n]; if (n < 36) return p.moe_w_expert[((size_t)sub * 1024 + k) * 32 + (n - 4)]; return 0.f; }
    }
    return 0.f;
}
struct JobInfo { int K, N, nsub; };
DI JobInfo job_info(int job) {
    switch (job) {
    case J_IN0: return {1024, LD0, 1};
    case J_UQ: return {256, 768, 1};
    case J_UKV: return {128, 1024, 1};
    case J_OUT0: return {1024, 1024, 1};
    case J_IN1: return {1024, LD1, 1};
    case J_OUT1: return {1024, 1024, 1};
    case J_GU: return {1024, 512, 64};
    case J_DN: return {256, 1024, 64};
    default: return {1024, 64, 2};
    }
}
constexpr size_t WO_IN0 = 0, WO_UQ = WO_IN0 + (size_t)LD0 * 1024, WO_UKV = WO_UQ + 768 * 256, WO_OUT0 = WO_UKV + 1024 * 128, WO_IN1 = WO_OUT0 + 1024 * 1024,
    WO_OUT1 = WO_IN1 + (size_t)LD1 * 1024, WO_GU = WO_OUT1 + 1024 * 1024, WO_DN = WO_GU + (size_t)64 * 512 * 1024, WO_R = WO_DN + (size_t)64 * 1024 * 256, WO_END = WO_R + 2 * 64 * 1024;
DI int slow_nt(int job) { switch (job) { case J_IN0: return 3; case J_UQ: return 24; case J_UKV: return 32; case J_IN1: return 8; case J_R: return 2; default: return 0; } }
DI int slow_nb(int job) { switch (job) { case J_IN0: return AB_IN; case J_IN1: return 2048; default: return 0; } }
DI size_t job_dst_off(int job) {
    switch (job) {
    case J_IN0: return WO_IN0; case J_UQ: return WO_UQ; case J_UKV: return WO_UKV; case J_OUT0: return WO_OUT0;
    case J_IN1: return WO_IN1; case J_OUT1: return WO_OUT1; case J_GU: return WO_GU; case J_DN: return WO_DN; default: return WO_R;
    }
}
DI void ph_prep(const P& p, LAS unsigned char* lds) {
    const int tid = tid_();
#ifndef PREP_A
#define PREP_A 1
#define PREP_B 1
#define PREP_C 1
#endif
    for (int rep_ = 0; rep_ < PREP_A; ++rep_)
    {
        const int lane = tid & 63, w = tid >> 6, lq = lane >> 4, lc = lane & 15;
        LAS float* cact = (LAS float*)lds;
        for (int item = blockIdx.x; item < 256; item += gridDim.x) {
            const int l = item >> 7, j0 = (item & 127) * 48;
            const float* W = p.adaln_w + ((size_t)l * 1024 + w * 128 + lq) * 6144 + j0 + 3 * lc;
            float wv0[16][3], wv1[16][3];
#define MOD_LOAD(wv_, half_) _Pragma("unroll") for (int i = 0; i < 16; ++i) { const float* q = W + (size_t)((half_) * 64 + 4 * i) * 6144; wv_[i][0] = q[0]; wv_[i][1] = q[1]; wv_[i][2] = q[2]; }
#define MOD_FMA(wv_, half_) _Pragma("unroll") for (int i = 0; i < 16; ++i) { const LAS f32x4* cp = (const LAS f32x4*)(cact + (w * 128 + (half_) * 64 + 4 * i + lq) * 16); \
                _Pragma("unroll") for (int b4 = 0; b4 < 4; ++b4) { const f32x4 cv = cp[b4]; \
                    _Pragma("unroll") for (int e = 0; e < 4; ++e) { acc[4 * b4 + e][0] += cv[e] * wv_[i][0]; acc[4 * b4 + e][1] += cv[e] * wv_[i][1]; acc[4 * b4 + e][2] += cv[e] * wv_[i][2]; } } }
            MOD_LOAD(wv0, 0)
            { float cv[32];
#pragma unroll
              for (int j = 0; j < 32; ++j) { const int i = tid + j * NTHR; cv[j] = p.c[(i & 15) * 1024 + (i >> 4)]; }
#pragma unroll
              for (int j = 0; j < 32; ++j) cact[tid + j * NTHR] = silu_f(cv[j]); }
            MOD_LOAD(wv1, 1)
            __syncthreads();
            float acc[16][3];
#pragma unroll
            for (int b = 0; b < 16; ++b) { acc[b][0] = 0.f; acc[b][1] = 0.f; acc[b][2] = 0.f; }
            MOD_FMA(wv0, 0)
            MOD_FMA(wv1, 1)
#undef MOD_LOAD
#undef MOD_FMA
            __syncthreads();
#pragma unroll
            for (int b = 0; b < 16; ++b)
#pragma unroll
                for (int e = 0; e < 3; ++e) cact[(w * 4 + lq) * 768 + b * 48 + 3 * lc + e] = acc[b][e];
            __syncthreads();
            for (int o = tid; o < 768; o += NTHR) {
                float s = 0.f;
#pragma unroll 8
                for (int q = 0; q < 32; ++q) s += cact[q * 768 + o];
                const int b = o / 48, jj = j0 + o % 48;
                p.mod[((size_t)l * 16 + b) * 6144 + jj] = s + p.adaln_b[l * 6144 + jj];
            }
            __syncthreads();
        }
    }
    for (int rep_ = 0; rep_ < PREP_B; ++rep_)
    {
        const int lane = tid & 63, wid = tid >> 6;
        LAS float* scr = (LAS float*)(lds + wid * (64 * 72 * 2));
        int total = 0;
#pragma unroll
        for (int j = 0; j < J_NUM; ++j) { const JobInfo ji = job_info(j); total += (ji.K / 64) * slow_nt(j) * ji.nsub; }
        for (int item = blockIdx.x * NWAVE + wid; item < total; item += gridDim.x * NWAVE) {
            int job = 0, jstart = 0, accn = 0;
#pragma unroll
            for (int j = 0; j < J_NUM; ++j) { const JobInfo jj = job_info(j); if (slow_nt(j) == 0) continue; if (item >= accn) { job = j; jstart = accn; } accn += (jj.K / 64) * slow_nt(j) * jj.nsub; }
#ifndef PREP_JOBREP
#define PREP_JOBREP -1
#endif
            for (int jr_ = 0; jr_ < ((job == PREP_JOBREP) ? 2 : 1); ++jr_) {
            const JobInfo ji = job_info(job);
            int r = item - jstart;
            const int kt = ji.K / 64, nt = slow_nt(job);
            const int sub = r / (kt * nt); r -= sub * kt * nt;
            const int n0 = slow_nb(job) + (r % nt) * 32, k0 = (r / nt) * 64;
            {
                const int n = n0 + (lane & 31);
                const float* cp = nullptr; size_t ldk = 0; const float* gain = nullptr; bool slow = false;
                switch (job) {
                case J_IN0: { if (n < AB_IN) { int src = n; if (n >= 384 && n < 416) { const int i = n - 384; src = 384 + (i >> 1) + (i & 1) * 16; } else if (n >= 928) { const int i = n - 928; src = ((i & 1) ? 1440 : 928) + (i >> 1); } cp = p.ab_w_in + src; ldk = AB_IN; } } break;
                case J_UQ: { const int h = n / 96, j = n % 96; int src = 96 * h + j; if (j >= 64) { const int i = j - 64; src = 96 * h + 64 + (i >> 1) + (i & 1) * 16; } cp = p.w_uq + src; ldk = 768; gain = p.q_norm_g; } break;
                case J_UKV: { int src; if (n < 512) src = 128 * (n >> 6) + (n & 63); else { const int m = n - 512; src = 128 * (m >> 6) + 64 + (m & 63); } cp = p.w_ukv + src; ldk = 1024; gain = p.kv_norm_g; } break;
                case J_OUT0: cp = p.ab_w_out + n; ldk = 1024; break;
                case J_IN1: { if (n < 2048) { cp = p.cd_w_in + n; ldk = CD_IN; } else if (n < 2304) slow = true; else { cp = p.cd_w_in + 2064 + (n - 2304); ldk = CD_IN; } } break;
                case J_OUT1: cp = p.cd_w_out + n; ldk = 1024; break;
                case J_GU: { const int j = n >> 1; cp = p.moe_w_gate_up + (size_t)sub * 1024 * 512 + ((n & 1) ? 256 + j : j); ldk = 512; } break;
                case J_DN: cp = p.moe_w_down + (size_t)sub * 256 * 1024 + n; ldk = 1024; break;
                default: { if (n < 4) { cp = p.moe_w_group + (size_t)sub * 1024 * 4 + n; ldk = 4; } else if (n < 36) { cp = p.moe_w_expert + (size_t)sub * 1024 * 32 + (n - 4); ldk = 32; } } break;
                }
                const int kb = k0 + (lane >> 5);
                if (job == J_IN1 && n0 >= 2048 && n0 < 2304) {
                    float g2[16];
#pragma unroll
                    for (int r2 = 0; r2 < 16; ++r2) g2[r2] = p.gla_w_g2[r2 * 256 + (n - 2048)];
                    {
                        const float* wr = p.cd_w_in + (size_t)(k0 + lane) * CD_IN + 2048;
                        const f32x4 a = *(const f32x4*)wr, b = *(const f32x4*)(wr + 4), c = *(const f32x4*)(wr + 8), d = *(const f32x4*)(wr + 12);
                        LAS f32x4* st = (LAS f32x4*)scr;
                        st[lane * 4 + 0] = a; st[lane * 4 + 1] = b; st[lane * 4 + 2] = c; st[lane * 4 + 3] = d;
                        asm volatile("s_waitcnt lgkmcnt(0)" ::: "memory");
                        float res[32];
#pragma unroll
                        for (int i = 0; i < 32; ++i) { const int row = 2 * i + (lane >> 5); const f32x4 x0 = st[row * 4 + 0], x1 = st[row * 4 + 1], x2 = st[row * 4 + 2], x3 = st[row * 4 + 3];
                            float v = 0.f;
#pragma unroll
                            for (int e = 0; e < 4; ++e) v += x0[e] * g2[e] + x1[e] * g2[4 + e] + x2[e] * g2[8 + e] + x3[e] * g2[12 + e];
                            res[i] = v; }
                        asm volatile("s_waitcnt lgkmcnt(0)" ::: "memory");
#pragma unroll
                        for (int i = 0; i < 32; ++i) scr[(2 * i + (lane >> 5)) * 33 + (lane & 31)] = res[i];
                    }
                } else if (__any(slow)) {
#pragma unroll 8
                    for (int i = 0; i < 32; ++i) scr[(2 * i + (lane >> 5)) * 33 + (lane & 31)] = wval(p, job, sub, kb + 2 * i, n);
                } else {
                    const float* q = cp ? cp + (size_t)kb * ldk : nullptr;
#pragma unroll
                    for (int i = 0; i < 32; ++i) { float v = q ? q[(size_t)(2 * i) * ldk] : 0.f; if (gain) v *= gain[kb + 2 * i]; scr[(2 * i + (lane >> 5)) * 33 + (lane & 31)] = v; }
                }
            }
            asm volatile("s_waitcnt lgkmcnt(0)" ::: "memory");
            bf16_t* dst = p.wt_in0 + job_dst_off(job) + (size_t)sub * ji.K * ji.N;
            const int c = lane & 7;
#pragma unroll
            for (int j = 0; j < 4; ++j) { const int n = (lane >> 3) + 8 * j; const LAS float* sp = scr + (8 * c) * 33 + n;
                u32x4 o; o.x = pk2(sp[0 * 33], sp[1 * 33]); o.y = pk2(sp[2 * 33], sp[3 * 33]); o.z = pk2(sp[4 * 33], sp[5 * 33]); o.w = pk2(sp[6 * 33], sp[7 * 33]);
                *(u32x4*)(dst + (size_t)(n0 + n) * ji.K + k0 + 8 * c) = o; }
            asm volatile("s_waitcnt lgkmcnt(0)" ::: "memory");
            }
        }
    }
    for (int rep_ = 0; rep_ < PREP_B; ++rep_)
    {
        const int lane = tid & 63, wid = tid >> 6, g = lane >> 4, i15 = lane & 15, tq = i15 >> 2, tp = i15 & 3;
        LAS unsigned char* tl = lds + wid * (64 * 72 * 2);
        const int NW = gridDim.x * NWAVE;
        for (int item = NW - 1 - (blockIdx.x * NWAVE + wid); item < 496 + 256 + 256 + 640; item += NW) {
            const float* src; bf16_t* dst; int ld, k0, c0, ncol, kind;
            if (item < 496) { k0 = (item / 31) * 64; c0 = (item % 31) * 64; ld = AB_IN; ncol = AB_IN; kind = 1; src = p.ab_w_in; dst = p.wt_in0; }
            else if (item < 752) { const int r = item - 496; k0 = (r >> 4) * 64; c0 = (r & 15) * 64; ld = 1024; ncol = 1024; kind = 0; src = p.ab_w_out; dst = p.wt_out0; }
            else if (item < 1008) { const int r = item - 752; k0 = (r >> 4) * 64; c0 = (r & 15) * 64; ld = 1024; ncol = 1024; kind = 0; src = p.cd_w_out; dst = p.wt_out1; }
            else { const int r = item - 1008; const int ct = r % 40; k0 = (r / 40) * 64; c0 = ct < 32 ? ct * 64 : 2064 + (ct - 32) * 64; ld = CD_IN; ncol = CD_IN; kind = 2; src = p.cd_w_in; dst = p.wt_in1; }
            src += (size_t)k0 * ld + c0;
            const bool lv = c0 + 4 * i15 < ncol;
            f32x4 v[16];
#pragma unroll
            for (int i = 0; i < 16; ++i) v[i] = lv ? *(const f32x4*)(src + (size_t)(4 * i + g) * ld + 4 * i15) : (f32x4){0.f, 0.f, 0.f, 0.f};
#pragma unroll
            for (int i = 0; i < 16; ++i) { u32x2 w; w.x = pk2(v[i][0], v[i][1]); w.y = pk2(v[i][2], v[i][3]); *(LAS u32x2*)(tl + ((4 * i + g) * 72 + 4 * i15) * 2) = w; }
            asm volatile("s_waitcnt lgkmcnt(0)" ::: "memory");
#pragma unroll
            for (int ps = 0; ps < 8; ++ps) {
                const int cb = 16 * (ps & 3), ch = (ps >> 2) * 4 + g;
                const s16x4 lo = vtr(tl + ((8 * ch + tq) * 72 + cb + 4 * tp) * 2), hi4 = vtr(tl + ((8 * ch + 4 + tq) * 72 + cb + 4 * tp) * 2);
                const int c = c0 + cb + i15;
                int n = c;
                if (kind == 1) { if (c >= 384 && c < 416) { const int j = c - 384; n = 384 + (j < 16 ? 2 * j : 2 * (j - 16) + 1); } else if (c >= 1440) n = 928 + 2 * (c - 1440) + 1; else if (c >= 928) n = 928 + 2 * (c - 928); }
                else if (kind == 2) { if (c >= 2064) n = c - 2064 + 2304; }
                u32x4 o; o.x = (unsigned)(unsigned short)lo[0] | ((unsigned)(unsigned short)lo[1] << 16); o.y = (unsigned)(unsigned short)lo[2] | ((unsigned)(unsigned short)lo[3] << 16);
                o.z = (unsigned)(unsigned short)hi4[0] | ((unsigned)(unsigned short)hi4[1] << 16); o.w = (unsigned)(unsigned short)hi4[2] | ((unsigned)(unsigned short)hi4[3] << 16);
                if (c < ncol) *(u32x4*)(dst + (size_t)n * 1024 + k0 + 8 * ch) = o;
            }
            asm volatile("s_waitcnt lgkmcnt(0)" ::: "memory");
        }
    }
    for (int rep_ = 0; rep_ < PREP_B; ++rep_)
    {
        const int lane = tid & 63, wid = tid >> 6, g = lane >> 4, i15 = lane & 15, tq = i15 >> 2, tp = i15 & 3;
        LAS unsigned char* tl = lds + wid * (64 * 72 * 2);
#define B2_SRC(it_, src_, ld_) do { if ((it_) < 8192) { const int sub_ = (it_) >> 7, rr_ = (it_) & 127; ld_ = 512; src_ = p.moe_w_gate_up + ((size_t)sub_ * 1024 + (rr_ >> 3) * 64) * 512 + (rr_ & 7) * 64; } \
            else { const int r_ = (it_) - 8192; const int sub_ = r_ >> 6, rr_ = r_ & 63; ld_ = 1024; src_ = p.moe_w_down + ((size_t)sub_ * 256 + (rr_ >> 4) * 64) * 1024 + (rr_ & 15) * 64; } } while (0)
        f32x4 v[16], vn[16];
        const int NW = gridDim.x * NWAVE, NI = 8192 + 4096;
#define B2_LOAD(v_, it_) do { const float* s_; int l_; B2_SRC(it_, s_, l_); _Pragma("unroll") for (int i = 0; i < 16; ++i) v_[i] = *(const f32x4*)(s_ + (size_t)(4 * i + g) * l_ + 4 * i15); } while (0)
#define B2_PROC(v_, it_) do { \
            bf16_t* dst; int Kd, k0, c0; bool gu; \
            if ((it_) < 8192) { const int sub = (it_) >> 7, rr = (it_) & 127; k0 = (rr >> 3) * 64; c0 = (rr & 7) * 64; Kd = 1024; gu = true; dst = p.wt_gu + (size_t)sub * 512 * 1024; } \
            else { const int r = (it_) - 8192; const int sub = r >> 6, rr = r & 63; k0 = (rr >> 4) * 64; c0 = (rr & 15) * 64; Kd = 256; gu = false; dst = p.wt_dn + (size_t)sub * 1024 * 256; } \
            _Pragma("unroll") for (int i = 0; i < 16; ++i) { u32x2 w; w.x = pk2(v_[i][0], v_[i][1]); w.y = pk2(v_[i][2], v_[i][3]); *(LAS u32x2*)(tl + ((4 * i + g) * 72 + 4 * i15) * 2) = w; } \
            asm volatile("s_waitcnt lgkmcnt(0)" ::: "memory"); \
            _Pragma("unroll") for (int ps = 0; ps < 8; ++ps) { \
                const int cb = 16 * (ps & 3), ch = (ps >> 2) * 4 + g; \
                const s16x4 lo = vtr(tl + ((8 * ch + tq) * 72 + cb + 4 * tp) * 2), hi4 = vtr(tl + ((8 * ch + 4 + tq) * 72 + cb + 4 * tp) * 2); \
                const int c = c0 + cb + i15; \
                const int n = gu ? ((c < 256) ? 2 * c : 2 * (c - 256) + 1) : c; \
                u32x4 o; o.x = (unsigned)(unsigned short)lo[0] | ((unsigned)(unsigned short)lo[1] << 16); o.y = (unsigned)(unsigned short)lo[2] | ((unsigned)(unsigned short)lo[3] << 16); \
                o.z = (unsigned)(unsigned short)hi4[0] | ((unsigned)(unsigned short)hi4[1] << 16); o.w = (unsigned)(unsigned short)hi4[2] | ((unsigned)(unsigned short)hi4[3] << 16); \
                *(u32x4*)(dst + (size_t)n * Kd + k0 + 8 * ch) = o; \
            } \
            asm volatile("s_waitcnt lgkmcnt(0)" ::: "memory"); } while (0)
        int item = blockIdx.x * NWAVE + wid;
        if (item < NI) B2_LOAD(v, item);
        for (; item < NI; item += 2 * NW) {
            { const int nx = item + NW < NI ? item + NW : NI - 1; B2_LOAD(vn, nx); }
            __builtin_amdgcn_sched_barrier(0);
            B2_PROC(v, item);
            if (item + NW < NI) {
                { const int nx = item + 2 * NW < NI ? item + 2 * NW : NI - 1; B2_LOAD(v, nx); }
                __builtin_amdgcn_sched_barrier(0);
                B2_PROC(vn, item + NW);
            }
        }
#undef B2_LOAD
#undef B2_PROC
#undef B2_SRC
    }
    for (int rep_ = 0; rep_ < PREP_C; ++rep_)
    if (gridDim.x * NTHR * 8 == NTOK * 16) {
        const int g0 = blockIdx.x * NTHR + tid; int ps[8];
#pragma unroll
        for (int j = 0; j < 8; ++j) ps[j] = p.pos[(g0 + j * (NTOK * 2)) >> 4];
        const float inv = exp2f(-(float)(g0 & 15) * (13.287712379549449f / 16.0f));
#pragma unroll 1
        for (int j = 0; j < 8; ++j) { const int gid = g0 + j * (NTOK * 2); float sn, cs; sincosf((float)ps[j] * inv, &sn, &cs); p.ropec[gid] = cs; p.ropes[gid] = sn; }
    } else
    for (int gid = blockIdx.x * NTHR + tid; gid < NTOK * 16; gid += gridDim.x * NTHR) {
        const int tok = gid >> 4, i = gid & 15;
        const float inv = exp2f(-(float)i * (13.287712379549449f / 16.0f));
        float sn, cs; sincosf((float)p.pos[tok] * inv, &sn, &cs);
        p.ropec[gid] = cs; p.ropes[gid] = sn;
    }
}

template <bool F32IN>
DI void ph_norm(const P& p, const void* xin_, const float* g, int l, int which) {
    const int tid = tid_(); const int lane = tid & 63;
    constexpr int R = 8;
    const int gw = blockIdx.x * NWAVE + (tid >> 6), NWV = gridDim.x * NWAVE; const bool bm = (NWV == 2048);
    f32x4 ggv[4], shv[4], scv[4]; int cur_b = -1;
    for (int it = 0;; ++it) {
        const int row0 = bm ? (gw & 15) * 4096 + (gw >> 4) * 32 + it * R : (gw + it * NWV) * R;
        if (bm ? (it >= 32 / R) : (row0 >= NTOK)) break;
        const int b = row0 >> 12;
        const float* md = p.mod + ((size_t)l * 16 + b) * 6144 + which * 3072;
        f32x4 v[R][4]; float ss[R];
#pragma unroll
        for (int r = 0; r < R; ++r)
#pragma unroll
            for (int i = 0; i < 4; ++i) {
                if (F32IN) v[r][i] = *(const f32x4*)((const float*)xin_ + (size_t)(row0 + r) * D + i * 256 + lane * 4);
                else { const u32x2 q = *(const u32x2*)((const bf16_t*)xin_ + (size_t)(row0 + r) * D + i * 256 + lane * 4);
                       v[r][i] = (f32x4){__uint_as_float(q.x << 16), __uint_as_float(q.x & 0xffff0000u), __uint_as_float(q.y << 16), __uint_as_float(q.y & 0xffff0000u)}; }
            }
        if (b != cur_b) { cur_b = b;
#pragma unroll
            for (int i = 0; i < 4; ++i) { const int c0 = i * 256 + lane * 4; ggv[i] = *(const f32x4*)(g + c0); shv[i] = *(const f32x4*)(md + c0); scv[i] = *(const f32x4*)(md + 1024 + c0); } }
        __builtin_amdgcn_sched_barrier(0);
#pragma unroll
        for (int r = 0; r < R; ++r) { float a = 0.f;
#pragma unroll
            for (int i = 0; i < 4; ++i) a += v[r][i][0] * v[r][i][0] + v[r][i][1] * v[r][i][1] + v[r][i][2] * v[r][i][2] + v[r][i][3] * v[r][i][3];
            ss[r] = rsqrtf(wave_sum(a) * (1.f / D) + EPS); }
#pragma unroll
        for (int i = 0; i < 4; ++i) {
            const int c0 = i * 256 + lane * 4;
            const f32x4 gg = ggv[i], sh = shv[i], sc = scv[i];
#pragma unroll
            for (int r = 0; r < R; ++r) {
                float o[4];
#pragma unroll
                for (int e = 0; e < 4; ++e) o[e] = v[r][i][e] * ss[r] * gg[e] * (1.f + sc[e]) + sh[e];
                u32x2 w; w.x = pk2(o[0], o[1]); w.y = pk2(o[2], o[3]);
                *(u32x2*)(p.xa + (size_t)(row0 + r) * D + c0) = w;
            }
        }
    }
}
DI void ph_rowstat0_conv(const P& p) {
    const int tid = tid_(); const int lane = tid & 63;
    float cw[3][8];
#pragma unroll
    for (int k = 0; k < 3; ++k) { const f32x4 a = *(const f32x4*)(p.conv_w + k * 512 + lane * 8), b = *(const f32x4*)(p.conv_w + k * 512 + lane * 8 + 4);
#pragma unroll
        for (int e = 0; e < 4; ++e) { cw[k][e] = a[e]; cw[k][4 + e] = b[e]; } }
    for (int blk = blockIdx.x * NWAVE + (tid >> 6); blk < NTOK / 16; blk += gridDim.x * NWAVE) {
        const int row0 = blk * 16;
        const bool seq0 = (row0 & 4095) == 0;
        u32x4 hc[2];
#pragma unroll
        for (int d = 1; d <= 2; ++d) hc[d - 1] = *(const u32x4*)(p.proj + (size_t)(seq0 ? row0 : row0 - d) * LD0 + 928 + lane * 8);
        f32x4 ps0, ps1, ps2;
        { const f32x4* pp = (const f32x4*)(p.rsp + (size_t)(row0 + (lane & 15)) * 16); ps0 = pp[0]; ps1 = pp[1]; ps2 = pp[2]; }
        float u1[8], u2[8];
#pragma unroll
        for (int hb = 0; hb < 2; ++hb) {
            u32x4 bgv[8], cv[8];
#pragma unroll
            for (int i = 0; i < 8; ++i) { const bf16_t* r = p.proj + (size_t)(row0 + hb * 8 + i) * LD0; bgv[i] = *(const u32x4*)(r + 416 + lane * 8); cv[i] = *(const u32x4*)(r + 928 + lane * 8); }
            __builtin_amdgcn_sched_barrier(0);
            if (hb == 0) {
#pragma unroll
                for (int e = 0; e < 4; ++e) { u1[2 * e] = seq0 ? 0.f : __uint_as_float(hc[0][e] << 16); u1[2 * e + 1] = seq0 ? 0.f : __uint_as_float(hc[0][e] & 0xffff0000u);
                    u2[2 * e] = seq0 ? 0.f : __uint_as_float(hc[1][e] << 16); u2[2 * e + 1] = seq0 ? 0.f : __uint_as_float(hc[1][e] & 0xffff0000u); }
                if (lane < 16) {
                    const float sq = ((ps0[0] + ps0[1]) + (ps0[2] + ps0[3])) + ((ps1[0] + ps1[1]) + (ps1[2] + ps1[3])), sk = (ps2[0] + ps2[1]) + (ps2[2] + ps2[3]);
                    p.rq[row0 + lane] = rsqrtf(sq * (1.f / 256.f) + EPS); p.rkv[row0 + lane] = rsqrtf(sk * (1.f / 128.f) + EPS);
                }
            }
#pragma unroll
            for (int i = 0; i < 8; ++i) {
                const int row = row0 + hb * 8 + i;
                const u32x4 bg = bgv[i], c = cv[i];
                u32x4 o;
#pragma unroll
                for (int e = 0; e < 4; ++e) {
                    const float v0 = __uint_as_float(c[e] << 16), v1 = __uint_as_float(c[e] & 0xffff0000u);
                    const float y0 = cw[0][2 * e] * u2[2 * e] + cw[1][2 * e] * u1[2 * e] + cw[2][2 * e] * v0;
                    const float y1 = cw[0][2 * e + 1] * u2[2 * e + 1] + cw[1][2 * e + 1] * u1[2 * e + 1] + cw[2][2 * e + 1] * v1;
                    u2[2 * e] = u1[2 * e]; u2[2 * e + 1] = u1[2 * e + 1]; u1[2 * e] = v0; u1[2 * e + 1] = v1;
                    o[e] = pk2(__uint_as_float(bg[e] << 16) * y0, __uint_as_float(bg[e] & 0xffff0000u) * y1);
                }
                *(u32x4*)(p.mix + (size_t)row * D + 512 + lane * 8) = o;
            }
        }
    }
}
constexpr int GL_QS = 72, GL_VS = 144;
constexpr int GX_SEG = 0, GX_QD = 2048, GX_KD = GX_QD + 64 * GL_QS * 2, GX_KE = GX_KD + 64 * GL_QS * 2, GX_V = GX_KE + 64 * GL_QS * 2, GX_DEC = GX_V + 64 * GL_VS * 2, GX_END = GX_DEC + 256;
constexpr int GL_NGRP = (NTOK / 64 / 8) * 4;
DI int gl_step_item(int s, int bx, int G) {
    const int gi = bx + (s >> 3) * G; if (gi >= GL_NGRP) return -1;
    return (((gi >> 5) * 64 + (gi & 7) * 8 + (s & 7)) << 2) + ((gi >> 3) & 3);
}
DI void ph_stat1x(const P& p, LAS unsigned char* lds) {
    const int tid = tid_(); const int lane = tid & 63, w = __builtin_amdgcn_readfirstlane(tid >> 6), l15 = lane & 15, g = lane >> 4, tq = l15 >> 2, tp = l15 & 3;
    const int G = gridDim.x, bx = blockIdx.x;
    for (int row = bx * NTHR + tid; row < NTOK; row += G * NTHR) {
        const f32x4* pp = (const f32x4*)(p.rvp + (size_t)row * 16);
        const f32x4 s0 = pp[0], s1 = pp[1], s2 = pp[2], s3 = pp[3];
        const float s = ((s0[0] + s0[1]) + (s0[2] + s0[3])) + ((s1[0] + s1[1]) + (s1[2] + s1[3])) + ((s2[0] + s2[1]) + (s2[2] + s2[3])) + ((s3[0] + s3[1]) + (s3[2] + s3[3]));
        p.rv[row] = rsqrtf(s * (1.f / 512.f) + EPS);
    }
    bf16_t nbc[8], nq[8], nk[8]; u32x4 nrv[2];
#define GX_LOAD(it_) do { const int h_ = (it_) & 3; const size_t row0_ = (size_t)((it_) >> 2) * 64; \
        const bf16_t* la_ = p.loga + (row0_ + 8 * w) * 256 + h_ * 64 + lane; const bf16_t* pq_ = p.proj + (row0_ + 8 * w) * LD1 + 1024 + h_ * 64 + lane; \
        _Pragma("unroll") for (int i = 0; i < 8; ++i) { nbc[i] = la_[(size_t)i * 256]; nq[i] = pq_[(size_t)i * LD1]; nk[i] = pq_[(size_t)i * LD1 + 256]; } \
        _Pragma("unroll") for (int i = 0; i < 2; ++i) { const int c = i * 512 + tid; nrv[i] = *(const u32x4*)(p.proj + (row0_ + (c >> 4)) * LD1 + 1536 + h_ * 128 + (c & 15) * 8); } } while (0)
#define GX_BAR() do { asm volatile("s_waitcnt lgkmcnt(0)" ::: "memory"); __builtin_amdgcn_s_barrier(); asm volatile("" ::: "memory"); } while (0)
    { const int it0 = gl_step_item(0, bx, G); if (it0 >= 0) GX_LOAD(it0); }
    f32x4 Sg[4]; float blsum = 0.f;
#pragma unroll
    for (int dkt = 0; dkt < 4; ++dkt) Sg[dkt] = (f32x4){0.f, 0.f, 0.f, 0.f};
    for (int st = 0;; ++st) {
        const int it = gl_step_item(st, bx, G); if (it < 0) break;
        const int h = it & 3, ck = it >> 2;
        const size_t row0 = (size_t)ck * 64;
        float bc[8], qv[8], kv[8]; u32x4 rvv[2];
#pragma unroll
        for (int i = 0; i < 8; ++i) { bc[i] = bf2f(nbc[i]); qv[i] = bf2f(nq[i]); kv[i] = bf2f(nk[i]); }
        rvv[0] = nrv[0]; rvv[1] = nrv[1];
        { const int itn = gl_step_item(st + 1, bx, G); const int itl = itn >= 0 ? itn : it; GX_LOAD(itl); }
#pragma unroll
        for (int i = 1; i < 8; ++i) bc[i] += bc[i - 1];
        ((LAS float*)(lds + GX_SEG))[w * 64 + lane] = bc[7];
#pragma unroll
        for (int i = 0; i < 2; ++i) { const int c = i * 512 + tid; *(LAS u32x4*)(lds + GX_V + ((c >> 4) * GL_VS + (c & 15) * 8) * 2) = rvv[i]; }
        GX_BAR();
        float off = 0.f, bl = 0.f;
#pragma unroll
        for (int ww = 0; ww < 8; ++ww) { const float sg = ((const LAS float*)(lds + GX_SEG))[ww * 64 + lane]; bl += sg; off += (ww < w) ? sg : 0.f; }
#pragma unroll
        for (int i = 0; i < 8; ++i) {
            const float x = bc[i] + off, eb = __expf(x);
            const int o = ((8 * w + i) * GL_QS + lane) * 2;
            *(LAS bf16_t*)(lds + GX_QD + o) = f2bf(qv[i] * 0.125f * eb); *(LAS bf16_t*)(lds + GX_KD + o) = f2bf(kv[i] * __builtin_amdgcn_rcpf(eb)); *(LAS bf16_t*)(lds + GX_KE + o) = f2bf(kv[i] * __expf(bl - x));
        }
        blsum += bl;
        if (w == 0) { const float dcy = __expf(bl); p.gdec[(size_t)ck * 256 + h * 64 + lane] = dcy; ((LAS float*)(lds + GX_DEC))[lane] = dcy; }
        GX_BAR();
        { const int o = ((tid >> 3) * GL_QS + (tid & 7) * 8) * 2; const size_t go = (row0 + (tid >> 3)) * 256 + h * 64 + (tid & 7) * 8;
          *(u32x4*)(p.gqd + go) = *(const LAS u32x4*)(lds + GX_QD + o); *(u32x4*)(p.gkd + go) = *(const LAS u32x4*)(lds + GX_KD + o); *(u32x4*)(p.gkv + go) = *(const LAS u32x4*)(lds + GX_KE + o); }
        bf16x8 vN[2];
#pragma unroll
        for (int ks = 0; ks < 2; ++ks) {
            const s16x4 lo = vtr(lds + GX_V + ((32 * ks + 8 * g + tq) * GL_VS + 16 * w + 4 * tp) * 2), hi4 = vtr(lds + GX_V + ((32 * ks + 8 * g + 4 + tq) * GL_VS + 16 * w + 4 * tp) * 2);
            vN[ks] = (bf16x8){lo[0], lo[1], lo[2], lo[3], hi4[0], hi4[1], hi4[2], hi4[3]};
        }
#pragma unroll
        for (int dkt = 0; dkt < 4; ++dkt) {
            const f32x4 dc = *(const LAS f32x4*)(lds + GX_DEC + (16 * dkt + 4 * g) * 4);
            f32x4 sc = Sg[dkt] * dc;
#pragma unroll
            for (int ks = 0; ks < 2; ++ks) {
                const s16x4 lo = vtr(lds + GX_KE + ((32 * ks + 8 * g + tq) * GL_QS + 16 * dkt + 4 * tp) * 2), hi4 = vtr(lds + GX_KE + ((32 * ks + 8 * g + 4 + tq) * GL_QS + 16 * dkt + 4 * tp) * 2);
                const bf16x8 keT = (bf16x8){lo[0], lo[1], lo[2], lo[3], hi4[0], hi4[1], hi4[2], hi4[3]};
                sc = __builtin_amdgcn_mfma_f32_16x16x32_bf16(keT, vN[ks], sc, 0, 0, 0);
            }
            Sg[dkt] = sc;
        }
        if ((st & 7) == 7) {
            const int gi = bx + (st >> 3) * G;
            float* so = (float*)p.gst + ((size_t)gi * 64) * 128 + 16 * w + l15;
#pragma unroll
            for (int dkt = 0; dkt < 4; ++dkt) {
#pragma unroll
                for (int j = 0; j < 4; ++j) so[(size_t)(16 * dkt + 4 * g + j) * 128] = Sg[dkt][j];
                Sg[dkt] = (f32x4){0.f, 0.f, 0.f, 0.f};
            }
            if (w == 0) ((float*)p.gst + (size_t)GL_NGRP * 64 * 128)[gi * 64 + lane] = __expf(blsum);
            blsum = 0.f;
        }
        GX_BAR();
    }
#undef GX_LOAD
#undef GX_BAR
}

constexpr int NCLS = 112;
DI void ph_router(const P& p, int l, LAS unsigned char* lds) {
    const int tid = tid_(); const int lane = tid & 63, wid = tid >> 6, fr = lane & 15, fq = lane >> 4;
    constexpr int RW_RS = 2064, RW_BYTES = 36 * RW_RS;
    LAS float* lg = (LAS float*)(lds + RW_BYTES) + wid * (32 * 65);
    const bf16_t* W = p.wt_r + (size_t)l * 64 * 1024;
    LAS int* hist = (LAS int*)(lds + RW_BYTES + 8 * 32 * 65 * 4);
    if (tid < 128) hist[tid] = 0;
#pragma unroll
    for (int i = 0; i < 9; ++i) { const int idx = tid + i * NTHR, row = idx >> 7, c = idx & 127; *(LAS u32x4*)(lds + row * RW_RS + c * 16) = *(const u32x4*)(W + (size_t)row * 1024 + c * 8); }
    __syncthreads();
    const size_t o = (size_t)l * NTOK;
    for (int mt = blockIdx.x * NWAVE + wid; mt < NTOK / 32; mt += gridDim.x * NWAVE) {
        const int m0 = mt * 32;
        const bf16_t* ap[2];
#pragma unroll
        for (int i = 0; i < 2; ++i) ap[i] = p.xa + (size_t)(m0 + 16 * i + fr) * D + fq * 8;
        const LAS unsigned char* bl = lds + fr * RW_RS + fq * 16;
        f32x4 acc[2][4];
#pragma unroll
        for (int i = 0; i < 2; ++i)
#pragma unroll
            for (int j = 0; j < 4; ++j) acc[i][j] = (f32x4){0.f, 0.f, 0.f, 0.f};
        for (int k = 0; k < 1024; k += 32) {
            bf16x8 a[2], b[4];
#pragma unroll
            for (int i = 0; i < 2; ++i) a[i] = *(const bf16x8*)(ap[i] + k);
#pragma unroll
            for (int j = 0; j < 3; ++j) b[j] = *(const LAS bf16x8*)(bl + j * 16 * RW_RS + k * 2);
#pragma unroll
            for (int i = 0; i < 2; ++i)
#pragma unroll
                for (int j = 0; j < 3; ++j) acc[i][j] = __builtin_amdgcn_mfma_f32_16x16x32_bf16(b[j], a[i], acc[i][j], 0, 0, 0);
        }
#pragma unroll
        for (int i = 0; i < 2; ++i)
#pragma unroll
            for (int j = 0; j < 4; ++j)
#pragma unroll
                for (int e = 0; e < 4; ++e) lg[(16 * i + fr) * 65 + 16 * j + 4 * fq + e] = acc[i][j][e];
        asm volatile("s_waitcnt lgkmcnt(0)" ::: "memory");
        if (lane < 32) {
            const LAS float* r = lg + lane * 65; const int tok = m0 + lane;
            float gl[4]; int gs = 0;
#pragma unroll
            for (int j = 0; j < 4; ++j) gl[j] = r[j] + p.moe_b_group[l * 4 + j];
            float gmax = gl[0];
#pragma unroll
            for (int j = 1; j < 4; ++j) if (gl[j] > gmax) { gmax = gl[j]; gs = j; }
            float den = 0.f;
#pragma unroll
            for (int j = 0; j < 4; ++j) den += __expf(gl[j] - gmax);
            const float pg = 1.f / den;
            float el[8];
#pragma unroll
            for (int j = 0; j < 8; ++j) el[j] = r[4 + gs * 8 + j] + p.moe_b_expert[l * 32 + gs * 8 + j];
            int i1 = 0; float v1 = el[0];
#pragma unroll
            for (int j = 1; j < 8; ++j) if (el[j] > v1) { v1 = el[j]; i1 = j; }
            int i2 = -1; float v2 = -INFINITY;
#pragma unroll
            for (int j = 0; j < 8; ++j) if (j != i1 && el[j] > v2) { v2 = el[j]; i2 = j; }
            const float e2 = __expf(v2 - v1);
            const float w1 = pg / (1.f + e2), w2 = pg * e2 / (1.f + e2);
            const int lo = i1 < i2 ? i1 : i2, hi = i1 < i2 ? i2 : i1;
            const int cls = gs * 28 + (lo * (15 - lo)) / 2 + (hi - lo - 1);
            const int pos = __hip_atomic_fetch_add(hist + cls, 1, __ATOMIC_RELAXED, __HIP_MEMORY_SCOPE_WORKGROUP);
            p.tope[o + tok] = cls; p.toppos[o + tok] = pos;
            p.topw[2 * (o + tok)] = (i1 < i2) ? w1 : w2; p.topw[2 * (o + tok) + 1] = (i1 < i2) ? w2 : w1;
        }
        asm volatile("s_waitcnt lgkmcnt(0)" ::: "memory");
    }
    __syncthreads();
    if (tid < 128) p.whist[((size_t)l * 256 + blockIdx.x) * 128 + tid] = hist[tid];
    __syncthreads();
}
DI void ph_slots(const P& p, int l, LAS unsigned char* lds) {
    LAS int* ss = (LAS int*)lds;
    const int tid = tid_();
    const int G = gridDim.x, bx = blockIdx.x;
    {
        const int cls = tid & 127, part = tid >> 7, per = (G + 3) >> 2, w0 = part * per, w1 = (w0 + per < G) ? w0 + per : G;
        int tot = 0, pre = 0;
#pragma unroll 16
        for (int w = w0; w < w1; ++w) { const int v = p.whist[((size_t)l * 256 + w) * 128 + cls]; tot += v; pre += (w < bx) ? v : 0; }
        ss[512 + part * 128 + cls] = tot; ss[1024 + part * 128 + cls] = pre;
    }
    __syncthreads();
    if (tid < 64) {
        int nt[2], pr[2];
#pragma unroll
        for (int q = 0; q < 2; ++q) { const int c = 2 * tid + q; int tot = 0, pre = 0;
#pragma unroll
            for (int part = 0; part < 4; ++part) { tot += ss[512 + part * 128 + c]; pre += ss[1024 + part * 128 + c]; }
            nt[q] = (c < NCLS) ? (tot + 255) >> 8 : 0; pr[q] = pre; }
        const int mine = nt[0] + nt[1];
        int inc = mine;
#pragma unroll
        for (int d = 1; d < 64; d <<= 1) { const int o = __shfl_up(inc, d); if (tid >= d) inc += o; }
        const int ex = inc - mine;
#pragma unroll
        for (int q = 0; q < 2; ++q) { const int c = 2 * tid + q; const int tb = ex + (q ? nt[0] : 0);
            if (c < NCLS) { ss[c] = pr[q] + tb * 256; ss[128 + c] = tb; } }
        if (tid == 63) ss[256] = inc;
    }
    __syncthreads();
    if (bx == 0) {
        if (tid < NCLS) {
            const int g = tid / 28; int r = tid % 28, lo = 0; while (r >= 7 - lo) { r -= 7 - lo; ++lo; } const int hi = lo + 1 + r;
            const int code = (g * 8 + lo) | ((g * 8 + hi) << 8);
            const int t0 = ss[128 + tid], t1 = (tid == NCLS - 1) ? ss[256] : ss[128 + tid + 1];
            for (int i = t0; i < t1; ++i) p.tile_e[l * 1024 + i] = code;
        }
        if (tid == 0) p.ntile[l] = ss[256];
    }
    const int lane = tid & 63, wid = tid >> 6;
    if (lane < 32)
    for (int mt = bx * NWAVE + wid; mt < NTOK / 32; mt += G * NWAVE) {
        const int tok = mt * 32 + lane;
        const size_t o = (size_t)l * NTOK + tok;
        const int slot = ss[p.tope[o]] + p.toppos[o];
        p.row_tok[(size_t)l * MAXSLOT + slot] = tok + 1;
        p.topslot[o] = slot;
        *(f32x2_t*)(p.row_w + 2 * ((size_t)l * MAXSLOT + slot)) = *(const f32x2_t*)(p.topw + 2 * o);
    }
    __syncthreads();
}
DI void ph_postnorm(const P& p, int l, int last) {
    const int tid = tid_(); const int lane = tid & 63;
    constexpr int R = 8;
    const int gw = blockIdx.x * NWAVE + (tid >> 6), NWV = gridDim.x * NWAVE; const bool bm = (NWV == 2048);
    f32x4 ggp[4], shp[4], scp[4]; int cur_b = -1;
    for (int it = 0;; ++it) {
        const int row0 = bm ? (gw & 15) * 4096 + (gw >> 4) * 32 + it * R : (gw + it * NWV) * R;
        if (bm ? (it >= 32 / R) : (row0 >= NTOK)) break;
        const int b = row0 >> 12;
        u32x2 xv[R][4];
#pragma unroll
        for (int r = 0; r < R; ++r)
#pragma unroll
            for (int i = 0; i < 4; ++i) xv[r][i] = *(const u32x2*)(p.xr + (size_t)(row0 + r) * D + i * 256 + lane * 4);
        if (b != cur_b) { cur_b = b;
          const float* mdn = p.mod + ((size_t)(last ? l : l + 1) * 16 + b) * 6144; const float* gn = last ? p.final_norm_g : p.norm_mix_g + (l + 1) * D;
#pragma unroll
          for (int i = 0; i < 4; ++i) { const int c0 = i * 256 + lane * 4; ggp[i] = *(const f32x4*)(gn + c0); shp[i] = *(const f32x4*)(mdn + c0); scp[i] = *(const f32x4*)(mdn + 1024 + c0); } }
        __builtin_amdgcn_sched_barrier(0);
        f32x4 v[R][4]; float rs[R];
#pragma unroll
        for (int r = 0; r < R; ++r) { float ss = 0.f;
#pragma unroll
            for (int i = 0; i < 4; ++i) {
                v[r][i] = (f32x4){__uint_as_float(xv[r][i].x << 16), __uint_as_float(xv[r][i].x & 0xffff0000u), __uint_as_float(xv[r][i].y << 16), __uint_as_float(xv[r][i].y & 0xffff0000u)};
                ss += v[r][i][0] * v[r][i][0] + v[r][i][1] * v[r][i][1] + v[r][i][2] * v[r][i][2] + v[r][i][3] * v[r][i][3];
            }
            rs[r] = rsqrtf(wave_sum(ss) * (1.f / D) + EPS); }
        if (last) {
#pragma unroll
            for (int i = 0; i < 4; ++i) { const int c0 = i * 256 + lane * 4; const f32x4 gg = ggp[i];
#pragma unroll
                for (int r = 0; r < R; ++r) *(f32x4*)(p.out + (size_t)(row0 + r) * D + c0) = v[r][i] * rs[r] * gg; }
        } else {
#pragma unroll
            for (int i = 0; i < 4; ++i) {
                const int c0 = i * 256 + lane * 4;
                const f32x4 gg = ggp[i], sh = shp[i], sc = scp[i];
#pragma unroll
                for (int r = 0; r < R; ++r) {
                    float oo[4];
#pragma unroll
                    for (int e = 0; e < 4; ++e) oo[e] = v[r][i][e] * rs[r] * gg[e] * (1.f + sc[e]) + sh[e];
                    u32x2 w; w.x = pk2(oo[0], oo[1]); w.y = pk2(oo[2], oo[3]);
                    *(u32x2*)(p.xa + (size_t)(row0 + r) * D + c0) = w;
                }
            }
        }
    }
}

namespace at2 {
using bf16=bf16_t;
constexpr int SEQ=4096,D=64,DM=1024,QP=768,KP=512,PP=32;
constexpr int NW=8,QBLK=32,QB=QBLK*NW,KVBLK=64,NQB=SEQ/QB;
#define SBAR() __builtin_amdgcn_sched_barrier(0)
__device__ __forceinline__ void cmask(f32x16&p0,f32x16&p1,int jb,int qrel,int hi){
  const float NEG=-INFINITY; int kb=64*jb+4*hi;
  #pragma unroll
  for(int r=0;r<16;++r){int kv=kb+(r&3)+8*(r>>2); if(kv>qrel)p0[r]=NEG; if(kv+32>qrel)p1[r]=NEG;}
}

constexpr int NSLOT=3, SLOTB=8192;
constexpr int LDS_K=0, LDS_V=NSLOT*SLOTB, LDS_P=2*NSLOT*SLOTB, PSLOTB=4096, LDS_WS=LDS_P+4*PSLOTB, LDS_OST=LDS_WS+NW*64*4, LDS_BYTES=LDS_OST+NW*4096;
__device__ __forceinline__ void glds16(const void*gsrc,unsigned lds_dst){unsigned keep;
  asm volatile("s_mov_b32 %0, m0\n\ts_mov_b32 m0, %2\n\ts_nop 0\n\tglobal_load_lds_dwordx4 %1, off\n\ts_mov_b32 m0, %0":"=&s"(keep):"v"(gsrc),"s"(lds_dst):"memory");}
__device__ __forceinline__ float max3f(float a,float b,float c){float r;asm("v_max3_f32 %0, %1, %2, %3":"=v"(r):"v"(a),"v"(b),"v"(c));return r;}
__device__ __forceinline__ float max2f(float a,float b){float r;asm("v_max_f32_e32 %0, %1, %2":"=v"(r):"v"(a),"v"(b));return r;}
__device__ __forceinline__ float fadd_s(float a,float b){float r;asm("v_add_f32_e32 %0, %1, %2":"=v"(r):"v"(a),"v"(b));return r;}
__device__ __forceinline__ float fsub_s(float a,float b){float r;asm("v_sub_f32_e32 %0, %1, %2":"=v"(r):"v"(a),"v"(b));return r;}
__device__ __forceinline__ unsigned cvtpk_s(float lo,float hi){return cvtpk(lo,hi);}
#define WAIT_BAR(N) asm volatile("s_waitcnt vmcnt(" #N ") lgkmcnt(0)\n\ts_barrier":::"memory")

__device__ __forceinline__ void qkt(f32x16&p0,f32x16&p1,const char*Kslot,const char*Pslot,const bf16x8*qr,const f32x16&negm,int r32,int hi){
  const char*kb=Kslot+hi*1024+r32*16; const char*pb=Pslot+hi*1024+r32*16;
  #pragma unroll
  for(int d0=0;d0<6;++d0){
    const char*src=(d0<4)?kb+d0*2048:pb+(d0-4)*2048;
    const bf16x8 b0=*reinterpret_cast<const bf16x8*>(src);
    const bf16x8 b1=*reinterpret_cast<const bf16x8*>(src+512);
    if(d0==0){p0=__builtin_amdgcn_mfma_f32_32x32x16_bf16(b0,qr[0],negm,0,0,0);p1=__builtin_amdgcn_mfma_f32_32x32x16_bf16(b1,qr[0],negm,0,0,0);}
    else{p0=__builtin_amdgcn_mfma_f32_32x32x16_bf16(b0,qr[d0],p0,0,0,0);p1=__builtin_amdgcn_mfma_f32_32x32x16_bf16(b1,qr[d0],p1,0,0,0);}}
}
typedef __attribute__((address_space(3))) const char* lds_cptr;
__device__ __forceinline__ void kload8(bf16x8*kf,lds_cptr kp){
  kf[0]=*(const __attribute__((address_space(3))) bf16x8*)(kp);      kf[1]=*(const __attribute__((address_space(3))) bf16x8*)(kp+512);
  kf[2]=*(const __attribute__((address_space(3))) bf16x8*)(kp+2048); kf[3]=*(const __attribute__((address_space(3))) bf16x8*)(kp+2560);
  kf[4]=*(const __attribute__((address_space(3))) bf16x8*)(kp+4096); kf[5]=*(const __attribute__((address_space(3))) bf16x8*)(kp+4608);
  kf[6]=*(const __attribute__((address_space(3))) bf16x8*)(kp+6144); kf[7]=*(const __attribute__((address_space(3))) bf16x8*)(kp+6656);
}
__device__ __forceinline__ void kload2(bf16x8*kf,lds_cptr kp,int j){ kf[2*j]=*(const __attribute__((address_space(3))) bf16x8*)(kp+j*2048); kf[2*j+1]=*(const __attribute__((address_space(3))) bf16x8*)(kp+j*2048+512); }
__device__ __forceinline__ s16x4 vtr(lds_cptr p){ return __builtin_bit_cast(s16x4,__builtin_amdgcn_ds_read_tr16_b64_v4i16((__attribute__((address_space(3))) v4i16_t*)p)); }
__device__ __forceinline__ float rowmax(const f32x16&p0,const f32x16&p1){
  float a=max3f(p0[0],p0[1],p1[0]),b=max3f(p0[2],p0[3],p1[1]);a=max3f(a,p1[2],p1[3]);
  #pragma unroll
  for(int r=4;r<16;r+=4){a=max3f(a,p0[r],p0[r+1]);b=max3f(b,p0[r+2],p0[r+3]);a=max3f(a,p1[r],p1[r+1]);b=max3f(b,p1[r+2],p1[r+3]);}
  const float m=max2f(a,b);
  auto rr=__builtin_amdgcn_permlane32_swap(__float_as_uint(m),__float_as_uint(m),false,false);
  return max2f(__uint_as_float(rr[0]),__uint_as_float(rr[1]));
}
__device__ __forceinline__ void pv(f32x16*o,int vb,bf16x8 pa0,bf16x8 pa1,bf16x8 pa2,bf16x8 pa3){
  #pragma unroll
  for(int d0=0;d0<2;++d0){s16x4 lo[4],hi[4];
    #pragma unroll
    for(int ks=0;ks<4;++ks){
      asm volatile("ds_read_b64_tr_b16 %0,%1 offset:%c2":"=&v"(lo[ks]):"v"(vb),"i"(d0*4096+ks*1024):"memory");
      asm volatile("ds_read_b64_tr_b16 %0,%1 offset:%c2":"=&v"(hi[ks]):"v"(vb),"i"(d0*4096+ks*1024+512):"memory");}
    asm volatile("s_waitcnt lgkmcnt(0)":::"memory");SBAR();
    #define PK(k) (bf16x8){lo[k][0],lo[k][1],lo[k][2],lo[k][3],hi[k][0],hi[k][1],hi[k][2],hi[k][3]}
    o[d0]=__builtin_amdgcn_mfma_f32_32x32x16_bf16(pa0,PK(0),o[d0],0,0,0);
    o[d0]=__builtin_amdgcn_mfma_f32_32x32x16_bf16(pa1,PK(1),o[d0],0,0,0);
    o[d0]=__builtin_amdgcn_mfma_f32_32x32x16_bf16(pa2,PK(2),o[d0],0,0,0);
    o[d0]=__builtin_amdgcn_mfma_f32_32x32x16_bf16(pa3,PK(3),o[d0],0,0,0);
    #undef PK
  }
}

#ifndef ATTN_STORE16
#define ATTN_STORE16(p,v) (*(u32x4*)(p)=(v))
#endif
template<int THRL> __device__ __forceinline__ void attn_unit(int tid,int b,int h,int qb,const bf16*Q,const bf16*__restrict__ K,const bf16*__restrict__ V,const bf16*__restrict__ KPE,bf16*O,char*shm){
  const int lane=tid&63,r32=lane&31,hi=lane>>5; const int wid=__builtin_amdgcn_readfirstlane(tid>>6);
  const long rowbase=(long)b*SEQ; const int q0=qb*QB;
  const bf16*Qw=Q+(rowbase+q0+wid*QBLK)*QP+h*96;
  const bf16*Kh=K+rowbase*KP+h*D,*Vh=V+rowbase*KP+h*D;
  const unsigned lds0=(unsigned)(uintptr_t)shm;
  float*wsf=(float*)(shm+LDS_WS)+wid*64;
  const bf16*ksrc=Kh+(long)lane*KP+wid*8;
  const bf16*vsrc=Vh+(long)(16*(wid&3)+(lane>>2))*KP+(wid>>2)*32+(lane&3)*8;
  const bf16*psrc=KPE+(rowbase+lane)*PP+(wid&3)*8;
  const unsigned kdst=lds0+LDS_K+wid*1024, vdst=lds0+LDS_V+wid*1024, pdst=lds0+LDS_P+(wid&3)*1024;
  #define DMA_K(t,slot) do{ glds16(ksrc+(long)(t)*KVBLK*KP,(unsigned)__builtin_amdgcn_readfirstlane(kdst+(slot))); glds16(psrc+(long)(t)*KVBLK*PP,(unsigned)__builtin_amdgcn_readfirstlane(pdst+((t)&3)*PSLOTB)); }while(0)
  #define DMA_V(t,slot) glds16(vsrc+(long)(t)*KVBLK*KP,(unsigned)__builtin_amdgcn_readfirstlane(vdst+(slot)))
  const int vb0=(int)(lds0+LDS_V)+((lane>>4)&1)*32+(lane&3)*8+(4*hi+((lane&15)>>2))*64;
  const char*Kbase=shm+LDS_K; bf16x8 kf[8];
  const lds_cptr shm3=(lds_cptr)shm; const lds_cptr kp0=shm3+LDS_K+hi*1024+r32*16; const lds_cptr pp0=shm3+LDS_P+hi*1024+r32*16; const lds_cptr vp0=shm3+LDS_V+((lane>>4)&1)*32+(lane&3)*8+(4*hi+((lane&15)>>2))*64;
  const int NT=(q0+QB)/KVBLK;
  DMA_K(0,0);DMA_V(0,0);DMA_K(1,SLOTB);
  bf16x8 qr[6];
  #pragma unroll
  for(int d0=0;d0<6;++d0)qr[d0]=*reinterpret_cast<const bf16x8*>(&Qw[(long)r32*QP+d0*16+hi*8]);
  float mhat=0.f,l_reg=0.f;f32x16 o[2],negm; { float z_; asm volatile("v_mov_b32 %0, 0":"=v"(z_));
    _Pragma("unroll") for(int r=0;r<16;++r){o[0][r]=z_;o[1][r]=z_;negm[r]=z_;} } asm volatile("":"+v"(negm));
  const int qrel=wid*QBLK+r32;
  #define CMASK(P0,P1,t) do{int jb_=(t)-(NT-4); if(jb_>=0)cmask(P0,P1,jb_,qrel,hi);}while(0)
  bool resc=false;
  #define START(P0,P1) do{ const float rm=rowmax(P0,P1); resc=false; \
    { const float dl=rm; mhat=fadd_s(mhat,dl); \
      _Pragma("unroll") for(int r=0;r<16;++r){P0[r]=fsub_s(P0[r],dl);P1[r]=fsub_s(P1[r],dl);} \
      _Pragma("unroll") for(int r=0;r<16;++r)negm[r]=-mhat; asm volatile("":"+v"(negm)); } \
    _Pragma("unroll") for(int r=0;r<16;++r)P0[r]=__builtin_amdgcn_exp2f(P0[r]); }while(0)
  #define RESC() do{ if(resc){ asm volatile("s_waitcnt lgkmcnt(0)":::"memory"); \
      _Pragma("unroll") for(int d_=0;d_<2;++d_) _Pragma("unroll") for(int r=0;r<16;++r)o[d_][r]*=wsf[crow(r,hi)]; } }while(0)
  f32x16 pA0,pA1,pB0,pB1;
  int sl_prev=0,sl_cur=0,sl_next=SLOTB;
  #define ROT() do{sl_prev=sl_cur;sl_cur=sl_next;sl_next=(sl_next==(NSLOT-1)*SLOTB)?0:sl_next+SLOTB;}while(0)
  DMA_K(2,2*SLOTB);
  WAIT_BAR(4);
  qkt(pA0,pA1,Kbase,shm+LDS_P,qr,negm,r32,hi);asm volatile("s_nop 15\n\ts_nop 7":"+v"(pA0),"+v"(pA1));CMASK(pA0,pA1,0);
  START(pA0,pA1);
  _Pragma("unroll") for(int r=0;r<16;++r)pA1[r]=__builtin_amdgcn_exp2f(pA1[r]);
  WAIT_BAR(0);
  DMA_K(3,0);DMA_V(1,SLOTB);
  ROT();
  kload8(kf,kp0+sl_cur);
  WAIT_BAR(3);
  s16x4 vlo[8],vhi[8]; u32x4 pw0,pw1,pw2,pw3;
  #define PKW(P,B) cvtpk_s(P[B],P[B+1])
  #define PAF(k) __builtin_bit_cast(bf16x8,pw##k)
  #define VFR(i) (bf16x8){vlo[i][0],vlo[i][1],vlo[i][2],vlo[i][3],vhi[i][0],vhi[i][1],vhi[i][2],vhi[i][3]}
  #define PIN(x) asm volatile("":"+v"(x))
  #define MX3(a,b,c) __builtin_fmaxf(__builtin_fmaxf((a),(b)),(c))
  #define GAPA(MF,A0,A1,A2,A3,W0,W1,PW) do{ MF; sacc+=A0; sacc+=A1; sacc+=A2; sacc+=A3; PIN(sacc); W0; W1; PIN(PW); SBAR(); }while(0)
  #define EX(v) __builtin_amdgcn_exp2f(v)
  #define GAPB(MF,X,B) do{ MF; X[B]=EX(X[B]); X[B+1]=EX(X[B+1]); X[B+2]=EX(X[B+2]); X[B+3]=EX(X[B+3]); PIN(X); SBAR(); }while(0)
  #define VRD(i) do{ vlo[i]=vtr(vp_+(((i)>>2)*4096+((i)&3)*1024)); vhi[i]=vtr(vp_+(((i)>>2)*4096+((i)&3)*1024+512)); }while(0)
  #define KRD(G,j) do{ if(G){ kload2(kf,kp0+sl_next,j); SBAR(); } }while(0)
  #define STEP(C0,C1,P0,P1,t,GK,GV,GL) do{ SBAR(); \
    const lds_cptr vp_=vp0+sl_prev; const lds_cptr pq_=pp0+((t)&3)*PSLOTB; \
    VRD(0); SBAR(); float sacc=(P0[0]+P0[1]); \
    C0=__builtin_amdgcn_mfma_f32_32x32x16_bf16(kf[0],qr[0],negm,0,0,0); sacc+=P0[2]; sacc+=P0[3]; PIN(sacc); pw0[0]=PKW(P0,0); PIN(pw0); SBAR(); \
    VRD(4); SBAR(); C1=__builtin_amdgcn_mfma_f32_32x32x16_bf16(kf[1],qr[0],negm,0,0,0); sacc+=P0[4]; sacc+=P0[5]; PIN(sacc); pw0[1]=PKW(P0,2); PIN(pw0); SBAR(); \
    VRD(1); SBAR(); C0=__builtin_amdgcn_mfma_f32_32x32x16_bf16(kf[2],qr[1],C0,0,0,0); sacc+=P0[6]; sacc+=P0[7]; PIN(sacc); pw0[2]=PKW(P0,4); PIN(pw0); SBAR(); \
    VRD(5); SBAR(); C1=__builtin_amdgcn_mfma_f32_32x32x16_bf16(kf[3],qr[1],C1,0,0,0); sacc+=P0[8]; sacc+=P0[9]; PIN(sacc); pw0[3]=PKW(P0,6); PIN(pw0); SBAR(); \
    VRD(2); SBAR(); C0=__builtin_amdgcn_mfma_f32_32x32x16_bf16(kf[4],qr[2],C0,0,0,0); sacc+=P0[10]; sacc+=P0[11]; sacc+=P0[12]; PIN(sacc); pw1[0]=PKW(P0,8); PIN(pw1); SBAR(); \
    VRD(6); SBAR(); C1=__builtin_amdgcn_mfma_f32_32x32x16_bf16(kf[5],qr[2],C1,0,0,0); sacc+=P0[13]; sacc+=P0[14]; sacc+=P0[15]; PIN(sacc); pw1[1]=PKW(P0,10); PIN(pw1); SBAR(); \
    const bf16x8 kq0=*(const __attribute__((address_space(3))) bf16x8*)(pq_), kq1=*(const __attribute__((address_space(3))) bf16x8*)(pq_+512), kq2=*(const __attribute__((address_space(3))) bf16x8*)(pq_+2048), kq3=*(const __attribute__((address_space(3))) bf16x8*)(pq_+2560); VRD(3); SBAR(); C0=__builtin_amdgcn_mfma_f32_32x32x16_bf16(kf[6],qr[3],C0,0,0,0); sacc+=P1[0]; sacc+=P1[1]; sacc+=P1[2]; PIN(sacc); pw1[2]=PKW(P0,12); PIN(pw1); SBAR(); \
    VRD(7); SBAR(); C1=__builtin_amdgcn_mfma_f32_32x32x16_bf16(kf[7],qr[3],C1,0,0,0); sacc+=P1[3]; sacc+=P1[4]; sacc+=P1[5]; PIN(sacc); pw1[3]=PKW(P0,14); PIN(pw1); SBAR(); \
    C0=__builtin_amdgcn_mfma_f32_32x32x16_bf16(kq0,qr[4],C0,0,0,0); sacc+=P1[6]; sacc+=P1[7]; sacc+=P1[8]; PIN(sacc); pw2[0]=PKW(P1,0); pw2[1]=PKW(P1,2); PIN(pw2); SBAR(); \
    C1=__builtin_amdgcn_mfma_f32_32x32x16_bf16(kq1,qr[4],C1,0,0,0); sacc+=P1[9]; sacc+=P1[10]; sacc+=P1[11]; PIN(sacc); pw2[2]=PKW(P1,4); pw2[3]=PKW(P1,6); PIN(pw2); SBAR(); \
    C0=__builtin_amdgcn_mfma_f32_32x32x16_bf16(kq2,qr[5],C0,0,0,0); sacc+=P1[12]; sacc+=P1[13]; PIN(sacc); pw3[0]=PKW(P1,8); pw3[1]=PKW(P1,10); PIN(pw3); SBAR(); \
    C1=__builtin_amdgcn_mfma_f32_32x32x16_bf16(kq3,qr[5],C1,0,0,0); sacc+=P1[14]; sacc+=P1[15]; PIN(sacc); pw3[2]=PKW(P1,12); pw3[3]=PKW(P1,14); PIN(pw3); SBAR(); \
    l_reg+=sacc; \
    if(GK){DMA_K((t)+3,sl_cur);} if(GV){DMA_V((t)+1,sl_next);} \
    CMASK(C0,C1,t); \
    { float a=MX3(C0[0],C0[1],C1[0]),b=MX3(C0[2],C0[3],C1[1]); a=MX3(a,C1[2],C1[3]); \
      _Pragma("unroll") for(int r=4;r<16;r+=4){a=MX3(a,C0[r],C0[r+1]);b=MX3(b,C0[r+2],C0[r+3]);a=MX3(a,C1[r],C1[r+1]);b=MX3(b,C1[r+2],C1[r+3]);} \
      float rm=__builtin_fmaxf(a,b); { auto rr=__builtin_amdgcn_permlane32_swap(__float_as_uint(rm),__float_as_uint(rm),false,false); rm=__builtin_fmaxf(__uint_as_float(rr[0]),__uint_as_float(rr[1])); } \
      resc=false; \
      if(__builtin_expect(__any(rm>(float)THRL),0)){ const float dl=__builtin_fmaxf(rm,0.f); mhat+=dl; \
        _Pragma("unroll") for(int r=0;r<16;++r){C0[r]-=dl;C1[r]-=dl;} \
        _Pragma("unroll") for(int r=0;r<16;++r)negm[r]=-mhat; asm volatile("":"+v"(negm)); \
        const float f=__builtin_amdgcn_exp2f(-dl); l_reg*=f; if(hi==0)wsf[r32]=f; resc=true; } } \
    SBAR(); \
    GAPB(o[0]=__builtin_amdgcn_mfma_f32_32x32x16_bf16(PAF(0),VFR(0),o[0],0,0,0), C0,0); \
    GAPB(o[1]=__builtin_amdgcn_mfma_f32_32x32x16_bf16(PAF(0),VFR(4),o[1],0,0,0), C0,4); \
    KRD(GL,0); GAPB(o[0]=__builtin_amdgcn_mfma_f32_32x32x16_bf16(PAF(1),VFR(1),o[0],0,0,0), C0,8); \
    KRD(GL,1); GAPB(o[1]=__builtin_amdgcn_mfma_f32_32x32x16_bf16(PAF(1),VFR(5),o[1],0,0,0), C0,12); \
    KRD(GL,2); GAPB(o[0]=__builtin_amdgcn_mfma_f32_32x32x16_bf16(PAF(2),VFR(2),o[0],0,0,0), C1,0); \
    KRD(GL,3); GAPB(o[1]=__builtin_amdgcn_mfma_f32_32x32x16_bf16(PAF(2),VFR(6),o[1],0,0,0), C1,4); \
    GAPB(o[0]=__builtin_amdgcn_mfma_f32_32x32x16_bf16(PAF(3),VFR(3),o[0],0,0,0), C1,8); \
    GAPB(o[1]=__builtin_amdgcn_mfma_f32_32x32x16_bf16(PAF(3),VFR(7),o[1],0,0,0), C1,12); \
    }while(0)
  int t=1;
  #undef CMASK
  #define CMASK(P0,P1,t) do{}while(0)
  for(;t+5<NT;t+=2){
    STEP(pB0,pB1,pA0,pA1,t,true,true,true);     WAIT_BAR(3); RESC(); ROT();
    STEP(pA0,pA1,pB0,pB1,t+1,true,true,true);   WAIT_BAR(3); RESC(); ROT();
  }
  #undef CMASK
  #define CMASK(P0,P1,t) do{int jb_=(t)-(NT-4); if(jb_>=0)cmask(P0,P1,jb_,qrel,hi);}while(0)
  #define ENDW(tt) do{ if((tt)+3<NT){WAIT_BAR(3);} else if((tt)+2<NT){WAIT_BAR(1);} else {WAIT_BAR(0);} }while(0)
  for(;t+1<NT;t+=2){
    STEP(pB0,pB1,pA0,pA1,t,(t+3<NT),(t+1<NT),(t+1<NT));       ENDW(t);   RESC(); ROT();
    STEP(pA0,pA1,pB0,pB1,t+1,(t+4<NT),(t+2<NT),(t+2<NT));     ENDW(t+1); RESC(); ROT();
  }
  STEP(pB0,pB1,pA0,pA1,NT-1,false,false,false); RESC();
  { float sacc=pB0[0]+pB0[1]; _Pragma("unroll") for(int r=2;r<16;++r)sacc+=pB0[r]; _Pragma("unroll") for(int r=0;r<16;++r)sacc+=pB1[r]; l_reg+=sacc;
    pw0=(u32x4){PKW(pB0,0),PKW(pB0,2),PKW(pB0,4),PKW(pB0,6)};pw1=(u32x4){PKW(pB0,8),PKW(pB0,10),PKW(pB0,12),PKW(pB0,14)};pw2=(u32x4){PKW(pB1,0),PKW(pB1,2),PKW(pB1,4),PKW(pB1,6)};pw3=(u32x4){PKW(pB1,8),PKW(pB1,10),PKW(pB1,12),PKW(pB1,14)};
    SBAR(); pv(o,vb0+sl_cur,PAF(0),PAF(1),PAF(2),PAF(3)); }
  #undef PKW
  #undef PAF
  #undef VFR
  #undef PIN
  #undef MX3
  #undef GAPA
  #undef GAPB
  #undef EX
  #undef VRD
  #undef KRD
  #undef STEP
  #undef ENDW
  {auto rr=__builtin_amdgcn_permlane32_swap(__float_as_uint(l_reg),__float_as_uint(l_reg),false,false);l_reg=__uint_as_float(rr[0])+__uint_as_float(rr[1]);}
  if(hi==0)wsf[32+r32]=l_reg;asm volatile("s_waitcnt lgkmcnt(0)":::"memory");
  float rli[16];
  #pragma unroll
  for(int r=0;r<16;++r)rli[r]=__builtin_amdgcn_rcpf(wsf[32+crow(r,hi)]);
  bf16*Ow=O+(rowbase+q0+wid*QBLK)*DM+h*D;
  { bf16*stg=(bf16*)(shm+LDS_OST)+wid*2048;
    #pragma unroll
    for(int r=0;r<16;++r){const int orow=crow(r,hi);
      #pragma unroll
      for(int d0=0;d0<2;++d0)stg[orow*64+d0*32+r32]=f2bf(o[d0][r]*rli[r]);}
    asm volatile("s_waitcnt lgkmcnt(0)":::"memory");
    #pragma unroll
    for(int i=0;i<4;++i){const int row=i*8+(lane>>3),ch=lane&7; const u32x4 v=*(const u32x4*)(stg+row*64+ch*8); ATTN_STORE16(Ow+(long)row*DM+ch*8,v);} }
  asm volatile("s_waitcnt lgkmcnt(0)\n\ts_barrier":::"memory");
  #undef DMA_K
  #undef DMA_V
  #undef CMASK
  #undef START
  #undef RESC
  #undef ROT
}
#undef SBAR
#undef WAIT_BAR
}

static_assert(at2::LDS_BYTES <= LDS_WTAB, "attention LDS map");
DI void ph_attn(const P& p, LAS unsigned char* lds) {
    const int G = gridDim.x, bx = blockIdx.x;
    const int vcu = (G % 8 == 0) ? (bx % 8) * (G / 8) + bx / 8 : bx;
#pragma unroll 1
    for (int u = vcu * 8; u < 2048; u += ((u & 7) == 7) ? (G * 8 - 7) : 1) {
        const int grp = u >> 3, i = u & 7;
        const int bh = grp >> 1, par = grp & 1;
        const int s = 2 * (i >> 1) + par;
        const int qb = (i & 1) ? 15 - s : s;
        at2::attn_unit<8>(tid_(), bh >> 3, bh & 7, qb, p.q, p.kn, p.v, p.kpe, p.mix, (char*)lds);
    }
}

DI void ph_gla_prefix(const P& p) {
    const int tid = tid_();
    const float* sg = (const float*)p.gst; const float* dg = sg + (size_t)GL_NGRP * 64 * 128; float* sin_ = (float*)(dg + GL_NGRP * 64);
    for (int gid = blockIdx.x * NTHR + tid; gid < 64 * 64 * 32; gid += gridDim.x * NTHR) {
        const int dvq = gid & 31, dk = (gid >> 5) & 63, bh = gid >> 11;
        f32x4 kv[8]; float d[8];
#pragma unroll
        for (int j = 0; j < 8; ++j) { kv[j] = *(const f32x4*)(sg + (((size_t)(bh * 8 + j)) * 64 + dk) * 128 + dvq * 4); d[j] = dg[(bh * 8 + j) * 64 + dk]; }
        f32x4 st = (f32x4){0.f, 0.f, 0.f, 0.f};
#pragma unroll
        for (int j = 0; j < 8; ++j) { *(f32x4*)(sin_ + (((size_t)(bh * 8 + j)) * 64 + dk) * 128 + dvq * 4) = st; st = st * d[j] + kv[j]; }
    }
}
constexpr int GZ_QD = 0, GZ_KD = 64 * GL_QS * 2, GZ_V = 2 * GZ_KD, GZ_KE = GZ_V + 64 * GL_VS * 2, GZ_DEC = GZ_KE + 64 * GL_QS * 2, GZ_BUF = GZ_DEC + 256, GZ_PART = 2 * GZ_BUF, GZ_END = GZ_PART + 2 * 8 * 64 * 4;
static_assert(GZ_END <= LDS_WTAB, "GLA LDS map");
DI void ph_gla_out(const P& p, LAS unsigned char* lds, int tid) {
    const int lane = tid & 63, w = __builtin_amdgcn_readfirstlane(tid >> 6), l15 = lane & 15, g = lane >> 4, tq = l15 >> 2, tp = l15 & 3;
    const int G = gridDim.x, bx = blockIdx.x;
    u32x4 rqd, rkd, rke, rvv[2]; float rdc;
#define GZ_LOAD(it_) do { const int h_ = (it_) & 3; const size_t row0_ = (size_t)((it_) >> 2) * 64; \
        const size_t o_ = (row0_ + (tid >> 3)) * 256 + h_ * 64 + (tid & 7) * 8; rqd = *(const u32x4*)(p.gqd + o_); rkd = *(const u32x4*)(p.gkd + o_); rke = *(const u32x4*)(p.gkv + o_); \
        rdc = p.gdec[(size_t)((it_) >> 2) * 256 + h_ * 64 + lane]; \
        _Pragma("unroll") for (int i_ = 0; i_ < 2; ++i_) { const int c_ = i_ * 512 + tid; rvv[i_] = *(const u32x4*)(p.proj + (row0_ + (c_ >> 4)) * LD1 + 1536 + h_ * 128 + (c_ & 15) * 8); } } while (0)
#define GZ_STAGE(buf) do { LAS unsigned char* B_ = lds + (buf) * GZ_BUF; const int o_ = ((tid >> 3) * GL_QS + (tid & 7) * 8) * 2; \
        *(LAS u32x4*)(B_ + GZ_QD + o_) = rqd; *(LAS u32x4*)(B_ + GZ_KD + o_) = rkd; *(LAS u32x4*)(B_ + GZ_KE + o_) = rke; if (w == 0) ((LAS float*)(B_ + GZ_DEC))[lane] = rdc; \
        _Pragma("unroll") for (int i_ = 0; i_ < 2; ++i_) { const int c_ = i_ * 512 + tid; const int vo_ = ((c_ >> 4) * GL_VS + (c_ & 15) * 8) * 2; *(LAS u32x4*)(B_ + GZ_V + vo_) = rvv[i_]; } } while (0)
#define GZ_BAR() do { asm volatile("s_waitcnt lgkmcnt(0)" ::: "memory"); __builtin_amdgcn_s_barrier(); asm volatile("" ::: "memory"); } while (0)
    u32x2 grn[4];
    { const int i0 = gl_step_item(0, bx, G); if (i0 >= 0) { GZ_LOAD(i0); GZ_STAGE(0); const int i1 = gl_step_item(1, bx, G); GZ_LOAD(i1 >= 0 ? i1 : i0);
#pragma unroll
        for (int tt = 0; tt < 4; ++tt) grn[tt] = *(const u32x2*)(p.proj + ((size_t)(i0 >> 2) * 64 + 16 * tt + l15) * LD1 + 2304 + (i0 & 3) * 128 + 16 * w + 4 * g); } }
    f32x4 S[4];
    for (int gq = 0;; ++gq) {
    const int gi = bx + gq * G; if (gi >= GL_NGRP) break;
    f32x4 gng;
    {
        const float* so = (const float*)p.gst + (size_t)GL_NGRP * 64 * 128 + GL_NGRP * 64 + ((size_t)gi * 64) * 128 + 16 * w + l15;
#pragma unroll
        for (int dkt = 0; dkt < 4; ++dkt)
#pragma unroll
            for (int j = 0; j < 4; ++j) S[dkt][j] = so[(size_t)(16 * dkt + 4 * g + j) * 128];
        gng = *(const f32x4*)(p.gla_norm_g + ((gi >> 3) & 3) * 128 + 16 * w + 4 * g);
    }
#pragma unroll 1
    for (int c8 = 0; c8 < 8; ++c8) {
        const int k = gq * 8 + c8;
        const int it = gl_step_item(k, bx, G);
        const int h = it & 3; const size_t row0 = (size_t)(it >> 2) * 64;
        GZ_BAR();
        u32x2 grv[4];
#pragma unroll
        for (int tt = 0; tt < 4; ++tt) grv[tt] = grn[tt];
        GZ_STAGE((k + 1) & 1);
        { const int i1 = gl_step_item(k + 1, bx, G), i2 = gl_step_item(k + 2, bx, G); const int j1 = i1 >= 0 ? i1 : it, j2 = i2 >= 0 ? i2 : j1;
          GZ_LOAD(j2);
          const int h1 = j1 & 3; const size_t r1 = (size_t)(j1 >> 2) * 64;
#pragma unroll
          for (int tt = 0; tt < 4; ++tt) grn[tt] = *(const u32x2*)(p.proj + (r1 + 16 * tt + l15) * LD1 + 2304 + h1 * 128 + 16 * w + 4 * g); }
        const LAS unsigned char* B_ = lds + (k & 1) * GZ_BUF;
        bf16x8 kdA[4][2];
#pragma unroll
        for (int st = 0; st < 4; ++st)
#pragma unroll
            for (int ks = 0; ks < 2; ++ks) kdA[st][ks] = *(const LAS bf16x8*)(B_ + GZ_KD + ((16 * st + l15) * GL_QS + 32 * ks + 8 * g) * 2);
        bf16x8 vP[2], sA[2];
#pragma unroll
        for (int ks = 0; ks < 2; ++ks) {
            { const s16x4 lo = vtr(B_ + GZ_V + ((32 * ks + 4 * g + tq) * GL_VS + 16 * w + 4 * tp) * 2), hi4 = vtr(B_ + GZ_V + ((32 * ks + 16 + 4 * g + tq) * GL_VS + 16 * w + 4 * tp) * 2);
              vP[ks] = (bf16x8){lo[0], lo[1], lo[2], lo[3], hi4[0], hi4[1], hi4[2], hi4[3]}; }
            { u32x4 sp; sp.x = pk2(S[2 * ks][0], S[2 * ks][1]); sp.y = pk2(S[2 * ks][2], S[2 * ks][3]); sp.z = pk2(S[2 * ks + 1][0], S[2 * ks + 1][1]); sp.w = pk2(S[2 * ks + 1][2], S[2 * ks + 1][3]);
              sA[ks] = __builtin_bit_cast(bf16x8, sp); }
        }
        f32x4 otile[4];
        LAS float* PW = (LAS float*)(lds + GZ_PART) + (k & 1) * 512 + w * 64;
#pragma unroll
        for (int tt = 0; tt < 4; ++tt) {
            bf16x8 qdB[2], qdP[2];
#pragma unroll
            for (int ks = 0; ks < 2; ++ks) { qdB[ks] = *(const LAS bf16x8*)(B_ + GZ_QD + ((16 * tt + l15) * GL_QS + 32 * ks + 8 * g) * 2);
                const u32x2 q0 = *(const LAS u32x2*)(B_ + GZ_QD + ((16 * tt + l15) * GL_QS + 32 * ks + 4 * g) * 2), q1 = *(const LAS u32x2*)(B_ + GZ_QD + ((16 * tt + l15) * GL_QS + 32 * ks + 16 + 4 * g) * 2);
                u32x4 qq; qq.x = q0.x; qq.y = q0.y; qq.z = q1.x; qq.w = q1.y; qdP[ks] = __builtin_bit_cast(bf16x8, qq); }
            f32x4 at[4];
#pragma unroll
            for (int st = 0; st < 4; ++st) {
                at[st] = (f32x4){0.f, 0.f, 0.f, 0.f};
                if (st <= tt) { at[st] = __builtin_amdgcn_mfma_f32_16x16x32_bf16(kdA[st][0], qdB[0], at[st], 0, 0, 0); at[st] = __builtin_amdgcn_mfma_f32_16x16x32_bf16(kdA[st][1], qdB[1], at[st], 0, 0, 0); }
            }
#pragma unroll
            for (int j = 0; j < 4; ++j) if (4 * g + j > l15) at[tt][j] = 0.f;
            f32x4 ot = (f32x4){0.f, 0.f, 0.f, 0.f};
            ot = __builtin_amdgcn_mfma_f32_16x16x32_bf16(sA[0], qdP[0], ot, 0, 0, 0);
            ot = __builtin_amdgcn_mfma_f32_16x16x32_bf16(sA[1], qdP[1], ot, 0, 0, 0);
            { u32x4 ab; ab.x = pk2(at[0][0], at[0][1]); ab.y = pk2(at[0][2], at[0][3]); ab.z = pk2(at[1][0], at[1][1]); ab.w = pk2(at[1][2], at[1][3]);
              ot = __builtin_amdgcn_mfma_f32_16x16x32_bf16(vP[0], __builtin_bit_cast(bf16x8, ab), ot, 0, 0, 0); }
            if (tt >= 2) { u32x4 ab; ab.x = pk2(at[2][0], at[2][1]); ab.y = pk2(at[2][2], at[2][3]); ab.z = pk2(at[3][0], at[3][1]); ab.w = pk2(at[3][2], at[3][3]);
              ot = __builtin_amdgcn_mfma_f32_16x16x32_bf16(vP[1], __builtin_bit_cast(bf16x8, ab), ot, 0, 0, 0); }
            otile[tt] = ot;
            float ss = ot[0] * ot[0] + ot[1] * ot[1] + ot[2] * ot[2] + ot[3] * ot[3];
            ss += __shfl_xor(ss, 16); ss += __shfl_xor(ss, 32);
            PW[16 * tt + l15] = ss;
        }
        { bf16x8 vN[2];
#pragma unroll
          for (int ks = 0; ks < 2; ++ks) {
              const s16x4 lo = vtr(B_ + GZ_V + ((32 * ks + 8 * g + tq) * GL_VS + 16 * w + 4 * tp) * 2), hi4 = vtr(B_ + GZ_V + ((32 * ks + 8 * g + 4 + tq) * GL_VS + 16 * w + 4 * tp) * 2);
              vN[ks] = (bf16x8){lo[0], lo[1], lo[2], lo[3], hi4[0], hi4[1], hi4[2], hi4[3]};
          }
#pragma unroll
          for (int dkt = 0; dkt < 4; ++dkt) {
              const f32x4 dc = *(const LAS f32x4*)(B_ + GZ_DEC + (16 * dkt + 4 * g) * 4);
              f32x4 sc = S[dkt] * dc;
#pragma unroll
              for (int ks = 0; ks < 2; ++ks) {
                  const s16x4 lo = vtr(B_ + GZ_KE + ((32 * ks + 8 * g + tq) * GL_QS + 16 * dkt + 4 * tp) * 2), hi4 = vtr(B_ + GZ_KE + ((32 * ks + 8 * g + 4 + tq) * GL_QS + 16 * dkt + 4 * tp) * 2);
                  const bf16x8 keT = (bf16x8){lo[0], lo[1], lo[2], lo[3], hi4[0], hi4[1], hi4[2], hi4[3]};
                  sc = __builtin_amdgcn_mfma_f32_16x16x32_bf16(keT, vN[ks], sc, 0, 0, 0);
              }
              S[dkt] = sc;
          } }
        GZ_BAR();
        const LAS float* PT = (const LAS float*)(lds + GZ_PART) + (k & 1) * 512;
#pragma unroll
        for (int tt = 0; tt < 4; ++tt) {
            float ss = 0.f;
#pragma unroll
            for (int ww = 0; ww < 8; ++ww) ss += PT[ww * 64 + 16 * tt + l15];
            const float r = rsqrtf(ss * (1.f / 128.f) + EPS);
            const float g0 = __uint_as_float(grv[tt].x << 16), g1 = __uint_as_float(grv[tt].x & 0xffff0000u), g2 = __uint_as_float(grv[tt].y << 16), g3 = __uint_as_float(grv[tt].y & 0xffff0000u);
            u32x2 o2; o2.x = pk2(silu_f(g0) * (otile[tt][0] * r * gng[0]), silu_f(g1) * (otile[tt][1] * r * gng[1]));
            o2.y = pk2(silu_f(g2) * (otile[tt][2] * r * gng[2]), silu_f(g3) * (otile[tt][3] * r * gng[3]));
            *(u32x2*)(p.mix + (row0 + 16 * tt + l15) * D + 512 + h * 128 + 16 * w + 4 * g) = o2;
        }
    }
    }
    GZ_BAR();
#undef GZ_LOAD
#undef GZ_STAGE
#undef GZ_BAR
}
constexpr int SG_WS = 136, SG_VS = 144, SG_OS = 132;
constexpr int SG_W = 0, SG_V = 128 * SG_WS * 2, SG_O = SG_V + 128 * SG_VS * 2, SG_END = SG_O + 128 * SG_OS * 4;
static_assert(SG_END <= LDS_WTAB, "gMLP LDS map");
DI void ph_sg(const P& p, LAS unsigned char* lds) {
    const int tid = tid_();
    const int G = gridDim.x, bx = blockIdx.x;
    const int nG = 0;
#define MIXREP_SG 1
    const int lane = tid & 63, w = __builtin_amdgcn_readfirstlane(tid >> 6), l15 = lane & 15, gq = lane >> 4, tq = l15 >> 2, tp = l15 & 3;
    int cur_g = -1;
    u32x4 rawv[4], uu[4]; float rvs[4];
    f32x4 gaR = (f32x4){0.f, 0.f, 0.f, 0.f}, gbR = gaR; float bsR[4] = {0.f, 0.f, 0.f, 0.f};
#define SG_LOADV(u_) do { const int g_ = (u_) >> 9; const size_t r0_ = (size_t)((u_) & 511) * 128; \
        _Pragma("unroll") for (int it = 0; it < 4; ++it) { const int c = it * 512 + tid, s_ = c >> 4, ch = c & 15; rawv[it] = *(const u32x4*)(p.proj + (r0_ + s_) * LD1 + 512 + g_ * 128 + ch * 8); rvs[it] = p.rv[r0_ + s_]; } } while (0)
#define SG_RAWBAR() do { asm volatile("s_waitcnt lgkmcnt(0)" ::: "memory"); __builtin_amdgcn_s_barrier(); asm volatile("" ::: "memory"); } while (0)
    const int u0 = bx - nG, ustep = G - nG;
    for (int rep = 0; rep < MIXREP_SG; ++rep) {
    if (u0 < 2048) SG_LOADV(u0);
    for (int u = u0; u < 2048; u += ustep) {
        const int g = u >> 9, bn = u & 511; const size_t r0 = (size_t)bn * 128;
        if (g != cur_g) {
            cur_g = g;
            gaR = *(const f32x4*)(p.sg_v_norm_g + g * 128 + (tid & 15) * 8); gbR = *(const f32x4*)(p.sg_v_norm_g + g * 128 + (tid & 15) * 8 + 4);
#pragma unroll
            for (int it = 0; it < 4; ++it) bsR[it] = p.sg_b_s[g * 128 + it * 32 + (tid >> 4)];
#pragma unroll
            for (int it = 0; it < 4; ++it) { const int c = it * 512 + tid, t = c >> 4, ch = c & 15; const float* src = p.sg_w_s + ((size_t)g * 128 + t) * 128 + ch * 8;
                const f32x4 a = *(const f32x4*)src, b = *(const f32x4*)(src + 4); float v[8] = {a[0], a[1], a[2], a[3], b[0], b[1], b[2], b[3]};
#pragma unroll
                for (int e = 0; e < 8; ++e) if (ch * 8 + e > t) v[e] = 0.f;
                u32x4 wv; wv.x = pk2(v[0], v[1]); wv.y = pk2(v[2], v[3]); wv.z = pk2(v[4], v[5]); wv.w = pk2(v[6], v[7]);
                *(LAS u32x4*)(lds + SG_W + (t * SG_WS + ch * 8) * 2) = wv; }
        }
#pragma unroll
        for (int it = 0; it < 4; ++it) { const int c = it * 512 + tid, s_ = c >> 4, ch = c & 15; const u32x4 raw = rawv[it]; const float rv = rvs[it];
            u32x4 wv; wv.x = pk2(__uint_as_float(raw.x << 16) * rv, __uint_as_float(raw.x & 0xffff0000u) * rv); wv.y = pk2(__uint_as_float(raw.y << 16) * rv, __uint_as_float(raw.y & 0xffff0000u) * rv);
            wv.z = pk2(__uint_as_float(raw.z << 16) * rv, __uint_as_float(raw.z & 0xffff0000u) * rv); wv.w = pk2(__uint_as_float(raw.w << 16) * rv, __uint_as_float(raw.w & 0xffff0000u) * rv);
            *(LAS u32x4*)(lds + SG_V + (s_ * SG_VS + ch * 8) * 2) = wv; }
        SG_RAWBAR();
#pragma unroll
        for (int it = 0; it < 4; ++it) { const int c = it * 512 + tid; uu[it] = *(const u32x4*)(p.proj + (r0 + (c >> 4)) * LD1 + g * 128 + (c & 15) * 8); }
        { const int un = u + ustep < 2048 ? u + ustep : u; SG_LOADV(un); }
        bf16x8 vA[4];
#pragma unroll
        for (int ks = 0; ks < 4; ++ks) {
            const s16x4 lo = vtr(lds + SG_V + ((32 * ks + 8 * gq + tq) * SG_VS + 16 * w + 4 * tp) * 2), hi4 = vtr(lds + SG_V + ((32 * ks + 8 * gq + 4 + tq) * SG_VS + 16 * w + 4 * tp) * 2);
            vA[ks] = (bf16x8){lo[0], lo[1], lo[2], lo[3], hi4[0], hi4[1], hi4[2], hi4[3]};
        }
#pragma unroll
        for (int tt = 0; tt < 8; ++tt) {
            f32x4 acc = (f32x4){0.f, 0.f, 0.f, 0.f};
#pragma unroll
            for (int ks = 0; ks <= tt / 2; ++ks) {
                const bf16x8 wB = *(const LAS bf16x8*)(lds + SG_W + ((16 * tt + l15) * SG_WS + 32 * ks + 8 * gq) * 2);
                acc = __builtin_amdgcn_mfma_f32_16x16x32_bf16(vA[ks], wB, acc, 0, 0, 0);
            }
            *(LAS f32x4*)(lds + SG_O + ((16 * tt + l15) * SG_OS + 16 * w + 4 * gq) * 4) = acc;
        }
        SG_RAWBAR();
#pragma unroll
        for (int it = 0; it < 4; ++it) { const int c = it * 512 + tid, t = c >> 4, ch = c & 15;
            const f32x4 a = *(const LAS f32x4*)(lds + SG_O + (t * SG_OS + ch * 8) * 4), b = *(const LAS f32x4*)(lds + SG_O + (t * SG_OS + ch * 8 + 4) * 4);
            const f32x4 ga = gaR, gb = gbR;
            const float bs = bsR[it];
            const u32x4 ux = uu[it];
            u32x4 o;
            o.x = pk2(__uint_as_float(ux.x << 16) * (a[0] * ga[0] + bs), __uint_as_float(ux.x & 0xffff0000u) * (a[1] * ga[1] + bs));
            o.y = pk2(__uint_as_float(ux.y << 16) * (a[2] * ga[2] + bs), __uint_as_float(ux.y & 0xffff0000u) * (a[3] * ga[3] + bs));
            o.z = pk2(__uint_as_float(ux.z << 16) * (b[0] * gb[0] + bs), __uint_as_float(ux.z & 0xffff0000u) * (b[1] * gb[1] + bs));
            o.w = pk2(__uint_as_float(ux.w << 16) * (b[2] * gb[2] + bs), __uint_as_float(ux.w & 0xffff0000u) * (b[3] * gb[3] + bs));
            *(u32x4*)(p.mix + (r0 + t) * D + g * 128 + ch * 8) = o; }
    }
    SG_RAWBAR();
    }
#undef SG_LOADV
#undef SG_RAWBAR
    __syncthreads();
}

enum { PH_PREP = 0, PH_NORM0, PH_IN0, PH_STAT0, PH_UP0, PH_ATTN, PH_OUT0,
       PH_MOE0  , PH_IN1 = PH_MOE0 + 6, PH_STAT1, PH_SCAN, PH_MIX1, PH_OUT1, PH_MOE1, PH_END = PH_MOE1 + 6 };

typedef __attribute__((address_space(4))) const P* KP;
#if defined(__HIP_DEVICE_COMPILE__)
#define LOADP() ({ KP k_ = kp; asm volatile("" : "+s"(k_)); *k_; })
#else
#define LOADP() (P{})
#endif
__global__ void __launch_bounds__(NTHR, 2) mega(P p_unused, int lo, int hi) {
    (void)p_unused;
    const KP kp = (KP)__builtin_amdgcn_kernarg_segment_ptr();
    extern __shared__ __attribute__((aligned(16))) unsigned char lds_raw[];
    LAS unsigned char* lds = (LAS unsigned char*)lds_raw;
    volatile LAS unsigned* misc = (volatile LAS unsigned*)(lds + LDS_MISC);
    { const int t0 = threadIdx.x; if (t0 < 64) misc[t0] = 0u; if ((t0 & 63) == 0) *(LAS int*)(size_t)(LDS_WTAB + 4 * hw_slot_()) = t0 >> 6; }
    __syncthreads();
    XcdBarrier bar; { const P p = LOADP(); bar.bar = p.bar; } bar.x = 0; bar.st = misc + 8;
    if (hi - lo > 1) bar = xcd_barrier_post(bar.bar, misc + 8);
#define IN(k) (lo <= (k) && (k) < hi)
#define SEAM(k) do { if (IN(k) && IN((k) + 1)) xcd_barrier(bar); } while (0)
    const int G = gridDim.x, bx = blockIdx.x;
#ifndef XPROBE
#define XPROBE 0
#endif
#ifndef STAGGER
#define STAGGER 0
#endif
#ifndef DUPMASK
#define DUPMASK 0u
#endif
#define PHASE(k, ...) do { if (IN(k)) { __VA_ARGS__ } if (((DUPMASK >> (k)) & 1u) && IN(k)) { xcd_barrier(bar); __VA_ARGS__ } SEAM(k); } while (0)
    PHASE(PH_PREP, const P p = LOADP(); ph_prep(p, lds););
    PHASE(PH_NORM0, const P p = LOADP(); ph_norm<true>(p, p.x, p.norm_mix_g, 0, 0););
    PHASE(PH_IN0,
        const P p = LOADP();
        g8::Order S; S.init(NTOK / 256, LD0 / 256, G, bx);
        SrcDense X{(unsigned)(D * 2), (const char*)p.wt_in0, (size_t)256 * 1024 * 2};
        g8::Epi<FIn0> E{{p}};
        g8::gemm8(lds, (const char*)p.xa, 1024, S, X, E););
    PHASE(PH_STAT0, const P p = LOADP(); ph_rowstat0_conv(p););
    PHASE(PH_UP0,
        const P p = LOADP();
        { g8::Order S; S.init(NTOK / 256, 3, G, bx);
          SrcDense X{(unsigned)(LD0 * 2), (const char*)p.wt_uq, (size_t)256 * 256 * 2};
          g8::Epi<FUq> E{{p}};
          g8::gemm8(lds, (const char*)p.proj, 256, S, X, E); }
        { g8::Order S; S.init(NTOK / 256, 4, G, bx);
          SrcDense X{(unsigned)(LD0 * 2), (const char*)p.wt_ukv, (size_t)256 * 128 * 2};
          g8::Epi<FUkv> E{{p}};
          g8::gemm8(lds, (const char*)(p.proj + 256), 128, S, X, E); });
    PHASE(PH_ATTN, const P p = LOADP(); ph_attn(p, lds););
    PHASE(PH_OUT0,
        const P p = LOADP();
        g8::Order S; S.init(NTOK / 256, 4, G, bx);
        SrcDense X{(unsigned)(D * 2), (const char*)p.wt_out0, (size_t)256 * 1024 * 2};
        g8::Epi<FOut> E{{p, 0}};
        g8::gemm8(lds, (const char*)p.mix, 1024, S, X, E, STAGGER);
        if (XPROBE == 3) { xcd_barrier(bar); g8::Epi<FNull> E2{{}}; g8::gemm8(lds, (const char*)p.mix, 1024, S, X, E2); });
#define MOE_PHASES(l, base) do { \
        PHASE((base) + 0, const P p = LOADP(); ph_norm<false>(p, p.xr, p.norm_ffn_g + (l) * D, (l), 1);); \
        PHASE((base) + 1, const P p = LOADP(); ph_router(p, (l), lds);); \
        PHASE((base) + 2, const P p = LOADP(); ph_slots(p, (l), lds);); \
        PHASE((base) + 3, \
            const P p = LOADP(); \
            g8::Order S; S.init(p.ntile[(l)], 4, G, bx, 1); \
            SrcGu X{(unsigned)(D * 2), p.row_tok + (size_t)(l) * MAXSLOT, p.tile_e + (l) * 1024, (const char*)(p.wt_gu + (size_t)(l) * 32 * 512 * 1024)}; \
            g8::Epi<FGu> E{{p, p.row_w + 2 * (size_t)(l) * MAXSLOT}}; \
            g8::gemm8(lds, (const char*)p.xa, 1024, S, X, E);); \
        PHASE((base) + 4, \
            const P p = LOADP(); \
            g8::Order S; S.init(p.ntile[(l)], 4, G, bx, 1); \
            SrcDn X{(unsigned)(512 * 2), p.tile_e + (l) * 1024, (const char*)(p.wt_dn + (size_t)(l) * 32 * 1024 * 256)}; \
            g8::Epi<FDn> E{{p, p.row_tok + (size_t)(l) * MAXSLOT, (l)}}; \
            g8::gemm8(lds, (const char*)p.act, 512, S, X, E);); \
        PHASE((base) + 5, const P p = LOADP(); ph_postnorm(p, (l), (l) == 1);); \
    } while (0)
    MOE_PHASES(0, PH_MOE0);
    PHASE(PH_IN1,
        const P p = LOADP();
        g8::Order S; S.init(NTOK / 256, LD1 / 256, G, bx);
        SrcDense X{(unsigned)(D * 2), (const char*)p.wt_in1, (size_t)256 * 1024 * 2};
        g8::Epi<FIn1> E{{p}};
        g8::gemm8(lds, (const char*)p.xa, 1024, S, X, E););
    PHASE(PH_STAT1, const P p = LOADP(); ph_stat1x(p, lds););
    PHASE(PH_SCAN, const P p = LOADP(); ph_gla_prefix(p); ph_sg(p, lds););
    PHASE(PH_MIX1, const P p = LOADP(); ph_gla_out(p, lds, tid_()););
    PHASE(PH_OUT1,
        const P p = LOADP();
        g8::Order S; S.init(NTOK / 256, 4, G, bx);
        SrcDense X{(unsigned)(D * 2), (const char*)p.wt_out1, (size_t)256 * 1024 * 2};
        g8::Epi<FOut> E{{p, 1}};
        g8::gemm8(lds, (const char*)p.mix, 1024, S, X, E, STAGGER););
    MOE_PHASES(1, PH_MOE1);
#undef MOE_PHASES
#undef PHASE
#undef IN
#undef SEAM
}

static size_t carve(size_t& off, size_t bytes) { const size_t o = off; off += (bytes + 255) & ~(size_t)255; return o; }

extern "C" void kernel_launch(void* const* d_in, const int* in_sizes, int n_in, void* d_out, int out_size, void* d_ws, size_t ws_size, hipStream_t stream) {
    (void)in_sizes; (void)n_in; (void)out_size;
    P p{};
    const float* const* fi = (const float* const*)d_in;
    p.x = fi[0]; p.c = fi[1]; p.pos = (const int*)d_in[2];
    p.adaln_w = fi[3]; p.adaln_b = fi[4]; p.norm_mix_g = fi[5]; p.norm_ffn_g = fi[6]; p.ab_w_in = fi[7]; p.q_norm_g = fi[8]; p.w_uq = fi[9];
    p.kv_norm_g = fi[10]; p.w_ukv = fi[11]; p.conv_w = fi[12]; p.ab_w_out = fi[13]; p.cd_w_in = fi[14]; p.sg_v_norm_g = fi[15]; p.sg_w_s = fi[16];
    p.sg_b_s = fi[17]; p.gla_w_g2 = fi[18]; p.gla_b_g = fi[19]; p.gla_norm_g = fi[20]; p.cd_w_out = fi[21]; p.moe_w_group = fi[22]; p.moe_b_group = fi[23];
    p.moe_w_expert = fi[24]; p.moe_b_expert = fi[25]; p.moe_w_gate_up = fi[26]; p.moe_w_down = fi[27]; p.final_norm_g = fi[28];
    p.out = (float*)d_out;
    char* ws = (char*)d_ws; size_t off = 0;
    const size_t ctl0 = off;
    p.bar = (unsigned*)(ws + carve(off, (size_t)XCD_BAR_WORDS * 4));
    p.row_tok = (int*)(ws + carve(off, (size_t)2 * MAXSLOT * 4));
    p.row_w = (float*)(ws + carve(off, (size_t)2 * MAXSLOT * 2 * 4));
    const size_t ctl_bytes = off - ctl0;
    p.whist = (int*)(ws + carve(off, (size_t)2 * 256 * 128 * 4));
    p.ntile = (int*)(ws + carve(off, 256));
    p.tile_e = (int*)(ws + carve(off, 2 * 1024 * 4));
    p.tope = (int*)(ws + carve(off, (size_t)4 * NTOK * 4));
    p.toppos = (int*)(ws + carve(off, (size_t)4 * NTOK * 4));
    p.topslot = (int*)(ws + carve(off, (size_t)4 * NTOK * 4));
    p.topw = (float*)(ws + carve(off, (size_t)4 * NTOK * 4));
    p.mod = (float*)(ws + carve(off, (size_t)2 * 16 * 6144 * 4));
    p.ropec = (float*)(ws + carve(off, (size_t)NTOK * 16 * 4));
    p.ropes = (float*)(ws + carve(off, (size_t)NTOK * 16 * 4));
    p.rq = (float*)(ws + carve(off, (size_t)NTOK * 4));
    p.rkv = (float*)(ws + carve(off, (size_t)NTOK * 4));
    p.rv = (float*)(ws + carve(off, (size_t)NTOK * 4));
    p.rvp = (float*)(ws + carve(off, (size_t)NTOK * 16 * 4));
    p.rsp = (float*)(ws + carve(off, (size_t)NTOK * 16 * 4));
    p.wt_in0 = (bf16_t*)(ws + carve(off, WO_END * 2));
    p.wt_uq = p.wt_in0 + WO_UQ; p.wt_ukv = p.wt_in0 + WO_UKV; p.wt_out0 = p.wt_in0 + WO_OUT0; p.wt_in1 = p.wt_in0 + WO_IN1; p.wt_out1 = p.wt_in0 + WO_OUT1;
    p.wt_gu = p.wt_in0 + WO_GU; p.wt_dn = p.wt_in0 + WO_DN; p.wt_r = p.wt_in0 + WO_R;
    p.xa = (bf16_t*)(ws + carve(off, (size_t)NTOK * D * 2));
    p.mix = (bf16_t*)(ws + carve(off, (size_t)NTOK * D * 2));
    p.xr = (bf16_t*)(ws + carve(off, (size_t)NTOK * D * 2));
    const size_t r0 = off;
    p.proj = (bf16_t*)(ws + carve(off, (size_t)NTOK * LD1 * 2));
    size_t o2 = r0 + (((size_t)NTOK * LD0 * 2 + 255) & ~(size_t)255);
    p.q = (bf16_t*)(ws + carve(o2, (size_t)NTOK * 768 * 2));
    p.kn = (bf16_t*)(ws + carve(o2, (size_t)NTOK * 512 * 2));
    p.v = (bf16_t*)(ws + carve(o2, (size_t)NTOK * 512 * 2));
    p.kpe = (bf16_t*)(ws + carve(o2, (size_t)NTOK * 32 * 2));
    size_t o3 = off;
    p.loga = (bf16_t*)(ws + carve(o3, (size_t)NTOK * 256 * 2));
    p.gqd = (bf16_t*)(ws + carve(o3, (size_t)NTOK * 256 * 2));
    p.gkd = (bf16_t*)(ws + carve(o3, (size_t)NTOK * 256 * 2));
    p.gkv = p.xa;
    p.gst = p.xa + (size_t)(NTOK / 64) * 4 * 64 * 128;
    p.gdec = (float*)(ws + carve(o3, (size_t)(NTOK / 64) * 256 * 4));
    size_t o4 = r0;
    p.act = (bf16_t*)(ws + carve(o4, (size_t)MAXSLOT * 512 * 2));
    p.y = (bf16_t*)(ws + carve(o4, (size_t)MAXSLOT * D * 2));
    if (off > ws_size || o2 > ws_size || o3 > ws_size || o4 > ws_size) return;

    static int grid = 0;
    if (grid == 0) {
        int dev = 0, cus = 0;
        if (hipGetDevice(&dev) != hipSuccess || hipDeviceGetAttribute(&cus, hipDeviceAttributeMultiprocessorCount, dev) != hipSuccess) { grid = -1; return; }
        if (hipFuncSetAttribute((const void*)mega, hipFuncAttributeMaxDynamicSharedMemorySize, LDS_BYTES) != hipSuccess) { grid = -1; return; }
        grid = cus < 256 ? cus : 256;
    }
    if (grid < 0) return;
    (void)hipMemsetAsync(ws + ctl0, 0, ctl_bytes, stream);
#define RUN(a, b) hipLaunchKernelGGL(mega, dim3(grid), dim3(NTHR), LDS_BYTES, stream, p, (a), (b))
    RUN(PH_PREP, PH_END);
#undef RUN
}
```
